# Optimizing an MI355X kernel written in HIP

```python
import jax, jax.numpy as jnp
from jax import lax
import numpy as np

D_MODEL = 1024
BATCH = 4
SEQ = 8192
DEPTH = 2

N_EVEN = (DEPTH + 1) // 2
N_ODD = DEPTH // 2
BLOCK = 128
NORM_EPS = 1e-6
ADA_CHUNKS = 6

A_HEADS = 8
A_KV_HEADS = 2
A_GROUP = A_HEADS // A_KV_HEADS
A_HEAD_DIM = 64
A_WINDOW = 128
A_Q = A_HEADS * A_HEAD_DIM
A_KV = A_KV_HEADS * A_HEAD_DIM

B_GROUPS = 8
B_GROUP_DIM = 64
B_WIDTH = B_GROUPS * B_GROUP_DIM
B_CHUNK = 128

C_GROUPS = 8
C_GROUP_DIM = 64
C_WIDTH = C_GROUPS * C_GROUP_DIM
C_CONV = 3

D_HEADS = 8
D_NOPE = 64
D_ROPE = 32
D_VDIM = 64
D_Q_RANK = 512
D_KV_RANK = 256
ROPE_THETA = 10000.0

EVEN_IN = A_Q + 2 * A_KV + 2 * B_WIDTH
EVEN_MIX = A_Q + B_WIDTH
ODD_IN = 3 * C_WIDTH + D_Q_RANK + D_KV_RANK + D_ROPE
ODD_MIX = C_WIDTH + D_HEADS * D_VDIM

FF_DENSE = 2816
N_EXPERTS = 8
TOP_K = 2
FF_EXPERT = 3584
MOE_BLOCK = 512

kernel_name = 'hybrid_swa_gmlp_conv_mla_moe_block'


def rmsnorm(x, g):
    xf = x.astype(jnp.float32)
    r = lax.rsqrt(jnp.mean(xf * xf, axis=-1, keepdims=True) + NORM_EPS)
    return (xf * r).astype(x.dtype) * g


def modulate(x, g, shift, scale):
    return rmsnorm(x, g) * (1.0 + scale[:, None, :]) + shift[:, None, :]


def alibi_slopes(n):
    return 2.0 ** (-8.0 * jnp.arange(1, n + 1, dtype=jnp.float32) / n)


def swa_sink_attention(q, k, v, sinks):
    Bn, S = q.shape[0], q.shape[1]
    nb = S // BLOCK
    qb = q.reshape(Bn, nb, BLOCK, A_KV_HEADS, A_GROUP, A_HEAD_DIM)
    kb = k.reshape(Bn, nb, BLOCK, A_KV_HEADS, A_HEAD_DIM)
    vb = v.reshape(Bn, nb, BLOCK, A_KV_HEADS, A_HEAD_DIM)
    kband = jnp.concatenate([jnp.concatenate([jnp.zeros_like(kb[:, :1]), kb[:, :-1]], axis=1), kb], axis=2)
    vband = jnp.concatenate([jnp.concatenate([jnp.zeros_like(vb[:, :1]), vb[:, :-1]], axis=1), vb], axis=2)
    scores = jnp.einsum('bnqhgd,bnshd->bnhgqs', qb, kband).astype(jnp.float32) * (A_HEAD_DIM ** -0.5)
    qi = jnp.arange(BLOCK)[:, None]
    kj = jnp.arange(2 * BLOCK)[None, :]
    dist = qi + BLOCK - kj
    valid = (dist >= 0) & (dist < A_WINDOW)
    valid = valid[None] & ((jnp.arange(nb)[:, None, None] > 0) | (kj[None] >= BLOCK))
    slopes = alibi_slopes(A_HEADS).reshape(A_KV_HEADS, A_GROUP)
    scores = scores - slopes[:, :, None, None] * dist.astype(jnp.float32)
    scores = jnp.where(valid[None, :, None, None], scores, -jnp.inf)
    sink = sinks.astype(jnp.float32).reshape(A_KV_HEADS, A_GROUP)[None, None, :, :, None, None]
    m = jnp.maximum(jnp.max(scores, axis=-1, keepdims=True), sink)
    p = jnp.exp(scores - m)
    p = p / (jnp.sum(p, axis=-1, keepdims=True) + jnp.exp(sink - m))
    out = jnp.einsum('bnhgqs,bnshd->bnqhgd', p.astype(v.dtype), vband)
    return out.reshape(Bn, S, A_Q)


def chunk_spatial_gate(u, v, ln_g, ln_b, w_s, b_s):
    Bn, S, _ = v.shape
    vf = v.astype(jnp.float32)
    mu = jnp.mean(vf, axis=-1, keepdims=True)
    var = jnp.mean((vf - mu) ** 2, axis=-1, keepdims=True)
    vn = ((vf - mu) * lax.rsqrt(var + NORM_EPS)).astype(v.dtype) * ln_g + ln_b
    nc = S // B_CHUNK
    vc = vn.reshape(Bn, nc, B_CHUNK, B_GROUPS, B_GROUP_DIM)
    causal = jnp.tril(jnp.ones((B_CHUNK, B_CHUNK), dtype=bool))
    w = jnp.where(causal[None], w_s, 0.0).astype(v.dtype)
    s = jnp.einsum('gts,bnsgc->bntgc', w, vc) + b_s.T[None, None, :, :, None]
    return u * s.reshape(Bn, S, B_WIDTH)


def short_conv_mixer(gate_b, gate_c, xin, conv_w):
    S = xin.shape[1]
    z = gate_c * xin
    zp = jnp.pad(z, ((0, 0), (C_CONV - 1, 0), (0, 0)))
    y = sum(conv_w[j] * zp[:, j:j + S] for j in range(C_CONV))
    return gate_b * y


def apply_rope(x, cos, sin):
    half = x.shape[-1] // 2
    x1, x2 = x[..., :half], x[..., half:]
    cos = cos.astype(x.dtype)
    sin = sin.astype(x.dtype)
    return jnp.concatenate([x1 * cos - x2 * sin, x1 * sin + x2 * cos], axis=-1)


def mla_attention(q_lat, kv_lat, k_rope, q_norm_g, w_q_b, kv_norm_g, w_kv_b):
    Bn, S, _ = q_lat.shape
    q = (rmsnorm(q_lat, q_norm_g) @ w_q_b).reshape(Bn, S, D_HEADS, D_NOPE + D_ROPE)
    kv = (rmsnorm(kv_lat, kv_norm_g) @ w_kv_b).reshape(Bn, S, D_HEADS, D_NOPE + D_VDIM)
    q_nope, q_pe = q[..., :D_NOPE], q[..., D_NOPE:]
    k_nope, v = kv[..., :D_NOPE], kv[..., D_NOPE:]
    inv = ROPE_THETA ** (-jnp.arange(0, D_ROPE, 2, dtype=jnp.float32) / D_ROPE)
    ang = jnp.arange(S, dtype=jnp.float32)[:, None] * inv[None, :]
    cos, sin = jnp.cos(ang), jnp.sin(ang)
    q_pe = apply_rope(q_pe, cos[:, None, :], sin[:, None, :])
    k_pe = apply_rope(k_rope, cos, sin)
    scale = (D_NOPE + D_ROPE) ** -0.5
    nb = S // BLOCK
    qn_b = q_nope.reshape(Bn, nb, BLOCK, D_HEADS, D_NOPE).transpose(1, 0, 2, 3, 4)
    qp_b = q_pe.reshape(Bn, nb, BLOCK, D_HEADS, D_ROPE).transpose(1, 0, 2, 3, 4)
    kpos = jnp.arange(S)

    def one_block(args):
        qn, qp, blk = args
        s = (jnp.einsum('bqhd,bshd->bhqs', qn, k_nope)
             + jnp.einsum('bqhr,bsr->bhqs', qp, k_pe)).astype(jnp.float32) * scale
        qpos = blk * BLOCK + jnp.arange(BLOCK)
        s = jnp.where(kpos[None, :] <= qpos[:, None], s, -jnp.inf)
        p = jax.nn.softmax(s, axis=-1).astype(v.dtype)
        return jnp.einsum('bhqs,bshd->bqhd', p, v)

    out = lax.map(one_block, (qn_b, qp_b, jnp.arange(nb)))
    return out.transpose(1, 0, 2, 3, 4).reshape(Bn, S, D_HEADS * D_VDIM)


def even_mixer(h, w_in, sinks, ln_g, ln_b, w_s, b_s, w_o):
    Bn, S, _ = h.shape
    proj = h @ w_in
    q, k, v, u, g = jnp.split(proj, [A_Q, A_Q + A_KV, A_Q + 2 * A_KV, A_Q + 2 * A_KV + B_WIDTH], axis=-1)
    a_out = swa_sink_attention(q.reshape(Bn, S, A_HEADS, A_HEAD_DIM),
                               k.reshape(Bn, S, A_KV_HEADS, A_HEAD_DIM),
                               v.reshape(Bn, S, A_KV_HEADS, A_HEAD_DIM), sinks)
    b_out = chunk_spatial_gate(jax.nn.gelu(u, approximate=False), jax.nn.gelu(g, approximate=False),
                               ln_g, ln_b, w_s, b_s)
    return jnp.concatenate([a_out, b_out], axis=-1) @ w_o


def odd_mixer(h, w_in, conv_w, q_norm_g, w_q_b, kv_norm_g, w_kv_b, w_o):
    proj = h @ w_in
    o1 = 3 * C_WIDTH
    gb, gc, xc, q_lat, kv_lat, k_rope = jnp.split(
        proj, [C_WIDTH, 2 * C_WIDTH, o1, o1 + D_Q_RANK, o1 + D_Q_RANK + D_KV_RANK], axis=-1)
    c_out = short_conv_mixer(gb, gc, xc, conv_w)
    d_out = mla_attention(q_lat, kv_lat, k_rope, q_norm_g, w_q_b, kv_norm_g, w_kv_b)
    return jnp.concatenate([c_out, d_out], axis=-1) @ w_o


def swiglu(h, w_gate, w_up, w_down):
    return (jax.nn.silu(h @ w_gate) * (h @ w_up)) @ w_down


def moe_swiglu(h, w_router, b_router, w_gate, w_up, w_down):
    Bn, S, Dm = h.shape
    xt = h.reshape(-1, Dm)
    N = xt.shape[0]
    NA = N * TOP_K
    logits = (xt @ w_router).astype(jnp.float32) + b_router.astype(jnp.float32)
    top_logit, top_e = lax.top_k(logits, TOP_K)
    gates = jax.nn.softmax(top_logit, axis=-1).astype(h.dtype)
    flat_e = top_e.reshape(-1).astype(jnp.int32)
    order = jnp.argsort(flat_e, stable=True)
    sorted_e = flat_e[order]
    counts = jnp.bincount(flat_e, length=N_EXPERTS).astype(jnp.int32)
    padded = (counts + MOE_BLOCK - 1) // MOE_BLOCK * MOE_BLOCK
    pad_end = jnp.cumsum(padded)
    pad_start = pad_end - padded
    grp_start = jnp.cumsum(counts) - counts
    dest_sorted = pad_start[sorted_e] + jnp.arange(NA, dtype=jnp.int32) - grp_start[sorted_e]
    dest = jnp.zeros((NA,), jnp.int32).at[order].set(dest_sorted)
    n_blk = -(-NA // MOE_BLOCK) + N_EXPERTS
    L = n_blk * MOE_BLOCK
    tok = jnp.arange(NA, dtype=jnp.int32) // TOP_K
    slot_tok = jnp.zeros((L,), jnp.int32).at[dest].set(tok)
    xs = xt[slot_tok].reshape(n_blk, MOE_BLOCK, Dm)
    blk_e = jnp.minimum(jnp.searchsorted(pad_end, jnp.arange(n_blk, dtype=jnp.int32) * MOE_BLOCK, side='right'),
                        N_EXPERTS - 1)

    def expert_block(args):
        xb, e = args
        return (jax.nn.silu(xb @ w_gate[e]) * (xb @ w_up[e])) @ w_down[e]

    ys = lax.map(expert_block, (xs, blk_e)).reshape(L, Dm)
    y = ys[dest].reshape(N, TOP_K, Dm)
    out = jnp.einsum('nk,nkd->nd', gates, y)
    return out.reshape(Bn, S, Dm)


def setup_inputs(seed: int = 0) -> dict:
    key = jax.random.key(seed)
    ks = iter(jax.random.split(key, 40))
    D = D_MODEL
    E_, O_ = N_EVEN, N_ODD

    def nrm(shape, scale):
        return jax.random.normal(next(ks), shape, jnp.float32) * scale

    def gain(shape):
        return 1.0 + nrm(shape, 0.02)

    return {
        'x': nrm((BATCH, SEQ, D), 1.0),
        'c': nrm((BATCH, D), 1.0),
        'even_ada_w': nrm((E_, D, ADA_CHUNKS * D), 0.5 * D ** -0.5),
        'even_ada_b': nrm((E_, ADA_CHUNKS * D), 0.01),
        'even_norm_mix_g': gain((E_, D)),
        'even_w_in': nrm((E_, D, EVEN_IN), D ** -0.5),
        'even_sinks': nrm((E_, A_HEADS), 0.5),
        'even_gmlp_ln_g': gain((E_, B_WIDTH)),
        'even_gmlp_ln_b': nrm((E_, B_WIDTH), 0.02),
        'even_w_s': nrm((E_, B_GROUPS, B_CHUNK, B_CHUNK), B_CHUNK ** -0.5),
        'even_b_s': 1.0 + nrm((E_, B_GROUPS, B_CHUNK), 0.1),
        'even_w_o': nrm((E_, EVEN_MIX, D), EVEN_MIX ** -0.5),
        'even_norm_ffn_g': gain((E_, D)),
        'even_ffn_w_gate': nrm((E_, D, FF_DENSE), D ** -0.5),
        'even_ffn_w_up': nrm((E_, D, FF_DENSE), D ** -0.5),
        'even_ffn_w_down': nrm((E_, FF_DENSE, D), FF_DENSE ** -0.5),
        'odd_ada_w': nrm((O_, D, ADA_CHUNKS * D), 0.5 * D ** -0.5),
        'odd_ada_b': nrm((O_, ADA_CHUNKS * D), 0.01),
        'odd_norm_mix_g': gain((O_, D)),
        'odd_w_in': nrm((O_, D, ODD_IN), D ** -0.5),
        'odd_conv_w': nrm((O_, C_CONV, C_WIDTH), C_CONV ** -0.5),
        'odd_q_norm_g': gain((O_, D_Q_RANK)),
        'odd_w_q_b': nrm((O_, D_Q_RANK, D_HEADS * (D_NOPE + D_ROPE)), D_Q_RANK ** -0.5),
        'odd_kv_norm_g': gain((O_, D_KV_RANK)),
        'odd_w_kv_b': nrm((O_, D_KV_RANK, D_HEADS * (D_NOPE + D_VDIM)), D_KV_RANK ** -0.5),
        'odd_w_o': nrm((O_, ODD_MIX, D), ODD_MIX ** -0.5),
        'odd_norm_ffn_g': gain((O_, D)),
        'odd_router_w': nrm((O_, D, N_EXPERTS), D ** -0.5),
        'odd_router_b': nrm((O_, N_EXPERTS), 0.01),
        'odd_exp_w_gate': nrm((O_, N_EXPERTS, D, FF_EXPERT), D ** -0.5),
        'odd_exp_w_up': nrm((O_, N_EXPERTS, D, FF_EXPERT), D ** -0.5),
        'odd_exp_w_down': nrm((O_, N_EXPERTS, FF_EXPERT, D), FF_EXPERT ** -0.5),
        'final_norm_g': gain((D,)),
    }


def reference(x, c, even_ada_w, even_ada_b, even_norm_mix_g, even_w_in, even_sinks, even_gmlp_ln_g,
              even_gmlp_ln_b, even_w_s, even_b_s, even_w_o, even_norm_ffn_g, even_ffn_w_gate, even_ffn_w_up,
              even_ffn_w_down, odd_ada_w, odd_ada_b, odd_norm_mix_g, odd_w_in, odd_conv_w, odd_q_norm_g,
              odd_w_q_b, odd_kv_norm_g, odd_w_kv_b, odd_w_o, odd_norm_ffn_g, odd_router_w, odd_router_b,
              odd_exp_w_gate, odd_exp_w_up, odd_exp_w_down, final_norm_g):
    cond = jax.nn.silu(c)
    h = x
    for layer in range(DEPTH):
        i = layer // 2
        if layer % 2 == 0:
            mod = cond @ even_ada_w[i] + even_ada_b[i]
            sh1, sc1, g1, sh2, sc2, g2 = jnp.split(mod, ADA_CHUNKS, axis=-1)
            hn = modulate(h, even_norm_mix_g[i], sh1, sc1)
            h = h + g1[:, None, :] * even_mixer(hn, even_w_in[i], even_sinks[i], even_gmlp_ln_g[i],
                                                even_gmlp_ln_b[i], even_w_s[i], even_b_s[i], even_w_o[i])
            hn = modulate(h, even_norm_ffn_g[i], sh2, sc2)
            h = h + g2[:, None, :] * swiglu(hn, even_ffn_w_gate[i], even_ffn_w_up[i], even_ffn_w_down[i])
        else:
            mod = cond @ odd_ada_w[i] + odd_ada_b[i]
            sh1, sc1, g1, sh2, sc2, g2 = jnp.split(mod, ADA_CHUNKS, axis=-1)
            hn = modulate(h, odd_norm_mix_g[i], sh1, sc1)
            h = h + g1[:, None, :] * odd_mixer(hn, odd_w_in[i], odd_conv_w[i], odd_q_norm_g[i], odd_w_q_b[i],
                                               odd_kv_norm_g[i], odd_w_kv_b[i], odd_w_o[i])
            hn = modulate(h, odd_norm_ffn_g[i], sh2, sc2)
            h = h + g2[:, None, :] * moe_swiglu(hn, odd_router_w[i], odd_router_b[i], odd_exp_w_gate[i],
                                                odd_exp_w_up[i], odd_exp_w_down[i])
    return rmsnorm(h, final_norm_g)
```

```cpp
#include <hip/hip_runtime.h>
#include <cstdio>
#include <cstdint>
#include <cmath>
namespace pg8 {
#define PG8_LAS __attribute__((address_space(3)))
typedef unsigned short bf16_t;
typedef short bf16x8 __attribute__((ext_vector_type(8)));
typedef float f32x4 __attribute__((ext_vector_type(4)));
typedef unsigned u32x4 __attribute__((ext_vector_type(4)));
constexpr int BM = 256, BK = 64, HALF = 128, HTB = HALF * BK * 2  , STAGE_BYTES = 8 * HTB, NXCD = 8, WGM = 8;

__host__ __device__ __forceinline__ int lds_byte(int r, int c) { const int st = (r >> 4) * 2 + (c >> 5), rr = r & 15, cc = c & 31, ob = rr * 64 + cc * 2; return st * 1024 + (ob ^ (((ob >> 9) & 1) << 5)); }
__host__ __device__ __forceinline__ void stage_rc(int b, int& R, int& C) { const int st = b / 1024, sb = b % 1024, swz = sb ^ (((sb >> 9) & 1) << 5); R = (st >> 1) * 16 + swz / 64; C = (st & 1) * 32 + (swz % 64) / 2; }
__host__ __device__ __forceinline__ int perm32(int rho) { const int n = rho >> 4, i = rho & 15; return 8 * (i >> 2) + 4 * n + (i & 3); }

struct Unit { int pm, pn, pb, po; };
struct Gemm { const bf16_t* A; const bf16_t* Bt; int M, N, K; };

struct StaticOrder {
    int nM, nN, nwg, G, c;
    __host__ __device__ void init(int M, int N, int G_, int c_) { nM = M / BM; nN = N / BM; nwg = nM * nN; G = G_; c = c_; }
    __host__ __device__ bool next(int i, Unit& u) const {
        const long L = (long)i * G + c; if (L >= nwg) return false;
        int wgid = (int)L; { const int q = nwg / NXCD, r = nwg % NXCD, xcd = wgid % NXCD, off = wgid / NXCD; wgid = (xcd < r ? xcd * (q + 1) : r * (q + 1) + (xcd - r) * q) + off; }
        const int nig = WGM * nN, gid = wgid / nig, fm = gid * WGM, gsz = (nM - fm) < WGM ? (nM - fm) : WGM;
        u.pm = fm + ((wgid % nig) % gsz); u.pn = (wgid % nig) / gsz; u.pb = u.pn; u.po = u.pm; return true;
    }
    __device__ __forceinline__ void a_ready(const Unit&) const {}
    __device__ __forceinline__ void done(const Unit&) const {}
};
template <int NT, bool A_REL> struct MoeOrder {
    int G, c, p0, nunits; const int* pexp;
    __device__ __forceinline__ bool next(int i, Unit& u) const {
        const int L = i * G + c; if (L >= nunits) return false;
        const int pl = L / NT, n = L - pl * NT, p = p0 + pl;
        const int e = __builtin_amdgcn_readfirstlane(pexp[p]);
        u.pm = A_REL ? pl : p; u.po = A_REL ? p : pl; u.pn = n; u.pb = e * NT + n; return true;
    }
    __device__ __forceinline__ void a_ready(const Unit&) const {}
    __device__ __forceinline__ void done(const Unit&) const {}
};

__device__ __forceinline__ unsigned cvt_pk_bf16(float lo, float hi) { unsigned r; asm volatile("v_cvt_pk_bf16_f32 %0, %1, %2" : "=v"(r) : "v"(lo), "v"(hi)); return r; }
typedef float f32x2 __attribute__((ext_vector_type(2)));
__device__ __forceinline__ f32x2 gelu_pk(f32x2 v) {
    const f32x2 av = __builtin_elementwise_abs(v), d = av * 0.2316418882f + 1.0f;
    f32x2 t; t.x = __builtin_amdgcn_rcpf(d.x); t.y = __builtin_amdgcn_rcpf(d.y);
    f32x2 q = t * 0.5307027145f + (-0.7265760135f); q = q * t + 0.7107068705f; q = q * t + (-0.142248368f); q = q * t + 0.127414796f; q = q * t;
    const f32x2 s = (v * v) * (-0.72134752044f);
    f32x2 e; e.x = __builtin_amdgcn_exp2f(s.x); e.y = __builtin_amdgcn_exp2f(s.y);
    const f32x2 m = v * (q * e), r = v - m;
    f32x2 o; o.x = v.x < 0.f ? m.x : r.x; o.y = v.y < 0.f ? m.y : r.y; return o;
}
__device__ __forceinline__ f32x4 gelu4(f32x4 v) { const f32x2 a = gelu_pk((f32x2){v[0], v[1]}), b = gelu_pk((f32x2){v[2], v[3]}); return (f32x4){a.x, a.y, b.x, b.y}; }
__device__ __forceinline__ float silu1(float x) { return x * __builtin_amdgcn_rcpf(1.0f + __builtin_amdgcn_exp2f(-1.4426950408889634f * x)); }
__device__ __forceinline__ u32x4 pack8(f32x4 v0, f32x4 v1) { u32x4 w; w.x = cvt_pk_bf16(v0[0], v0[1]); w.y = cvt_pk_bf16(v0[2], v0[3]); w.z = cvt_pk_bf16(v1[0], v1[1]); w.w = cvt_pk_bf16(v1[2], v1[3]); return w; }

struct EpiBf16Plain {
    static constexpr bool PERM = true, AFTER_DRAIN = false;
    bf16_t* O; int ldc;
    __device__ __forceinline__ void operator()(const f32x4 (&acc)[2][2][4][2], const Unit& u, int wr, int wc, int fr, int fq) const {
        const int row0 = u.po * BM + wr * 64 + fr, col0 = u.pn * BM + wc * 32 + 8 * fq;
#pragma unroll
        for (int ai = 0; ai < 2; ++ai)
#pragma unroll
            for (int m = 0; m < 4; ++m) { bf16_t* rowp = O + (size_t)(row0 + ai * HALF + m * 16) * ldc + col0;
#pragma unroll
                for (int bj = 0; bj < 2; ++bj) *(u32x4*)(rowp + bj * HALF) = pack8(acc[ai][bj][m][0], acc[ai][bj][m][1]); }
    }
};
struct EpiProj0 {
    static constexpr bool PERM = true, AFTER_DRAIN = false;
    bf16_t* O; int ldc; float qscale;
    __device__ __forceinline__ void operator()(const f32x4 (&acc)[2][2][4][2], const Unit& u, int wr, int wc, int fr, int fq) const {
        const int row0 = u.po * BM + wr * 64 + fr, col0 = u.pn * BM + wc * 32 + 8 * fq;
        const int mode = u.pn < 2 ? 0 : (u.pn == 2 ? 1 : 2);
#pragma unroll
        for (int ai = 0; ai < 2; ++ai)
#pragma unroll
            for (int m = 0; m < 4; ++m) { bf16_t* rowp = O + (size_t)(row0 + ai * HALF + m * 16) * ldc + col0;
#pragma unroll
                for (int bj = 0; bj < 2; ++bj) { f32x4 v0 = acc[ai][bj][m][0], v1 = acc[ai][bj][m][1];
                    if (mode == 2) { v0 = gelu4(v0); v1 = gelu4(v1); } else if (mode == 0) { v0 = v0 * qscale; v1 = v1 * qscale; }
                    *(u32x4*)(rowp + bj * HALF) = pack8(v0, v1); } }
    }
};
struct EpiResGate {
    static constexpr bool PERM = false, AFTER_DRAIN = false;
    const float* base; float* out; int ldc; const float* gate; int gate_ld; int rows_per_batch;
    __device__ __forceinline__ void operator()(const f32x4 (&acc)[2][2][4][2], const Unit& u, int wr, int wc, int fr, int fq) const {
        const int row0 = u.po * BM + wr * 64 + fr, col0 = u.pn * BM + wc * 32 + 4 * fq;
        const float* gp = gate + (size_t)((u.po * BM) / rows_per_batch) * gate_ld + col0;
        f32x4 gv[2][2];
#pragma unroll
        for (int bj = 0; bj < 2; ++bj)
#pragma unroll
            for (int n = 0; n < 2; ++n) gv[bj][n] = *(const f32x4*)(gp + bj * HALF + n * 16);
#pragma unroll
        for (int ai = 0; ai < 2; ++ai)
#pragma unroll
            for (int m = 0; m < 4; ++m) { const size_t off = (size_t)(row0 + ai * HALF + m * 16) * ldc + col0;
#pragma unroll
                for (int bj = 0; bj < 2; ++bj)
#pragma unroll
                    for (int n = 0; n < 2; ++n) { const f32x4 bs = *(const f32x4*)(base + off + bj * HALF + n * 16); *(f32x4*)(out + off + bj * HALF + n * 16) = bs + gv[bj][n] * acc[ai][bj][m][n]; } }
    }
};
struct EpiSwiGLU {
    static constexpr bool PERM = true, AFTER_DRAIN = false;
    bf16_t* O; int ldc;
    __device__ __forceinline__ void operator()(const f32x4 (&acc)[2][2][4][2], const Unit& u, int wr, int wc, int fr, int fq) const {
        const int row0 = u.po * BM + wr * 64 + fr, col0 = u.pn * HALF + wc * 32 + 8 * fq;
#pragma unroll
        for (int ai = 0; ai < 2; ++ai)
#pragma unroll
            for (int m = 0; m < 4; ++m) { bf16_t* rowp = O + (size_t)(row0 + ai * HALF + m * 16) * ldc + col0;
                f32x4 r0, r1;
#pragma unroll
                for (int j = 0; j < 4; ++j) { r0[j] = silu1(acc[ai][0][m][0][j]) * acc[ai][1][m][0][j]; r1[j] = silu1(acc[ai][0][m][1][j]) * acc[ai][1][m][1][j]; }
                *(u32x4*)rowp = pack8(r0, r1); }
    }
};
struct EpiQRope {
    static constexpr bool PERM = true, AFTER_DRAIN = false;
    bf16_t* O; int ldc; const float* ctab; const float* stab; float qscale; int seq_mask;
    __device__ __forceinline__ void operator()(const f32x4 (&acc)[2][2][4][2], const Unit& u, int wr, int wc, int fr, int fq) const {
        const int row0 = u.po * BM + wr * 64 + fr, col0 = u.pn * BM + wc * 32 + 8 * fq;
#pragma unroll
        for (int ai = 0; ai < 2; ++ai)
#pragma unroll
            for (int m = 0; m < 4; ++m) { const int row = row0 + ai * HALF + m * 16; bf16_t* rowp = O + (size_t)row * ldc + col0; const int pos = row & seq_mask;
#pragma unroll
                for (int bj = 0; bj < 2; ++bj) { f32x4 v0 = acc[ai][bj][m][0] * qscale, v1 = acc[ai][bj][m][1] * qscale;
                    const int off = (col0 + bj * HALF) % 96;
                    if (off >= 64) { const int i0 = (off - 64) >> 1; const f32x4 cs = *(const f32x4*)(ctab + pos * 16 + i0), sn = *(const f32x4*)(stab + pos * 16 + i0);
                        const f32x4 a = v0, b = v1;
                        v0[0] = a[0] * cs[0] - a[1] * sn[0]; v0[1] = a[0] * sn[0] + a[1] * cs[0]; v0[2] = a[2] * cs[1] - a[3] * sn[1]; v0[3] = a[2] * sn[1] + a[3] * cs[1];
                        v1[0] = b[0] * cs[2] - b[1] * sn[2]; v1[1] = b[0] * sn[2] + b[1] * cs[2]; v1[2] = b[2] * cs[3] - b[3] * sn[3]; v1[3] = b[2] * sn[3] + b[3] * cs[3]; }
                    *(u32x4*)(rowp + bj * HALF) = pack8(v0, v1); }
                asm volatile("" ::: "memory"); }
    }
};

template <class Epi, class Sched, bool ALIGN_EPI = false, bool SP2 = false>
__device__ __forceinline__ void gemm_phase(PG8_LAS unsigned char* lds, const Gemm g, const Sched& S, const Epi& E) {
    int tid_ = threadIdx.x; asm volatile("" : "+v"(tid_));
    const int tid = tid_, wid = __builtin_amdgcn_readfirstlane(tid >> 6), lane = tid & 63, wr = wid >> 2, wc = wid & 3, fr = lane & 15, fq = lane >> 4;
    const int K = g.K, nt = K / BK;
    unsigned voffA[2], voffB[2];
#pragma unroll
    for (int i = 0; i < 2; ++i) { int R, C; stage_rc(tid * 16 + i * 8192, R, C); const int Rb = Epi::PERM ? ((R & ~31) + perm32(R & 31)) : R;
        voffA[i] = (unsigned)(R * K + C) * 2u; voffB[i] = (unsigned)(Rb * K + C) * 2u; }
    const size_t kstep = (size_t)(BK * 2);
    const size_t hstep = (size_t)HALF * K * 2;
    const size_t tstep = 2 * hstep;
    const unsigned ldsw = (unsigned)wid * 1024u;
    const int aoff = lds_byte(wr * 64 + fr, fq * 8), boff = lds_byte(wc * 32 + fr, fq * 8);
#define PG8_SA(b, h) (((b) * 2 + (h)) * HTB)
#define PG8_SB(b, h) ((4 + (b) * 2 + (h)) * HTB)
#define PG8_STAGE(bufoff, gbase, voff) do { _Pragma("unroll") for (int _i = 0; _i < 2; ++_i) \
        __builtin_amdgcn_global_load_lds((const unsigned*)((const char*)(gbase) + (voff)[_i]), (PG8_LAS unsigned*)(lds + (bufoff) + ldsw + _i * 8192), 16, 0, 0); } while (0)
#define PG8_LDA(dst, b, h) do { _Pragma("unroll") for (int m = 0; m < 4; ++m) _Pragma("unroll") for (int k = 0; k < 2; ++k) dst[m][k] = *(const PG8_LAS bf16x8*)(lds + PG8_SA(b, h) + aoff + m * 2048 + k * 1024); } while (0)
#define PG8_LDB(dst, b, h) do { _Pragma("unroll") for (int n = 0; n < 2; ++n) _Pragma("unroll") for (int k = 0; k < 2; ++k) dst[n][k] = *(const PG8_LAS bf16x8*)(lds + PG8_SB(b, h) + boff + n * 2048 + k * 1024); } while (0)
#define PG8_MMA(ai, bj, At, Bt) do { __builtin_amdgcn_s_setprio(1); _Pragma("unroll") for (int m = 0; m < 4; ++m) _Pragma("unroll") for (int n = 0; n < 2; ++n) _Pragma("unroll") for (int k = 0; k < 2; ++k) \
        acc[ai][bj][m][n] = __builtin_amdgcn_mfma_f32_16x16x32_bf16(Bt[n][k], At[m][k], acc[ai][bj][m][n], 0, 0, 0); __builtin_amdgcn_s_setprio(0); } while (0)
#define PG8_WAIT_V(n) asm volatile("s_waitcnt vmcnt(" #n ")" ::: "memory")
#define PG8_WAIT_L(n) asm volatile("s_waitcnt lgkmcnt(" #n ")" ::: "memory")
#define PG8_BAR __builtin_amdgcn_s_barrier()
#define PG8_SCHED __builtin_amdgcn_sched_barrier(0)
    Unit cur, nxt; int ui = 0;
    if (!S.next(0, cur)) return;
    f32x4 acc[2][2][4][2];
#pragma unroll
    for (int a = 0; a < 2; ++a)
#pragma unroll
        for (int b = 0; b < 2; ++b)
#pragma unroll
            for (int m = 0; m < 4; ++m)
#pragma unroll
                for (int n = 0; n < 2; ++n) acc[a][b][m][n] = (f32x4){0.f, 0.f, 0.f, 0.f};
    bf16x8 At[4][2], B0[2][2], B1[2][2];
    const char* cA = (const char*)g.A + (size_t)cur.pm * tstep; const char* cB = (const char*)g.Bt + (size_t)cur.pb * tstep;
    S.a_ready(cur);
    if constexpr (SP2) {
        PG8_STAGE(PG8_SB(0, 0), cB, voffB); PG8_STAGE(PG8_SB(0, 1), cB + hstep, voffB); PG8_STAGE(PG8_SA(0, 0), cA, voffA); PG8_STAGE(PG8_SA(0, 1), cA + hstep, voffA);
        if (wr == 1) PG8_BAR;
        PG8_WAIT_V(2); PG8_BAR;
        PG8_STAGE(PG8_SB(1, 0), cB + kstep, voffB); PG8_STAGE(PG8_SA(1, 0), cA + kstep, voffA); PG8_STAGE(PG8_SB(1, 1), cB + hstep + kstep, voffB);
        PG8_WAIT_V(6); PG8_BAR;
    } else {
        PG8_STAGE(PG8_SB(0, 0), cB, voffB); PG8_STAGE(PG8_SA(0, 0), cA, voffA); PG8_STAGE(PG8_SB(0, 1), cB + hstep, voffB); PG8_STAGE(PG8_SA(0, 1), cA + hstep, voffA);
        if (wr == 1) PG8_BAR;
        PG8_WAIT_V(4); PG8_BAR;
        PG8_STAGE(PG8_SB(1, 0), cB + kstep, voffB); PG8_STAGE(PG8_SA(1, 0), cA + kstep, voffA); PG8_STAGE(PG8_SB(1, 1), cB + hstep + kstep, voffB);
        PG8_WAIT_V(6); PG8_BAR;
    }
    for (;;) {
        const bool has_next = S.next(ui + 1, nxt);
        const char* nA = has_next ? (const char*)g.A + (size_t)nxt.pm * tstep : cA; const char* nB = has_next ? (const char*)g.Bt + (size_t)nxt.pb * tstep : cB;
        for (int t = 0; t < nt; t += 2) {
            const bool last = (t == nt - 2);
            const char* a1 = cA + (size_t)(t + 1) * kstep;
            const char* a2 = last ? nA : cA + (size_t)(t + 2) * kstep; const char* b2 = last ? nB : cB + (size_t)(t + 2) * kstep;
            const char* a3 = a2 + kstep; const char* b3 = b2 + kstep;
            if (last && has_next) S.a_ready(nxt);
            if constexpr (SP2) {
            PG8_LDB(B0, 0, 0); PG8_LDB(B1, 0, 1); PG8_SCHED; PG8_LDA(At, 0, 0); PG8_STAGE(PG8_SA(1, 1), a1 + hstep, voffA);
            PG8_WAIT_V(8); PG8_WAIT_L(0); PG8_BAR; PG8_MMA(0, 0, At, B0); PG8_MMA(0, 1, At, B1); PG8_BAR; PG8_SCHED;
            PG8_LDA(At, 0, 1); PG8_STAGE(PG8_SB(0, 0), b2, voffB); PG8_STAGE(PG8_SB(0, 1), b2 + hstep, voffB); PG8_STAGE(PG8_SA(0, 0), a2, voffA);
            PG8_WAIT_V(8); PG8_WAIT_L(0); PG8_BAR; PG8_MMA(1, 0, At, B0); PG8_MMA(1, 1, At, B1); PG8_BAR; PG8_SCHED;
            PG8_LDB(B0, 1, 0); PG8_LDB(B1, 1, 1); PG8_SCHED; PG8_LDA(At, 1, 0); PG8_STAGE(PG8_SA(0, 1), a2 + hstep, voffA);
            PG8_WAIT_V(8); PG8_WAIT_L(0); PG8_BAR; PG8_MMA(0, 0, At, B0); PG8_MMA(0, 1, At, B1); PG8_BAR; PG8_SCHED;
            PG8_LDA(At, 1, 1); PG8_STAGE(PG8_SB(1, 0), b3, voffB); PG8_STAGE(PG8_SB(1, 1), b3 + hstep, voffB); PG8_STAGE(PG8_SA(1, 0), a3, voffA);
            PG8_WAIT_V(8); PG8_WAIT_L(0); PG8_BAR; PG8_MMA(1, 0, At, B0); PG8_MMA(1, 1, At, B1); PG8_BAR; PG8_SCHED;
            } else {
            PG8_LDB(B0, 0, 0); PG8_SCHED; PG8_LDA(At, 0, 0); PG8_STAGE(PG8_SA(1, 1), a1 + hstep, voffA);
            PG8_WAIT_L(8); PG8_BAR; PG8_WAIT_L(0); PG8_MMA(0, 0, At, B0); PG8_BAR; PG8_SCHED;
            PG8_LDB(B1, 0, 1); PG8_STAGE(PG8_SB(0, 0), b2, voffB);
            PG8_BAR; PG8_WAIT_L(0); PG8_MMA(0, 1, At, B1); PG8_BAR;
            PG8_LDA(At, 0, 1); PG8_STAGE(PG8_SA(0, 0), a2, voffA);
            PG8_BAR; PG8_WAIT_L(0); PG8_MMA(1, 0, At, B0); PG8_BAR; PG8_SCHED;
            PG8_STAGE(PG8_SB(0, 1), b2 + hstep, voffB);
            PG8_WAIT_V(6); PG8_BAR; PG8_MMA(1, 1, At, B1); PG8_BAR;
            PG8_LDB(B0, 1, 0); PG8_SCHED; PG8_LDA(At, 1, 0); PG8_STAGE(PG8_SA(0, 1), a2 + hstep, voffA);
            PG8_WAIT_L(8); PG8_BAR; PG8_WAIT_L(0); PG8_MMA(0, 0, At, B0); PG8_BAR; PG8_SCHED;
            PG8_LDB(B1, 1, 1); PG8_STAGE(PG8_SB(1, 0), b3, voffB);
            PG8_BAR; PG8_WAIT_L(0); PG8_MMA(0, 1, At, B1); PG8_BAR;
            PG8_LDA(At, 1, 1); PG8_STAGE(PG8_SA(1, 0), a3, voffA);
            PG8_BAR; PG8_WAIT_L(0); PG8_MMA(1, 0, At, B0); PG8_BAR; PG8_SCHED;
            PG8_STAGE(PG8_SB(1, 1), b3 + hstep, voffB);
            PG8_WAIT_V(6); PG8_BAR; PG8_MMA(1, 1, At, B1); PG8_BAR;
            }
        }
        if constexpr (ALIGN_EPI) { if (wr == 0) PG8_BAR; }
        if constexpr (!Epi::AFTER_DRAIN) { E(acc, cur, wr, wc, fr, fq); S.done(cur); }
        if (!has_next) break;
#pragma unroll
        for (int a = 0; a < 2; ++a)
#pragma unroll
            for (int b = 0; b < 2; ++b)
#pragma unroll
                for (int m = 0; m < 4; ++m)
#pragma unroll
                    for (int n = 0; n < 2; ++n) acc[a][b][m][n] = (f32x4){0.f, 0.f, 0.f, 0.f};
        cur = nxt; cA = nA; cB = nB; ++ui;
        if constexpr (ALIGN_EPI) { if (wr == 1) PG8_BAR; }
    }
    PG8_WAIT_V(0);
    if constexpr (!ALIGN_EPI) { if (wr == 0) PG8_BAR; }
    PG8_BAR;
    if constexpr (Epi::AFTER_DRAIN) { E.fused(acc, cur, wr, wc, fr, fq, lds, wid, lane); S.done(cur); }
#undef PG8_SA
#undef PG8_SB
#undef PG8_STAGE
#undef PG8_LDA
#undef PG8_LDB
#undef PG8_MMA
#undef PG8_WAIT_V
#undef PG8_WAIT_L
#undef PG8_BAR
#undef PG8_SCHED
}
}
#define GAS __attribute__((address_space(1)))
#define LAS __attribute__((address_space(3)))
typedef unsigned short bf16;
typedef unsigned v4u __attribute__((ext_vector_type(4)));
typedef float f32x4 __attribute__((ext_vector_type(4)));
typedef short bf16x8 __attribute__((ext_vector_type(8)));
typedef GAS unsigned gu32;
typedef GAS unsigned long long gu64;
#define RLX_AGENT __ATOMIC_RELAXED, __HIP_MEMORY_SCOPE_AGENT
#define LDS_WAIT() asm volatile("s_waitcnt lgkmcnt(0)" ::: "memory")
#define VM_WAIT() asm volatile("s_waitcnt vmcnt(0)" ::: "memory")
__device__ __forceinline__ unsigned long long rt() { return __builtin_amdgcn_s_memrealtime(); }

#define XB_TMO      128
#define XB_XCNT(j)  (256  + 64 * (j))
#define XB_XSUB(j)  (1280 + 64 * (j))
#define XB_XGEN(j)  (2304 + 64 * (j))
#define XB_TOP      3328
#define XB_TOPGEN   3392
#define XCD_BAR_WORDS 3456
#define XB_SPIN_CAP (1u << 18)

__device__ __forceinline__ unsigned xb_ld(unsigned* p)              { return __hip_atomic_load(p, __ATOMIC_RELAXED, __HIP_MEMORY_SCOPE_AGENT); }
__device__ __forceinline__ unsigned xb_add(unsigned* p, unsigned v) { return __hip_atomic_fetch_add(p, v, __ATOMIC_RELAXED, __HIP_MEMORY_SCOPE_AGENT); }
__device__ __forceinline__ unsigned xb_xcc_id() { return (unsigned)__builtin_amdgcn_s_getreg((3 << 11) | 20) & 0xFu; }
#define XB_SPIN(cond, bar) do { unsigned _sp = 0; while (cond) { __builtin_amdgcn_s_sleep(1); \
    if ((++_sp & 255u) == 0u) { if (xb_ld(&(bar)[XB_TMO])) break; if (_sp > XB_SPIN_CAP) { atomicAdd(&(bar)[XB_TMO], 1u); break; } } } } while (0)

struct XcdBarrier {
    unsigned* bar; unsigned x;
    volatile LAS unsigned* st;
};

__device__ __forceinline__ XcdBarrier xcd_barrier_post(unsigned* bar, volatile LAS unsigned* st) {
    XcdBarrier b; b.bar = bar; b.x = xb_xcc_id(); b.st = st;
    if (threadIdx.x == 0) (void)xb_add(&bar[XB_XCNT(b.x)], 1u);
    return b;
}
__device__ __forceinline__ void xcd_barrier_complete(unsigned* bar, unsigned x, unsigned& nloc, unsigned& nx) {
    const unsigned G = gridDim.x * gridDim.y * gridDim.z;
    unsigned sum, cnt, mine, sp = 0u;
    for (;;) {
        sum = 0u; cnt = 0u; mine = 0u;
#pragma unroll
        for (unsigned j = 0; j < 16; ++j) { const unsigned c = xb_ld(&bar[XB_XCNT(j)]); sum += c; cnt += (c > 0u) ? 1u : 0u; mine = (j == x) ? c : mine; }
        if (sum == G) break;
        __builtin_amdgcn_s_sleep(1);
        if ((++sp & 255u) == 0u) { if (xb_ld(&bar[XB_TMO])) break; if (sp > XB_SPIN_CAP) { atomicAdd(&bar[XB_TMO], 1u); break; } }
    }
    nloc = mine > 0u ? mine : 1u; nx = cnt > 0u ? cnt : 1u;
}

__device__ __forceinline__ void xcd_barrier(const XcdBarrier& b) {
    asm volatile("s_waitcnt vmcnt(0)" ::: "memory");
    __syncthreads();
    if (threadIdx.x == 0) {
        unsigned* bar = b.bar;
        __builtin_amdgcn_s_waitcnt(0);
        unsigned nloc = b.st[0], nx = b.st[1];
        if (nloc == 0u) { xcd_barrier_complete(bar, b.x, nloc, nx); b.st[0] = nloc; b.st[1] = nx; }
        const unsigned old = xb_add(&bar[XB_XSUB(b.x)], 1u);
        const unsigned gen = old / nloc;
        if (old + 1u == (gen + 1u) * nloc) {
            __builtin_amdgcn_fence(__ATOMIC_RELEASE, "agent");
            asm volatile("s_waitcnt vmcnt(0)" ::: "memory");
            const unsigned og = xb_add(&bar[XB_TOP], 1u);
            const unsigned tg = og / nx;
            if (og + 1u == (tg + 1u) * nx) xb_add(&bar[XB_TOPGEN], 1u);
            else XB_SPIN(xb_ld(&bar[XB_TOPGEN]) == tg, bar);
            __builtin_amdgcn_fence(__ATOMIC_ACQUIRE, "agent");
            xb_add(&bar[XB_XGEN(b.x)], 1u);
            asm volatile("s_waitcnt vmcnt(0)" ::: "memory");
        } else {
            XB_SPIN(xb_ld(&bar[XB_XGEN(b.x)]) == gen, bar);
            __builtin_amdgcn_fence(__ATOMIC_ACQUIRE, "agent");
            asm volatile("s_waitcnt vmcnt(0)" ::: "memory");
        }
    }
    __syncthreads();
}

constexpr int NWAVES = 8;
constexpr int BATCH = 4, SEQ = 8192, DM = 1024, NTOK = BATCH * SEQ;
constexpr int EVEN_IN = 1792, ODD_IN = 2336, ODD_IN_PAD = 2560, FF = 2816, FFE = 3584, NEXP = 8, ADA = 6144;
constexpr float NORM_EPS = 1e-6f, LOG2E = 1.4426950408889634f;
constexpr float QS_EVEN = 0.125f * LOG2E;
constexpr float QS_ODD = 0.10206207261596577f * LOG2E;
#ifndef MK_PER_PHASE
#define MK_PER_PHASE 0
#endif
constexpr int NPH = 21;

constexpr size_t MiB = 1u << 20, KiB = 1024;
constexpr size_t WS_CTL = 0, CTL_ZERO_BYTES = 1 * MiB;
constexpr size_t WS_MOD = 1 * MiB;
constexpr size_t WS_ROPEC = 1 * MiB + 256 * KiB, WS_ROPES = WS_ROPEC + 512 * KiB;
constexpr size_t WS_TOKE = 2 * MiB + 256 * KiB, WS_TOKG = WS_TOKE + 256 * KiB, WS_TOKS = WS_TOKG + 256 * KiB;
constexpr size_t WS_PEXP = WS_TOKS + 256 * KiB;
constexpr size_t WS_WEGU = 4 * MiB;
constexpr size_t WS_WED = 116 * MiB;
constexpr size_t WS_HN = 172 * MiB;
constexpr size_t WS_PROJ = 236 * MiB;
constexpr size_t WS_MIX0 = 348 * MiB;
constexpr size_t WS_ACT = 236 * MiB;
constexpr size_t WS_QN = 396 * MiB, WS_KVN = 428 * MiB, WS_KPE = 444 * MiB, WS_MIX1 = 446 * MiB;
constexpr size_t WS_Q = 236 * MiB, WS_KV = 284 * MiB;
constexpr size_t WS_WNE = 510 * MiB;
constexpr size_t WS_WIN0 = WS_WNE, WS_WO0 = WS_WIN0 + 3584 * KiB, WS_WGU0 = WS_WO0 + 2 * MiB, WS_WD0 = WS_WGU0 + 11 * MiB, WS_WIN1 = WS_WD0 + 5632 * KiB,
                 WS_WQB = WS_WIN1 + 5 * MiB, WS_WKVB = WS_WQB + 768 * KiB, WS_WO1 = WS_WKVB + 512 * KiB, WS_WNE_END = WS_WO1 + 2 * MiB;
constexpr size_t WS_HN2 = 478 * MiB;
constexpr size_t WS_XS = 172 * MiB;
constexpr size_t WS_ACTE = 304 * MiB;
constexpr size_t WS_END = 542 * MiB;
static_assert(WS_WNE_END <= WS_END && WS_MIX1 + 64 * MiB <= WS_WNE && WS_ACTE + (size_t)136 * 256 * FFE * 2 <= WS_END, "d_ws map");
constexpr int MOE_CH0 = 128;
constexpr int CW_TMO = 0, CW_CODE = 1, CW_BAR = 4096, CW_CNT = 8192, CW_CUR = 9216;
constexpr int RING_BYTES = 131072, LDSCTL_OFF = RING_BYTES, MISC_OFF = LDSCTL_OFF + 320, LDS_BYTES = 147456;

typedef unsigned v2u __attribute__((ext_vector_type(2)));
__device__ __forceinline__ unsigned pk2(float lo, float hi) { return pg8::cvt_pk_bf16(lo, hi); }
__device__ __forceinline__ float bflo(unsigned u) { return __uint_as_float(u << 16); }
__device__ __forceinline__ float bfhi(unsigned u) { return __uint_as_float(u & 0xffff0000u); }
__device__ __forceinline__ float bf2f(bf16 h) { return __uint_as_float(((unsigned)h) << 16); }
__device__ __forceinline__ float wave_sum(float v) {
#pragma unroll
    for (int o = 1; o < 64; o <<= 1) v += __shfl_xor(v, o);
    return v;
}
__device__ __forceinline__ float rsqrt_f(float x) { return 1.0f / sqrtf(x); }

struct Ctx { LAS unsigned char* lds; int tid, lane, wave, vcu, G, gw, NGW; };

__device__ __forceinline__ void transpose_item(const float* W, int K, int N, bf16* WT, int row_base, bool pp, LAS float* scr, int kb, int nb, int lane) {
    const int k0 = 64 * kb, n0 = 32 * nb;
#pragma unroll 8
    for (int i = 0; i < 32; ++i) { const int kk = 2 * i + (lane >> 5); scr[kk * 33 + (lane & 31)] = W[(size_t)(k0 + kk) * N + n0 + (lane & 31)]; }
    LDS_WAIT(); asm volatile("" ::: "memory");
    const int c = lane & 7;
#pragma unroll
    for (int j = 0; j < 4; ++j) { const int n = (lane >> 3) + 8 * j; const LAS float* s = scr + (8 * c) * 33 + n;
        v4u o; o.x = pk2(s[0 * 33], s[1 * 33]); o.y = pk2(s[2 * 33], s[3 * 33]); o.z = pk2(s[4 * 33], s[5 * 33]); o.w = pk2(s[6 * 33], s[7 * 33]);
        const int nd = pp ? ((n < 16) ? 2 * n : 2 * (n - 16) + 1) : n;
        *(v4u*)(WT + (size_t)(row_base + nd) * K + k0 + 8 * c) = o; }
    LDS_WAIT(); asm volatile("" ::: "memory");
}
struct In {
    const float *x, *c, *e_ada_w, *e_ada_b, *e_nmix_g, *e_w_in, *e_sinks, *e_ln_g, *e_ln_b, *e_w_s, *e_b_s, *e_w_o, *e_nffn_g, *e_wg, *e_wu, *e_wd,
                *o_ada_w, *o_ada_b, *o_nmix_g, *o_w_in, *o_conv_w, *o_qn_g, *o_w_qb, *o_kvn_g, *o_w_kvb, *o_w_o, *o_nffn_g, *o_rw, *o_rb, *o_xg, *o_xu, *o_xd, *fin_g;
};
__device__ __forceinline__ void p0_prologue(const Ctx& C, const In& I, unsigned char* ws) {
    if (blockIdx.x < 192) {
        const int layer = blockIdx.x / 96, j = (blockIdx.x % 96) * 64 + C.lane;
        const float* W = layer ? I.o_ada_w : I.e_ada_w; const float* Bv = layer ? I.o_ada_b : I.e_ada_b;
        float a0 = 0.f, a1 = 0.f, a2 = 0.f, a3 = 0.f;
        const int kb = C.wave * 128;
#pragma unroll 4
        for (int k = kb; k < kb + 128; ++k) { const float w = W[(size_t)k * ADA + j];
            const float c0 = I.c[k], c1 = I.c[DM + k], c2 = I.c[2 * DM + k], c3 = I.c[3 * DM + k];
            a0 += w * (c0 / (1.f + __expf(-c0))); a1 += w * (c1 / (1.f + __expf(-c1))); a2 += w * (c2 / (1.f + __expf(-c2))); a3 += w * (c3 / (1.f + __expf(-c3))); }
        LAS float* red = (LAS float*)C.lds;
        red[(C.wave * 4 + 0) * 64 + C.lane] = a0; red[(C.wave * 4 + 1) * 64 + C.lane] = a1; red[(C.wave * 4 + 2) * 64 + C.lane] = a2; red[(C.wave * 4 + 3) * 64 + C.lane] = a3;
        __syncthreads();
        if (C.wave < 4) { float s = 0.f;
#pragma unroll
            for (int w = 0; w < 8; ++w) s += red[(w * 4 + C.wave) * 64 + C.lane];
            ((float*)(ws + WS_MOD))[(size_t)(layer * BATCH + C.wave) * ADA + j] = s + Bv[j]; }
        __syncthreads();
    }
    {
        float* ct = (float*)(ws + WS_ROPEC); float* st = (float*)(ws + WS_ROPES);
        for (int idx = blockIdx.x * 512 + C.tid; idx < SEQ * 16; idx += C.G * 512) { const int pos = idx >> 4, i = idx & 15;
            const double inv = (double)exp2f(-(float)i * (13.287712379549449f / 16.0f));
            const double rev = (double)((float)pos * (float)inv) * 0.15915494309189535;
            const float fr = (float)(rev - __builtin_rint(rev));
            ct[idx] = __builtin_amdgcn_cosf(fr); st[idx] = __builtin_amdgcn_sinf(fr); }
    }
    LAS float* scr = (LAS float*)(C.lds + C.wave * 16384);
    constexpr int I_IN0 = 16 * 56, I_O = 16 * 32, I_GU0 = 16 * 88, I_D0 = 44 * 32, I_IN1 = 16 * 73, I_QB = 8 * 24, I_KVB = 4 * 32, I_XG1 = 16 * 112, I_XD1 = 56 * 32;
    constexpr int NITEMS = I_IN0 + I_O + 2 * I_GU0 + I_D0 + I_IN1 + I_QB + I_KVB + I_O + 8 * (2 * I_XG1 + I_XD1);
    for (int it = C.gw; it < NITEMS; it += C.NGW) {
        int r = it;
        if (r < I_IN0) { const int kb = r / 56, nb = r % 56; transpose_item(I.e_w_in, DM, EVEN_IN, (bf16*)(ws + WS_WIN0), nb * 32, false, scr, kb, nb, C.lane); continue; } r -= I_IN0;
        if (r < I_O) { const int kb = r / 32, nb = r % 32; transpose_item(I.e_w_o, DM, DM, (bf16*)(ws + WS_WO0), nb * 32, false, scr, kb, nb, C.lane); continue; } r -= I_O;
        if (r < I_GU0) { const int kb = r / 88, nb = r % 88, n0 = nb * 32; transpose_item(I.e_wg, DM, FF, (bf16*)(ws + WS_WGU0), 256 * (n0 >> 7) + (n0 & 127), false, scr, kb, nb, C.lane); continue; } r -= I_GU0;
        if (r < I_GU0) { const int kb = r / 88, nb = r % 88, n0 = nb * 32; transpose_item(I.e_wu, DM, FF, (bf16*)(ws + WS_WGU0), 256 * (n0 >> 7) + (n0 & 127) + 128, false, scr, kb, nb, C.lane); continue; } r -= I_GU0;
        if (r < I_D0) { const int kb = r / 32, nb = r % 32; transpose_item(I.e_wd, FF, DM, (bf16*)(ws + WS_WD0), nb * 32, false, scr, kb, nb, C.lane); continue; } r -= I_D0;
        if (r < I_IN1) { const int kb = r / 73, nb = r % 73; transpose_item(I.o_w_in, DM, ODD_IN, (bf16*)(ws + WS_WIN1), nb * 32, nb == 72, scr, kb, nb, C.lane); continue; } r -= I_IN1;
        if (r < I_QB) { const int kb = r / 24, nb = r % 24; transpose_item(I.o_w_qb, 512, 768, (bf16*)(ws + WS_WQB), nb * 32, (nb % 3) == 2, scr, kb, nb, C.lane); continue; } r -= I_QB;
        if (r < I_KVB) { const int kb = r / 32, nb = r % 32; transpose_item(I.o_w_kvb, 256, 1024, (bf16*)(ws + WS_WKVB), nb * 32, false, scr, kb, nb, C.lane); continue; } r -= I_KVB;
        if (r < I_O) { const int kb = r / 32, nb = r % 32; transpose_item(I.o_w_o, DM, DM, (bf16*)(ws + WS_WO1), nb * 32, false, scr, kb, nb, C.lane); continue; } r -= I_O;
        if (r < 8 * I_XG1) { const int e = r / I_XG1, rr = r % I_XG1, kb = rr / 112, nb = rr % 112, n0 = nb * 32;
            transpose_item(I.o_xg + (size_t)e * DM * FFE, DM, FFE, (bf16*)(ws + WS_WEGU) + (size_t)e * 7168 * DM, 256 * (n0 >> 7) + (n0 & 127), false, scr, kb, nb, C.lane); continue; } r -= 8 * I_XG1;
        if (r < 8 * I_XG1) { const int e = r / I_XG1, rr = r % I_XG1, kb = rr / 112, nb = rr % 112, n0 = nb * 32;
            transpose_item(I.o_xu + (size_t)e * DM * FFE, DM, FFE, (bf16*)(ws + WS_WEGU) + (size_t)e * 7168 * DM, 256 * (n0 >> 7) + (n0 & 127) + 128, false, scr, kb, nb, C.lane); continue; } r -= 8 * I_XG1;
        { const int e = r / I_XD1, rr = r % I_XD1, kb = rr / 32, nb = rr % 32;
            transpose_item(I.o_xd + (size_t)e * FFE * DM, FFE, DM, (bf16*)(ws + WS_WED) + (size_t)e * DM * FFE, nb * 32, false, scr, kb, nb, C.lane); }
    }
}

__device__ __forceinline__ void modulate_rows(const Ctx& C, const float* h, const float* g, const float* shift, const float* scale, bf16* hn) {
    for (int m = C.gw; m < NTOK; m += C.NGW) {
        const int b = m >> 13;
        const f32x4* xr = (const f32x4*)(h + (size_t)m * DM) + C.lane;
        f32x4 v[4]; float s = 0.f;
#pragma unroll
        for (int j = 0; j < 4; ++j) { v[j] = xr[64 * j]; s += (v[j].x * v[j].x + v[j].y * v[j].y) + (v[j].z * v[j].z + v[j].w * v[j].w); }
        const float r = rsqrt_f(wave_sum(s) * (1.f / DM) + NORM_EPS);
        v2u* o8 = (v2u*)(hn + (size_t)m * DM) + C.lane;
#pragma unroll
        for (int j = 0; j < 4; ++j) { const f32x4 gg = ((const f32x4*)g)[64 * j + C.lane], sc = ((const f32x4*)(scale + (size_t)b * ADA))[64 * j + C.lane], sh = ((const f32x4*)(shift + (size_t)b * ADA))[64 * j + C.lane];
            const f32x4 o = (v[j] * r) * gg * (sc + 1.0f) + sh; v2u w; w.x = pk2(o.x, o.y); w.y = pk2(o.z, o.w); o8[64 * j] = w; }
    }
}

__device__ __forceinline__ void even_mixer_simple(const Ctx& C, const bf16* proj, const float* sinks, const float* ln_g, const float* ln_b, const float* w_s, const float* b_s, bf16* mix) {
    for (int unit = C.vcu; unit < NTOK / 128; unit += C.G) {
        const int row0 = unit * 128, tblk = (unit & 63) * 128, seq0 = row0 - tblk;
        for (int it = 0; it < 2; ++it) {
            const int h = __builtin_amdgcn_readfirstlane((C.tid >> 7) + 4 * it), tl = C.tid & 127, kvh = h >> 2;
            const int t = tblk + tl, grow = row0 + tl;
            float q[64];
            { const v4u* qp = (const v4u*)(proj + (size_t)grow * EVEN_IN + h * 64);
#pragma unroll
              for (int i = 0; i < 8; ++i) { const v4u w = qp[i]; q[8 * i] = bflo(w.x); q[8 * i + 1] = bfhi(w.x); q[8 * i + 2] = bflo(w.y); q[8 * i + 3] = bfhi(w.y); q[8 * i + 4] = bflo(w.z); q[8 * i + 5] = bfhi(w.z); q[8 * i + 6] = bflo(w.w); q[8 * i + 7] = bfhi(w.w); } }
            const float slope2 = exp2f(-(float)(h + 1)) * LOG2E, sink2 = sinks[h] * LOG2E;
            float m = sink2, l = 1.f, o[64];
#pragma unroll
            for (int d = 0; d < 64; ++d) o[d] = 0.f;
            const int tw0 = __builtin_amdgcn_readfirstlane(tblk + (tl & 64));
            const int klo = (tw0 - 127) > 0 ? (tw0 - 127) : 0, khi = tw0 + 63;
            for (int kk = klo; kk <= khi; ++kk) {
                const int dist = t - kk; const bool valid = dist >= 0 && dist < 128;
                const v4u* kp = (const v4u*)(proj + (size_t)(seq0 + kk) * EVEN_IN + 512 + kvh * 64); const v4u* vp = (const v4u*)(proj + (size_t)(seq0 + kk) * EVEN_IN + 640 + kvh * 64);
                float s = 0.f;
#pragma unroll
                for (int i = 0; i < 8; ++i) { const v4u w = kp[i]; s += q[8 * i] * bflo(w.x) + q[8 * i + 1] * bfhi(w.x) + q[8 * i + 2] * bflo(w.y) + q[8 * i + 3] * bfhi(w.y) + q[8 * i + 4] * bflo(w.z) + q[8 * i + 5] * bfhi(w.z) + q[8 * i + 6] * bflo(w.w) + q[8 * i + 7] * bfhi(w.w); }
                s -= slope2 * (float)dist;
                if (valid && s > m) { const float corr = exp2f(m - s); l *= corr;
#pragma unroll
                    for (int d = 0; d < 64; ++d) o[d] *= corr;
                    m = s; }
                const float p = valid ? exp2f(s - m) : 0.f; l += p;
#pragma unroll
                for (int i = 0; i < 8; ++i) { const v4u w = vp[i]; o[8 * i] += p * bflo(w.x); o[8 * i + 1] += p * bfhi(w.x); o[8 * i + 2] += p * bflo(w.y); o[8 * i + 3] += p * bfhi(w.y); o[8 * i + 4] += p * bflo(w.z); o[8 * i + 5] += p * bfhi(w.z); o[8 * i + 6] += p * bflo(w.w); o[8 * i + 7] += p * bfhi(w.w); }
            }
            const float rl = 1.f / l; v4u* op = (v4u*)(mix + (size_t)grow * DM + h * 64);
#pragma unroll
            for (int i = 0; i < 8; ++i) { v4u w; w.x = pk2(o[8 * i] * rl, o[8 * i + 1] * rl); w.y = pk2(o[8 * i + 2] * rl, o[8 * i + 3] * rl); w.z = pk2(o[8 * i + 4] * rl, o[8 * i + 5] * rl); w.w = pk2(o[8 * i + 6] * rl, o[8 * i + 7] * rl); op[i] = w; }
        }
        __syncthreads();
        LAS bf16* vnl = (LAS bf16*)C.lds;
        for (int i = 0; i < 16; ++i) { const int tl = C.wave * 16 + i, grow = row0 + tl;
            const v4u w = *(const v4u*)(proj + (size_t)grow * EVEN_IN + 1280 + C.lane * 8);
            float x[8] = {bflo(w.x), bfhi(w.x), bflo(w.y), bfhi(w.y), bflo(w.z), bfhi(w.z), bflo(w.w), bfhi(w.w)};
            float s = 0.f;
#pragma unroll
            for (int j = 0; j < 8; ++j) s += x[j];
            const float mu = wave_sum(s) * (1.f / 512.f); float qq = 0.f;
#pragma unroll
            for (int j = 0; j < 8; ++j) { x[j] -= mu; qq += x[j] * x[j]; }
            const float rstd = rsqrt_f(wave_sum(qq) * (1.f / 512.f) + NORM_EPS);
            const f32x4 g0 = ((const f32x4*)ln_g)[C.lane * 2], g1 = ((const f32x4*)ln_g)[C.lane * 2 + 1], b0 = ((const f32x4*)ln_b)[C.lane * 2], b1 = ((const f32x4*)ln_b)[C.lane * 2 + 1];
            v4u ov; ov.x = pk2(x[0] * rstd * g0.x + b0.x, x[1] * rstd * g0.y + b0.y); ov.y = pk2(x[2] * rstd * g0.z + b0.z, x[3] * rstd * g0.w + b0.w);
            ov.z = pk2(x[4] * rstd * g1.x + b1.x, x[5] * rstd * g1.y + b1.y); ov.w = pk2(x[6] * rstd * g1.z + b1.z, x[7] * rstd * g1.w + b1.w);
            *(LAS v4u*)(vnl + tl * 512 + C.lane * 8) = ov; }
        __syncthreads();
        { const int c = C.tid, g = C.wave;
          for (int t = 0; t < 128; ++t) { const float* wrow = w_s + (size_t)(g * 128 + t) * 128; float s = 0.f;
              for (int sp = 0; sp <= t; ++sp) s += wrow[sp] * bf2f(vnl[sp * 512 + c]);
              s += b_s[g * 128 + t];
              const float uu = bf2f(proj[(size_t)(row0 + t) * EVEN_IN + 768 + c]);
              mix[(size_t)(row0 + t) * DM + 512 + c] = (bf16)(pk2(uu * s, 0.f) & 0xffffu); } }
        __syncthreads();
    }
}

__device__ __forceinline__ void odd_pre(const Ctx& C, const bf16* proj, const float* conv_w, const float* qn_g, const float* kvn_g, const float* ctab, const float* stab,
                                        bf16* mix, bf16* qn, bf16* kvn, bf16* kpe) {
    for (int m = C.gw; m < NTOK; m += C.NGW) {
        const int pos = m & (SEQ - 1); const bf16* pr = proj + (size_t)m * ODD_IN_PAD; const int c0 = C.lane * 8;
        float y[8];
#pragma unroll
        for (int j = 0; j < 8; ++j) y[j] = 0.f;
#pragma unroll
        for (int jj = 0; jj < 3; ++jj) { const int dt = 2 - jj;
            if (pos >= dt) { const bf16* p2 = pr - (size_t)dt * ODD_IN_PAD; const v4u a = *(const v4u*)(p2 + 512 + c0), x = *(const v4u*)(p2 + 1024 + c0);
                const f32x4 w0 = *(const f32x4*)(conv_w + jj * 512 + c0), w1 = *(const f32x4*)(conv_w + jj * 512 + c0 + 4);
                y[0] += w0.x * bflo(a.x) * bflo(x.x); y[1] += w0.y * bfhi(a.x) * bfhi(x.x); y[2] += w0.z * bflo(a.y) * bflo(x.y); y[3] += w0.w * bfhi(a.y) * bfhi(x.y);
                y[4] += w1.x * bflo(a.z) * bflo(x.z); y[5] += w1.y * bfhi(a.z) * bfhi(x.z); y[6] += w1.z * bflo(a.w) * bflo(x.w); y[7] += w1.w * bfhi(a.w) * bfhi(x.w); } }
        { const v4u gb = *(const v4u*)(pr + c0); v4u o; o.x = pk2(y[0] * bflo(gb.x), y[1] * bfhi(gb.x)); o.y = pk2(y[2] * bflo(gb.y), y[3] * bfhi(gb.y)); o.z = pk2(y[4] * bflo(gb.z), y[5] * bfhi(gb.z)); o.w = pk2(y[6] * bflo(gb.w), y[7] * bfhi(gb.w));
          *(v4u*)(mix + (size_t)m * DM + c0) = o; }
        { const v4u w = *(const v4u*)(pr + 1536 + c0); const float x[8] = {bflo(w.x), bfhi(w.x), bflo(w.y), bfhi(w.y), bflo(w.z), bfhi(w.z), bflo(w.w), bfhi(w.w)};
          float s = 0.f;
#pragma unroll
          for (int j = 0; j < 8; ++j) s += x[j] * x[j];
          const float r = rsqrt_f(wave_sum(s) * (1.f / 512.f) + NORM_EPS);
          const f32x4 g0 = *(const f32x4*)(qn_g + c0), g1 = *(const f32x4*)(qn_g + c0 + 4);
          v4u o; o.x = pk2(x[0] * r * g0.x, x[1] * r * g0.y); o.y = pk2(x[2] * r * g0.z, x[3] * r * g0.w); o.z = pk2(x[4] * r * g1.x, x[5] * r * g1.y); o.w = pk2(x[6] * r * g1.z, x[7] * r * g1.w);
          *(v4u*)(qn + (size_t)m * 512 + c0) = o; }
        { const v2u w = *(const v2u*)(pr + 2048 + C.lane * 4); const float x[4] = {bflo(w.x), bfhi(w.x), bflo(w.y), bfhi(w.y)};
          const float s = (x[0] * x[0] + x[1] * x[1]) + (x[2] * x[2] + x[3] * x[3]);
          const float r = rsqrt_f(wave_sum(s) * (1.f / 256.f) + NORM_EPS);
          const f32x4 g0 = *(const f32x4*)(kvn_g + C.lane * 4);
          v2u o; o.x = pk2(x[0] * r * g0.x, x[1] * r * g0.y); o.y = pk2(x[2] * r * g0.z, x[3] * r * g0.w);
          *(v2u*)(kvn + (size_t)m * 256 + C.lane * 4) = o; }
        if (C.lane < 16) { const unsigned w = *(const unsigned*)(pr + 2304 + 2 * C.lane); const float x1 = bflo(w), x2 = bfhi(w), cs = ctab[pos * 16 + C.lane], sn = stab[pos * 16 + C.lane];
            *(unsigned*)(kpe + (size_t)m * 32 + 2 * C.lane) = pk2(x1 * cs - x2 * sn, x1 * sn + x2 * cs); }
    }
}

__device__ __forceinline__ void mla_simple(const Ctx& C, const bf16* q, const bf16* kv, const bf16* kpe, bf16* mix) {
    for (int task = C.gw; task < 2048; task += C.NGW) {
        const int bh = task >> 6, pr = task & 63, b = bh >> 3, h = bh & 7;
        for (int half = 0; half < 2; ++half) {
            const int tb = half ? 127 - pr : pr, t = tb * 64 + C.lane; const size_t grow = (size_t)b * SEQ + t;
            float qv[96];
            { const v4u* qp = (const v4u*)(q + grow * 768 + h * 96);
#pragma unroll
              for (int i = 0; i < 12; ++i) { const v4u w = qp[i]; qv[8 * i] = bflo(w.x); qv[8 * i + 1] = bfhi(w.x); qv[8 * i + 2] = bflo(w.y); qv[8 * i + 3] = bfhi(w.y); qv[8 * i + 4] = bflo(w.z); qv[8 * i + 5] = bfhi(w.z); qv[8 * i + 6] = bflo(w.w); qv[8 * i + 7] = bfhi(w.w); } }
            float m = -INFINITY, l = 0.f, o[64];
#pragma unroll
            for (int d = 0; d < 64; ++d) o[d] = 0.f;
            const int kend = tb * 64 + 63;
            for (int kk = 0; kk <= kend; ++kk) {
                const size_t krow = (size_t)b * SEQ + kk;
                const v4u* kp = (const v4u*)(kv + krow * 1024 + h * 128); const v4u* pp = (const v4u*)(kpe + krow * 32);
                float s = 0.f;
#pragma unroll
                for (int i = 0; i < 8; ++i) { const v4u w = kp[i]; s += qv[8 * i] * bflo(w.x) + qv[8 * i + 1] * bfhi(w.x) + qv[8 * i + 2] * bflo(w.y) + qv[8 * i + 3] * bfhi(w.y) + qv[8 * i + 4] * bflo(w.z) + qv[8 * i + 5] * bfhi(w.z) + qv[8 * i + 6] * bflo(w.w) + qv[8 * i + 7] * bfhi(w.w); }
#pragma unroll
                for (int i = 0; i < 4; ++i) { const v4u w = pp[i]; s += qv[64 + 8 * i] * bflo(w.x) + qv[64 + 8 * i + 1] * bfhi(w.x) + qv[64 + 8 * i + 2] * bflo(w.y) + qv[64 + 8 * i + 3] * bfhi(w.y) + qv[64 + 8 * i + 4] * bflo(w.z) + qv[64 + 8 * i + 5] * bfhi(w.z) + qv[64 + 8 * i + 6] * bflo(w.w) + qv[64 + 8 * i + 7] * bfhi(w.w); }
                const bool valid = kk <= t;
                if (valid && s > m) { const float corr = exp2f(m - s); l *= corr;
#pragma unroll
                    for (int d = 0; d < 64; ++d) o[d] *= corr;
                    m = s; }
                const float p = valid ? exp2f(s - m) : 0.f; l += p;
#pragma unroll
                for (int i = 0; i < 8; ++i) { const v4u w = kp[8 + i]; o[8 * i] += p * bflo(w.x); o[8 * i + 1] += p * bfhi(w.x); o[8 * i + 2] += p * bflo(w.y); o[8 * i + 3] += p * bfhi(w.y); o[8 * i + 4] += p * bflo(w.z); o[8 * i + 5] += p * bfhi(w.z); o[8 * i + 6] += p * bflo(w.w); o[8 * i + 7] += p * bfhi(w.w); }
            }
            const float rl = 1.f / l; v4u* op = (v4u*)(mix + grow * DM + 512 + h * 64);
#pragma unroll
            for (int i = 0; i < 8; ++i) { v4u w; w.x = pk2(o[8 * i] * rl, o[8 * i + 1] * rl); w.y = pk2(o[8 * i + 2] * rl, o[8 * i + 3] * rl); w.z = pk2(o[8 * i + 4] * rl, o[8 * i + 5] * rl); w.w = pk2(o[8 * i + 6] * rl, o[8 * i + 7] * rl); op[i] = w; }
        }
    }
}

__device__ __forceinline__ void modulate_route(const Ctx& C, const float* h, const float* g, const float* shift, const float* scale, const float* rw, const float* rb,
                                               bf16* hn, int* tok_e, float* tok_g, unsigned* counts) {
    volatile LAS unsigned* hist = (volatile LAS unsigned*)(C.lds + LDSCTL_OFF);
    f32x4 w[4][4][2];
#pragma unroll
    for (int j = 0; j < 4; ++j)
#pragma unroll
        for (int k = 0; k < 4; ++k) { const float* p = rw + (size_t)(256 * j + 4 * C.lane + k) * 8; w[j][k][0] = *(const f32x4*)p; w[j][k][1] = *(const f32x4*)(p + 4); }
    unsigned my0 = 0u;
    for (int m = C.gw; m < NTOK; m += C.NGW) {
        const int b = m >> 13;
        const f32x4* xr = (const f32x4*)(h + (size_t)m * DM) + C.lane;
        f32x4 v[4]; float s = 0.f;
#pragma unroll
        for (int j = 0; j < 4; ++j) { v[j] = xr[64 * j]; s += (v[j].x * v[j].x + v[j].y * v[j].y) + (v[j].z * v[j].z + v[j].w * v[j].w); }
        const float r = rsqrt_f(wave_sum(s) * (1.f / DM) + NORM_EPS);
        v2u* o8 = (v2u*)(hn + (size_t)m * DM) + C.lane;
        f32x4 la = (f32x4){0.f, 0.f, 0.f, 0.f}, lb = (f32x4){0.f, 0.f, 0.f, 0.f};
#pragma unroll
        for (int j = 0; j < 4; ++j) { const f32x4 gg = ((const f32x4*)g)[64 * j + C.lane], sc = ((const f32x4*)(scale + (size_t)b * ADA))[64 * j + C.lane], sh = ((const f32x4*)(shift + (size_t)b * ADA))[64 * j + C.lane];
            const f32x4 o = (v[j] * r) * gg * (sc + 1.0f) + sh; v2u wv; wv.x = pk2(o.x, o.y); wv.y = pk2(o.z, o.w); o8[64 * j] = wv;
            la += w[j][0][0] * o.x + w[j][1][0] * o.y + w[j][2][0] * o.z + w[j][3][0] * o.w; lb += w[j][0][1] * o.x + w[j][1][1] * o.y + w[j][2][1] * o.z + w[j][3][1] * o.w; }
        float lg[8] = {la.x, la.y, la.z, la.w, lb.x, lb.y, lb.z, lb.w};
#pragma unroll
        for (int e = 0; e < 8; ++e) lg[e] = wave_sum(lg[e]) + rb[e];
        int e0 = 0; float v0 = lg[0];
#pragma unroll
        for (int e = 1; e < 8; ++e) if (lg[e] > v0) { v0 = lg[e]; e0 = e; }
        int e1 = -1; float v1 = -INFINITY;
#pragma unroll
        for (int e = 0; e < 8; ++e) if (e != e0 && lg[e] > v1) { v1 = lg[e]; e1 = e; }
        const float p1 = __expf(v1 - v0), g0 = 1.f / (1.f + p1), g1 = p1 * g0;
        if (C.lane == 0) { tok_e[2 * m] = e0; tok_e[2 * m + 1] = e1; tok_g[2 * m] = g0; tok_g[2 * m + 1] = g1;
            __hip_atomic_fetch_add((LAS unsigned*)&hist[e0], 1u, __ATOMIC_RELAXED, __HIP_MEMORY_SCOPE_WORKGROUP); __hip_atomic_fetch_add((LAS unsigned*)&hist[e1], 1u, __ATOMIC_RELAXED, __HIP_MEMORY_SCOPE_WORKGROUP); }
    }
    (void)my0;
    LDS_WAIT(); __syncthreads();
    if (C.tid < 8) { const unsigned n = hist[C.tid]; if (n) __hip_atomic_fetch_add(counts + 64 * C.tid, n, __ATOMIC_RELAXED, __HIP_MEMORY_SCOPE_AGENT); }
    __syncthreads();
}

__device__ __forceinline__ void moe_pstart(const unsigned* counts, int (&pstart)[8], int (&pend)[8]) {
    int acc = 0;
#pragma unroll
    for (int e = 0; e < 8; ++e) { const int n = (int)__hip_atomic_load(counts + 64 * e, __ATOMIC_RELAXED, __HIP_MEMORY_SCOPE_AGENT); pstart[e] = acc; acc += (n + 255) >> 8; pend[e] = acc; }
}
__device__ __forceinline__ void moe_gather(const Ctx& C, const bf16* hn, const int* tok_e, const unsigned* counts, unsigned* cursor, int* tok_slot, bf16* xs, int* pexp) {
    int pstart[8], pend[8]; moe_pstart(counts, pstart, pend);
    if (blockIdx.x == 0 && C.tid < 273) { int e = 0;
#pragma unroll
        for (int k = 0; k < 7; ++k) e += (C.tid >= pend[k]) ? 1 : 0;
        pexp[C.tid] = (C.tid == 272) ? pend[7] : e; }
    for (int task = C.gw; task < NTOK / 16; task += C.NGW) {
        const int tok = task * 16 + (C.lane & 15); const bool act = C.lane < 16;
        const int e0 = act ? tok_e[2 * tok] : -1, e1 = act ? tok_e[2 * tok + 1] : -2;
        int s0 = 0, s1 = 0;
        const unsigned long long lt = (1ull << C.lane) - 1ull;
#pragma unroll
        for (int e = 0; e < 8; ++e) { const unsigned long long m0 = __ballot(e0 == e), m1 = __ballot(e1 == e); const int n0 = __popcll(m0), n1 = __popcll(m1);
            unsigned base = 0u; if (C.lane == 0 && (n0 + n1) > 0) base = __hip_atomic_fetch_add(cursor + 64 * e, (unsigned)(n0 + n1), __ATOMIC_RELAXED, __HIP_MEMORY_SCOPE_AGENT);
            base = (unsigned)__builtin_amdgcn_readfirstlane((int)base) + (unsigned)pstart[e] * 256u;
            if (e0 == e) s0 = (int)base + __popcll(m0 & lt); if (e1 == e) s1 = (int)base + n0 + __popcll(m1 & lt); }
        if (act) { tok_slot[2 * tok] = s0; tok_slot[2 * tok + 1] = s1; }
#pragma unroll 4
        for (int i = 0; i < 16; ++i) { const int d0 = __shfl(s0, i), d1 = __shfl(s1, i);
            const v4u* src = (const v4u*)(hn + (size_t)(task * 16 + i) * DM) + C.lane; const v4u a = src[0], bq = src[64];
            v4u* p0 = (v4u*)(xs + (size_t)d0 * DM) + C.lane; v4u* p1 = (v4u*)(xs + (size_t)d1 * DM) + C.lane; p0[0] = a; p0[64] = bq; p1[0] = a; p1[64] = bq; }
    }
}

__device__ __forceinline__ void final_rows(const Ctx& C, float* hio, const bf16* y, const int* tok_slot, const float* tok_g, const float* gate, const float* fin_g) {
    for (int m = C.gw; m < NTOK; m += C.NGW) {
        const int b = m >> 13; const int s0 = tok_slot[2 * m], s1 = tok_slot[2 * m + 1]; const float g0 = tok_g[2 * m], g1 = tok_g[2 * m + 1];
        f32x4* xr = (f32x4*)(hio + (size_t)m * DM) + C.lane; const v2u* y0 = (const v2u*)(y + (size_t)s0 * DM) + C.lane; const v2u* y1 = (const v2u*)(y + (size_t)s1 * DM) + C.lane;
        f32x4 v[4]; float s = 0.f;
#pragma unroll
        for (int j = 0; j < 4; ++j) { const f32x4 hv = xr[64 * j]; const v2u a = y0[64 * j], c = y1[64 * j]; const f32x4 gt = ((const f32x4*)(gate + (size_t)b * ADA))[64 * j + C.lane];
            f32x4 mo; mo.x = g0 * bflo(a.x) + g1 * bflo(c.x); mo.y = g0 * bfhi(a.x) + g1 * bfhi(c.x); mo.z = g0 * bflo(a.y) + g1 * bflo(c.y); mo.w = g0 * bfhi(a.y) + g1 * bfhi(c.y);
            v[j] = hv + gt * mo; s += (v[j].x * v[j].x + v[j].y * v[j].y) + (v[j].z * v[j].z + v[j].w * v[j].w); }
        const float r = rsqrt_f(wave_sum(s) * (1.f / DM) + NORM_EPS);
#pragma unroll
        for (int j = 0; j < 4; ++j) xr[64 * j] = (v[j] * r) * ((const f32x4*)fin_g)[64 * j + C.lane];
    }
}

struct Args { In in; float* out; unsigned char* ws; int ph_lo, ph_hi; };
__global__ void __launch_bounds__(NWAVES * 64, 2) fwd(Args args) {
    extern __shared__ __attribute__((aligned(16))) unsigned char lds_raw[];
#define MKCTX() Ctx C; { int t_ = threadIdx.x; asm volatile("" : "+v"(t_)); C.lds = (LAS unsigned char*)lds_raw; C.tid = t_; C.lane = t_ & 63; C.wave = __builtin_amdgcn_readfirstlane(t_ >> 6); \
        C.G = gridDim.x; const int bx_ = blockIdx.x; C.vcu = (C.G % 8 == 0) ? (bx_ % 8) * (C.G / 8) + bx_ / 8 : bx_; C.gw = C.vcu * NWAVES + C.wave; C.NGW = C.G * NWAVES; }
    LAS unsigned char* const lds0 = (LAS unsigned char*)lds_raw;
    unsigned char* ws = args.ws; const In& I = args.in;
    unsigned* ctl = (unsigned*)(ws + WS_CTL);
    for (int u = threadIdx.x; u < (LDS_BYTES - LDSCTL_OFF) / 4; u += NWAVES * 64) ((LAS unsigned*)(lds0 + LDSCTL_OFF))[u] = 0u;
    __syncthreads();
    XcdBarrier bar; bar.bar = ctl + CW_BAR; bar.x = 0; bar.st = nullptr;
    if (!MK_PER_PHASE) bar = xcd_barrier_post(ctl + CW_BAR, (volatile LAS unsigned*)(lds0 + MISC_OFF) + 8);
    const int lo = args.ph_lo, hi = args.ph_hi;
#define IN(k) (lo <= (k) && (k) < hi)
#define SEAM(k) do { if (!MK_PER_PHASE && IN(k) && IN((k) + 1)) xcd_barrier(bar); } while (0)

    float* const hbuf = args.out;
    const float* mod0 = (const float*)(ws + WS_MOD); const float* mod1 = mod0 + BATCH * ADA;
    bf16* const HN = (bf16*)(ws + WS_HN); bf16* const PROJ = (bf16*)(ws + WS_PROJ); bf16* const MIX0 = (bf16*)(ws + WS_MIX0); bf16* const ACT = (bf16*)(ws + WS_ACT);
    bf16* const QN = (bf16*)(ws + WS_QN); bf16* const KVN = (bf16*)(ws + WS_KVN); bf16* const KPE = (bf16*)(ws + WS_KPE); bf16* const MIX1 = (bf16*)(ws + WS_MIX1);
    bf16* const Q = (bf16*)(ws + WS_Q); bf16* const KV = (bf16*)(ws + WS_KV); bf16* const HN2 = (bf16*)(ws + WS_HN2); bf16* const XS = (bf16*)(ws + WS_XS); bf16* const ACTE = (bf16*)(ws + WS_ACTE);
    const float* ctab = (const float*)(ws + WS_ROPEC); const float* stab = (const float*)(ws + WS_ROPES);
    int* const pexp = (int*)(ws + WS_PEXP); int* tok_e = (int*)(ws + WS_TOKE); float* tok_g = (float*)(ws + WS_TOKG); int* tok_slot = (int*)(ws + WS_TOKS);

    if (IN(0)) { MKCTX(); p0_prologue(C, I, ws); } SEAM(0);
    if (IN(1)) { MKCTX(); modulate_rows(C, I.x, I.e_nmix_g, mod0 + 0 * DM, mod0 + 1 * DM, HN); } SEAM(1);
    if (IN(2)) { MKCTX(); pg8::Gemm g{HN, (const bf16*)(ws + WS_WIN0), NTOK, EVEN_IN, DM}; pg8::StaticOrder S; S.init(NTOK, EVEN_IN, C.G, (int)blockIdx.x);
        pg8::EpiProj0 E{PROJ, EVEN_IN, QS_EVEN}; pg8::gemm_phase<pg8::EpiProj0, pg8::StaticOrder, true, true>(C.lds, g, S, E); } SEAM(2);
    if (IN(3)) { MKCTX(); even_mixer_simple(C, PROJ, I.e_sinks, I.e_ln_g, I.e_ln_b, I.e_w_s, I.e_b_s, MIX0); } SEAM(3);
    if (IN(4)) { MKCTX(); pg8::Gemm g{MIX0, (const bf16*)(ws + WS_WO0), NTOK, DM, DM}; pg8::StaticOrder S; S.init(NTOK, DM, C.G, (int)blockIdx.x);
        pg8::EpiResGate E{I.x, hbuf, DM, mod0 + 2 * DM, ADA, SEQ}; pg8::gemm_phase<pg8::EpiResGate, pg8::StaticOrder, true, true>(C.lds, g, S, E); } SEAM(4);
    if (IN(5)) { MKCTX(); modulate_rows(C, hbuf, I.e_nffn_g, mod0 + 3 * DM, mod0 + 4 * DM, HN); } SEAM(5);
    if (IN(6)) { MKCTX(); pg8::Gemm g{HN, (const bf16*)(ws + WS_WGU0), NTOK, 2 * FF, DM}; pg8::StaticOrder S; S.init(NTOK, 2 * FF, C.G, (int)blockIdx.x);
        pg8::EpiSwiGLU E{ACT, FF}; pg8::gemm_phase<pg8::EpiSwiGLU, pg8::StaticOrder, true, true>(C.lds, g, S, E); } SEAM(6);
    if (IN(7)) { MKCTX(); pg8::Gemm g{ACT, (const bf16*)(ws + WS_WD0), NTOK, DM, FF}; pg8::StaticOrder S; S.init(NTOK, DM, C.G, (int)blockIdx.x);
        pg8::EpiResGate E{hbuf, hbuf, DM, mod0 + 5 * DM, ADA, SEQ}; pg8::gemm_phase<pg8::EpiResGate, pg8::StaticOrder, true, true>(C.lds, g, S, E); } SEAM(7);
    if (IN(8)) { MKCTX(); modulate_rows(C, hbuf, I.o_nmix_g, mod1 + 0 * DM, mod1 + 1 * DM, HN); } SEAM(8);
    if (IN(9)) { MKCTX(); pg8::Gemm g{HN, (const bf16*)(ws + WS_WIN1), NTOK, ODD_IN_PAD, DM}; pg8::StaticOrder S; S.init(NTOK, ODD_IN_PAD, C.G, (int)blockIdx.x);
        pg8::EpiBf16Plain E{PROJ, ODD_IN_PAD}; pg8::gemm_phase<pg8::EpiBf16Plain, pg8::StaticOrder, true, true>(C.lds, g, S, E); } SEAM(9);
    if (IN(10)) { MKCTX(); odd_pre(C, PROJ, I.o_conv_w, I.o_qn_g, I.o_kvn_g, ctab, stab, MIX1, QN, KVN, KPE); } SEAM(10);
    if (IN(11)) { MKCTX();
        { pg8::Gemm g{QN, (const bf16*)(ws + WS_WQB), NTOK, 768, 512}; pg8::StaticOrder S; S.init(NTOK, 768, C.G, (int)blockIdx.x);
          pg8::EpiQRope E{Q, 768, ctab, stab, QS_ODD, SEQ - 1}; pg8::gemm_phase<pg8::EpiQRope, pg8::StaticOrder, true, true>(C.lds, g, S, E); }
        { pg8::Gemm g{KVN, (const bf16*)(ws + WS_WKVB), NTOK, 1024, 256}; pg8::StaticOrder S; S.init(NTOK, 1024, C.G, (int)blockIdx.x);
          pg8::EpiBf16Plain E{KV, 1024}; pg8::gemm_phase<pg8::EpiBf16Plain, pg8::StaticOrder, true, true>(C.lds, g, S, E); }
    } SEAM(11);
    if (IN(12)) { MKCTX(); mla_simple(C, Q, KV, KPE, MIX1); } SEAM(12);
    if (IN(13)) { MKCTX(); pg8::Gemm g{MIX1, (const bf16*)(ws + WS_WO1), NTOK, DM, DM}; pg8::StaticOrder S; S.init(NTOK, DM, C.G, (int)blockIdx.x);
        pg8::EpiResGate E{hbuf, hbuf, DM, mod1 + 2 * DM, ADA, SEQ}; pg8::gemm_phase<pg8::EpiResGate, pg8::StaticOrder, true, true>(C.lds, g, S, E); } SEAM(13);
    if (IN(14)) { MKCTX(); modulate_route(C, hbuf, I.o_nffn_g, mod1 + 3 * DM, mod1 + 4 * DM, I.o_rw, I.o_rb, HN2, tok_e, tok_g, ctl + CW_CNT); } SEAM(14);
    if (IN(15)) { MKCTX(); moe_gather(C, HN2, tok_e, ctl + CW_CNT, ctl + CW_CUR, tok_slot, XS, pexp); } SEAM(15);
#pragma unroll 1
    for (int ch = 0; ch < 2; ++ch) {
        if (IN(16 + 2 * ch)) { MKCTX();
            const int P = __builtin_amdgcn_readfirstlane(pexp[272]); const int np = ch ? (P - MOE_CH0 > 0 ? P - MOE_CH0 : 0) : (P < MOE_CH0 ? P : MOE_CH0);
            pg8::MoeOrder<28, false> S{C.G, C.vcu, ch * MOE_CH0, np * 28, pexp};
            pg8::Gemm g{XS, (const bf16*)(ws + WS_WEGU), 0, 0, DM};
            pg8::EpiSwiGLU E{ACTE, FFE}; pg8::gemm_phase<pg8::EpiSwiGLU, pg8::MoeOrder<28, false>, true, true>(C.lds, g, S, E);
        } SEAM(16 + 2 * ch);
        if (IN(17 + 2 * ch)) { MKCTX();
            const int P = __builtin_amdgcn_readfirstlane(pexp[272]); const int np = ch ? (P - MOE_CH0 > 0 ? P - MOE_CH0 : 0) : (P < MOE_CH0 ? P : MOE_CH0);
            pg8::MoeOrder<4, true> S{C.G, C.vcu, ch * MOE_CH0, np * 4, pexp};
            pg8::Gemm g{ACTE, (const bf16*)(ws + WS_WED), 0, 0, FFE};
            pg8::EpiBf16Plain E{XS, DM}; pg8::gemm_phase<pg8::EpiBf16Plain, pg8::MoeOrder<4, true>, true, true>(C.lds, g, S, E);
        } SEAM(17 + 2 * ch);
    }
    if (IN(20)) { MKCTX(); final_rows(C, hbuf, XS, tok_slot, tok_g, mod1 + 5 * DM, I.fin_g); }
#undef IN
#undef SEAM
}

extern "C" void kernel_launch(void* const* d_in, const int* in_sizes, int n_in, void* d_out, int out_size, void* d_ws, size_t ws_size, hipStream_t stream) {
    static int grid = 0;
    if (grid == 0) {
        if (n_in != 33 || in_sizes[0] != NTOK * DM || out_size != NTOK * DM || ws_size < WS_END) { fprintf(stderr, "kernel_launch: unexpected shapes (n_in %d, in0 %d, out %d, ws %zu < %zu); nothing launched\n", n_in, n_in > 0 ? in_sizes[0] : -1, out_size, ws_size, (size_t)WS_END); grid = -1; return; }
        int dev = 0, cus = 0, per_cu = 0;
        if (hipGetDevice(&dev) != hipSuccess || hipDeviceGetAttribute(&cus, hipDeviceAttributeMultiprocessorCount, dev) != hipSuccess) { grid = -1; return; }
        if (hipFuncSetAttribute((const void*)fwd, hipFuncAttributeMaxDynamicSharedMemorySize, LDS_BYTES) != hipSuccess) { fprintf(stderr, "kernel_launch: hipFuncSetAttribute failed\n"); grid = -1; return; }
        if (hipOccupancyMaxActiveBlocksPerMultiprocessor(&per_cu, (const void*)fwd, NWAVES * 64, LDS_BYTES) != hipSuccess || per_cu < 1) fprintf(stderr, "kernel_launch: occupancy query reports %d\n", per_cu);
        (void)hipGetLastError();
        grid = cus;
    }
    if (grid < 0) return;
    if (hipMemsetAsync((char*)d_ws + WS_CTL, 0, CTL_ZERO_BYTES, stream) != hipSuccess) return;
    Args a{};
    const float** ip = (const float**)&a.in;
    for (int i = 0; i < 33; ++i) ip[i] = (const float*)d_in[i];
    a.out = (float*)d_out; a.ws = (unsigned char*)d_ws;
#if MK_PER_PHASE
    for (int p = 0; p < NPH; ++p) { a.ph_lo = p; a.ph_hi = p + 1; hipLaunchKernelGGL(fwd, dim3(grid), dim3(NWAVES * 64), LDS_BYTES, stream, a); }
#else
    a.ph_lo = 0; a.ph_hi = NPH; hipLaunchKernelGGL(fwd, dim3(grid), dim3(NWAVES * 64), LDS_BYTES, stream, a);
#endif
}
```

```cpp
#include <hip/hip_runtime.h>
#include <cstdio>
#include <cstdint>
#include <cmath>
__device__ __forceinline__ int tid_from_wave(int wave) { unsigned l_; asm volatile("v_mbcnt_lo_u32_b32 %0, -1, 0\n\tv_mbcnt_hi_u32_b32 %0, -1, %0" : "=v"(l_)); return wave * 64 + (int)l_; }
namespace pg8 {
#define PG8_LAS __attribute__((address_space(3)))
typedef unsigned short bf16_t;
typedef short bf16x8 __attribute__((ext_vector_type(8)));
typedef float f32x4 __attribute__((ext_vector_type(4)));
typedef unsigned u32x4 __attribute__((ext_vector_type(4)));
typedef int v8i_t __attribute__((ext_vector_type(8)));
typedef int v4i_t __attribute__((ext_vector_type(4)));
typedef unsigned u32x2 __attribute__((ext_vector_type(2)));
constexpr int BM = 256, BK = 64, HALF = 128, HTB = HALF * BK * 2  , STAGE_BYTES = 8 * HTB, NXCD = 8, WGM = 8;

__host__ __device__ __forceinline__ int lds_byte(int r, int c) { const int st = (r >> 4) * 2 + (c >> 5), rr = r & 15, cc = c & 31, ob = rr * 64 + cc * 2; return st * 1024 + (ob ^ (((ob >> 9) & 1) << 5)); }
__host__ __device__ __forceinline__ void stage_rc(int b, int& R, int& C) { const int st = b / 1024, sb = b % 1024, swz = sb ^ (((sb >> 9) & 1) << 5); R = (st >> 1) * 16 + swz / 64; C = (st & 1) * 32 + (swz % 64) / 2; }
__host__ __device__ __forceinline__ int perm32(int rho) { const int n = rho >> 4, i = rho & 15; return 8 * (i >> 2) + 4 * n + (i & 3); }

struct Unit { int pm, pn, pb, po; };
struct Gemm { const bf16_t* A; const bf16_t* Bt; int M, N, K; };

struct StaticOrder {
    int nM, nN, nwg, G, c;
    __host__ __device__ void init(int M, int N, int G_, int c_) { nM = M / BM; nN = N / BM; nwg = nM * nN; G = G_; c = c_; }
    __host__ __device__ bool next(int i, Unit& u) const {
        const long L = (long)i * G + c; if (L >= nwg) return false;
        int wgid = (int)L; { const int q = nwg / NXCD, r = nwg % NXCD, xcd = wgid % NXCD, off = wgid / NXCD; wgid = (xcd < r ? xcd * (q + 1) : r * (q + 1) + (xcd - r) * q) + off; }
        const int nig = WGM * nN, gid = wgid / nig, fm = gid * WGM, gsz = (nM - fm) < WGM ? (nM - fm) : WGM;
        u.pm = fm + ((wgid % nig) % gsz); u.pn = (wgid % nig) / gsz; u.pb = u.pn; u.po = u.pm; return true;
    }
    __device__ __forceinline__ void a_ready(const Unit&) const {}
    __device__ __forceinline__ void done(const Unit&) const {}
};
template <int NT, bool A_REL> struct MoeOrder {
    int G, c, p0, nunits; const int* pexp; int l0;
    __device__ __forceinline__ bool next(int i, Unit& u) const {
        const int L = l0 + i * G + c; if (L >= nunits) return false;
        const int pl = L / NT, n = L - pl * NT, p = p0 + pl;
        const int e = __builtin_amdgcn_readfirstlane(pexp[p]);
        u.pm = A_REL ? pl : p; u.po = A_REL ? p : pl; u.pn = n; u.pb = e * NT + n; return true;
    }
    __device__ __forceinline__ void a_ready(const Unit&) const {}
    __device__ __forceinline__ void done(const Unit&) const {}
};

__device__ __forceinline__ unsigned cvt_pk_bf16(float lo, float hi) { unsigned r; asm volatile("v_cvt_pk_bf16_f32 %0, %1, %2" : "=v"(r) : "v"(lo), "v"(hi)); return r; }
typedef float f32x2 __attribute__((ext_vector_type(2)));
__device__ __forceinline__ f32x2 gelu_pk(f32x2 v) {
    const f32x2 av = __builtin_elementwise_abs(v), d = av * 0.2316418882f + 1.0f;
    f32x2 t; t.x = __builtin_amdgcn_rcpf(d.x); t.y = __builtin_amdgcn_rcpf(d.y);
    f32x2 q = t * 0.5307027145f + (-0.7265760135f); q = q * t + 0.7107068705f; q = q * t + (-0.142248368f); q = q * t + 0.127414796f; q = q * t;
    const f32x2 s = (v * v) * (-0.72134752044f);
    f32x2 e; e.x = __builtin_amdgcn_exp2f(s.x); e.y = __builtin_amdgcn_exp2f(s.y);
    const f32x2 m = v * (q * e), r = v - m;
    f32x2 o; o.x = v.x < 0.f ? m.x : r.x; o.y = v.y < 0.f ? m.y : r.y; return o;
}
__device__ __forceinline__ f32x4 gelu4(f32x4 v) { const f32x2 a = gelu_pk((f32x2){v[0], v[1]}), b = gelu_pk((f32x2){v[2], v[3]}); return (f32x4){a.x, a.y, b.x, b.y}; }
__device__ __forceinline__ float silu1(float x) { return x * __builtin_amdgcn_rcpf(1.0f + __builtin_amdgcn_exp2f(-1.4426950408889634f * x)); }
__device__ __forceinline__ u32x4 pack8(f32x4 v0, f32x4 v1) { u32x4 w; w.x = cvt_pk_bf16(v0[0], v0[1]); w.y = cvt_pk_bf16(v0[2], v0[3]); w.z = cvt_pk_bf16(v1[0], v1[1]); w.w = cvt_pk_bf16(v1[2], v1[3]); return w; }

__device__ __forceinline__ f32x2 swiglu_pk(f32x2 g, f32x2 u, float s) {
    const f32x2 t = g * (-1.4426950408889634f * s); f32x2 e; e.x = __builtin_amdgcn_exp2f(t.x); e.y = __builtin_amdgcn_exp2f(t.y);
    const f32x2 d = e + 1.0f; f32x2 r; r.x = __builtin_amdgcn_rcpf(d.x); r.y = __builtin_amdgcn_rcpf(d.y);
    return (g * u) * (r * (s * s));
}
struct EpiNull {
    static constexpr bool PERM = true, AFTER_DRAIN = false;
    __device__ __forceinline__ void operator()(const f32x4 (&acc)[2][2][4][2], const Unit&, int, int, int, int) const {}
};
struct EpiKeep {
    static constexpr bool PERM = true, AFTER_DRAIN = false;
    __device__ __forceinline__ void operator()(const f32x4 (&acc)[2][2][4][2], const Unit&, int, int, int, int) const {
#pragma unroll
        for (int ai = 0; ai < 2; ++ai)
#pragma unroll
            for (int bj = 0; bj < 2; ++bj)
#pragma unroll
                for (int m = 0; m < 4; ++m)
#pragma unroll
                    for (int n = 0; n < 2; ++n) asm volatile("" :: "v"(acc[ai][bj][m][n]));
    }
};
struct EpiBf16Plain {
    static constexpr bool PERM = true, AFTER_DRAIN = false;
    bf16_t* O; int ldc; float scale;
    __device__ __forceinline__ void operator()(const f32x4 (&acc)[2][2][4][2], const Unit& u, int wr, int wc, int fr, int fq) const {
        const int row0 = u.po * BM + wr * 64 + fr, col0 = u.pn * BM + wc * 32 + 8 * fq;
#pragma unroll
        for (int ai = 0; ai < 2; ++ai)
#pragma unroll
            for (int m = 0; m < 4; ++m) { bf16_t* rowp = O + (size_t)(row0 + ai * HALF + m * 16) * ldc + col0;
#pragma unroll
                for (int bj = 0; bj < 2; ++bj) *(u32x4*)(rowp + bj * HALF) = pack8(acc[ai][bj][m][0] * scale, acc[ai][bj][m][1] * scale); }
    }
};
struct EpiProj0 {
    static constexpr bool PERM = true, AFTER_DRAIN = false;
    bf16_t* O; int ldc; float qscale;
    __device__ __forceinline__ void operator()(const f32x4 (&acc)[2][2][4][2], const Unit& u, int wr, int wc, int fr, int fq) const {
        const int row0 = u.po * BM + wr * 64 + fr, col0 = u.pn * BM + wc * 32 + 8 * fq;
        const int mode = u.pn < 2 ? 0 : (u.pn == 2 ? 1 : 2);
#pragma unroll
        for (int ai = 0; ai < 2; ++ai)
#pragma unroll
            for (int m = 0; m < 4; ++m) { bf16_t* rowp = O + (size_t)(row0 + ai * HALF + m * 16) * ldc + col0;
#pragma unroll
                for (int bj = 0; bj < 2; ++bj) { f32x4 v0 = acc[ai][bj][m][0], v1 = acc[ai][bj][m][1];
                    if (mode == 2) { v0 = gelu4(v0); v1 = gelu4(v1); } else if (mode == 0) { v0 = v0 * qscale; v1 = v1 * qscale; }
                    *(u32x4*)(rowp + bj * HALF) = pack8(v0, v1); } }
    }
};
struct EpiResGate {
    static constexpr bool PERM = false, AFTER_DRAIN = false;
    const float* base; float* out; int ldc; const float* gate; int gate_ld; int rows_per_batch;
    __device__ __forceinline__ void operator()(const f32x4 (&acc)[2][2][4][2], const Unit& u, int wr, int wc, int fr, int fq) const {
        const int row0 = u.po * BM + wr * 64 + fr, col0 = u.pn * BM + wc * 32 + 4 * fq;
        const float* gp = gate + (size_t)((u.po * BM) / rows_per_batch) * gate_ld + col0;
        f32x4 gv[2][2];
#pragma unroll
        for (int bj = 0; bj < 2; ++bj)
#pragma unroll
            for (int n = 0; n < 2; ++n) gv[bj][n] = *(const f32x4*)(gp + bj * HALF + n * 16);
#pragma unroll
        for (int ai = 0; ai < 2; ++ai)
#pragma unroll
            for (int m = 0; m < 4; ++m) { const size_t off = (size_t)(row0 + ai * HALF + m * 16) * ldc + col0;
#pragma unroll
                for (int bj = 0; bj < 2; ++bj)
#pragma unroll
                    for (int n = 0; n < 2; ++n) { const f32x4 bs = *(const f32x4*)(base + off + bj * HALF + n * 16); *(f32x4*)(out + off + bj * HALF + n * 16) = bs + gv[bj][n] * acc[ai][bj][m][n]; } }
    }
};
template <bool BASE_F32> struct EpiResGateH {
    static constexpr bool PERM = true, AFTER_DRAIN = false;
    const void* base; bf16_t* out; int ldc; const float* gate; int gate_ld; int rows_per_batch; float ascale;
    __device__ __forceinline__ void operator()(const f32x4 (&acc)[2][2][4][2], const Unit& u, int wr, int wc, int fr, int fq) const {
        const int row0 = u.po * BM + wr * 64 + fr, col0 = u.pn * BM + wc * 32 + 8 * fq;
        const float* gp = gate + (size_t)((u.po * BM) / rows_per_batch) * gate_ld + col0;
        f32x4 gv[2][2];
#pragma unroll
        for (int bj = 0; bj < 2; ++bj)
#pragma unroll
            for (int n = 0; n < 2; ++n) gv[bj][n] = *(const f32x4*)(gp + bj * HALF + n * 4) * ascale;
#pragma unroll
        for (int ai = 0; ai < 2; ++ai) {
            f32x4 bf[BASE_F32 ? 4 : 1][2][2]; u32x4 bh[BASE_F32 ? 1 : 4][2];
#pragma unroll
            for (int m = 0; m < 4; ++m) { const size_t off = (size_t)(row0 + ai * HALF + m * 16) * ldc + col0;
#pragma unroll
                for (int bj = 0; bj < 2; ++bj) {
                    if (BASE_F32) { bf[m][bj][0] = *(const f32x4*)((const float*)base + off + bj * HALF); bf[m][bj][1] = *(const f32x4*)((const float*)base + off + bj * HALF + 4); }
                    else bh[m][bj] = *(const u32x4*)((const bf16_t*)base + off + bj * HALF); } }
            asm volatile("" ::: "memory");
#pragma unroll
            for (int m = 0; m < 4; ++m) { const size_t off = (size_t)(row0 + ai * HALF + m * 16) * ldc + col0;
#pragma unroll
                for (int bj = 0; bj < 2; ++bj) { f32x4 b0, b1;
                    if (BASE_F32) { b0 = bf[m][bj][0]; b1 = bf[m][bj][1]; }
                    else { const u32x4 w = bh[m][bj];
                        b0 = (f32x4){__uint_as_float(w.x << 16), __uint_as_float(w.x & 0xffff0000u), __uint_as_float(w.y << 16), __uint_as_float(w.y & 0xffff0000u)};
                        b1 = (f32x4){__uint_as_float(w.z << 16), __uint_as_float(w.z & 0xffff0000u), __uint_as_float(w.w << 16), __uint_as_float(w.w & 0xffff0000u)}; }
                    *(u32x4*)(out + off + bj * HALF) = pack8(b0 + gv[bj][0] * acc[ai][bj][m][0], b1 + gv[bj][1] * acc[ai][bj][m][1]); } }
            asm volatile("" ::: "memory");
        }
    }
};
struct EpiSwiGLU {
    static constexpr bool PERM = true, AFTER_DRAIN = false;
    bf16_t* O; int ldc;
    __device__ __forceinline__ void operator()(const f32x4 (&acc)[2][2][4][2], const Unit& u, int wr, int wc, int fr, int fq) const {
        const int row0 = u.po * BM + wr * 64 + fr, col0 = u.pn * HALF + wc * 32 + 8 * fq;
#pragma unroll
        for (int ai = 0; ai < 2; ++ai)
#pragma unroll
            for (int m = 0; m < 4; ++m) { bf16_t* rowp = O + (size_t)(row0 + ai * HALF + m * 16) * ldc + col0;
                f32x4 r0, r1;
#pragma unroll
                for (int j = 0; j < 4; j += 2) { const f32x2 a = swiglu_pk((f32x2){acc[ai][0][m][0][j], acc[ai][0][m][0][j + 1]}, (f32x2){acc[ai][1][m][0][j], acc[ai][1][m][0][j + 1]}, 1.0f);
                    const f32x2 b = swiglu_pk((f32x2){acc[ai][0][m][1][j], acc[ai][0][m][1][j + 1]}, (f32x2){acc[ai][1][m][1][j], acc[ai][1][m][1][j + 1]}, 1.0f);
                    r0[j] = a.x; r0[j + 1] = a.y; r1[j] = b.x; r1[j + 1] = b.y; }
                *(u32x4*)rowp = pack8(r0, r1); }
    }
};
__device__ __forceinline__ float clamp448(float x) { return __builtin_fminf(__builtin_fmaxf(x, -448.f), 448.f); }
__device__ __forceinline__ unsigned pack4_fp8(float a, float b, float c, float d) { int w = 0; w = __builtin_amdgcn_cvt_pk_fp8_f32(clamp448(a), clamp448(b), w, false); w = __builtin_amdgcn_cvt_pk_fp8_f32(clamp448(c), clamp448(d), w, true); return (unsigned)w; }
__device__ __forceinline__ unsigned pack4_i8(float a, float b, float c, float d) {
    const int ia = (int)__builtin_rintf(__builtin_fminf(__builtin_fmaxf(a, -127.f), 127.f)), ib = (int)__builtin_rintf(__builtin_fminf(__builtin_fmaxf(b, -127.f), 127.f)), ic = (int)__builtin_rintf(__builtin_fminf(__builtin_fmaxf(c, -127.f), 127.f)), id = (int)__builtin_rintf(__builtin_fminf(__builtin_fmaxf(d, -127.f), 127.f));
    return ((unsigned)ia & 0xffu) | (((unsigned)ib & 0xffu) << 8) | (((unsigned)ic & 0xffu) << 16) | ((unsigned)id << 24); }
struct EpiSwiGLU8 {
    static constexpr bool PERM = true, AFTER_DRAIN = false;
    unsigned char* O; int ldc; float s;
    __device__ __forceinline__ void operator()(const f32x4 (&acc)[2][2][4][2], const Unit& u, int wr, int wc, int fr, int fq) const {
        const int row0 = u.po * BM + wr * 64 + fr, col0 = u.pn * HALF + wc * 32 + 8 * fq;
#pragma unroll
        for (int ai = 0; ai < 2; ++ai)
#pragma unroll
            for (int m = 0; m < 4; ++m) { unsigned char* rowp = O + (size_t)(row0 + ai * HALF + m * 16) * ldc + col0;
                f32x4 r0, r1;
#pragma unroll
                for (int j = 0; j < 4; j += 2) { const f32x2 a = swiglu_pk((f32x2){acc[ai][0][m][0][j], acc[ai][0][m][0][j + 1]}, (f32x2){acc[ai][1][m][0][j], acc[ai][1][m][0][j + 1]}, s);
                    const f32x2 b = swiglu_pk((f32x2){acc[ai][0][m][1][j], acc[ai][0][m][1][j + 1]}, (f32x2){acc[ai][1][m][1][j], acc[ai][1][m][1][j + 1]}, s);
                    r0[j] = a.x; r0[j + 1] = a.y; r1[j] = b.x; r1[j + 1] = b.y; }
                u32x2 w; w.x = pack4_fp8(r0[0], r0[1], r0[2], r0[3]); w.y = pack4_fp8(r1[0], r1[1], r1[2], r1[3]); *(u32x2*)rowp = w;
                asm volatile("" ::: "memory"); }
    }
};
__device__ __forceinline__ void colscales(const unsigned* cm, int col0, f32x4 (&sv)[2][2]) {
#pragma unroll
    for (int bj = 0; bj < 2; ++bj)
#pragma unroll
        for (int n = 0; n < 2; ++n) { const u32x4 w = *(const u32x4*)(cm + col0 + bj * HALF + n * 4); sv[bj][n] = (f32x4){__uint_as_float(w.x), __uint_as_float(w.y), __uint_as_float(w.z), __uint_as_float(w.w)} * (1.0f / 127.0f); }
}
struct EpiSwiGLUI {
    static constexpr bool PERM = true, AFTER_DRAIN = false;
    bf16_t* O; int ldc; const float* sa; const unsigned* cm;
    __device__ __forceinline__ void operator()(const f32x4 (&acc)[2][2][4][2], const Unit& u, int wr, int wc, int fr, int fq) const {
        const int row0 = u.po * BM + wr * 64 + fr, col0 = u.pn * HALF + wc * 32 + 8 * fq;
        f32x4 sv[2][2]; colscales(cm, u.pn * BM + wc * 32 + 8 * fq, sv);
#pragma unroll
        for (int ai = 0; ai < 2; ++ai)
#pragma unroll
            for (int m = 0; m < 4; ++m) { const int row = row0 + ai * HALF + m * 16; bf16_t* rowp = O + (size_t)row * ldc + col0; const float s = sa[row];
                f32x4 r0, r1;
#pragma unroll
                for (int j = 0; j < 4; j += 2) { const v4i_t g0 = __builtin_bit_cast(v4i_t, acc[ai][0][m][0]), g1 = __builtin_bit_cast(v4i_t, acc[ai][0][m][1]), u0 = __builtin_bit_cast(v4i_t, acc[ai][1][m][0]), u1 = __builtin_bit_cast(v4i_t, acc[ai][1][m][1]);
                    const f32x2 a = swiglu_pk((f32x2){(float)g0[j] * sv[0][0][j], (float)g0[j + 1] * sv[0][0][j + 1]}, (f32x2){(float)u0[j] * sv[1][0][j], (float)u0[j + 1] * sv[1][0][j + 1]}, s);
                    const f32x2 b = swiglu_pk((f32x2){(float)g1[j] * sv[0][1][j], (float)g1[j + 1] * sv[0][1][j + 1]}, (f32x2){(float)u1[j] * sv[1][1][j], (float)u1[j + 1] * sv[1][1][j + 1]}, s);
                    r0[j] = a.x; r0[j + 1] = a.y; r1[j] = b.x; r1[j + 1] = b.y; }
                *(u32x4*)rowp = pack8(r0, r1);
                asm volatile("" ::: "memory"); }
    }
};
struct EpiSwiGLUI8 {
    static constexpr bool PERM = true, AFTER_DRAIN = false;
    unsigned char* O; int ldc; const float* sa; const unsigned* cm;
    __device__ __forceinline__ void operator()(const f32x4 (&acc)[2][2][4][2], const Unit& u, int wr, int wc, int fr, int fq) const {
        const int row0 = u.po * BM + wr * 64 + fr, col0 = u.pn * HALF + wc * 32 + 8 * fq;
        f32x4 sv[2][2]; colscales(cm, u.pn * BM + wc * 32 + 8 * fq, sv);
#pragma unroll
        for (int ai = 0; ai < 2; ++ai)
#pragma unroll
            for (int m = 0; m < 4; ++m) { const int row = row0 + ai * HALF + m * 16; unsigned char* rowp = O + (size_t)row * ldc + col0; const float s = sa[row];
                f32x4 r0, r1;
#pragma unroll
                for (int j = 0; j < 4; j += 2) { const v4i_t g0 = __builtin_bit_cast(v4i_t, acc[ai][0][m][0]), g1 = __builtin_bit_cast(v4i_t, acc[ai][0][m][1]), u0 = __builtin_bit_cast(v4i_t, acc[ai][1][m][0]), u1 = __builtin_bit_cast(v4i_t, acc[ai][1][m][1]);
                    const f32x2 a = swiglu_pk((f32x2){(float)g0[j] * sv[0][0][j], (float)g0[j + 1] * sv[0][0][j + 1]}, (f32x2){(float)u0[j] * sv[1][0][j], (float)u0[j + 1] * sv[1][0][j + 1]}, s);
                    const f32x2 b = swiglu_pk((f32x2){(float)g1[j] * sv[0][1][j], (float)g1[j + 1] * sv[0][1][j + 1]}, (f32x2){(float)u1[j] * sv[1][1][j], (float)u1[j + 1] * sv[1][1][j + 1]}, s);
                    r0[j] = a.x; r0[j + 1] = a.y; r1[j] = b.x; r1[j + 1] = b.y; }
                { u32x2 w; w.x = pack4_fp8(r0[0], r0[1], r0[2], r0[3]); w.y = pack4_fp8(r1[0], r1[1], r1[2], r1[3]); *(u32x2*)rowp = w; }
                asm volatile("" ::: "memory"); }
    }
};
struct EpiProj0I {
    static constexpr bool PERM = true, AFTER_DRAIN = false;
    bf16_t* O; int ldc; float qscale; const float* sa; const unsigned* cm;
    __device__ __forceinline__ void operator()(const f32x4 (&acc)[2][2][4][2], const Unit& u, int wr, int wc, int fr, int fq) const {
        const int row0 = u.po * BM + wr * 64 + fr, col0 = u.pn * BM + wc * 32 + 8 * fq; const float sw = (u.pn < 2 ? qscale : 1.0f);
        f32x4 sv[2][2]; colscales(cm, col0, sv);
        const bool act = u.pn >= 3;
#pragma unroll
        for (int ai = 0; ai < 2; ++ai)
#pragma unroll
            for (int m = 0; m < 4; ++m) { const int row = row0 + ai * HALF + m * 16; bf16_t* rowp = O + (size_t)row * ldc + col0; const float s = sa[row] * sw;
#pragma unroll
                for (int bj = 0; bj < 2; ++bj) { const v4i_t i0 = __builtin_bit_cast(v4i_t, acc[ai][bj][m][0]), i1 = __builtin_bit_cast(v4i_t, acc[ai][bj][m][1]);
                    f32x4 v0 = (f32x4){(float)i0[0], (float)i0[1], (float)i0[2], (float)i0[3]} * sv[bj][0] * s, v1 = (f32x4){(float)i1[0], (float)i1[1], (float)i1[2], (float)i1[3]} * sv[bj][1] * s;
                    if (act) { v0 = gelu4(v0); v1 = gelu4(v1); }
                    *(u32x4*)(rowp + bj * HALF) = pack8(v0, v1); } }
    }
};
struct EpiBf16PlainI {
    static constexpr bool PERM = true, AFTER_DRAIN = false;
    bf16_t* O; int ldc; const float* sa; const unsigned* cm;
    __device__ __forceinline__ void operator()(const f32x4 (&acc)[2][2][4][2], const Unit& u, int wr, int wc, int fr, int fq) const {
        const int row0 = u.po * BM + wr * 64 + fr, col0 = u.pn * BM + wc * 32 + 8 * fq;
        f32x4 sv[2][2]; colscales(cm, col0, sv);
#pragma unroll
        for (int ai = 0; ai < 2; ++ai)
#pragma unroll
            for (int m = 0; m < 4; ++m) { const int row = row0 + ai * HALF + m * 16; bf16_t* rowp = O + (size_t)row * ldc + col0; const float s = sa[row];
#pragma unroll
                for (int bj = 0; bj < 2; ++bj) { const v4i_t i0 = __builtin_bit_cast(v4i_t, acc[ai][bj][m][0]), i1 = __builtin_bit_cast(v4i_t, acc[ai][bj][m][1]);
                    *(u32x4*)(rowp + bj * HALF) = pack8((f32x4){(float)i0[0], (float)i0[1], (float)i0[2], (float)i0[3]} * sv[bj][0] * s, (f32x4){(float)i1[0], (float)i1[1], (float)i1[2], (float)i1[3]} * sv[bj][1] * s); } }
    }
};
struct EpiSwiGLU8I {
    static constexpr bool PERM = true, AFTER_DRAIN = false;
    unsigned char* O; int ldc; const float* sa; const float* swp;
    __device__ __forceinline__ void operator()(const f32x4 (&acc)[2][2][4][2], const Unit& u, int wr, int wc, int fr, int fq) const {
        const int row0 = u.po * BM + wr * 64 + fr, col0 = u.pn * HALF + wc * 32 + 8 * fq; const float sw = *swp;
#pragma unroll
        for (int ai = 0; ai < 2; ++ai)
#pragma unroll
            for (int m = 0; m < 4; ++m) { const int row = row0 + ai * HALF + m * 16; unsigned char* rowp = O + (size_t)row * ldc + col0; const float s = sa[row] * sw;
                f32x4 r0, r1;
#pragma unroll
                for (int j = 0; j < 4; j += 2) { const v4i_t g0 = __builtin_bit_cast(v4i_t, acc[ai][0][m][0]), g1 = __builtin_bit_cast(v4i_t, acc[ai][0][m][1]), u0 = __builtin_bit_cast(v4i_t, acc[ai][1][m][0]), u1 = __builtin_bit_cast(v4i_t, acc[ai][1][m][1]);
                    const f32x2 a = swiglu_pk((f32x2){(float)g0[j], (float)g0[j + 1]}, (f32x2){(float)u0[j], (float)u0[j + 1]}, s);
                    const f32x2 b = swiglu_pk((f32x2){(float)g1[j], (float)g1[j + 1]}, (f32x2){(float)u1[j], (float)u1[j + 1]}, s);
                    r0[j] = a.x; r0[j + 1] = a.y; r1[j] = b.x; r1[j + 1] = b.y; }
                u32x2 w; w.x = pack4_fp8(r0[0], r0[1], r0[2], r0[3]); w.y = pack4_fp8(r1[0], r1[1], r1[2], r1[3]); *(u32x2*)rowp = w;
                asm volatile("" ::: "memory"); }
    }
};
struct EpiQRope {
    static constexpr bool PERM = true, AFTER_DRAIN = false;
    bf16_t* O; int ldc; const float* ctab; const float* stab; float qscale; int seq_mask;
    __device__ __forceinline__ void operator()(const f32x4 (&acc)[2][2][4][2], const Unit& u, int wr, int wc, int fr, int fq) const {
        const int row0 = u.po * BM + wr * 64 + fr, col0 = u.pn * BM + wc * 32 + 8 * fq;
#pragma unroll
        for (int ai = 0; ai < 2; ++ai)
#pragma unroll
            for (int m = 0; m < 4; ++m) { const int row = row0 + ai * HALF + m * 16; bf16_t* rowp = O + (size_t)row * ldc + col0; const int pos = row & seq_mask;
#pragma unroll
                for (int bj = 0; bj < 2; ++bj) { f32x4 v0 = acc[ai][bj][m][0] * qscale, v1 = acc[ai][bj][m][1] * qscale;
                    const int off = (col0 + bj * HALF) % 96;
                    if (off >= 64) { const int i0 = (off - 64) >> 1; const f32x4 cs = *(const f32x4*)(ctab + pos * 16 + i0), sn = *(const f32x4*)(stab + pos * 16 + i0);
                        const f32x4 a = v0, b = v1;
                        v0[0] = a[0] * cs[0] - a[1] * sn[0]; v0[1] = a[0] * sn[0] + a[1] * cs[0]; v0[2] = a[2] * cs[1] - a[3] * sn[1]; v0[3] = a[2] * sn[1] + a[3] * cs[1];
                        v1[0] = b[0] * cs[2] - b[1] * sn[2]; v1[1] = b[0] * sn[2] + b[1] * cs[2]; v1[2] = b[2] * cs[3] - b[3] * sn[3]; v1[3] = b[2] * sn[3] + b[3] * cs[3]; }
                    *(u32x4*)(rowp + bj * HALF) = pack8(v0, v1); }
                asm volatile("" ::: "memory"); }
    }
};

#ifndef PG8_F8_ASM_STAGE
#define PG8_F8_ASM_STAGE 0
#endif
template <class Epi, class Sched, bool ALIGN_EPI = false, bool SP2 = false, bool F8 = false, bool I8 = false, bool PF = false>
__device__ __forceinline__ void gemm_phase(PG8_LAS unsigned char* lds, const Gemm g, const Sched& S, const Epi& E, const int wave_) {
    int tid_ = tid_from_wave(wave_); asm volatile("" : "+v"(tid_));
    const int tid = tid_, wid = __builtin_amdgcn_readfirstlane(tid >> 6), lane = tid & 63, wr = wid >> 2, wc = wid & 3, fr = lane & 15, fq = lane >> 4;
    const int K = g.K, nt = K / BK;
    unsigned voffA[2], voffB[2];
#pragma unroll
    for (int i = 0; i < 2; ++i) { int R, C; stage_rc(tid * 16 + i * 8192, R, C); const int Rb = Epi::PERM ? ((R & ~31) + perm32(R & 31)) : R;
        voffA[i] = (unsigned)(R * K + C) * 2u; voffB[i] = (unsigned)(Rb * K + C) * 2u; }
    const size_t kstep = (size_t)(BK * 2);
    const size_t hstep = (size_t)HALF * K * 2;
    const size_t tstep = 2 * hstep;
    const unsigned lds_a32 = (unsigned)(uintptr_t)lds;
    const unsigned ldsw = (unsigned)wid * 1024u;
    const int aoff = lds_byte(wr * 64 + fr, fq * 8), boff = lds_byte(wc * 32 + fr, fq * 8);
#define PG8_SA(b, h) (((b) * 2 + (h)) * HTB)
#define PG8_SB(b, h) ((4 + (b) * 2 + (h)) * HTB)
#define PG8_STAGE(bufoff, gbase, voff) do { _Pragma("unroll") for (int _i = 0; _i < 2; ++_i) { \
        if constexpr (F8 && PG8_F8_ASM_STAGE) { unsigned keep_; asm volatile("s_mov_b32 %0, m0\n\ts_mov_b32 m0, %3\n\ts_nop 0\n\tglobal_load_lds_dwordx4 %1, %2\n\ts_mov_b32 m0, %0" : "=&s"(keep_) : "v"((voff)[_i]), "s"((const char*)(gbase)), "s"((unsigned)__builtin_amdgcn_readfirstlane((int)(lds_a32 + (unsigned)(bufoff) + ldsw + (unsigned)(_i * 8192)))) : "memory"); } \
        else __builtin_amdgcn_global_load_lds((const unsigned*)((const char*)(gbase) + (voff)[_i]), (PG8_LAS unsigned*)(lds + (bufoff) + ldsw + _i * 8192), 16, 0, 0); } } while (0)
#define PG8_LDA(dst, b, h) do { _Pragma("unroll") for (int m = 0; m < 4; ++m) _Pragma("unroll") for (int k = 0; k < 2; ++k) dst[m][k] = *(const PG8_LAS bf16x8*)(lds + PG8_SA(b, h) + aoff + m * 2048 + k * 1024); } while (0)
#define PG8_LDB(dst, b, h) do { _Pragma("unroll") for (int n = 0; n < 2; ++n) _Pragma("unroll") for (int k = 0; k < 2; ++k) dst[n][k] = *(const PG8_LAS bf16x8*)(lds + PG8_SB(b, h) + boff + n * 2048 + k * 1024); } while (0)
#define PG8_MMA(ai, bj, At, Bt) do { __builtin_amdgcn_s_setprio(1); _Pragma("unroll") for (int m = 0; m < 4; ++m) _Pragma("unroll") for (int n = 0; n < 2; ++n) { \
        if constexpr (F8) { const v8i_t b8_ = __builtin_shufflevector(__builtin_bit_cast(v4i_t, Bt[n][0]), __builtin_bit_cast(v4i_t, Bt[n][1]), 0, 1, 2, 3, 4, 5, 6, 7), a8_ = __builtin_shufflevector(__builtin_bit_cast(v4i_t, At[m][0]), __builtin_bit_cast(v4i_t, At[m][1]), 0, 1, 2, 3, 4, 5, 6, 7); \
            asm volatile("v_mfma_f32_16x16x128_f8f6f4 %0, %1, %2, %0" : "+v"(acc[ai][bj][m][n]) : "v"(b8_), "v"(a8_)); } \
        else if constexpr (I8) { _Pragma("unroll") for (int k = 0; k < 2; ++k) acc[ai][bj][m][n] = __builtin_bit_cast(f32x4, __builtin_amdgcn_mfma_i32_16x16x64_i8(__builtin_bit_cast(v4i_t, Bt[n][k]), __builtin_bit_cast(v4i_t, At[m][k]), __builtin_bit_cast(v4i_t, acc[ai][bj][m][n]), 0, 0, 0)); } \
        else { _Pragma("unroll") for (int k = 0; k < 2; ++k) acc[ai][bj][m][n] = __builtin_amdgcn_mfma_f32_16x16x32_bf16(Bt[n][k], At[m][k], acc[ai][bj][m][n], 0, 0, 0); } } __builtin_amdgcn_s_setprio(0); } while (0)
#define PG8_MF(ai, bj, m, n, At, Bt) do { \
        if constexpr (F8) { const v8i_t b8_ = __builtin_shufflevector(__builtin_bit_cast(v4i_t, Bt[n][0]), __builtin_bit_cast(v4i_t, Bt[n][1]), 0, 1, 2, 3, 4, 5, 6, 7), a8_ = __builtin_shufflevector(__builtin_bit_cast(v4i_t, At[m][0]), __builtin_bit_cast(v4i_t, At[m][1]), 0, 1, 2, 3, 4, 5, 6, 7); \
            asm volatile("v_mfma_f32_16x16x128_f8f6f4 %0, %1, %2, %0" : "+v"(acc[ai][bj][m][n]) : "v"(b8_), "v"(a8_)); } \
        else if constexpr (I8) { _Pragma("unroll") for (int k = 0; k < 2; ++k) acc[ai][bj][m][n] = __builtin_bit_cast(f32x4, __builtin_amdgcn_mfma_i32_16x16x64_i8(__builtin_bit_cast(v4i_t, Bt[n][k]), __builtin_bit_cast(v4i_t, At[m][k]), __builtin_bit_cast(v4i_t, acc[ai][bj][m][n]), 0, 0, 0)); } \
        else { _Pragma("unroll") for (int k = 0; k < 2; ++k) acc[ai][bj][m][n] = __builtin_amdgcn_mfma_f32_16x16x32_bf16(Bt[n][k], At[m][k], acc[ai][bj][m][n], 0, 0, 0); } } while (0)
#define PG8_RA(dst, b, h, m, k) dst[m][k] = *(const PG8_LAS bf16x8*)(lds + PG8_SA(b, h) + aoff + (m) * 2048 + (k) * 1024)
#define PG8_RB(dst, b, h, n, k) dst[n][k] = *(const PG8_LAS bf16x8*)(lds + PG8_SB(b, h) + boff + (n) * 2048 + (k) * 1024)
#define PG8_X1(b) do { __builtin_amdgcn_s_setprio(1); \
        PG8_MF(0, 0, 0, 0, At, B0); PG8_RB(B1, b, 1, 0, 0); PG8_SCHED; PG8_MF(0, 0, 0, 1, At, B0); PG8_RB(B1, b, 1, 0, 1); PG8_SCHED; PG8_MF(0, 0, 1, 0, At, B0); PG8_RB(B1, b, 1, 1, 0); PG8_SCHED; PG8_MF(0, 0, 1, 1, At, B0); PG8_RB(B1, b, 1, 1, 1); PG8_SCHED; \
        PG8_MF(0, 0, 2, 0, At, B0); PG8_MF(0, 0, 2, 1, At, B0); PG8_MF(0, 0, 3, 0, At, B0); PG8_MF(0, 0, 3, 1, At, B0); PG8_SCHED; \
        PG8_MF(0, 1, 0, 0, At, B1); PG8_RA(At2, b, 1, 0, 0); PG8_SCHED; PG8_MF(0, 1, 0, 1, At, B1); PG8_RA(At2, b, 1, 0, 1); PG8_SCHED; PG8_MF(0, 1, 1, 0, At, B1); PG8_RA(At2, b, 1, 1, 0); PG8_SCHED; PG8_MF(0, 1, 1, 1, At, B1); PG8_RA(At2, b, 1, 1, 1); PG8_SCHED; \
        PG8_MF(0, 1, 2, 0, At, B1); PG8_RA(At2, b, 1, 2, 0); PG8_SCHED; PG8_MF(0, 1, 2, 1, At, B1); PG8_RA(At2, b, 1, 2, 1); PG8_SCHED; PG8_MF(0, 1, 3, 0, At, B1); PG8_RA(At2, b, 1, 3, 0); PG8_SCHED; PG8_MF(0, 1, 3, 1, At, B1); PG8_RA(At2, b, 1, 3, 1); PG8_SCHED; \
        __builtin_amdgcn_s_setprio(0); } while (0)
#define PG8_X2(b) do { __builtin_amdgcn_s_setprio(1); \
        PG8_MF(1, 0, 0, 0, At2, B0); PG8_RA(At, (b) ^ 1, 0, 0, 0); PG8_SCHED; PG8_MF(1, 0, 0, 1, At2, B0); PG8_RA(At, (b) ^ 1, 0, 0, 1); PG8_SCHED; PG8_MF(1, 0, 1, 0, At2, B0); PG8_RA(At, (b) ^ 1, 0, 1, 0); PG8_SCHED; PG8_MF(1, 0, 1, 1, At2, B0); PG8_RA(At, (b) ^ 1, 0, 1, 1); PG8_SCHED; \
        PG8_MF(1, 0, 2, 0, At2, B0); PG8_RA(At, (b) ^ 1, 0, 2, 0); PG8_SCHED; PG8_MF(1, 0, 2, 1, At2, B0); PG8_RA(At, (b) ^ 1, 0, 2, 1); PG8_SCHED; PG8_MF(1, 0, 3, 0, At2, B0); PG8_RA(At, (b) ^ 1, 0, 3, 0); PG8_SCHED; PG8_MF(1, 0, 3, 1, At2, B0); PG8_RA(At, (b) ^ 1, 0, 3, 1); PG8_SCHED; \
        PG8_MF(1, 1, 0, 0, At2, B1); PG8_RB(B0, (b) ^ 1, 0, 0, 0); PG8_SCHED; PG8_MF(1, 1, 0, 1, At2, B1); PG8_RB(B0, (b) ^ 1, 0, 0, 1); PG8_SCHED; PG8_MF(1, 1, 1, 0, At2, B1); PG8_RB(B0, (b) ^ 1, 0, 1, 0); PG8_SCHED; PG8_MF(1, 1, 1, 1, At2, B1); PG8_RB(B0, (b) ^ 1, 0, 1, 1); PG8_SCHED; \
        PG8_MF(1, 1, 2, 0, At2, B1); PG8_MF(1, 1, 2, 1, At2, B1); PG8_MF(1, 1, 3, 0, At2, B1); PG8_MF(1, 1, 3, 1, At2, B1); __builtin_amdgcn_s_setprio(0); } while (0)
#define PG8_WAIT_V(n) asm volatile("s_waitcnt vmcnt(" #n ")" ::: "memory")
#define PG8_WAIT_L(n) asm volatile("s_waitcnt lgkmcnt(" #n ")" ::: "memory")
#define PG8_BAR __builtin_amdgcn_s_barrier()
#define PG8_SCHED __builtin_amdgcn_sched_barrier(0)
    Unit cur, nxt; int ui = 0;
    if (!S.next(0, cur)) return;
    f32x4 acc[2][2][4][2];
#pragma unroll
    for (int a = 0; a < 2; ++a)
#pragma unroll
        for (int b = 0; b < 2; ++b)
#pragma unroll
            for (int m = 0; m < 4; ++m)
#pragma unroll
                for (int n = 0; n < 2; ++n) acc[a][b][m][n] = (f32x4){0.f, 0.f, 0.f, 0.f};
    bf16x8 At[4][2], B0[2][2], B1[2][2]; bf16x8 At2[PF ? 4 : 1][2];
    const char* cA = (const char*)g.A + (size_t)cur.pm * tstep; const char* cB = (const char*)g.Bt + (size_t)cur.pb * tstep;
    S.a_ready(cur);
    if constexpr (PF) {
        PG8_STAGE(PG8_SA(0, 0), cA, voffA); PG8_STAGE(PG8_SB(0, 0), cB, voffB); PG8_STAGE(PG8_SA(0, 1), cA + hstep, voffA); PG8_STAGE(PG8_SB(0, 1), cB + hstep, voffB);
        PG8_STAGE(PG8_SA(1, 0), cA + kstep, voffA); PG8_STAGE(PG8_SB(1, 0), cB + kstep, voffB);
        if (wr == 1) { PG8_STAGE(PG8_SA(1, 1), cA + hstep + kstep, voffA); PG8_STAGE(PG8_SB(1, 1), cB + hstep + kstep, voffB); }
        PG8_WAIT_V(8); PG8_BAR;
        PG8_LDA(At, 0, 0); PG8_LDB(B0, 0, 0); __builtin_amdgcn_s_waitcnt(0xC07F);
        if (wr == 1) PG8_BAR;
    } else
    if constexpr (SP2) {
        PG8_STAGE(PG8_SB(0, 0), cB, voffB); PG8_STAGE(PG8_SB(0, 1), cB + hstep, voffB); PG8_STAGE(PG8_SA(0, 0), cA, voffA); PG8_STAGE(PG8_SA(0, 1), cA + hstep, voffA);
        if (wr == 1) PG8_BAR;
        PG8_WAIT_V(2); PG8_BAR;
        PG8_STAGE(PG8_SB(1, 0), cB + kstep, voffB); PG8_STAGE(PG8_SA(1, 0), cA + kstep, voffA); PG8_STAGE(PG8_SB(1, 1), cB + hstep + kstep, voffB);
        PG8_WAIT_V(6); PG8_BAR;
    } else {
        PG8_STAGE(PG8_SB(0, 0), cB, voffB); PG8_STAGE(PG8_SA(0, 0), cA, voffA); PG8_STAGE(PG8_SB(0, 1), cB + hstep, voffB); PG8_STAGE(PG8_SA(0, 1), cA + hstep, voffA);
        if (wr == 1) PG8_BAR;
        PG8_WAIT_V(4); PG8_BAR;
        PG8_STAGE(PG8_SB(1, 0), cB + kstep, voffB); PG8_STAGE(PG8_SA(1, 0), cA + kstep, voffA); PG8_STAGE(PG8_SB(1, 1), cB + hstep + kstep, voffB);
        PG8_WAIT_V(6); PG8_BAR;
    }
    for (;;) {
        const bool has_next = S.next(ui + 1, nxt);
        const char* nA = has_next ? (const char*)g.A + (size_t)nxt.pm * tstep : cA; const char* nB = has_next ? (const char*)g.Bt + (size_t)nxt.pb * tstep : cB;
        for (int t = 0; t < nt; t += 2) {
            const bool last = (t == nt - 2);
            const char* a1 = cA + (size_t)(t + 1) * kstep;
            const char* a2 = last ? nA : cA + (size_t)(t + 2) * kstep; const char* b2 = last ? nB : cB + (size_t)(t + 2) * kstep;
            const char* a3 = a2 + kstep; const char* b3 = b2 + kstep;
            if (last && has_next) S.a_ready(nxt);
            if constexpr (PF) {
            PG8_STAGE(wr ? PG8_SA(0, 0) : PG8_SA(1, 1), wr ? a2 : a1 + hstep, voffA); PG8_STAGE(wr ? PG8_SB(0, 0) : PG8_SB(1, 1), wr ? b2 : cB + (size_t)(t + 1) * kstep + hstep, voffB);
            PG8_WAIT_V(8); PG8_BAR;
            PG8_X1(0); __builtin_amdgcn_s_waitcnt(0xC07F); PG8_BAR; PG8_SCHED;
            PG8_STAGE(wr ? PG8_SA(0, 1) : PG8_SA(0, 0), wr ? a2 + hstep : a2, voffA); PG8_STAGE(wr ? PG8_SB(0, 1) : PG8_SB(0, 0), wr ? b2 + hstep : b2, voffB);
            PG8_WAIT_V(8); PG8_BAR;
            PG8_X2(0); __builtin_amdgcn_s_waitcnt(0xC07F); PG8_BAR; PG8_SCHED;
            PG8_STAGE(wr ? PG8_SA(1, 0) : PG8_SA(0, 1), wr ? a3 : a2 + hstep, voffA); PG8_STAGE(wr ? PG8_SB(1, 0) : PG8_SB(0, 1), wr ? b3 : b2 + hstep, voffB);
            PG8_WAIT_V(8); PG8_BAR;
            PG8_X1(1); __builtin_amdgcn_s_waitcnt(0xC07F); PG8_BAR; PG8_SCHED;
            PG8_STAGE(wr ? PG8_SA(1, 1) : PG8_SA(1, 0), wr ? a3 + hstep : a3, voffA); PG8_STAGE(wr ? PG8_SB(1, 1) : PG8_SB(1, 0), wr ? b3 + hstep : b3, voffB);
            PG8_WAIT_V(8); PG8_BAR;
            PG8_X2(1); __builtin_amdgcn_s_waitcnt(0xC07F); PG8_BAR; PG8_SCHED;
            } else
            if constexpr (SP2) {
            PG8_LDB(B0, 0, 0); PG8_LDB(B1, 0, 1); PG8_SCHED; PG8_LDA(At, 0, 0); PG8_STAGE(PG8_SA(1, 1), a1 + hstep, voffA);
            PG8_WAIT_V(8); PG8_WAIT_L(0); PG8_BAR; PG8_MMA(0, 0, At, B0); PG8_MMA(0, 1, At, B1); PG8_BAR; PG8_SCHED;
            PG8_LDA(At, 0, 1); PG8_STAGE(PG8_SB(0, 0), b2, voffB); PG8_STAGE(PG8_SB(0, 1), b2 + hstep, voffB); PG8_STAGE(PG8_SA(0, 0), a2, voffA);
            PG8_WAIT_V(8); PG8_WAIT_L(0); PG8_BAR; PG8_MMA(1, 0, At, B0); PG8_MMA(1, 1, At, B1); PG8_BAR; PG8_SCHED;
            PG8_LDB(B0, 1, 0); PG8_LDB(B1, 1, 1); PG8_SCHED; PG8_LDA(At, 1, 0); PG8_STAGE(PG8_SA(0, 1), a2 + hstep, voffA);
            PG8_WAIT_V(8); PG8_WAIT_L(0); PG8_BAR; PG8_MMA(0, 0, At, B0); PG8_MMA(0, 1, At, B1); PG8_BAR; PG8_SCHED;
            PG8_LDA(At, 1, 1); PG8_STAGE(PG8_SB(1, 0), b3, voffB); PG8_STAGE(PG8_SB(1, 1), b3 + hstep, voffB); PG8_STAGE(PG8_SA(1, 0), a3, voffA);
            PG8_WAIT_V(8); PG8_WAIT_L(0); PG8_BAR; PG8_MMA(1, 0, At, B0); PG8_MMA(1, 1, At, B1); PG8_BAR; PG8_SCHED;
            } else {
            PG8_LDB(B0, 0, 0); PG8_SCHED; PG8_LDA(At, 0, 0); PG8_STAGE(PG8_SA(1, 1), a1 + hstep, voffA);
            PG8_WAIT_L(8); PG8_BAR; PG8_WAIT_L(0); PG8_MMA(0, 0, At, B0); PG8_BAR; PG8_SCHED;
            PG8_LDB(B1, 0, 1); PG8_STAGE(PG8_SB(0, 0), b2, voffB);
            PG8_BAR; PG8_WAIT_L(0); PG8_MMA(0, 1, At, B1); PG8_BAR;
            PG8_LDA(At, 0, 1); PG8_STAGE(PG8_SA(0, 0), a2, voffA);
            PG8_BAR; PG8_WAIT_L(0); PG8_MMA(1, 0, At, B0); PG8_BAR; PG8_SCHED;
            PG8_STAGE(PG8_SB(0, 1), b2 + hstep, voffB);
            PG8_WAIT_V(6); PG8_BAR; PG8_MMA(1, 1, At, B1); PG8_BAR;
            PG8_LDB(B0, 1, 0); PG8_SCHED; PG8_LDA(At, 1, 0); PG8_STAGE(PG8_SA(0, 1), a2 + hstep, voffA);
            PG8_WAIT_L(8); PG8_BAR; PG8_WAIT_L(0); PG8_MMA(0, 0, At, B0); PG8_BAR; PG8_SCHED;
            PG8_LDB(B1, 1, 1); PG8_STAGE(PG8_SB(1, 0), b3, voffB);
            PG8_BAR; PG8_WAIT_L(0); PG8_MMA(0, 1, At, B1); PG8_BAR;
            PG8_LDA(At, 1, 1); PG8_STAGE(PG8_SA(1, 0), a3, voffA);
            PG8_BAR; PG8_WAIT_L(0); PG8_MMA(1, 0, At, B0); PG8_BAR; PG8_SCHED;
            PG8_STAGE(PG8_SB(1, 1), b3 + hstep, voffB);
            PG8_WAIT_V(6); PG8_BAR; PG8_MMA(1, 1, At, B1); PG8_BAR;
            }
        }
        if constexpr (ALIGN_EPI) { if (wr == 0) PG8_BAR; }
        if constexpr (F8) asm volatile("s_nop 15\n\ts_nop 7" ::: "memory");
        if constexpr (!Epi::AFTER_DRAIN) { int t2_ = tid_from_wave(wave_); asm volatile("" : "+v"(t2_)); const int l2_ = t2_ & 63;
            E(acc, cur, wr, wc, l2_ & 15, l2_ >> 4); S.done(cur); }
        if (!has_next) break;
#pragma unroll
        for (int a = 0; a < 2; ++a)
#pragma unroll
            for (int b = 0; b < 2; ++b)
#pragma unroll
                for (int m = 0; m < 4; ++m)
#pragma unroll
                    for (int n = 0; n < 2; ++n) acc[a][b][m][n] = (f32x4){0.f, 0.f, 0.f, 0.f};
        cur = nxt; cA = nA; cB = nB; ++ui;
        if constexpr (ALIGN_EPI) { if (wr == 1) PG8_BAR; }
    }
    PG8_WAIT_V(0);
    if constexpr (!ALIGN_EPI) { if (wr == 0) PG8_BAR; }
    PG8_BAR;
    if constexpr (Epi::AFTER_DRAIN) { E.fused(acc, cur, wr, wc, fr, fq, lds, wid, lane); S.done(cur); }
#undef PG8_SA
#undef PG8_SB
#undef PG8_STAGE
#undef PG8_LDA
#undef PG8_LDB
#undef PG8_MMA
#undef PG8_MF
#undef PG8_RA
#undef PG8_RB
#undef PG8_X1
#undef PG8_X2
#undef PG8_WAIT_V
#undef PG8_WAIT_L
#undef PG8_BAR
#undef PG8_SCHED
}
}
#define GAS __attribute__((address_space(1)))
#define LAS __attribute__((address_space(3)))
typedef unsigned short bf16;
typedef unsigned v4u __attribute__((ext_vector_type(4)));
typedef float f32x4 __attribute__((ext_vector_type(4)));
typedef short bf16x8 __attribute__((ext_vector_type(8)));
typedef GAS unsigned gu32;
typedef GAS unsigned long long gu64;
#define RLX_AGENT __ATOMIC_RELAXED, __HIP_MEMORY_SCOPE_AGENT
#define LDS_WAIT() asm volatile("s_waitcnt lgkmcnt(0)" ::: "memory")
#define VM_WAIT() asm volatile("s_waitcnt vmcnt(0)" ::: "memory")
__device__ __forceinline__ unsigned long long rt() { return __builtin_amdgcn_s_memrealtime(); }

#define XB_TMO      128
#define XB_XCNT(j)  (256  + 64 * (j))
#define XB_XSUB(j)  (1280 + 64 * (j))
#define XB_XGEN(j)  (2304 + 64 * (j))
#define XB_TOP      3328
#define XB_TOPGEN   3392
#define XCD_BAR_WORDS 3456
#define XB_SPIN_CAP (1u << 18)

__device__ __forceinline__ unsigned xb_ld(unsigned* p)              { return __hip_atomic_load(p, __ATOMIC_RELAXED, __HIP_MEMORY_SCOPE_AGENT); }
__device__ __forceinline__ unsigned xb_add(unsigned* p, unsigned v) { return __hip_atomic_fetch_add(p, v, __ATOMIC_RELAXED, __HIP_MEMORY_SCOPE_AGENT); }
__device__ __forceinline__ unsigned xb_xcc_id() { return (unsigned)__builtin_amdgcn_s_getreg((3 << 11) | 20) & 0xFu; }
#define XB_SPIN(cond, bar) do { unsigned _sp = 0; while (cond) { __builtin_amdgcn_s_sleep(1); \
    if ((++_sp & 255u) == 0u) { if (xb_ld(&(bar)[XB_TMO])) break; if (_sp > XB_SPIN_CAP) { atomicAdd(&(bar)[XB_TMO], 1u); break; } } } } while (0)

struct XcdBarrier {
    unsigned* bar; unsigned x; int wave;
    volatile LAS unsigned* st;
};

__device__ __forceinline__ XcdBarrier xcd_barrier_post(unsigned* bar, volatile LAS unsigned* st, int wave) {
    XcdBarrier b; b.bar = bar; b.x = xb_xcc_id(); b.st = st; b.wave = wave;
    if (tid_from_wave(wave) == 0) (void)xb_add(&bar[XB_XCNT(b.x)], 1u);
    return b;
}
__device__ __forceinline__ void xcd_barrier_complete(unsigned* bar, unsigned x, unsigned& nloc, unsigned& nx) {
    const unsigned G = gridDim.x * gridDim.y * gridDim.z;
    unsigned sum, cnt, mine, sp = 0u;
    for (;;) {
        sum = 0u; cnt = 0u; mine = 0u;
#pragma unroll
        for (unsigned j = 0; j < 16; ++j) { const unsigned c = xb_ld(&bar[XB_XCNT(j)]); sum += c; cnt += (c > 0u) ? 1u : 0u; mine = (j == x) ? c : mine; }
        if (sum == G) break;
        __builtin_amdgcn_s_sleep(1);
        if ((++sp & 255u) == 0u) { if (xb_ld(&bar[XB_TMO])) break; if (sp > XB_SPIN_CAP) { atomicAdd(&bar[XB_TMO], 1u); break; } }
    }
    nloc = mine > 0u ? mine : 1u; nx = cnt > 0u ? cnt : 1u;
}

__device__ __forceinline__ void xcd_barrier(const XcdBarrier& b) {
    asm volatile("s_waitcnt vmcnt(0)" ::: "memory");
    __syncthreads();
    if (tid_from_wave(b.wave) == 0) {
        unsigned* bar = b.bar;
        __builtin_amdgcn_s_waitcnt(0);
        unsigned nloc = b.st[0], nx = b.st[1];
        if (nloc == 0u) { xcd_barrier_complete(bar, b.x, nloc, nx); b.st[0] = nloc; b.st[1] = nx; }
        const unsigned old = xb_add(&bar[XB_XSUB(b.x)], 1u);
        const unsigned gen = old / nloc;
        if (old + 1u == (gen + 1u) * nloc) {
            __builtin_amdgcn_fence(__ATOMIC_RELEASE, "agent");
            asm volatile("s_waitcnt vmcnt(0)" ::: "memory");
            const unsigned og = xb_add(&bar[XB_TOP], 1u);
            const unsigned tg = og / nx;
            if (og + 1u == (tg + 1u) * nx) xb_add(&bar[XB_TOPGEN], 1u);
            else XB_SPIN(xb_ld(&bar[XB_TOPGEN]) == tg, bar);
            __builtin_amdgcn_fence(__ATOMIC_ACQUIRE, "agent");
            xb_add(&bar[XB_XGEN(b.x)], 1u);
            asm volatile("s_waitcnt vmcnt(0)" ::: "memory");
        } else {
            XB_SPIN(xb_ld(&bar[XB_XGEN(b.x)]) == gen, bar);
            __builtin_amdgcn_fence(__ATOMIC_ACQUIRE, "agent");
            asm volatile("s_waitcnt vmcnt(0)" ::: "memory");
        }
    }
    __syncthreads();
}

namespace mla {
using bf16x8 = __attribute__((ext_vector_type(8))) short;
using s16x4 = __attribute__((ext_vector_type(4))) short;
using f32x16 = __attribute__((ext_vector_type(16))) float;
using u32x4 = __attribute__((ext_vector_type(4))) unsigned;
typedef __attribute__((address_space(3))) const char* lds_cptr;
constexpr int SEQ = 8192, NW = 8, QBLK = 32, QB = 256, KVBLK = 64, NSLOT = 3, KSLOT = 12288, VSLOT = 8192;
constexpr int QP = 768, KVP = 1024, PEP = 32, OP = 1024;
constexpr int LDS_K = 0, LDS_V = NSLOT * KSLOT, LDS_WS = LDS_V + NSLOT * VSLOT, LDS_OST = LDS_WS + NW * 64 * 4, LDS_TOTAL = LDS_OST + NW * 4096;
__device__ __forceinline__ int crow(int r, int hi) { return (r & 3) + 8 * (r >> 2) + 4 * hi; }
__device__ __forceinline__ void glds16(const void* gsrc, unsigned lds_dst) { unsigned keep;
    asm volatile("s_mov_b32 %0, m0\n\ts_mov_b32 m0, %2\n\ts_nop 0\n\tglobal_load_lds_dwordx4 %1, off\n\ts_mov_b32 m0, %0" : "=&s"(keep) : "v"(gsrc), "s"(lds_dst) : "memory"); }
__device__ __forceinline__ float max3f(float a, float b, float c) { float r; asm("v_max3_f32 %0, %1, %2, %3" : "=v"(r) : "v"(a), "v"(b), "v"(c)); return r; }
typedef float f32x2_t __attribute__((ext_vector_type(2))); typedef __bf16 bf16x2_t __attribute__((ext_vector_type(2)));
__device__ __forceinline__ unsigned cvtpk_s(float lo, float hi) { f32x2_t v = {lo, hi}; bf16x2_t b = __builtin_convertvector(v, bf16x2_t); return __builtin_bit_cast(unsigned, b); }
__device__ __forceinline__ void cmask(f32x16& p0, f32x16& p1, int jb, int qrel, int hi) {
    const float NEG = -INFINITY; const int kb = 64 * jb + 4 * hi;
#pragma unroll
    for (int r = 0; r < 16; ++r) { const int kv = kb + (r & 3) + 8 * (r >> 2); if (kv > qrel) p0[r] = NEG; if (kv + 32 > qrel) p1[r] = NEG; }
}
__device__ __forceinline__ float rowmax(const f32x16& p0, const f32x16& p1) {
    float a = max3f(p0[0], p0[1], p1[0]), b = max3f(p0[2], p0[3], p1[1]); a = max3f(a, p1[2], p1[3]);
#pragma unroll
    for (int r = 4; r < 16; r += 4) { a = max3f(a, p0[r], p0[r + 1]); b = max3f(b, p0[r + 2], p0[r + 3]); a = max3f(a, p1[r], p1[r + 1]); b = max3f(b, p1[r + 2], p1[r + 3]); }
    const float m = fmaxf(a, b);
    auto rr = __builtin_amdgcn_permlane32_swap(__float_as_uint(m), __float_as_uint(m), false, false);
    return fmaxf(__uint_as_float(rr[0]), __uint_as_float(rr[1]));
}
__device__ __forceinline__ void pv(f32x16* o, int vb, bf16x8 pa0, bf16x8 pa1, bf16x8 pa2, bf16x8 pa3) {
#pragma unroll
    for (int d0 = 0; d0 < 2; ++d0) { s16x4 lo[4], hi[4];
#pragma unroll
        for (int ks = 0; ks < 4; ++ks) {
            asm volatile("ds_read_b64_tr_b16 %0,%1 offset:%c2" : "=&v"(lo[ks]) : "v"(vb), "i"(d0 * 4096 + ks * 1024) : "memory");
            asm volatile("ds_read_b64_tr_b16 %0,%1 offset:%c2" : "=&v"(hi[ks]) : "v"(vb), "i"(d0 * 4096 + ks * 1024 + 512) : "memory"); }
        asm volatile("s_waitcnt lgkmcnt(0)" ::: "memory"); __builtin_amdgcn_sched_barrier(0);
#define MLA_PK(k) (bf16x8){lo[k][0], lo[k][1], lo[k][2], lo[k][3], hi[k][0], hi[k][1], hi[k][2], hi[k][3]}
        o[d0] = __builtin_amdgcn_mfma_f32_32x32x16_bf16(pa0, MLA_PK(0), o[d0], 0, 0, 0);
        o[d0] = __builtin_amdgcn_mfma_f32_32x32x16_bf16(pa1, MLA_PK(1), o[d0], 0, 0, 0);
        o[d0] = __builtin_amdgcn_mfma_f32_32x32x16_bf16(pa2, MLA_PK(2), o[d0], 0, 0, 0);
        o[d0] = __builtin_amdgcn_mfma_f32_32x32x16_bf16(pa3, MLA_PK(3), o[d0], 0, 0, 0);
#undef MLA_PK
    }
}
#define MLA_WAIT_BAR(N) asm volatile("s_waitcnt vmcnt(" #N ") lgkmcnt(0)\n\ts_barrier" ::: "memory")

__device__ __forceinline__ void unit(int b, int h, int qb, const unsigned short* Q, const unsigned short* KV, const unsigned short* KPE, unsigned short* O, char* shm, const int wave_) {
    int tid_ = tid_from_wave(wave_); asm volatile("" : "+v"(tid_));
    const int tid = tid_, lane = tid & 63, r32 = lane & 31, hi = lane >> 5; const int wid = __builtin_amdgcn_readfirstlane(tid >> 6);
    const long rowbase = (long)b * SEQ; const int q0 = qb * QB;
    const unsigned short* Qw = Q + (rowbase + q0 + wid * QBLK) * QP + h * 96;
    const unsigned short* Kh = KV + rowbase * KVP + h * 128; const unsigned short* Vh = Kh + 64; const unsigned short* Ph = KPE + rowbase * PEP;
    const unsigned lds0 = (unsigned)(uintptr_t)shm;
    __attribute__((address_space(3))) float* wsf = (__attribute__((address_space(3))) float*)((lds_cptr)shm + LDS_WS) + wid * 64;
    const unsigned short* ksrc = Kh + (long)lane * KVP + wid * 8;
    const unsigned short* psrc = Ph + (long)(32 * (wid & 1) + r32) * PEP + (wid >> 1) * 8;
    const unsigned short* vsrc = Vh + (long)(16 * (wid & 3) + (lane >> 2)) * KVP + (wid >> 2) * 32 + (lane & 3) * 8;
    const unsigned kdst = lds0 + LDS_K + wid * 1024, pdst = lds0 + LDS_K + (8 + (wid >> 1)) * 1024 + (wid & 1) * 512, vdst = lds0 + LDS_V + wid * 1024;
#define MLA_DMA(t, s) do { glds16(ksrc + (long)(t) * KVBLK * KVP, (unsigned)__builtin_amdgcn_readfirstlane(kdst + (s) * KSLOT)); \
        if (lane < 32) glds16(psrc + (long)(t) * KVBLK * PEP, (unsigned)__builtin_amdgcn_readfirstlane(pdst + (s) * KSLOT)); \
        glds16(vsrc + (long)(t) * KVBLK * KVP, (unsigned)__builtin_amdgcn_readfirstlane(vdst + (s) * VSLOT)); } while (0)
    const int vb0 = (int)(lds0 + LDS_V) + ((lane >> 4) & 1) * 32 + (lane & 3) * 8 + (4 * hi + ((lane & 15) >> 2)) * 64;
    const lds_cptr kp0 = (lds_cptr)shm + LDS_K + hi * 1024 + r32 * 16;
    const int NT = (q0 + QB) / KVBLK;
    bf16x8 qr[6];
#pragma unroll
    for (int d0 = 0; d0 < 6; ++d0) qr[d0] = *reinterpret_cast<const bf16x8*>(&Qw[(long)r32 * QP + d0 * 16 + hi * 8]);
    asm volatile("s_waitcnt vmcnt(0)" ::: "memory");
    MLA_DMA(0, 0); MLA_DMA(1, 1);
    float m = -INFINITY, l = 0.f; f32x16 o[2]; o[0] = f32x16{}; o[1] = f32x16{};
    const int qrel = wid * QBLK + r32;
    int slot = 0, slot2 = 2;
    for (int t = 0; t < NT; ++t) {
        if (t + 1 < NT) MLA_WAIT_BAR(3); else MLA_WAIT_BAR(0);
        if (t + 2 < NT) MLA_DMA(t + 2, slot2);
        f32x16 p0 = f32x16{}, p1 = f32x16{};
        { const lds_cptr kp = kp0 + slot * KSLOT;
#pragma unroll
          for (int d0 = 0; d0 < 6; ++d0) { const bf16x8 b0 = *(const __attribute__((address_space(3))) bf16x8*)(kp + d0 * 2048), b1 = *(const __attribute__((address_space(3))) bf16x8*)(kp + d0 * 2048 + 512);
              p0 = __builtin_amdgcn_mfma_f32_32x32x16_bf16(b0, qr[d0], p0, 0, 0, 0); p1 = __builtin_amdgcn_mfma_f32_32x32x16_bf16(b1, qr[d0], p1, 0, 0, 0); } }
        { const int jb = t - (NT - 4); if (jb >= 0) cmask(p0, p1, jb, qrel, hi); }
        const float rm = rowmax(p0, p1), mn = fmaxf(m, rm);
        if (__any(mn > m)) {
            const float al = __builtin_amdgcn_exp2f(m - mn); l *= al; m = mn;
            if (hi == 0) wsf[r32] = al;
            asm volatile("s_waitcnt lgkmcnt(0)" ::: "memory");
#pragma unroll
            for (int r = 0; r < 16; ++r) { const float f = wsf[crow(r, hi)]; o[0][r] *= f; o[1][r] *= f; }
        }
        float sacc = 0.f;
#pragma unroll
        for (int r = 0; r < 16; ++r) { p0[r] = __builtin_amdgcn_exp2f(p0[r] - m); p1[r] = __builtin_amdgcn_exp2f(p1[r] - m); sacc += p0[r] + p1[r]; }
        l += sacc;
        u32x4 pw0, pw1, pw2, pw3;
#define MLA_PKW(P, B) cvtpk_s(P[B], P[B + 1])
        pw0 = (u32x4){MLA_PKW(p0, 0), MLA_PKW(p0, 2), MLA_PKW(p0, 4), MLA_PKW(p0, 6)}; pw1 = (u32x4){MLA_PKW(p0, 8), MLA_PKW(p0, 10), MLA_PKW(p0, 12), MLA_PKW(p0, 14)};
        pw2 = (u32x4){MLA_PKW(p1, 0), MLA_PKW(p1, 2), MLA_PKW(p1, 4), MLA_PKW(p1, 6)}; pw3 = (u32x4){MLA_PKW(p1, 8), MLA_PKW(p1, 10), MLA_PKW(p1, 12), MLA_PKW(p1, 14)};
#undef MLA_PKW
        pv(o, vb0 + slot * VSLOT, __builtin_bit_cast(bf16x8, pw0), __builtin_bit_cast(bf16x8, pw1), __builtin_bit_cast(bf16x8, pw2), __builtin_bit_cast(bf16x8, pw3));
        slot = (slot == NSLOT - 1) ? 0 : slot + 1; slot2 = (slot2 == NSLOT - 1) ? 0 : slot2 + 1;
    }
    { auto rr = __builtin_amdgcn_permlane32_swap(__float_as_uint(l), __float_as_uint(l), false, false); l = __uint_as_float(rr[0]) + __uint_as_float(rr[1]); }
    if (hi == 0) wsf[32 + r32] = l; asm volatile("s_waitcnt lgkmcnt(0)" ::: "memory");
    float rli[16];
#pragma unroll
    for (int r = 0; r < 16; ++r) rli[r] = __builtin_amdgcn_rcpf(wsf[32 + crow(r, hi)]);
    unsigned short* Ow = O + (rowbase + q0 + wid * QBLK) * OP + 512 + h * 64;
    { __attribute__((address_space(3))) unsigned short* stg = (__attribute__((address_space(3))) unsigned short*)((lds_cptr)shm + LDS_OST) + wid * 2048;
#pragma unroll
      for (int r = 0; r < 16; ++r) { const int orow = crow(r, hi);
#pragma unroll
          for (int d0 = 0; d0 < 2; ++d0) stg[orow * 64 + d0 * 32 + r32] = (unsigned short)(cvtpk_s(o[d0][r] * rli[r], 0.f) & 0xffffu); }
      asm volatile("s_waitcnt lgkmcnt(0)" ::: "memory");
#pragma unroll
      for (int i = 0; i < 4; ++i) { const int row = i * 8 + (lane >> 3), ch = lane & 7; const u32x4 v = *(const __attribute__((address_space(3))) u32x4*)(stg + row * 64 + ch * 8); *(u32x4*)(Ow + (long)row * OP + ch * 8) = v; } }
    asm volatile("s_waitcnt vmcnt(0) lgkmcnt(0)\n\ts_barrier" ::: "memory");
#undef MLA_DMA
}

#define MLA_SB() __builtin_amdgcn_sched_barrier(0)
#define MLA_PIN(x) asm volatile("" : "+v"(x))
#define MLA_LDK(kp, d0, h) (*(const __attribute__((address_space(3))) bf16x8*)((kp) + (d0) * 2048 + (h) * 512))
#define MLA_E4(P, B) do { P[B] = __builtin_amdgcn_exp2f(P[B]); P[B + 1] = __builtin_amdgcn_exp2f(P[B + 1]); P[B + 2] = __builtin_amdgcn_exp2f(P[B + 2]); P[B + 3] = __builtin_amdgcn_exp2f(P[B + 3]); MLA_PIN(P); } while (0)
#define MLA_A4(P, B) do { sacc += P[B]; sacc += P[B + 1]; sacc += P[B + 2]; sacc += P[B + 3]; MLA_PIN(sacc); } while (0)
#define MLA_PK2(W, I, P, B) do { W[I] = cvtpk_s(P[B], P[B + 1]); W[I + 1] = cvtpk_s(P[B + 2], P[B + 3]); MLA_PIN(W); } while (0)
#define MLA_MF(C, K, Q) C = __builtin_amdgcn_mfma_f32_32x32x16_bf16(K, Q, C, 0, 0, 0)
#define MLA_MF0(C, K, Q) C = __builtin_amdgcn_mfma_f32_32x32x16_bf16(K, Q, negm, 0, 0, 0)
#define MLA_SOFT(P0, P1) do { float sacc = 0.f; \
    MLA_E4(P0, 0); MLA_E4(P0, 4); MLA_E4(P0, 8); MLA_E4(P0, 12); MLA_E4(P1, 0); MLA_E4(P1, 4); MLA_E4(P1, 8); MLA_E4(P1, 12); \
    MLA_A4(P0, 0); MLA_A4(P0, 4); MLA_A4(P0, 8); MLA_A4(P0, 12); MLA_A4(P1, 0); MLA_A4(P1, 4); MLA_A4(P1, 8); MLA_A4(P1, 12); \
    MLA_PK2(pw0, 0, P0, 0); MLA_PK2(pw0, 2, P0, 4); MLA_PK2(pw1, 0, P0, 8); MLA_PK2(pw1, 2, P0, 12); MLA_PK2(pw2, 0, P1, 0); MLA_PK2(pw2, 2, P1, 4); MLA_PK2(pw3, 0, P1, 8); MLA_PK2(pw3, 2, P1, 12); \
    l_reg += sacc; } while (0)
#define MLA_REF(C0, C1, RESC_O) do { const float rm_ = rowmax(C0, C1); \
    if (__builtin_expect(__any(rm_ > (float)THRL), 0)) { const float dl_ = fmaxf(rm_, 0.f); mhat += dl_; \
        _Pragma("unroll") for (int r = 0; r < 16; ++r) { C0[r] -= dl_; C1[r] -= dl_; } \
        _Pragma("unroll") for (int r = 0; r < 16; ++r) negm[r] = -mhat; MLA_PIN(negm); \
        const float f_ = __builtin_amdgcn_exp2f(-dl_); l_reg *= f_; \
        if (RESC_O) { if (hi == 0) wsf[r32] = f_; asm volatile("s_waitcnt lgkmcnt(0)" ::: "memory"); \
            _Pragma("unroll") for (int r = 0; r < 16; ++r) { const float g_ = wsf[crow(r, hi)]; o[0][r] *= g_; o[1][r] *= g_; } } } } while (0)
#define MLA_STEP(C0, C1, P0, P1, t, JB, WAITN, GK, GV) do { \
    MLA_WAIT_BAR(WAITN); \
    if (GK) { glds16(ksrc + (long)((t) + 3) * KVBLK * KVP, (unsigned)__builtin_amdgcn_readfirstlane(kdst + s0 * KSLOT)); \
              if (lane < 32) glds16(psrc + (long)((t) + 3) * KVBLK * PEP, (unsigned)__builtin_amdgcn_readfirstlane(pdst + s0 * KSLOT)); } \
    if (GV) { glds16(vsrc + (long)((t) + 2) * KVBLK * KVP, (unsigned)__builtin_amdgcn_readfirstlane(vdst + s2 * VSLOT)); } \
    { const lds_cptr kp = kp0 + s1 * KSLOT; float sacc = 0.f; bf16x8 ka0, ka1, kb0, kb1; \
      ka0 = MLA_LDK(kp, 0, 0); ka1 = MLA_LDK(kp, 0, 1); MLA_E4(P0, 0); MLA_E4(P0, 4); MLA_SB(); \
      kb0 = MLA_LDK(kp, 1, 0); kb1 = MLA_LDK(kp, 1, 1); \
      MLA_MF0(C0, ka0, qr[0]); MLA_E4(P0, 8); MLA_SB(); \
      MLA_MF0(C1, ka1, qr[0]); MLA_E4(P0, 12); MLA_A4(P0, 0); MLA_SB(); \
      ka0 = MLA_LDK(kp, 2, 0); ka1 = MLA_LDK(kp, 2, 1); \
      MLA_MF(C0, kb0, qr[1]); MLA_E4(P1, 0); MLA_A4(P0, 4); MLA_SB(); \
      MLA_MF(C1, kb1, qr[1]); MLA_E4(P1, 4); MLA_A4(P0, 8); MLA_PK2(pw0, 0, P0, 0); MLA_SB(); \
      kb0 = MLA_LDK(kp, 3, 0); kb1 = MLA_LDK(kp, 3, 1); \
      MLA_MF(C0, ka0, qr[2]); MLA_E4(P1, 8); MLA_A4(P0, 12); MLA_PK2(pw0, 2, P0, 4); MLA_SB(); \
      MLA_MF(C1, ka1, qr[2]); MLA_E4(P1, 12); MLA_A4(P1, 0); MLA_PK2(pw1, 0, P0, 8); MLA_SB(); \
      ka0 = MLA_LDK(kp, 4, 0); ka1 = MLA_LDK(kp, 4, 1); \
      MLA_MF(C0, kb0, qr[3]); MLA_A4(P1, 4); MLA_PK2(pw1, 2, P0, 12); MLA_SB(); \
      MLA_MF(C1, kb1, qr[3]); MLA_A4(P1, 8); MLA_PK2(pw2, 0, P1, 0); MLA_SB(); \
      kb0 = MLA_LDK(kp, 5, 0); kb1 = MLA_LDK(kp, 5, 1); \
      MLA_MF(C0, ka0, qr[4]); MLA_A4(P1, 12); MLA_PK2(pw2, 2, P1, 4); MLA_SB(); \
      MLA_MF(C1, ka1, qr[4]); MLA_PK2(pw3, 0, P1, 8); MLA_SB(); \
      MLA_MF(C0, kb0, qr[5]); MLA_PK2(pw3, 2, P1, 12); MLA_SB(); \
      MLA_MF(C1, kb1, qr[5]); MLA_SB(); \
      l_reg += sacc; } \
    pv(o, vb0 + s0 * VSLOT, __builtin_bit_cast(bf16x8, pw0), __builtin_bit_cast(bf16x8, pw1), __builtin_bit_cast(bf16x8, pw2), __builtin_bit_cast(bf16x8, pw3)); \
    if ((JB) >= 0) cmask(C0, C1, (JB), qrel, hi); \
    MLA_REF(C0, C1, true); \
    { const int s_ = s0; s0 = s1; s1 = s2; s2 = s_; } \
} while (0)

template <int THRL> __device__ __forceinline__ void unit_pipe(int b, int h, int qb, const unsigned short* Q, const unsigned short* KV, const unsigned short* KPE, unsigned short* O, char* shm, const int wave_) {
    int tid_ = tid_from_wave(wave_); asm volatile("" : "+v"(tid_));
    const int tid = tid_, lane = tid & 63, r32 = lane & 31, hi = lane >> 5; const int wid = __builtin_amdgcn_readfirstlane(tid >> 6);
    const long rowbase = (long)b * SEQ; const int q0 = qb * QB;
    const unsigned short* Qw = Q + (rowbase + q0 + wid * QBLK) * QP + h * 96;
    const unsigned short* Kh = KV + rowbase * KVP + h * 128; const unsigned short* Vh = Kh + 64; const unsigned short* Ph = KPE + rowbase * PEP;
    const unsigned lds0 = (unsigned)(uintptr_t)shm;
    __attribute__((address_space(3))) float* wsf = (__attribute__((address_space(3))) float*)((lds_cptr)shm + LDS_WS) + wid * 64;
    const unsigned short* ksrc = Kh + (long)lane * KVP + wid * 8;
    const unsigned short* psrc = Ph + (long)(32 * (wid & 1) + r32) * PEP + (wid >> 1) * 8;
    const unsigned short* vsrc = Vh + (long)(16 * (wid & 3) + (lane >> 2)) * KVP + (wid >> 2) * 32 + (lane & 3) * 8;
    const unsigned kdst = lds0 + LDS_K + wid * 1024, pdst = lds0 + LDS_K + (8 + (wid >> 1)) * 1024 + (wid & 1) * 512, vdst = lds0 + LDS_V + wid * 1024;
    const int vb0 = (int)(lds0 + LDS_V) + ((lane >> 4) & 1) * 32 + (lane & 3) * 8 + (4 * hi + ((lane & 15) >> 2)) * 64;
    const lds_cptr kp0 = (lds_cptr)shm + LDS_K + hi * 1024 + r32 * 16;
    const int NT = (q0 + QB) / KVBLK;
    bf16x8 qr[6];
#pragma unroll
    for (int d0 = 0; d0 < 6; ++d0) qr[d0] = *reinterpret_cast<const bf16x8*>(&Qw[(long)r32 * QP + d0 * 16 + hi * 8]);
    asm volatile("s_waitcnt vmcnt(0)" ::: "memory");
    glds16(ksrc, (unsigned)__builtin_amdgcn_readfirstlane(kdst)); if (lane < 32) glds16(psrc, (unsigned)__builtin_amdgcn_readfirstlane(pdst));
    glds16(ksrc + (long)KVBLK * KVP, (unsigned)__builtin_amdgcn_readfirstlane(kdst + KSLOT)); if (lane < 32) glds16(psrc + (long)KVBLK * PEP, (unsigned)__builtin_amdgcn_readfirstlane(pdst + KSLOT)); glds16(vsrc, (unsigned)__builtin_amdgcn_readfirstlane(vdst));
    glds16(ksrc + (long)2 * KVBLK * KVP, (unsigned)__builtin_amdgcn_readfirstlane(kdst + 2 * KSLOT)); if (lane < 32) glds16(psrc + (long)2 * KVBLK * PEP, (unsigned)__builtin_amdgcn_readfirstlane(pdst + 2 * KSLOT)); glds16(vsrc + (long)KVBLK * KVP, (unsigned)__builtin_amdgcn_readfirstlane(vdst + VSLOT));
    float mhat = 0.f, l_reg = 0.f; f32x16 o[2]; o[0] = f32x16{}; o[1] = f32x16{}; f32x16 negm = f32x16{}; MLA_PIN(negm);
    const int qrel = wid * QBLK + r32;
    f32x16 pA0, pA1, pB0, pB1; u32x4 pw0, pw1, pw2, pw3;
    int s0 = 0, s1 = 1, s2 = 2;
    MLA_WAIT_BAR(6);
    { const lds_cptr kp = kp0;
      pA0 = f32x16{}; pA1 = f32x16{};
#pragma unroll
      for (int d0 = 0; d0 < 6; ++d0) { const bf16x8 k0 = MLA_LDK(kp, d0, 0), k1 = MLA_LDK(kp, d0, 1); MLA_MF(pA0, k0, qr[d0]); MLA_MF(pA1, k1, qr[d0]); } }
    { const float rm_ = rowmax(pA0, pA1); mhat = rm_;
#pragma unroll
      for (int r = 0; r < 16; ++r) { pA0[r] -= rm_; pA1[r] -= rm_; negm[r] = -mhat; }
      MLA_PIN(negm); }
    int t = 0;
    MLA_STEP(pB0, pB1, pA0, pA1, t, -1, 3, true, true); ++t;
    for (; t + 1 <= NT - 6; t += 2) {
        MLA_STEP(pA0, pA1, pB0, pB1, t, -1, 3, true, true);
        MLA_STEP(pB0, pB1, pA0, pA1, t + 1, -1, 3, true, true);
    }
    MLA_STEP(pA0, pA1, pB0, pB1, t, 0, 3, true, true); ++t;
    MLA_STEP(pB0, pB1, pA0, pA1, t, 1, 3, true, true); ++t;
    MLA_STEP(pA0, pA1, pB0, pB1, t, 2, 3, false, true); ++t;
    MLA_STEP(pB0, pB1, pA0, pA1, t, 3, 1, false, false); ++t;
    MLA_WAIT_BAR(0);
    MLA_SOFT(pB0, pB1);
    pv(o, vb0 + s0 * VSLOT, __builtin_bit_cast(bf16x8, pw0), __builtin_bit_cast(bf16x8, pw1), __builtin_bit_cast(bf16x8, pw2), __builtin_bit_cast(bf16x8, pw3));
    { auto rr = __builtin_amdgcn_permlane32_swap(__float_as_uint(l_reg), __float_as_uint(l_reg), false, false); l_reg = __uint_as_float(rr[0]) + __uint_as_float(rr[1]); }
    if (hi == 0) wsf[32 + r32] = l_reg; asm volatile("s_waitcnt lgkmcnt(0)" ::: "memory");
    float rli[16];
#pragma unroll
    for (int r = 0; r < 16; ++r) rli[r] = __builtin_amdgcn_rcpf(wsf[32 + crow(r, hi)]);
    unsigned short* Ow = O + (rowbase + q0 + wid * QBLK) * OP + 512 + h * 64;
    { __attribute__((address_space(3))) unsigned short* stg = (__attribute__((address_space(3))) unsigned short*)((lds_cptr)shm + LDS_OST) + wid * 2048;
#pragma unroll
      for (int r = 0; r < 16; ++r) { const int orow = crow(r, hi);
#pragma unroll
          for (int d0 = 0; d0 < 2; ++d0) stg[orow * 64 + d0 * 32 + r32] = (unsigned short)(cvtpk_s(o[d0][r] * rli[r], 0.f) & 0xffffu); }
      asm volatile("s_waitcnt lgkmcnt(0)" ::: "memory");
#pragma unroll
      for (int i = 0; i < 4; ++i) { const int row = i * 8 + (lane >> 3), ch = lane & 7; const u32x4 v = *(const __attribute__((address_space(3))) u32x4*)(stg + row * 64 + ch * 8); *(u32x4*)(Ow + (long)row * OP + ch * 8) = v; } }
    asm volatile("s_waitcnt vmcnt(0) lgkmcnt(0)\n\ts_barrier" ::: "memory");
}

constexpr int S4_V = NSLOT * KSLOT, S4_WS = S4_V + 4 * VSLOT, S4_OST = S4_WS + NW * 64 * 4, S4_TOTAL = S4_OST + NW * 4096;
#define MLA_R1(C0, C1, P0, P1, kp) do { float sacc = 0.f; bf16x8 ka0, ka1, kb0, kb1; \
      ka0 = MLA_LDK(kp, 0, 0); ka1 = MLA_LDK(kp, 0, 1); MLA_E4(P0, 0); MLA_E4(P0, 4); MLA_SB(); \
      kb0 = MLA_LDK(kp, 1, 0); kb1 = MLA_LDK(kp, 1, 1); \
      MLA_MF0(C0, ka0, qr[0]); MLA_E4(P0, 8); MLA_SB(); \
      MLA_MF0(C1, ka1, qr[0]); MLA_E4(P0, 12); MLA_A4(P0, 0); MLA_SB(); \
      ka0 = MLA_LDK(kp, 2, 0); ka1 = MLA_LDK(kp, 2, 1); \
      MLA_MF(C0, kb0, qr[1]); MLA_E4(P1, 0); MLA_A4(P0, 4); MLA_SB(); \
      MLA_MF(C1, kb1, qr[1]); MLA_E4(P1, 4); MLA_A4(P0, 8); MLA_PK2(pw0, 0, P0, 0); MLA_SB(); \
      kb0 = MLA_LDK(kp, 3, 0); kb1 = MLA_LDK(kp, 3, 1); \
      MLA_MF(C0, ka0, qr[2]); MLA_E4(P1, 8); MLA_A4(P0, 12); MLA_PK2(pw0, 2, P0, 4); MLA_SB(); \
      MLA_MF(C1, ka1, qr[2]); MLA_E4(P1, 12); MLA_A4(P1, 0); MLA_PK2(pw1, 0, P0, 8); MLA_SB(); \
      ka0 = MLA_LDK(kp, 4, 0); ka1 = MLA_LDK(kp, 4, 1); \
      MLA_MF(C0, kb0, qr[3]); MLA_A4(P1, 4); MLA_PK2(pw1, 2, P0, 12); MLA_SB(); \
      MLA_MF(C1, kb1, qr[3]); MLA_A4(P1, 8); MLA_PK2(pw2, 0, P1, 0); MLA_SB(); \
      kb0 = MLA_LDK(kp, 5, 0); kb1 = MLA_LDK(kp, 5, 1); \
      MLA_MF(C0, ka0, qr[4]); MLA_A4(P1, 12); MLA_PK2(pw2, 2, P1, 4); MLA_SB(); \
      MLA_MF(C1, ka1, qr[4]); MLA_PK2(pw3, 0, P1, 8); MLA_SB(); \
      MLA_MF(C0, kb0, qr[5]); MLA_PK2(pw3, 2, P1, 12); MLA_SB(); \
      MLA_MF(C1, kb1, qr[5]); MLA_SB(); \
      l_reg += sacc; } while (0)
#define MLA_PVW(slot) pv(o, vb0 + (slot) * VSLOT, __builtin_bit_cast(bf16x8, pw0), __builtin_bit_cast(bf16x8, pw1), __builtin_bit_cast(bf16x8, pw2), __builtin_bit_cast(bf16x8, pw3))
#define MLA_DMA4(t, GK, GV) do { \
    if (GK) { glds16(ksrc + (long)((t) + 3) * KVBLK * KVP, (unsigned)__builtin_amdgcn_readfirstlane(kdst + s0 * KSLOT)); \
              if (lane < 32) glds16(psrc + (long)((t) + 3) * KVBLK * PEP, (unsigned)__builtin_amdgcn_readfirstlane(pdst + s0 * KSLOT)); } \
    if (GV) { glds16(vsrc + (long)((t) + 2) * KVBLK * KVP, (unsigned)__builtin_amdgcn_readfirstlane(vdst + (((t) + 2) & 3) * VSLOT)); } } while (0)
#define MLA_REFB(C0, C1) do { const float rm_ = rowmax(C0, C1); \
      if (__builtin_expect(__any(rm_ > (float)THRL), 0)) { const float dl_ = fmaxf(rm_, 0.f); mhat += dl_; \
          _Pragma("unroll") for (int r = 0; r < 16; ++r) { C0[r] -= dl_; C1[r] -= dl_; } \
          _Pragma("unroll") for (int r = 0; r < 16; ++r) negm[r] = -mhat; MLA_PIN(negm); \
          const float f_ = __builtin_amdgcn_exp2f(-dl_); l_reg *= f_; if (hi == 0) wsf[r32] = f_; resc = true; } } while (0)
#define MLA_RESCB() do { if (resc) { asm volatile("s_waitcnt lgkmcnt(0)" ::: "memory"); _Pragma("unroll") for (int r = 0; r < 16; ++r) { const float g_ = wsf[crow(r, hi)]; o[0][r] *= g_; o[1][r] *= g_; } resc = false; } } while (0)
#define MLA_STEPS(C0, C1, P0, P1, t, JB, WAITN, GK, GV, HASPV) do { \
    MLA_WAIT_BAR(WAITN); MLA_DMA4(t, GK, GV); \
    if (LATE) { if (HASPV) { MLA_PVW(((t) + 3) & 3); } MLA_RESCB(); } \
    { const lds_cptr kp = kp0 + s1 * KSLOT; MLA_R1(C0, C1, P0, P1, kp); } \
    if (!LATE) { MLA_PVW((t) & 3); } \
    if ((JB) >= 0) cmask(C0, C1, (JB), qrel, hi); \
    if (LATE) MLA_REFB(C0, C1); else MLA_REF(C0, C1, true); \
    { const int s_ = s0; s0 = s1; s1 = s2; s2 = s_; } } while (0)

template <int THRL, bool LATE> __device__ __forceinline__ void unit_stag(int b, int h, int qb, const unsigned short* Q, const unsigned short* KV, const unsigned short* KPE, unsigned short* O, char* shm, const int wave_) {
    int tid_ = tid_from_wave(wave_); asm volatile("" : "+v"(tid_));
    const int tid = tid_, lane = tid & 63, r32 = lane & 31, hi = lane >> 5; const int wid = __builtin_amdgcn_readfirstlane(tid >> 6);
    const long rowbase = (long)b * SEQ; const int q0 = qb * QB;
    const unsigned short* Qw = Q + (rowbase + q0 + wid * QBLK) * QP + h * 96;
    const unsigned short* Kh = KV + rowbase * KVP + h * 128; const unsigned short* Vh = Kh + 64; const unsigned short* Ph = KPE + rowbase * PEP;
    const unsigned lds0 = (unsigned)(uintptr_t)shm;
    __attribute__((address_space(3))) float* wsf = (__attribute__((address_space(3))) float*)((lds_cptr)shm + S4_WS) + wid * 64;
    const unsigned short* ksrc = Kh + (long)lane * KVP + wid * 8;
    const unsigned short* psrc = Ph + (long)(32 * (wid & 1) + r32) * PEP + (wid >> 1) * 8;
    const unsigned short* vsrc = Vh + (long)(16 * (wid & 3) + (lane >> 2)) * KVP + (wid >> 2) * 32 + (lane & 3) * 8;
    const unsigned kdst = lds0 + LDS_K + wid * 1024, pdst = lds0 + LDS_K + (8 + (wid >> 1)) * 1024 + (wid & 1) * 512, vdst = lds0 + S4_V + wid * 1024;
    const int vb0 = (int)(lds0 + S4_V) + ((lane >> 4) & 1) * 32 + (lane & 3) * 8 + (4 * hi + ((lane & 15) >> 2)) * 64;
    const lds_cptr kp0 = (lds_cptr)shm + LDS_K + hi * 1024 + r32 * 16;
    const int NT = (q0 + QB) / KVBLK;
    bf16x8 qr[6];
#pragma unroll
    for (int d0 = 0; d0 < 6; ++d0) qr[d0] = *reinterpret_cast<const bf16x8*>(&Qw[(long)r32 * QP + d0 * 16 + hi * 8]);
    asm volatile("s_waitcnt vmcnt(0)" ::: "memory");
    glds16(ksrc, (unsigned)__builtin_amdgcn_readfirstlane(kdst)); if (lane < 32) glds16(psrc, (unsigned)__builtin_amdgcn_readfirstlane(pdst));
    glds16(ksrc + (long)KVBLK * KVP, (unsigned)__builtin_amdgcn_readfirstlane(kdst + KSLOT)); if (lane < 32) glds16(psrc + (long)KVBLK * PEP, (unsigned)__builtin_amdgcn_readfirstlane(pdst + KSLOT)); glds16(vsrc, (unsigned)__builtin_amdgcn_readfirstlane(vdst));
    glds16(ksrc + (long)2 * KVBLK * KVP, (unsigned)__builtin_amdgcn_readfirstlane(kdst + 2 * KSLOT)); if (lane < 32) glds16(psrc + (long)2 * KVBLK * PEP, (unsigned)__builtin_amdgcn_readfirstlane(pdst + 2 * KSLOT)); glds16(vsrc + (long)KVBLK * KVP, (unsigned)__builtin_amdgcn_readfirstlane(vdst + VSLOT));
    float mhat = 0.f, l_reg = 0.f; f32x16 o[2]; o[0] = f32x16{}; o[1] = f32x16{}; f32x16 negm = f32x16{}; MLA_PIN(negm);
    const int qrel = wid * QBLK + r32; bool resc = false;
    f32x16 pA0, pA1, pB0, pB1; u32x4 pw0, pw1, pw2, pw3;
    int s0 = 0, s1 = 1, s2 = 2;
    MLA_WAIT_BAR(6);
    { const lds_cptr kp = kp0;
      pA0 = f32x16{}; pA1 = f32x16{};
#pragma unroll
      for (int d0 = 0; d0 < 6; ++d0) { const bf16x8 k0 = MLA_LDK(kp, d0, 0), k1 = MLA_LDK(kp, d0, 1); MLA_MF(pA0, k0, qr[d0]); MLA_MF(pA1, k1, qr[d0]); } }
    { const float rm_ = rowmax(pA0, pA1); mhat = rm_;
#pragma unroll
      for (int r = 0; r < 16; ++r) { pA0[r] -= rm_; pA1[r] -= rm_; negm[r] = -mhat; }
      MLA_PIN(negm); }
    int t = 0;
    MLA_STEPS(pB0, pB1, pA0, pA1, t, -1, 3, true, true, false); ++t;
    for (; t + 1 <= NT - 6; t += 2) {
        MLA_STEPS(pA0, pA1, pB0, pB1, t, -1, 3, true, true, true);
        MLA_STEPS(pB0, pB1, pA0, pA1, t + 1, -1, 3, true, true, true);
    }
    MLA_STEPS(pA0, pA1, pB0, pB1, t, 0, 3, true, true, true); ++t;
    MLA_STEPS(pB0, pB1, pA0, pA1, t, 1, 3, true, true, true); ++t;
    MLA_STEPS(pA0, pA1, pB0, pB1, t, 2, 3, false, true, true); ++t;
    MLA_STEPS(pB0, pB1, pA0, pA1, t, 3, 1, false, false, true); ++t;
    MLA_WAIT_BAR(0);
    if (LATE) { MLA_PVW((NT - 2) & 3); MLA_RESCB(); }
    MLA_SOFT(pB0, pB1);
    MLA_PVW((NT - 1) & 3);
    { auto rr = __builtin_amdgcn_permlane32_swap(__float_as_uint(l_reg), __float_as_uint(l_reg), false, false); l_reg = __uint_as_float(rr[0]) + __uint_as_float(rr[1]); }
    if (hi == 0) wsf[32 + r32] = l_reg; asm volatile("s_waitcnt lgkmcnt(0)" ::: "memory");
    float rli[16];
#pragma unroll
    for (int r = 0; r < 16; ++r) rli[r] = __builtin_amdgcn_rcpf(wsf[32 + crow(r, hi)]);
    unsigned short* Ow = O + (rowbase + q0 + wid * QBLK) * OP + 512 + h * 64;
    { __attribute__((address_space(3))) unsigned short* stg = (__attribute__((address_space(3))) unsigned short*)((lds_cptr)shm + S4_OST) + wid * 2048;
#pragma unroll
      for (int r = 0; r < 16; ++r) { const int orow = crow(r, hi);
#pragma unroll
          for (int d0 = 0; d0 < 2; ++d0) stg[orow * 64 + d0 * 32 + r32] = (unsigned short)(cvtpk_s(o[d0][r] * rli[r], 0.f) & 0xffffu); }
      asm volatile("s_waitcnt lgkmcnt(0)" ::: "memory");
#pragma unroll
      for (int i = 0; i < 4; ++i) { const int row = i * 8 + (lane >> 3), ch = lane & 7; const u32x4 v = *(const __attribute__((address_space(3))) u32x4*)(stg + row * 64 + ch * 8); *(u32x4*)(Ow + (long)row * OP + ch * 8) = v; } }
    asm volatile("s_waitcnt vmcnt(0) lgkmcnt(0)\n\ts_barrier" ::: "memory");
}
__device__ __forceinline__ void phase(char* lds, const unsigned short* Q, const unsigned short* KV, const unsigned short* KPE, unsigned short* O, int vcu, int G, const int wave_) {
    for (int v = vcu; v < 256; v += G) { const int s = v & 7, bh = v >> 3;
#pragma unroll 1
        for (int i = 0; i < 4; ++i) { const int qb = (i == 0) ? s : (i == 1) ? 15 - s : (i == 2) ? 16 + s : 31 - s; if (qb == 0) unit(bh >> 3, bh & 7, qb, Q, KV, KPE, O, lds, wave_); else if (wave_ < 4) unit_stag<8, false>(bh >> 3, bh & 7, qb, Q, KV, KPE, O, lds, wave_); else unit_stag<8, true>(bh >> 3, bh & 7, qb, Q, KV, KPE, O, lds, wave_); } }
}
#undef MLA_WAIT_BAR
}

namespace evm {
using bf16x8 = __attribute__((ext_vector_type(8))) short;
using s16x4 = __attribute__((ext_vector_type(4))) short;
using f32x16 = __attribute__((ext_vector_type(16))) float;
using u32x4 = __attribute__((ext_vector_type(4))) unsigned;
typedef __attribute__((address_space(3))) char* lds_ptr;
constexpr int PP = 1792, VNP = 1088;
constexpr int LDS_VT = 0, LDS_WS = 65536, LDS_OST = LDS_WS + 2048, LDS_TOTAL = 139264;
__device__ __forceinline__ s16x4 trr(int addr) { s16x4 v; asm volatile("ds_read_b64_tr_b16 %0,%1" : "=&v"(v) : "v"(addr) : "memory"); return v; }
#define EVM_TR(dst, addr, off) asm volatile("ds_read_b64_tr_b16 %0,%1 offset:%c2" : "=&v"(dst) : "v"(addr), "i"(off) : "memory")
__device__ __forceinline__ float bflo(unsigned u) { return __uint_as_float(u << 16); }
__device__ __forceinline__ float bfhi(unsigned u) { return __uint_as_float(u & 0xffff0000u); }

__device__ __forceinline__ void unit(int un, const unsigned short* proj, const float* sinks, const float* ln_g, const float* ln_b, const unsigned short* wsb, const float* b_s, unsigned short* mix, char* shm, const int wave_) {
    int tid_ = tid_from_wave(wave_); asm volatile("" : "+v"(tid_));
    const int tid = tid_, lane = tid & 63, r32 = lane & 31, hi = lane >> 5; const int wid = __builtin_amdgcn_readfirstlane(tid >> 6);
    const int row0 = un * 128, tblk = (un & 63) * 128, seq0 = row0 - tblk;
    const lds_ptr L = (lds_ptr)shm; const unsigned lds0 = (unsigned)(uintptr_t)shm;
    for (int i = 0; i < 16; ++i) { const int tl = wid * 16 + i, grow = row0 + tl;
        const u32x4 w = *(const u32x4*)(proj + (size_t)grow * PP + 1280 + lane * 8);
        float x[8] = {bflo(w.x), bfhi(w.x), bflo(w.y), bfhi(w.y), bflo(w.z), bfhi(w.z), bflo(w.w), bfhi(w.w)};
        float s = 0.f;
#pragma unroll
        for (int j = 0; j < 8; ++j) s += x[j];
#pragma unroll
        for (int o = 1; o < 64; o <<= 1) s += __shfl_xor(s, o);
        const float mu = s * (1.f / 512.f); float qq = 0.f;
#pragma unroll
        for (int j = 0; j < 8; ++j) { x[j] -= mu; qq += x[j] * x[j]; }
#pragma unroll
        for (int o = 1; o < 64; o <<= 1) qq += __shfl_xor(qq, o);
        const float rstd = 1.0f / sqrtf(qq * (1.f / 512.f) + 1e-6f);
        const f32x4 g0 = ((const f32x4*)ln_g)[lane * 2], g1 = ((const f32x4*)ln_g)[lane * 2 + 1], b0 = ((const f32x4*)ln_b)[lane * 2], b1 = ((const f32x4*)ln_b)[lane * 2 + 1];
        u32x4 ov; ov.x = pg8::cvt_pk_bf16(x[0] * rstd * g0.x + b0.x, x[1] * rstd * g0.y + b0.y); ov.y = pg8::cvt_pk_bf16(x[2] * rstd * g0.z + b0.z, x[3] * rstd * g0.w + b0.w);
        ov.z = pg8::cvt_pk_bf16(x[4] * rstd * g1.x + b1.x, x[5] * rstd * g1.y + b1.y); ov.w = pg8::cvt_pk_bf16(x[6] * rstd * g1.z + b1.z, x[7] * rstd * g1.w + b1.w);
        *(__attribute__((address_space(3))) u32x4*)(L + tl * VNP + lane * 16) = ov; }
    __syncthreads();
    { const int g = wid;
      const int trb = (int)lds0 + ((lane >> 4) & 1) * 32 + (lane & 3) * 8 + (8 * hi + ((lane & 15) >> 2)) * VNP + g * 128;
#pragma unroll 1
      for (int i = 0; i < 4; ++i) { f32x16 a0 = f32x16{}, a1 = f32x16{};
          for (int s = 0; s < 2 * i + 2; ++s) {
              const bf16x8 A = *(const bf16x8*)(wsb + ((size_t)(g * 128 + 32 * i + r32) * 128 + 16 * s + 8 * hi));
              const int ad = trb + s * 16 * VNP; s16x4 l0, h0, l1, h1;
              EVM_TR(l0, ad, 0); EVM_TR(h0, ad, 4 * VNP); EVM_TR(l1, ad, 64); EVM_TR(h1, ad, 64 + 4 * VNP);
              asm volatile("s_waitcnt lgkmcnt(0)" : "+v"(l0), "+v"(h0), "+v"(l1), "+v"(h1) :: "memory"); __builtin_amdgcn_sched_barrier(0);
              const bf16x8 B0 = (bf16x8){l0[0], l0[1], l0[2], l0[3], h0[0], h0[1], h0[2], h0[3]}, B1 = (bf16x8){l1[0], l1[1], l1[2], l1[3], h1[0], h1[1], h1[2], h1[3]};
              a0 = __builtin_amdgcn_mfma_f32_32x32x16_bf16(A, B0, a0, 0, 0, 0); a1 = __builtin_amdgcn_mfma_f32_32x32x16_bf16(A, B1, a1, 0, 0, 0); }
#pragma unroll
          for (int r = 0; r < 16; ++r) { const int t = 32 * i + (r & 3) + 8 * (r >> 2) + 4 * hi; const float bs = b_s[g * 128 + t];
              const unsigned short* up = proj + (size_t)(row0 + t) * PP + 768 + g * 64 + r32; unsigned short* op = mix + (size_t)(row0 + t) * 1024 + 512 + g * 64 + r32;
              const float u0 = __uint_as_float(((unsigned)up[0]) << 16), u1 = __uint_as_float(((unsigned)up[32]) << 16);
              op[0] = (unsigned short)(pg8::cvt_pk_bf16(u0 * (a0[r] + bs), 0.f) & 0xffffu); op[32] = (unsigned short)(pg8::cvt_pk_bf16(u1 * (a1[r] + bs), 0.f) & 0xffffu); } } }
    asm volatile("s_waitcnt vmcnt(0) lgkmcnt(0)" ::: "memory");
    __syncthreads();
    { const int h = wid, kvh = h >> 2; const bool first = (tblk == 0);
#pragma unroll
      for (int T = 0; T < 8; ++T) { const int jt = T & 3; if (first && jt < 2) continue;
          const unsigned short* src = proj + (size_t)(seq0 + tblk - 128 + 64 * jt + 16 * (wid & 3) + (lane >> 2)) * PP + 640 + (T >> 2) * 64 + (wid >> 2) * 32 + (lane & 3) * 8;
          mla::glds16(src, (unsigned)__builtin_amdgcn_readfirstlane(lds0 + LDS_VT + T * 8192 + wid * 1024)); }
      asm volatile("s_waitcnt vmcnt(0)\n\ts_barrier" ::: "memory");
      const float slope2 = __builtin_amdgcn_exp2f(-(float)(h + 1)) * 1.4426950408889634f, sink2 = sinks[h] * 1.4426950408889634f;
      const int vb0 = (int)(lds0 + LDS_VT) + ((lane >> 4) & 1) * 32 + (lane & 3) * 8 + (4 * hi + ((lane & 15) >> 2)) * 64 + kvh * 4 * 8192;
      __attribute__((address_space(3))) float* wsf = (__attribute__((address_space(3))) float*)(L + LDS_WS) + wid * 64;
      __attribute__((address_space(3))) unsigned short* stg = (__attribute__((address_space(3))) unsigned short*)(L + LDS_OST) + wid * 2048;
#pragma unroll 1
      for (int i = 0; i < 4; ++i) {
          bf16x8 qr[4];
#pragma unroll
          for (int d0 = 0; d0 < 4; ++d0) qr[d0] = *(const bf16x8*)(proj + (size_t)(row0 + 32 * i + r32) * PP + h * 64 + d0 * 16 + hi * 8);
          f32x16 S[5]; float mx = sink2;
#pragma unroll
          for (int jj = 0; jj < 5; ++jj) { const int j = i + jj; S[jj] = f32x16{};
              if (first && j < 4) continue;
              const unsigned short* kp = proj + (size_t)(seq0 + tblk - 128 + 32 * j + r32) * PP + 512 + kvh * 64 + hi * 8;
              bf16x8 kf[4];
#pragma unroll
              for (int d0 = 0; d0 < 4; ++d0) kf[d0] = *(const bf16x8*)(kp + d0 * 16);
#pragma unroll
              for (int d0 = 0; d0 < 4; ++d0) S[jj] = __builtin_amdgcn_mfma_f32_32x32x16_bf16(kf[d0], qr[d0], S[jj], 0, 0, 0);
#pragma unroll
              for (int r = 0; r < 16; ++r) { const int dist = (128 + 32 * i + r32) - (32 * j + (r & 3) + 8 * (r >> 2) + 4 * hi);
                  const float v = S[jj][r] - slope2 * (float)dist; const bool ok = dist >= 0 && dist < 128;
                  S[jj][r] = ok ? v : -INFINITY; mx = fmaxf(mx, S[jj][r]); } }
          { auto rr = __builtin_amdgcn_permlane32_swap(__float_as_uint(mx), __float_as_uint(mx), false, false); mx = fmaxf(__uint_as_float(rr[0]), __uint_as_float(rr[1])); }
          float l = 0.f; f32x16 o[2]; o[0] = f32x16{}; o[1] = f32x16{};
#pragma unroll
          for (int jj = 0; jj < 5; ++jj) { const int j = i + jj;
              if (first && j < 4) continue;
#pragma unroll
              for (int r = 0; r < 16; ++r) { S[jj][r] = __builtin_amdgcn_exp2f(S[jj][r] - mx); l += S[jj][r]; }
              u32x4 pw0, pw1;
              pw0 = (u32x4){mla::cvtpk_s(S[jj][0], S[jj][1]), mla::cvtpk_s(S[jj][2], S[jj][3]), mla::cvtpk_s(S[jj][4], S[jj][5]), mla::cvtpk_s(S[jj][6], S[jj][7])};
              pw1 = (u32x4){mla::cvtpk_s(S[jj][8], S[jj][9]), mla::cvtpk_s(S[jj][10], S[jj][11]), mla::cvtpk_s(S[jj][12], S[jj][13]), mla::cvtpk_s(S[jj][14], S[jj][15])};
              const int va = vb0 + (j >> 1) * 8192 + (j & 1) * 2048;
#pragma unroll
              for (int d0 = 0; d0 < 2; ++d0) { s16x4 l0, h0, l1, h1;
                  EVM_TR(l0, va, d0 * 4096); EVM_TR(h0, va, d0 * 4096 + 512); EVM_TR(l1, va, d0 * 4096 + 1024); EVM_TR(h1, va, d0 * 4096 + 1024 + 512);
                  asm volatile("s_waitcnt lgkmcnt(0)" : "+v"(l0), "+v"(h0), "+v"(l1), "+v"(h1) :: "memory"); __builtin_amdgcn_sched_barrier(0);
                  const bf16x8 V0 = (bf16x8){l0[0], l0[1], l0[2], l0[3], h0[0], h0[1], h0[2], h0[3]}, V1 = (bf16x8){l1[0], l1[1], l1[2], l1[3], h1[0], h1[1], h1[2], h1[3]};
                  o[d0] = __builtin_amdgcn_mfma_f32_32x32x16_bf16(__builtin_bit_cast(bf16x8, pw0), V0, o[d0], 0, 0, 0);
                  o[d0] = __builtin_amdgcn_mfma_f32_32x32x16_bf16(__builtin_bit_cast(bf16x8, pw1), V1, o[d0], 0, 0, 0); } }
          { auto rr = __builtin_amdgcn_permlane32_swap(__float_as_uint(l), __float_as_uint(l), false, false); l = __uint_as_float(rr[0]) + __uint_as_float(rr[1]); }
          l += __builtin_amdgcn_exp2f(sink2 - mx);
          if (hi == 0) wsf[r32] = l; asm volatile("s_waitcnt lgkmcnt(0)" ::: "memory");
#pragma unroll
          for (int r = 0; r < 16; ++r) { const int orow = (r & 3) + 8 * (r >> 2) + 4 * hi; const float rl = __builtin_amdgcn_rcpf(wsf[orow]);
#pragma unroll
              for (int d0 = 0; d0 < 2; ++d0) stg[orow * 64 + d0 * 32 + r32] = (unsigned short)(mla::cvtpk_s(o[d0][r] * rl, 0.f) & 0xffffu); }
          asm volatile("s_waitcnt lgkmcnt(0)" ::: "memory");
          unsigned short* Ow = mix + (size_t)(row0 + 32 * i) * 1024 + h * 64;
#pragma unroll
          for (int k = 0; k < 4; ++k) { const int row = k * 8 + (lane >> 3), ch = lane & 7; const u32x4 v = *(const __attribute__((address_space(3))) u32x4*)(stg + row * 64 + ch * 8); *(u32x4*)(Ow + (size_t)row * 1024 + ch * 8) = v; }
          asm volatile("s_waitcnt lgkmcnt(0)" ::: "memory");
      } }
    asm volatile("s_waitcnt vmcnt(0) lgkmcnt(0)" ::: "memory");
    __syncthreads();
}
#undef EVM_TR
}

constexpr int NWAVES = 8;
constexpr int BATCH = 4, SEQ = 8192, DM = 1024, NTOK = BATCH * SEQ;
constexpr int EVEN_IN = 1792, ODD_IN = 2336, ODD_IN_PAD = 2560, FF = 2816, FFE = 3584, NEXP = 8, ADA = 6144;
constexpr float NORM_EPS = 1e-6f, LOG2E = 1.4426950408889634f;
constexpr float QS_EVEN = 0.125f * LOG2E;
constexpr float QS_ODD = 0.10206207261596577f * LOG2E;
#ifndef MK_PER_PHASE
#define MK_PER_PHASE 0
#endif
constexpr int NPH = 20;
#ifndef MK_DUPMASK
#define MK_DUPMASK 0u
#endif
#ifndef MK_PROBE_NULLEPI
#define MK_PROBE_NULLEPI 0
#endif
#ifndef MK_CLKPH
#define MK_CLKPH -1
#endif
#define CLKW ((volatile LAS unsigned long long*)(lds0 + LDSCTL_OFF + 768))
#define CLK0(k) do { if (MK_CLKPH == (k) && wave_s == 0) { CLKW[0] = __builtin_amdgcn_s_memtime(); CLKW[1] = __builtin_amdgcn_s_memrealtime(); } } while (0)
#define CLK1(k) do { if (MK_CLKPH == (k) && wave_s == 0) { const unsigned long long c1_ = __builtin_amdgcn_s_memtime(), r1_ = __builtin_amdgcn_s_memrealtime(); CLKW[2] = (c1_ - CLKW[0]) * 100ull / (r1_ - CLKW[1]); } } while (0)
#define NREP(k) ((((unsigned)MK_DUPMASK >> (k)) & 1u) ? 2 : 1)

constexpr size_t MiB = 1u << 20, KiB = 1024;
constexpr size_t WS_CTL = 0, CTL_ZERO_BYTES = 128 * KiB;
constexpr size_t WS_MOD = 1 * MiB;
constexpr size_t WS_ROPEC = 1 * MiB + 256 * KiB, WS_ROPES = WS_ROPEC + 512 * KiB;
constexpr size_t WS_TOKE = 2 * MiB + 256 * KiB, WS_TOKG = WS_TOKE + 256 * KiB, WS_TOKS = WS_TOKG + 256 * KiB;
constexpr size_t WS_SA = 3 * MiB + 512 * KiB;
constexpr size_t WS_PEXP = WS_TOKS + 256 * KiB, WS_WSB = WS_PEXP + 64 * KiB;
constexpr size_t WS_WEGU = 4 * MiB;
constexpr size_t WS_WED = 60 * MiB;
constexpr float WSC_GU = 32.f, WSC_D = 64.f;
constexpr size_t WS_H = 88 * MiB;
constexpr size_t WS_HN = 152 * MiB;
constexpr size_t WS_PROJ = 216 * MiB;
constexpr size_t WS_MIX0 = 328 * MiB;
constexpr size_t WS_ACT = 216 * MiB;
constexpr size_t WS_QN = 376 * MiB, WS_KVN = 408 * MiB, WS_KPE = 424 * MiB, WS_MIX1 = 426 * MiB;
constexpr size_t WS_Q = 216 * MiB, WS_KV = 264 * MiB;
constexpr size_t WS_WNE = 490 * MiB;
constexpr size_t WS_WIN0 = WS_WNE, WS_WO0 = WS_WIN0 + 3584 * KiB, WS_WGU0 = WS_WO0 + 2 * MiB, WS_WD0 = WS_WGU0 + 11 * MiB, WS_WIN1 = WS_WD0 + 5632 * KiB,
                 WS_WQB = WS_WIN1 + 5 * MiB, WS_WKVB = WS_WQB + 768 * KiB, WS_WO1 = WS_WKVB + 512 * KiB, WS_WNE_END = WS_WO1 + 2 * MiB;
constexpr int MOE_ROWS = 264 * 256;
constexpr size_t WS_XS = 152 * MiB;
constexpr size_t WS_HN2 = 218 * MiB;
constexpr size_t WS_Y = 152 * MiB;
constexpr size_t WS_ACTE = 284 * MiB;
constexpr size_t WS_END = 522 * MiB;
static_assert(WS_WNE_END <= WS_END && WS_MIX1 + 64 * MiB <= WS_WNE && WS_ACTE + (size_t)MOE_ROWS * FFE <= WS_END && WS_WED + (size_t)8 * DM * FFE <= WS_H && WS_H + (size_t)NTOK * DM * 2 <= WS_HN
              && WS_XS + (size_t)MOE_ROWS * DM <= WS_HN2 && WS_HN2 + (size_t)NTOK * DM <= WS_ACTE && WS_Y + (size_t)MOE_ROWS * DM * 2 <= WS_ACTE && WS_ACT + (size_t)NTOK * FF * 2 <= WS_MIX0 + 64 * MiB, "d_ws map");
constexpr int CW_TMO = 0, CW_CODE = 1, CW_BAR = 4096, CW_CNT = 8192, CW_CUR = 9216, CW_CM0 = 16384, CW_CM1 = CW_CM0 + 2048, CW_CMG = CW_CM1 + 2560, CW_CM_END = CW_CMG + 5632;
static_assert(CW_CM_END * 4 <= (int)CTL_ZERO_BYTES, "control words inside the memset");
constexpr int RING_BYTES = 131072, LDS_BYTES = 147456, LDSCTL_OFF = LDS_BYTES - 1024, MISC_OFF = LDSCTL_OFF + 320;

typedef unsigned v2u __attribute__((ext_vector_type(2)));
__device__ __forceinline__ unsigned pk2(float lo, float hi) { return pg8::cvt_pk_bf16(lo, hi); }
__device__ __forceinline__ float bflo(unsigned u) { return __uint_as_float(u << 16); }
__device__ __forceinline__ float bfhi(unsigned u) { return __uint_as_float(u & 0xffff0000u); }
__device__ __forceinline__ float bf2f(bf16 h) { return __uint_as_float(((unsigned)h) << 16); }
__device__ __forceinline__ float wave_sum(float v) {
#pragma unroll
    for (int o = 1; o < 64; o <<= 1) v += __shfl_xor(v, o);
    return v;
}
__device__ __forceinline__ float rsqrt_f(float x) { return 1.0f / sqrtf(x); }

struct Ctx { LAS unsigned char* lds; int tid, lane, wave, vcu, G, gw, NGW; };

__device__ __forceinline__ void transpose_item(const float* W, int K, int N, bf16* WT, int row_base, bool pp, LAS float* scr, int kb, int nb, int lane) {
    const int k0 = 64 * kb, n0 = 32 * nb;
    float tv_[32];
#pragma unroll
    for (int i = 0; i < 32; ++i) tv_[i] = W[(size_t)(k0 + 2 * i + (lane >> 5)) * N + n0 + (lane & 31)];
#pragma unroll
    for (int i = 0; i < 32; ++i) scr[(2 * i + (lane >> 5)) * 33 + (lane & 31)] = tv_[i];
    LDS_WAIT(); asm volatile("" ::: "memory");
    const int c = lane & 7;
#pragma unroll
    for (int j = 0; j < 4; ++j) { const int n = (lane >> 3) + 8 * j; const LAS float* s = scr + (8 * c) * 33 + n;
        v4u o; o.x = pk2(s[0 * 33], s[1 * 33]); o.y = pk2(s[2 * 33], s[3 * 33]); o.z = pk2(s[4 * 33], s[5 * 33]); o.w = pk2(s[6 * 33], s[7 * 33]);
        const int nd = pp ? ((n < 16) ? 2 * n : 2 * (n - 16) + 1) : n;
        *(v4u*)(WT + (size_t)(row_base + nd) * K + k0 + 8 * c) = o; }
    LDS_WAIT(); asm volatile("" ::: "memory");
}
__device__ __forceinline__ void transpose_item8(const float* W, int K, int N, unsigned char* WT, int row_base, float sc, LAS float* scr, int kb, int nb, int lane) {
    const int k0 = 64 * kb, n0 = 32 * nb;
    f32x4 tv_[8];
#pragma unroll
    for (int i = 0; i < 8; ++i) tv_[i] = *(const f32x4*)(W + (size_t)(k0 + 8 * i + (lane >> 3)) * N + n0 + 4 * (lane & 7));
#pragma unroll
    for (int i = 0; i < 8; ++i) { LAS float* d = scr + (8 * i + (lane >> 3)) * 33 + 4 * (lane & 7); d[0] = tv_[i].x; d[1] = tv_[i].y; d[2] = tv_[i].z; d[3] = tv_[i].w; }
    LDS_WAIT(); asm volatile("" ::: "memory");
    const int c = lane & 7;
#pragma unroll
    for (int j = 0; j < 4; ++j) { const int n = (lane >> 3) + 8 * j; const LAS float* s = scr + (8 * c) * 33 + n;
        v2u o; o.x = pg8::pack4_fp8(s[0 * 33] * sc, s[1 * 33] * sc, s[2 * 33] * sc, s[3 * 33] * sc); o.y = pg8::pack4_fp8(s[4 * 33] * sc, s[5 * 33] * sc, s[6 * 33] * sc, s[7 * 33] * sc);
        *(v2u*)(WT + (size_t)(row_base + n) * K + k0 + 8 * c) = o; }
    LDS_WAIT(); asm volatile("" ::: "memory");
}
__device__ __forceinline__ void amax_item(const float* W, int N, unsigned* cm, int row_base, bool pp, int kb, int nb, int lane) {
    const int k0 = 64 * kb, n0 = 32 * nb; float mx = 0.f;
#pragma unroll
    for (int i = 0; i < 32; ++i) mx = fmaxf(mx, fabsf(W[(size_t)(k0 + 2 * i + (lane >> 5)) * N + n0 + (lane & 31)]));
    mx = fmaxf(mx, __shfl_xor(mx, 32));
    if (lane < 32) { const int n = lane, nd = pp ? ((n < 16) ? 2 * n : 2 * (n - 16) + 1) : n; atomicMax(cm + row_base + nd, __float_as_uint(mx)); }
}
__device__ __forceinline__ void transpose_item_i8(const float* W, int K, int N, unsigned char* WT, int row_base, const unsigned* cm, LAS float* scr, int kb, int nb, int lane, bool pp = false) {
    const int k0 = 64 * kb, n0 = 32 * nb;
    float tv_[32];
#pragma unroll
    for (int i = 0; i < 32; ++i) tv_[i] = W[(size_t)(k0 + 2 * i + (lane >> 5)) * N + n0 + (lane & 31)];
#pragma unroll
    for (int i = 0; i < 32; ++i) scr[(2 * i + (lane >> 5)) * 33 + (lane & 31)] = tv_[i];
    LDS_WAIT(); asm volatile("" ::: "memory");
    const int c = lane & 7;
#pragma unroll
    for (int j = 0; j < 4; ++j) { const int n = (lane >> 3) + 8 * j; const LAS float* s = scr + (8 * c) * 33 + n;
        const int nd = pp ? ((n < 16) ? 2 * n : 2 * (n - 16) + 1) : n;
        const float cmv = __uint_as_float(cm[row_base + nd]), qs = cmv > 0.f ? 127.f / cmv : 0.f;
        v2u o; o.x = pg8::pack4_i8(s[0 * 33] * qs, s[1 * 33] * qs, s[2 * 33] * qs, s[3 * 33] * qs); o.y = pg8::pack4_i8(s[4 * 33] * qs, s[5 * 33] * qs, s[6 * 33] * qs, s[7 * 33] * qs);
        *(v2u*)(WT + (size_t)(row_base + nd) * K + k0 + 8 * c) = o; }
    LDS_WAIT(); asm volatile("" ::: "memory");
}
struct In {
    const float *x, *c, *e_ada_w, *e_ada_b, *e_nmix_g, *e_w_in, *e_sinks, *e_ln_g, *e_ln_b, *e_w_s, *e_b_s, *e_w_o, *e_nffn_g, *e_wg, *e_wu, *e_wd,
                *o_ada_w, *o_ada_b, *o_nmix_g, *o_w_in, *o_conv_w, *o_qn_g, *o_w_qb, *o_kvn_g, *o_w_kvb, *o_w_o, *o_nffn_g, *o_rw, *o_rb, *o_xg, *o_xu, *o_xd, *fin_g;
};
struct TD8 { const float* W; unsigned char* WT; int K, N, k0, n0, half, inter; float sc; };
__device__ __forceinline__ TD8 td8_decode(int t, const In& I, unsigned char* ws) {
    TD8 d; const int m = t / 1792, rr = t % 1792, e = rr / 224, r2 = rr % 224;
    if (m < 2) { d.W = (m ? I.o_xu : I.o_xg) + (size_t)e * DM * FFE; d.WT = ws + WS_WEGU + (size_t)e * 7168 * DM; d.K = DM; d.N = FFE; d.k0 = 64 * (r2 / 14); d.n0 = 256 * (r2 % 14); d.half = m; d.inter = 1; d.sc = WSC_GU; }
    else { d.W = I.o_xd + (size_t)e * FFE * DM; d.WT = ws + WS_WED + (size_t)e * DM * FFE; d.K = FFE; d.N = DM; d.k0 = 64 * (r2 / 4); d.n0 = 256 * (r2 % 4); d.half = 0; d.inter = 0; d.sc = WSC_D; }
    return d;
}
__device__ __forceinline__ void expert_tiles8(const Ctx& C, const In& I, unsigned char* ws) {
    constexpr int TP = 260, NTILE = 3 * 1792;
    LAS float* const buf0 = (LAS float*)C.lds; LAS float* const buf1 = buf0 + 64 * TP;
    int tile = C.vcu; if (tile >= NTILE) return;
    TD8 d = td8_decode(tile, I, ws);
    f32x4 r[8];
#pragma unroll
    for (int i = 0; i < 8; ++i) r[i] = *(const f32x4*)(d.W + (size_t)(d.k0 + 8 * C.wave + i) * d.N + d.n0 + 4 * C.lane);
    for (int it = 0; ; ++it) {
        LAS float* const buf = (it & 1) ? buf1 : buf0;
#pragma unroll
        for (int i = 0; i < 8; ++i) *(LAS f32x4*)(buf + (8 * C.wave + i) * TP + 4 * C.lane) = r[i];
        const TD8 c = d; const int nxt = tile + C.G;
        if (nxt < NTILE) { d = td8_decode(nxt, I, ws);
#pragma unroll
            for (int i = 0; i < 8; ++i) r[i] = *(const f32x4*)(d.W + (size_t)(d.k0 + 8 * C.wave + i) * d.N + d.n0 + 4 * C.lane); }
        LDS_WAIT(); __syncthreads();
        { const int nl = 32 * C.wave + (C.lane & 31), kh = C.lane >> 5, n = c.n0 + nl;
          const LAS float* s = buf + (32 * kh) * TP + nl; float v[32];
#pragma unroll
          for (int j = 0; j < 32; ++j) v[j] = s[j * TP] * c.sc;
          v4u o0, o1;
          o0.x = pg8::pack4_fp8(v[0], v[1], v[2], v[3]); o0.y = pg8::pack4_fp8(v[4], v[5], v[6], v[7]); o0.z = pg8::pack4_fp8(v[8], v[9], v[10], v[11]); o0.w = pg8::pack4_fp8(v[12], v[13], v[14], v[15]);
          o1.x = pg8::pack4_fp8(v[16], v[17], v[18], v[19]); o1.y = pg8::pack4_fp8(v[20], v[21], v[22], v[23]); o1.z = pg8::pack4_fp8(v[24], v[25], v[26], v[27]); o1.w = pg8::pack4_fp8(v[28], v[29], v[30], v[31]);
          const int row = c.inter ? (256 * (n >> 7) + (n & 127) + 128 * c.half) : n;
          v4u* dst = (v4u*)(c.WT + (size_t)row * c.K + c.k0 + 32 * kh); dst[0] = o0; dst[1] = o1; }
        if (nxt >= NTILE) break;
        tile = nxt;
    }
    __syncthreads();
}
__device__ __forceinline__ void p0_prologue(const Ctx& C, const In& I, unsigned char* ws) {
    if (blockIdx.x < 192) {
        const int layer = blockIdx.x / 96, cb = blockIdx.x % 96, j0 = cb * 64 + 4 * (C.lane & 15), rsub = C.lane >> 4;
        const float* W = layer ? I.o_ada_w : I.e_ada_w; const float* Bv = layer ? I.o_ada_b : I.e_ada_b;
        f32x4 acc[4]; acc[0] = acc[1] = acc[2] = acc[3] = (f32x4){0.f, 0.f, 0.f, 0.f};
#pragma unroll 1
        for (int ch = 0; ch < 4; ++ch) { const int k0 = C.wave * 128 + ch * 32; f32x4 wv[8];
#pragma unroll
            for (int i = 0; i < 8; ++i) wv[i] = *(const f32x4*)(W + (size_t)(k0 + 4 * i + rsub) * ADA + j0);
#pragma unroll
            for (int i = 0; i < 8; ++i) { const int k = k0 + 4 * i + rsub;
#pragma unroll
                for (int bb = 0; bb < 4; ++bb) { const float cv = I.c[bb * DM + k]; acc[bb] += wv[i] * (cv / (1.f + __expf(-cv))); } } }
#pragma unroll
        for (int bb = 0; bb < 4; ++bb)
#pragma unroll
            for (int e = 0; e < 4; ++e) { float v = acc[bb][e]; v += __shfl_xor(v, 16); v += __shfl_xor(v, 32); acc[bb][e] = v; }
        LAS float* red = (LAS float*)C.lds;
        if (C.lane < 16) {
#pragma unroll
            for (int bb = 0; bb < 4; ++bb) *(LAS f32x4*)(red + (C.wave * 4 + bb) * 64 + 4 * C.lane) = acc[bb]; }
        __syncthreads();
        if (C.tid < 256) { const int bb = C.tid >> 6, col = C.tid & 63; float s = 0.f;
#pragma unroll
            for (int w = 0; w < 8; ++w) s += red[(w * 4 + bb) * 64 + col];
            ((float*)(ws + WS_MOD))[(size_t)(layer * BATCH + bb) * ADA + cb * 64 + col] = s + Bv[cb * 64 + col]; }
        __syncthreads();
    }
    {
        bf16* wsb = (bf16*)(ws + WS_WSB);
        for (int idx = blockIdx.x * 512 + C.tid; idx < 8 * 128 * 128; idx += C.G * 512) { const int t = (idx >> 7) & 127, sp = idx & 127; wsb[idx] = (bf16)(pk2((sp <= t) ? I.e_w_s[idx] : 0.f, 0.f) & 0xffffu); }
        float* ct = (float*)(ws + WS_ROPEC); float* st = (float*)(ws + WS_ROPES);
        for (int idx = blockIdx.x * 512 + C.tid; idx < SEQ * 16; idx += C.G * 512) { const int pos = idx >> 4, i = idx & 15;
            const double inv = (double)exp2f(-(float)i * (13.287712379549449f / 16.0f));
            const double rev = (double)((float)pos * (float)inv) * 0.15915494309189535;
            const float fr = (float)(rev - __builtin_rint(rev));
            ct[idx] = __builtin_amdgcn_cosf(fr); st[idx] = __builtin_amdgcn_sinf(fr); }
    }
    LAS float* scr = (LAS float*)(C.lds + C.wave * 16384);
    constexpr int I_IN0 = 16 * 56, I_O = 16 * 32, I_GU0 = 16 * 88, I_D0 = 44 * 32, I_IN1 = 16 * 73, I_QB = 8 * 24, I_KVB = 4 * 32, I_XG1 = 16 * 112, I_XD1 = 56 * 32;
    constexpr int NITEMS = I_IN0 + I_O + 2 * I_GU0 + I_D0 + I_IN1 + I_QB + I_KVB + I_O;
    for (int it = C.gw; it < NITEMS; it += C.NGW) {
        int r = it;
        if (r < I_IN0) { const int kb = r / 56, nb = r % 56; amax_item(I.e_w_in, EVEN_IN, (unsigned*)(ws + WS_CTL) + CW_CM0, nb * 32, false, kb, nb, C.lane); continue; } r -= I_IN0;
        if (r < I_O) { const int kb = r / 32, nb = r % 32; transpose_item(I.e_w_o, DM, DM, (bf16*)(ws + WS_WO0), nb * 32, false, scr, kb, nb, C.lane); continue; } r -= I_O;
        if (r < I_GU0) { const int kb = r / 88, nb = r % 88, n0 = nb * 32; amax_item(I.e_wg, FF, (unsigned*)(ws + WS_CTL) + CW_CMG, 256 * (n0 >> 7) + (n0 & 127), false, kb, nb, C.lane); continue; } r -= I_GU0;
        if (r < I_GU0) { const int kb = r / 88, nb = r % 88, n0 = nb * 32; amax_item(I.e_wu, FF, (unsigned*)(ws + WS_CTL) + CW_CMG, 256 * (n0 >> 7) + (n0 & 127) + 128, false, kb, nb, C.lane); continue; } r -= I_GU0;
        if (r < I_D0) { const int kb = r / 32, nb = r % 32; transpose_item8(I.e_wd, FF, DM, (unsigned char*)(ws + WS_WD0), nb * 32, WSC_D, scr, kb, nb, C.lane); continue; } r -= I_D0;
        if (r < I_IN1) { const int kb = r / 73, nb = r % 73; amax_item(I.o_w_in, ODD_IN, (unsigned*)(ws + WS_CTL) + CW_CM1, nb * 32, nb == 72, kb, nb, C.lane); continue; } r -= I_IN1;
        if (r < I_QB) { const int kb = r / 24, nb = r % 24; transpose_item(I.o_w_qb, 512, 768, (bf16*)(ws + WS_WQB), nb * 32, (nb % 3) == 2, scr, kb, nb, C.lane); continue; } r -= I_QB;
        if (r < I_KVB) { const int kb = r / 32, nb = r % 32; transpose_item(I.o_w_kvb, 256, 1024, (bf16*)(ws + WS_WKVB), nb * 32, false, scr, kb, nb, C.lane); continue; } r -= I_KVB;
        if (r < I_O) { const int kb = r / 32, nb = r % 32; transpose_item(I.o_w_o, DM, DM, (bf16*)(ws + WS_WO1), nb * 32, false, scr, kb, nb, C.lane); continue; } r -= I_O;
    }
    __syncthreads();
    expert_tiles8(C, I, ws);
}

__device__ __forceinline__ void unpack8(const v4u w, float (&x)[8]) { x[0] = bflo(w.x); x[1] = bfhi(w.x); x[2] = bflo(w.y); x[3] = bfhi(w.y); x[4] = bflo(w.z); x[5] = bfhi(w.z); x[6] = bflo(w.w); x[7] = bfhi(w.w); }
template <bool IN_F32> __device__ __forceinline__ void load_row16(const void* h, int m, int lane, float (&x)[2][8]) {
    if (IN_F32) { const f32x4* p = (const f32x4*)((const float*)h + (size_t)m * DM) + 2 * lane;
#pragma unroll
        for (int j = 0; j < 2; ++j) { const f32x4 a = p[128 * j], b = p[128 * j + 1]; x[j][0] = a.x; x[j][1] = a.y; x[j][2] = a.z; x[j][3] = a.w; x[j][4] = b.x; x[j][5] = b.y; x[j][6] = b.z; x[j][7] = b.w; } }
    else { const v4u* p = (const v4u*)((const bf16*)h + (size_t)m * DM) + lane;
#pragma unroll
        for (int j = 0; j < 2; ++j) unpack8(p[64 * j], x[j]); }
}
template <bool IN_F32, bool OUT8> __device__ __forceinline__ void modulate2(const Ctx& C, const void* h, const float* g, const float* shift, const float* scale, void* hn) {
    for (int m0 = 2 * C.gw; m0 < NTOK; m0 += 2 * C.NGW) {
        const int b = m0 >> 13;
        float x[2][2][8];
        load_row16<IN_F32>(h, m0, C.lane, x[0]); load_row16<IN_F32>(h, m0 + 1, C.lane, x[1]);
        float r[2];
#pragma unroll
        for (int rr = 0; rr < 2; ++rr) { float s = 0.f;
#pragma unroll
            for (int j = 0; j < 2; ++j)
#pragma unroll
                for (int k = 0; k < 8; ++k) s += x[rr][j][k] * x[rr][j][k];
            r[rr] = rsqrt_f(wave_sum(s) * (1.f / DM) + NORM_EPS); }
#pragma unroll
        for (int j = 0; j < 2; ++j) { const int c4 = 2 * C.lane + 128 * j;
            const f32x4 g0 = ((const f32x4*)g)[c4], g1 = ((const f32x4*)g)[c4 + 1], s0 = ((const f32x4*)(scale + (size_t)b * ADA))[c4], s1 = ((const f32x4*)(scale + (size_t)b * ADA))[c4 + 1],
                        h0 = ((const f32x4*)(shift + (size_t)b * ADA))[c4], h1 = ((const f32x4*)(shift + (size_t)b * ADA))[c4 + 1];
            const float mg[8] = {g0.x * (s0.x + 1.f), g0.y * (s0.y + 1.f), g0.z * (s0.z + 1.f), g0.w * (s0.w + 1.f), g1.x * (s1.x + 1.f), g1.y * (s1.y + 1.f), g1.z * (s1.z + 1.f), g1.w * (s1.w + 1.f)};
            const float sh[8] = {h0.x, h0.y, h0.z, h0.w, h1.x, h1.y, h1.z, h1.w};
#pragma unroll
            for (int rr = 0; rr < 2; ++rr) { float o[8];
#pragma unroll
                for (int k = 0; k < 8; ++k) o[k] = x[rr][j][k] * r[rr] * mg[k] + sh[k];
                if (OUT8) { v2u w; w.x = pg8::pack4_fp8(o[0], o[1], o[2], o[3]); w.y = pg8::pack4_fp8(o[4], o[5], o[6], o[7]); ((v2u*)((unsigned char*)hn + (size_t)(m0 + rr) * DM))[C.lane + 64 * j] = w; }
                else { v4u w; w.x = pk2(o[0], o[1]); w.y = pk2(o[2], o[3]); w.z = pk2(o[4], o[5]); w.w = pk2(o[6], o[7]); ((v4u*)((bf16*)hn + (size_t)(m0 + rr) * DM))[C.lane + 64 * j] = w; } } }
    }
}

template <bool IN_F32> __device__ __forceinline__ void modulate2_i8(const Ctx& C, const void* h, const float* g, const float* shift, const float* scale, unsigned char* hn, float* sa) {
    for (int m0 = 2 * C.gw; m0 < NTOK; m0 += 2 * C.NGW) {
        const int b = m0 >> 13;
        float x[2][2][8];
        load_row16<IN_F32>(h, m0, C.lane, x[0]); load_row16<IN_F32>(h, m0 + 1, C.lane, x[1]);
        float r[2];
#pragma unroll
        for (int rr = 0; rr < 2; ++rr) { float s = 0.f;
#pragma unroll
            for (int j = 0; j < 2; ++j)
#pragma unroll
                for (int k = 0; k < 8; ++k) s += x[rr][j][k] * x[rr][j][k];
            r[rr] = rsqrt_f(wave_sum(s) * (1.f / DM) + NORM_EPS); }
        float mx[2] = {0.f, 0.f};
#pragma unroll
        for (int j = 0; j < 2; ++j) { const int c4 = 2 * C.lane + 128 * j;
            const f32x4 g0 = ((const f32x4*)g)[c4], g1 = ((const f32x4*)g)[c4 + 1], s0 = ((const f32x4*)(scale + (size_t)b * ADA))[c4], s1 = ((const f32x4*)(scale + (size_t)b * ADA))[c4 + 1],
                        h0 = ((const f32x4*)(shift + (size_t)b * ADA))[c4], h1 = ((const f32x4*)(shift + (size_t)b * ADA))[c4 + 1];
            const float mg[8] = {g0.x * (s0.x + 1.f), g0.y * (s0.y + 1.f), g0.z * (s0.z + 1.f), g0.w * (s0.w + 1.f), g1.x * (s1.x + 1.f), g1.y * (s1.y + 1.f), g1.z * (s1.z + 1.f), g1.w * (s1.w + 1.f)};
            const float sh[8] = {h0.x, h0.y, h0.z, h0.w, h1.x, h1.y, h1.z, h1.w};
#pragma unroll
            for (int rr = 0; rr < 2; ++rr)
#pragma unroll
                for (int k = 0; k < 8; ++k) { x[rr][j][k] = x[rr][j][k] * r[rr] * mg[k] + sh[k]; mx[rr] = fmaxf(mx[rr], fabsf(x[rr][j][k])); } }
#pragma unroll
        for (int rr = 0; rr < 2; ++rr) {
#pragma unroll
            for (int o = 1; o < 64; o <<= 1) mx[rr] = fmaxf(mx[rr], __shfl_xor(mx[rr], o));
            const float qs = mx[rr] > 0.f ? 127.f / mx[rr] : 0.f;
            if (C.lane == 0) sa[m0 + rr] = mx[rr] * (1.f / 127.f);
#pragma unroll
            for (int j = 0; j < 2; ++j) { v2u w; w.x = pg8::pack4_i8(x[rr][j][0] * qs, x[rr][j][1] * qs, x[rr][j][2] * qs, x[rr][j][3] * qs); w.y = pg8::pack4_i8(x[rr][j][4] * qs, x[rr][j][5] * qs, x[rr][j][6] * qs, x[rr][j][7] * qs);
                ((v2u*)(hn + (size_t)(m0 + rr) * DM))[C.lane + 64 * j] = w; } }
    }
}

__device__ __forceinline__ void odd_pre(const Ctx& C, const bf16* proj, const float* conv_w, const float* qn_g, const float* kvn_g, const float* ctab, const float* stab,
                                        bf16* mix, bf16* qn, bf16* kvn, bf16* kpe) {
    for (int m0 = 2 * C.gw; m0 < NTOK; m0 += 2 * C.NGW) {
        const int pos0 = m0 & (SEQ - 1); const bf16* pr = proj + (size_t)m0 * ODD_IN_PAD; const int c0 = C.lane * 8;
        float z[4][8];
#pragma unroll
        for (int i = 0; i < 4; ++i) { const int dt = 2 - i;
            if (pos0 >= dt) { const bf16* p2 = pr - (ptrdiff_t)dt * ODD_IN_PAD; float a[8], xx[8]; unpack8(*(const v4u*)(p2 + 512 + c0), a); unpack8(*(const v4u*)(p2 + 1024 + c0), xx);
#pragma unroll
                for (int k = 0; k < 8; ++k) z[i][k] = a[k] * xx[k]; }
            else {
#pragma unroll
                for (int k = 0; k < 8; ++k) z[i][k] = 0.f; } }
        float cw[3][8];
#pragma unroll
        for (int jj = 0; jj < 3; ++jj) { const f32x4 w0 = *(const f32x4*)(conv_w + jj * 512 + c0), w1 = *(const f32x4*)(conv_w + jj * 512 + c0 + 4); cw[jj][0] = w0.x; cw[jj][1] = w0.y; cw[jj][2] = w0.z; cw[jj][3] = w0.w; cw[jj][4] = w1.x; cw[jj][5] = w1.y; cw[jj][6] = w1.z; cw[jj][7] = w1.w; }
#pragma unroll
        for (int rr = 0; rr < 2; ++rr) { const bf16* p1 = pr + (size_t)rr * ODD_IN_PAD; const int m = m0 + rr;
            float gb[8]; unpack8(*(const v4u*)(p1 + c0), gb); float y[8];
#pragma unroll
            for (int k = 0; k < 8; ++k) y[k] = gb[k] * (cw[0][k] * z[rr][k] + cw[1][k] * z[rr + 1][k] + cw[2][k] * z[rr + 2][k]);
            { v4u o; o.x = pk2(y[0], y[1]); o.y = pk2(y[2], y[3]); o.z = pk2(y[4], y[5]); o.w = pk2(y[6], y[7]); *(v4u*)(mix + (size_t)m * DM + c0) = o; }
            { float x[8]; unpack8(*(const v4u*)(p1 + 1536 + c0), x); float s = 0.f;
#pragma unroll
              for (int k = 0; k < 8; ++k) s += x[k] * x[k];
              const float r = rsqrt_f(wave_sum(s) * (1.f / 512.f) + NORM_EPS);
              const f32x4 g0 = *(const f32x4*)(qn_g + c0), g1 = *(const f32x4*)(qn_g + c0 + 4);
              v4u o; o.x = pk2(x[0] * r * g0.x, x[1] * r * g0.y); o.y = pk2(x[2] * r * g0.z, x[3] * r * g0.w); o.z = pk2(x[4] * r * g1.x, x[5] * r * g1.y); o.w = pk2(x[6] * r * g1.z, x[7] * r * g1.w);
              *(v4u*)(qn + (size_t)m * 512 + c0) = o; }
            { const v2u w = *(const v2u*)(p1 + 2048 + C.lane * 4); const float x[4] = {bflo(w.x), bfhi(w.x), bflo(w.y), bfhi(w.y)};
              const float s = (x[0] * x[0] + x[1] * x[1]) + (x[2] * x[2] + x[3] * x[3]);
              const float r = rsqrt_f(wave_sum(s) * (1.f / 256.f) + NORM_EPS);
              const f32x4 g0 = *(const f32x4*)(kvn_g + C.lane * 4);
              v2u o; o.x = pk2(x[0] * r * g0.x, x[1] * r * g0.y); o.y = pk2(x[2] * r * g0.z, x[3] * r * g0.w);
              *(v2u*)(kvn + (size_t)m * 256 + C.lane * 4) = o; }
            if (C.lane < 16) { const int pos = pos0 + rr; const unsigned w = *(const unsigned*)(p1 + 2304 + 2 * C.lane); const float x1 = bflo(w), x2 = bfhi(w), cs = ctab[pos * 16 + C.lane], sn = stab[pos * 16 + C.lane];
                *(unsigned*)(kpe + (size_t)m * 32 + 2 * C.lane) = pk2(x1 * cs - x2 * sn, x1 * sn + x2 * cs); } }
    }
}

__device__ __forceinline__ void modulate_route(const Ctx& C, const bf16* h, const float* g, const float* shift, const float* scale, const float* rw, const float* rb,
                                               unsigned char* hn, int* tok_e, float* tok_g, unsigned* counts) {
    volatile LAS unsigned* hist = (volatile LAS unsigned*)(C.lds + LDSCTL_OFF);
    f32x4 w[2][8][2];
#pragma unroll
    for (int j = 0; j < 2; ++j)
#pragma unroll
        for (int k = 0; k < 8; ++k) { const float* p = rw + (size_t)(512 * j + 8 * C.lane + k) * 8; w[j][k][0] = *(const f32x4*)p; w[j][k][1] = *(const f32x4*)(p + 4); }
    for (int m0 = 2 * C.gw; m0 < NTOK; m0 += 2 * C.NGW) {
        const int b = m0 >> 13;
        float x[2][2][8];
        load_row16<false>(h, m0, C.lane, x[0]); load_row16<false>(h, m0 + 1, C.lane, x[1]);
        float r[2];
#pragma unroll
        for (int rr = 0; rr < 2; ++rr) { float s = 0.f;
#pragma unroll
            for (int j = 0; j < 2; ++j)
#pragma unroll
                for (int k = 0; k < 8; ++k) s += x[rr][j][k] * x[rr][j][k];
            r[rr] = rsqrt_f(wave_sum(s) * (1.f / DM) + NORM_EPS); }
        f32x4 la[2], lb[2]; la[0] = la[1] = lb[0] = lb[1] = (f32x4){0.f, 0.f, 0.f, 0.f};
#pragma unroll
        for (int j = 0; j < 2; ++j) { const int c4 = 2 * C.lane + 128 * j;
            const f32x4 g0 = ((const f32x4*)g)[c4], g1 = ((const f32x4*)g)[c4 + 1], s0 = ((const f32x4*)(scale + (size_t)b * ADA))[c4], s1 = ((const f32x4*)(scale + (size_t)b * ADA))[c4 + 1],
                        h0 = ((const f32x4*)(shift + (size_t)b * ADA))[c4], h1 = ((const f32x4*)(shift + (size_t)b * ADA))[c4 + 1];
            const float mg[8] = {g0.x * (s0.x + 1.f), g0.y * (s0.y + 1.f), g0.z * (s0.z + 1.f), g0.w * (s0.w + 1.f), g1.x * (s1.x + 1.f), g1.y * (s1.y + 1.f), g1.z * (s1.z + 1.f), g1.w * (s1.w + 1.f)};
            const float sh[8] = {h0.x, h0.y, h0.z, h0.w, h1.x, h1.y, h1.z, h1.w};
#pragma unroll
            for (int rr = 0; rr < 2; ++rr) { float o[8];
#pragma unroll
                for (int k = 0; k < 8; ++k) { o[k] = x[rr][j][k] * r[rr] * mg[k] + sh[k]; la[rr] += w[j][k][0] * o[k]; lb[rr] += w[j][k][1] * o[k]; }
                v2u wv; wv.x = pg8::pack4_fp8(o[0], o[1], o[2], o[3]); wv.y = pg8::pack4_fp8(o[4], o[5], o[6], o[7]); ((v2u*)(hn + (size_t)(m0 + rr) * DM))[C.lane + 64 * j] = wv; } }
#pragma unroll
        for (int rr = 0; rr < 2; ++rr) { const int m = m0 + rr;
            float lg[8] = {la[rr].x, la[rr].y, la[rr].z, la[rr].w, lb[rr].x, lb[rr].y, lb[rr].z, lb[rr].w};
#pragma unroll
            for (int e = 0; e < 8; ++e) lg[e] = wave_sum(lg[e]) + rb[e];
            int e0 = 0; float v0 = lg[0];
#pragma unroll
            for (int e = 1; e < 8; ++e) if (lg[e] > v0) { v0 = lg[e]; e0 = e; }
            int e1 = -1; float v1 = -INFINITY;
#pragma unroll
            for (int e = 0; e < 8; ++e) if (e != e0 && lg[e] > v1) { v1 = lg[e]; e1 = e; }
            const float p1 = __expf(v1 - v0), g0 = 1.f / (1.f + p1), g1 = p1 * g0;
            if (C.lane == 0) { tok_e[2 * m] = e0; tok_e[2 * m + 1] = e1; tok_g[2 * m] = g0; tok_g[2 * m + 1] = g1;
                __hip_atomic_fetch_add((LAS unsigned*)&hist[e0], 1u, __ATOMIC_RELAXED, __HIP_MEMORY_SCOPE_WORKGROUP); __hip_atomic_fetch_add((LAS unsigned*)&hist[e1], 1u, __ATOMIC_RELAXED, __HIP_MEMORY_SCOPE_WORKGROUP); } }
    }
    LDS_WAIT(); __syncthreads();
    if (C.tid < 8) { const unsigned n = hist[C.tid]; if (n) __hip_atomic_fetch_add(counts + 64 * C.tid, n, __ATOMIC_RELAXED, __HIP_MEMORY_SCOPE_AGENT); }
    __syncthreads();
}

__device__ __forceinline__ void moe_pstart(const unsigned* counts, int (&pstart)[8], int (&pend)[8]) {
    int acc = 0;
#pragma unroll
    for (int e = 0; e < 8; ++e) { const int n = (int)__hip_atomic_load(counts + 64 * e, __ATOMIC_RELAXED, __HIP_MEMORY_SCOPE_AGENT); pstart[e] = acc; acc += (n + 255) >> 8; pend[e] = acc; }
}
__device__ __forceinline__ void moe_gather(const Ctx& C, const unsigned char* hn, const int* tok_e, const unsigned* counts, unsigned* cursor, int* tok_slot, unsigned char* xs, int* pexp) {
    int pstart[8], pend[8]; moe_pstart(counts, pstart, pend);
    if (blockIdx.x == 0 && C.tid < 273) { int e = 0;
#pragma unroll
        for (int k = 0; k < 7; ++k) e += (C.tid >= pend[k]) ? 1 : 0;
        pexp[C.tid] = (C.tid == 272) ? pend[7] : e; }
    for (int task = C.gw; task < NTOK / 16; task += C.NGW) {
        const int tok = task * 16 + (C.lane & 15); const bool act = C.lane < 16;
        const int e0 = act ? tok_e[2 * tok] : -1, e1 = act ? tok_e[2 * tok + 1] : -2;
        int s0 = 0, s1 = 0;
        const unsigned long long lt = (1ull << C.lane) - 1ull;
#pragma unroll
        for (int e = 0; e < 8; ++e) { const unsigned long long m0 = __ballot(e0 == e), m1 = __ballot(e1 == e); const int n0 = __popcll(m0), n1 = __popcll(m1);
            unsigned base = 0u; if (C.lane == 0 && (n0 + n1) > 0) base = __hip_atomic_fetch_add(cursor + 64 * e, (unsigned)(n0 + n1), __ATOMIC_RELAXED, __HIP_MEMORY_SCOPE_AGENT);
            base = (unsigned)__builtin_amdgcn_readfirstlane((int)base) + (unsigned)pstart[e] * 256u;
            if (e0 == e) s0 = (int)base + __popcll(m0 & lt); if (e1 == e) s1 = (int)base + n0 + __popcll(m1 & lt); }
        if (act) { tok_slot[2 * tok] = s0; tok_slot[2 * tok + 1] = s1; }
#pragma unroll 4
        for (int i = 0; i < 16; ++i) { const int d0 = __shfl(s0, i), d1 = __shfl(s1, i);
            const v4u a = ((const v4u*)(hn + (size_t)(task * 16 + i) * DM))[C.lane];
            ((v4u*)(xs + (size_t)d0 * DM))[C.lane] = a; ((v4u*)(xs + (size_t)d1 * DM))[C.lane] = a; }
    }
}

__device__ __forceinline__ void final_rows(int gw, int NGW, int lane, const bf16* h, float* out, const bf16* y, const int* tok_slot, const float* tok_g, const float* gate, const float* fin_g, int s_ready, int mode) {
    for (int m0 = 2 * gw; m0 < NTOK; m0 += 2 * NGW) {
        const int b = m0 >> 13;
        int sl[2][2]; bool sel[2];
#pragma unroll
        for (int rr = 0; rr < 2; ++rr) { sl[rr][0] = __builtin_amdgcn_readfirstlane(tok_slot[2 * (m0 + rr)]); sl[rr][1] = __builtin_amdgcn_readfirstlane(tok_slot[2 * (m0 + rr) + 1]);
            const bool ready = sl[rr][0] < s_ready && sl[rr][1] < s_ready; sel[rr] = mode ? !ready : ready; }
        if (!sel[0] && !sel[1]) continue;
        float v[2][2][8]; float r[2];
#pragma unroll
        for (int rr = 0; rr < 2; ++rr) { const int m = m0 + rr; const float g0 = tok_g[2 * m], g1 = tok_g[2 * m + 1];
            float hx[2][8], ya[2][8], yb[2][8];
            load_row16<false>(h, m, lane, hx); load_row16<false>(y, sl[rr][0], lane, ya); load_row16<false>(y, sl[rr][1], lane, yb);
            float s = 0.f;
#pragma unroll
            for (int j = 0; j < 2; ++j) { const int c4 = 2 * lane + 128 * j; const f32x4 t0 = ((const f32x4*)(gate + (size_t)b * ADA))[c4], t1 = ((const f32x4*)(gate + (size_t)b * ADA))[c4 + 1];
                const float gt[8] = {t0.x, t0.y, t0.z, t0.w, t1.x, t1.y, t1.z, t1.w};
#pragma unroll
                for (int k = 0; k < 8; ++k) { v[rr][j][k] = hx[j][k] + gt[k] * (g0 * ya[j][k] + g1 * yb[j][k]); s += v[rr][j][k] * v[rr][j][k]; } }
            r[rr] = s; }
#pragma unroll
        for (int rr = 0; rr < 2; ++rr) r[rr] = rsqrt_f(wave_sum(r[rr]) * (1.f / DM) + NORM_EPS);
#pragma unroll
        for (int rr = 0; rr < 2; ++rr) { if (!sel[rr]) continue;
#pragma unroll
            for (int j = 0; j < 2; ++j) { const int c4 = 2 * lane + 128 * j; const f32x4 f0 = ((const f32x4*)fin_g)[c4], f1 = ((const f32x4*)fin_g)[c4 + 1];
                f32x4* op = (f32x4*)(out + (size_t)(m0 + rr) * DM) + c4;
                op[0] = (f32x4){v[rr][j][0] * r[rr] * f0.x, v[rr][j][1] * r[rr] * f0.y, v[rr][j][2] * r[rr] * f0.z, v[rr][j][3] * r[rr] * f0.w};
                op[1] = (f32x4){v[rr][j][4] * r[rr] * f1.x, v[rr][j][5] * r[rr] * f1.y, v[rr][j][6] * r[rr] * f1.z, v[rr][j][7] * r[rr] * f1.w}; } }
    }
}

struct Args { In in; float* out; unsigned char* ws; int ph_lo, ph_hi; };
__global__ void __launch_bounds__(NWAVES * 64, 2) fwd(Args args) {
    extern __shared__ __attribute__((aligned(16))) unsigned char lds_raw[];
#define MKCTX() Ctx C; { int t_ = tid_from_wave(wave_s); asm volatile("" : "+v"(t_)); C.lds = (LAS unsigned char*)lds_raw; C.tid = t_; C.lane = t_ & 63; C.wave = __builtin_amdgcn_readfirstlane(t_ >> 6); \
        C.G = gridDim.x; const int bx_ = blockIdx.x; C.vcu = (C.G % 8 == 0) ? (bx_ % 8) * (C.G / 8) + bx_ / 8 : bx_; C.gw = C.vcu * NWAVES + C.wave; C.NGW = C.G * NWAVES; }
    LAS unsigned char* const lds0 = (LAS unsigned char*)lds_raw;
    const int wave_s = __builtin_amdgcn_readfirstlane((int)(threadIdx.x >> 6));
    unsigned char* ws = args.ws; const In& I = args.in;
    unsigned* ctl = (unsigned*)(ws + WS_CTL);
    for (int u = threadIdx.x; u < (LDS_BYTES - LDSCTL_OFF) / 4; u += NWAVES * 64) ((LAS unsigned*)(lds0 + LDSCTL_OFF))[u] = 0u;
    __syncthreads();
    XcdBarrier bar; bar.bar = ctl + CW_BAR; bar.x = 0; bar.st = nullptr; bar.wave = wave_s;
    if (!MK_PER_PHASE) bar = xcd_barrier_post(ctl + CW_BAR, (volatile LAS unsigned*)(lds0 + MISC_OFF) + 8, wave_s);
    const int lo = args.ph_lo, hi = args.ph_hi;
#define IN(k) (lo <= (k) && (k) < hi)
#define SEAM(k) do { if (!MK_PER_PHASE && IN(k) && IN((k) + 1)) xcd_barrier(bar); } while (0)

    bf16* const hbuf = (bf16*)(ws + WS_H);
    const float* mod0 = (const float*)(ws + WS_MOD); const float* mod1 = mod0 + BATCH * ADA;
    bf16* const HN = (bf16*)(ws + WS_HN); bf16* const PROJ = (bf16*)(ws + WS_PROJ); bf16* const MIX0 = (bf16*)(ws + WS_MIX0); bf16* const ACT = (bf16*)(ws + WS_ACT);
    bf16* const QN = (bf16*)(ws + WS_QN); bf16* const KVN = (bf16*)(ws + WS_KVN); bf16* const KPE = (bf16*)(ws + WS_KPE); bf16* const MIX1 = (bf16*)(ws + WS_MIX1);
    bf16* const Q = (bf16*)(ws + WS_Q); bf16* const KV = (bf16*)(ws + WS_KV); unsigned char* const HN2 = ws + WS_HN2; unsigned char* const XS = ws + WS_XS; unsigned char* const ACTE = ws + WS_ACTE; bf16* const YB = (bf16*)(ws + WS_Y);
    const float* ctab = (const float*)(ws + WS_ROPEC); const float* stab = (const float*)(ws + WS_ROPES);
    int* const pexp = (int*)(ws + WS_PEXP); int* tok_e = (int*)(ws + WS_TOKE); float* tok_g = (float*)(ws + WS_TOKG); int* tok_slot = (int*)(ws + WS_TOKS);

    if (IN(0)) for (int rep_ = 0; rep_ < NREP(0); ++rep_) { MKCTX(); p0_prologue(C, I, ws); } SEAM(0);
    if (IN(1)) for (int rep_ = 0; rep_ < NREP(1); ++rep_) { MKCTX(); modulate2_i8<true>(C, I.x, I.e_nmix_g, mod0 + 0 * DM, mod0 + 1 * DM, (unsigned char*)HN, (float*)(ws + WS_SA));
        { LAS float* scr = (LAS float*)(C.lds + C.wave * 16384);
          for (int it = C.gw; it < 16 * 56; it += C.NGW) { const int kb = it / 56, nb = it % 56; transpose_item_i8(I.e_w_in, DM, EVEN_IN, ws + WS_WIN0, nb * 32, ctl + CW_CM0, scr, kb, nb, C.lane); } } } SEAM(1);
    CLK0(2);
    if (IN(2)) for (int rep_ = 0; rep_ < NREP(2); ++rep_) { MKCTX(); pg8::Gemm g{HN, (const bf16*)(ws + WS_WIN0), NTOK, EVEN_IN, DM / 2}; pg8::StaticOrder S; S.init(NTOK, EVEN_IN, C.G, (int)blockIdx.x);
        pg8::EpiProj0I E{PROJ, EVEN_IN, QS_EVEN, (const float*)(ws + WS_SA), ctl + CW_CM0}; pg8::gemm_phase<pg8::EpiProj0I, pg8::StaticOrder, true, true, false, true, true>(C.lds, g, S, E, wave_s);
        { const int nwg = (NTOK / 256) * (EVEN_IN / 256), first_idle = nwg - 3 * C.G;
          const bool tail_ok = first_idle > 0 && first_idle < C.G;
          if (!tail_ok || (int)blockIdx.x >= first_idle) {
              LAS float* scr = (LAS float*)(C.lds + C.wave * 16384); const int wv = tail_ok ? ((int)blockIdx.x - first_idle) * NWAVES + C.wave : C.gw, nwv = tail_ok ? (C.G - first_idle) * NWAVES : C.NGW;
              for (int it = wv; it < 2 * 16 * 88; it += nwv) { const int half = it / (16 * 88), r = it % (16 * 88), kb = r / 88, nb = r % 88, n0 = nb * 32;
                  transpose_item_i8(half ? I.e_wu : I.e_wg, DM, FF, ws + WS_WGU0, 256 * (n0 >> 7) + (n0 & 127) + 128 * half, ctl + CW_CMG, scr, kb, nb, C.lane); }
              for (int it = wv; it < 16 * 73; it += nwv) { const int kb = it / 73, nb = it % 73; transpose_item_i8(I.o_w_in, DM, ODD_IN, ws + WS_WIN1, nb * 32, ctl + CW_CM1, scr, kb, nb, C.lane, nb == 72); } } }
    } CLK1(2); SEAM(2);
    if (IN(3)) for (int rep_ = 0; rep_ < NREP(3); ++rep_) { MKCTX(); for (int un = C.vcu; un < NTOK / 128; un += C.G) evm::unit(un, PROJ, I.e_sinks, I.e_ln_g, I.e_ln_b, (const bf16*)(ws + WS_WSB), I.e_b_s, MIX0, (char*)lds_raw, wave_s); } SEAM(3);
    CLK0(4);
    if (IN(4)) for (int rep_ = 0; rep_ < NREP(4); ++rep_) { MKCTX(); pg8::Gemm g{MIX0, (const bf16*)(ws + WS_WO0), NTOK, DM, DM}; pg8::StaticOrder S; S.init(NTOK, DM, C.G, (int)blockIdx.x);
        pg8::EpiResGateH<true> E{I.x, hbuf, DM, mod0 + 2 * DM, ADA, SEQ, 1.0f}; pg8::gemm_phase<pg8::EpiResGateH<true>, pg8::StaticOrder, true, true>(C.lds, g, S, E, wave_s); } CLK1(4); SEAM(4);
    if (IN(5)) for (int rep_ = 0; rep_ < NREP(5); ++rep_) { MKCTX(); modulate2_i8<false>(C, hbuf, I.e_nffn_g, mod0 + 3 * DM, mod0 + 4 * DM, (unsigned char*)HN, (float*)(ws + WS_SA)); } SEAM(5);
    CLK0(6);
    if (IN(6)) for (int rep_ = 0; rep_ < NREP(6); ++rep_) { MKCTX(); pg8::Gemm g{HN, (const bf16*)(ws + WS_WGU0), NTOK, 2 * FF, DM / 2}; pg8::StaticOrder S; S.init(NTOK, 2 * FF, C.G, (int)blockIdx.x);
        pg8::EpiSwiGLUI8 E{(unsigned char*)ACT, FF, (const float*)(ws + WS_SA), ctl + CW_CMG}; pg8::gemm_phase<pg8::EpiSwiGLUI8, pg8::StaticOrder, true, true, false, true, true>(C.lds, g, S, E, wave_s); } CLK1(6); SEAM(6);
    CLK0(7);
    if (IN(7)) for (int rep_ = 0; rep_ < NREP(7); ++rep_) { MKCTX(); pg8::Gemm g{ACT, (const bf16*)(ws + WS_WD0), NTOK, DM, FF / 2}; pg8::StaticOrder S; S.init(NTOK, DM, C.G, (int)blockIdx.x);
        pg8::EpiResGateH<false> E{hbuf, hbuf, DM, mod0 + 5 * DM, ADA, SEQ, 1.0f / WSC_D}; pg8::gemm_phase<pg8::EpiResGateH<false>, pg8::StaticOrder, true, true, true, false, true>(C.lds, g, S, E, wave_s); } CLK1(7); SEAM(7);
    if (IN(8)) for (int rep_ = 0; rep_ < NREP(8); ++rep_) { MKCTX(); modulate2_i8<false>(C, hbuf, I.o_nmix_g, mod1 + 0 * DM, mod1 + 1 * DM, (unsigned char*)HN, (float*)(ws + WS_SA)); } SEAM(8);
    CLK0(9);
    if (IN(9)) for (int rep_ = 0; rep_ < NREP(9); ++rep_) { MKCTX(); pg8::Gemm g{HN, (const bf16*)(ws + WS_WIN1), NTOK, ODD_IN_PAD, DM / 2}; pg8::StaticOrder S; S.init(NTOK, ODD_IN_PAD, C.G, (int)blockIdx.x);
        pg8::EpiBf16PlainI E{PROJ, ODD_IN_PAD, (const float*)(ws + WS_SA), ctl + CW_CM1}; pg8::gemm_phase<pg8::EpiBf16PlainI, pg8::StaticOrder, true, true, false, true, true>(C.lds, g, S, E, wave_s); } CLK1(9); SEAM(9);
    if (IN(10)) for (int rep_ = 0; rep_ < NREP(10); ++rep_) { MKCTX(); odd_pre(C, PROJ, I.o_conv_w, I.o_qn_g, I.o_kvn_g, ctab, stab, MIX1, QN, KVN, KPE); } SEAM(10);
    if (IN(11)) for (int rep_ = 0; rep_ < NREP(11); ++rep_) { MKCTX();
        { pg8::Gemm g{QN, (const bf16*)(ws + WS_WQB), NTOK, 768, 512}; pg8::StaticOrder S; S.init(NTOK, 768, C.G, (int)blockIdx.x);
          pg8::EpiQRope E{Q, 768, ctab, stab, QS_ODD, SEQ - 1}; pg8::gemm_phase<pg8::EpiQRope, pg8::StaticOrder, true, true>(C.lds, g, S, E, wave_s); }
        { pg8::Gemm g{KVN, (const bf16*)(ws + WS_WKVB), NTOK, 1024, 256}; pg8::StaticOrder S; S.init(NTOK, 1024, C.G, (int)blockIdx.x);
          pg8::EpiBf16Plain E{KV, 1024, 1.0f}; pg8::gemm_phase<pg8::EpiBf16Plain, pg8::StaticOrder, true, true>(C.lds, g, S, E, wave_s); }
    } SEAM(11);
    CLK0(12);
    if (IN(12)) for (int rep_ = 0; rep_ < NREP(12); ++rep_) { MKCTX(); mla::phase((char*)lds_raw, Q, KV, KPE, MIX1, C.vcu, C.G, wave_s); } CLK1(12); SEAM(12);
    if (IN(13)) for (int rep_ = 0; rep_ < NREP(13); ++rep_) { MKCTX(); pg8::Gemm g{MIX1, (const bf16*)(ws + WS_WO1), NTOK, DM, DM}; pg8::StaticOrder S; S.init(NTOK, DM, C.G, (int)blockIdx.x);
        pg8::EpiResGateH<false> E{hbuf, hbuf, DM, mod1 + 2 * DM, ADA, SEQ, 1.0f}; pg8::gemm_phase<pg8::EpiResGateH<false>, pg8::StaticOrder, true, true>(C.lds, g, S, E, wave_s); } SEAM(13);
    if (IN(14)) for (int rep_ = 0; rep_ < NREP(14); ++rep_) { MKCTX(); modulate_route(C, hbuf, I.o_nffn_g, mod1 + 3 * DM, mod1 + 4 * DM, I.o_rw, I.o_rb, HN2, tok_e, tok_g, ctl + CW_CNT); } SEAM(14);
    if (IN(15)) for (int rep_ = 0; rep_ < NREP(15); ++rep_) { MKCTX(); moe_gather(C, HN2, tok_e, ctl + CW_CNT, ctl + CW_CUR, tok_slot, XS, pexp); } SEAM(15);
    CLK0(16);
    if (IN(16)) for (int rep_ = 0; rep_ < NREP(16); ++rep_) { MKCTX();
        const int P = __builtin_amdgcn_readfirstlane(pexp[272]);
        pg8::MoeOrder<28, false> S{C.G, C.vcu, 0, P * 28, pexp, 0};
        pg8::Gemm g{(const bf16*)XS, (const bf16*)(ws + WS_WEGU), 0, 0, DM / 2};
#if MK_PROBE_NULLEPI
        if (rep_ == 1) { pg8::EpiNull E0; pg8::gemm_phase<pg8::EpiNull, pg8::MoeOrder<28, false>, true, true, true>(C.lds, g, S, E0, wave_s); } else
#endif
        { pg8::EpiSwiGLU8 E{ACTE, FFE, 1.0f / WSC_GU}; pg8::gemm_phase<pg8::EpiSwiGLU8, pg8::MoeOrder<28, false>, true, true, true, false, true>(C.lds, g, S, E, wave_s); }
    } CLK1(16); SEAM(16);
    CLK0(17);
    if (IN(17)) for (int rep_ = 0; rep_ < NREP(17); ++rep_) { MKCTX();
        const int P = __builtin_amdgcn_readfirstlane(pexp[272]); const int nfull = (P * 4 / C.G) * C.G;
        pg8::MoeOrder<4, false> S{C.G, C.vcu, 0, nfull, pexp, 0};
        pg8::Gemm g{(const bf16*)ACTE, (const bf16*)(ws + WS_WED), 0, 0, FFE / 2};
        pg8::EpiBf16Plain E{YB, DM, 1.0f / WSC_D}; pg8::gemm_phase<pg8::EpiBf16Plain, pg8::MoeOrder<4, false>, true, true, true, false, true>(C.lds, g, S, E, wave_s);
    } CLK1(17); SEAM(17);
    if (IN(18)) { MKCTX();
        const int P = __builtin_amdgcn_readfirstlane(pexp[272]); const int nfull = (P * 4 / C.G) * C.G, nleft = P * 4 - nfull;
        if (C.vcu < nleft) {
            pg8::MoeOrder<4, false> S{C.G, C.vcu, 0, P * 4, pexp, nfull};
            pg8::Gemm g{(const bf16*)ACTE, (const bf16*)(ws + WS_WED), 0, 0, FFE / 2};
            pg8::EpiBf16Plain E{YB, DM, 1.0f / WSC_D}; pg8::gemm_phase<pg8::EpiBf16Plain, pg8::MoeOrder<4, false>, true, true, true, false, true>(C.lds, g, S, E, wave_s);
        } else {
            final_rows((C.vcu - nleft) * NWAVES + C.wave, (C.G - nleft) * NWAVES, C.lane, hbuf, args.out, YB, tok_slot, tok_g, mod1 + 5 * DM, I.fin_g, (nfull / 4) * 256, 0);
        }
    } SEAM(18);
    if (IN(19)) { MKCTX();
        const int P = __builtin_amdgcn_readfirstlane(pexp[272]); const int nfull = (P * 4 / C.G) * C.G;
        final_rows(C.gw, C.NGW, C.lane, hbuf, args.out, YB, tok_slot, tok_g, mod1 + 5 * DM, I.fin_g, (nfull / 4) * 256, 1);
    }
    if (MK_CLKPH >= 0 && blockIdx.x == 0 && wave_s == 0) { const unsigned long long mhz_ = CLKW[2], r0_ = __builtin_amdgcn_s_memrealtime(); while (__builtin_amdgcn_s_memrealtime() - r0_ < mhz_ * 100ull) __builtin_amdgcn_s_sleep(8); }
#undef IN
#undef SEAM
}

extern "C" void kernel_launch(void* const* d_in, const int* in_sizes, int n_in, void* d_out, int out_size, void* d_ws, size_t ws_size, hipStream_t stream) {
    static int grid = 0;
    if (grid == 0) {
        if (n_in != 33 || in_sizes[0] != NTOK * DM || out_size != NTOK * DM || ws_size < WS_END) { fprintf(stderr, "kernel_launch: unexpected shapes (n_in %d, in0 %d, out %d, ws %zu < %zu); nothing launched\n", n_in, n_in > 0 ? in_sizes[0] : -1, out_size, ws_size, (size_t)WS_END); grid = -1; return; }
        int dev = 0, cus = 0, per_cu = 0;
        if (hipGetDevice(&dev) != hipSuccess || hipDeviceGetAttribute(&cus, hipDeviceAttributeMultiprocessorCount, dev) != hipSuccess) { grid = -1; return; }
        if (hipFuncSetAttribute((const void*)fwd, hipFuncAttributeMaxDynamicSharedMemorySize, LDS_BYTES) != hipSuccess) { fprintf(stderr, "kernel_launch: hipFuncSetAttribute failed\n"); grid = -1; return; }
        if (hipOccupancyMaxActiveBlocksPerMultiprocessor(&per_cu, (const void*)fwd, NWAVES * 64, LDS_BYTES) != hipSuccess || per_cu < 1) fprintf(stderr, "kernel_launch: occupancy query reports %d\n", per_cu);
        (void)hipGetLastError();
        grid = cus;
    }
    if (grid < 0) return;
    if (hipMemsetAsync((char*)d_ws + WS_CTL, 0, CTL_ZERO_BYTES, stream) != hipSuccess) return;
    Args a{};
    const float** ip = (const float**)&a.in;
    for (int i = 0; i < 33; ++i) ip[i] = (const float*)d_in[i];
    a.out = (float*)d_out; a.ws = (unsigned char*)d_ws;
#if MK_PER_PHASE
    for (int p = 0; p < NPH; ++p) { a.ph_lo = p; a.ph_hi = p + 1; hipLaunchKernelGGL(fwd, dim3(grid), dim3(NWAVES * 64), LDS_BYTES, stream, a); }
#else
    a.ph_lo = 0; a.ph_hi = NPH; hipLaunchKernelGGL(fwd, dim3(grid), dim3(NWAVES * 64), LDS_BYTES, stream, a);
#endif
}
```

```cpp
#include <hip/hip_runtime.h>
#include <cstdio>
#include <cstdint>
#include <cmath>
__device__ __forceinline__ int tid_from_wave(int wave) { unsigned l_; asm volatile("v_mbcnt_lo_u32_b32 %0, -1, 0\n\tv_mbcnt_hi_u32_b32 %0, -1, %0" : "=v"(l_)); return wave * 64 + (int)l_; }
namespace pg8 {
#define PG8_LAS __attribute__((address_space(3)))
typedef unsigned short bf16_t;
typedef short bf16x8 __attribute__((ext_vector_type(8)));
typedef float f32x4 __attribute__((ext_vector_type(4)));
typedef unsigned u32x4 __attribute__((ext_vector_type(4)));
typedef int v8i_t __attribute__((ext_vector_type(8)));
typedef int v4i_t __attribute__((ext_vector_type(4)));
typedef unsigned u32x2 __attribute__((ext_vector_type(2)));
constexpr int BM = 256, BK = 64, HALF = 128, HTB = HALF * BK * 2  , STAGE_BYTES = 8 * HTB, NXCD = 8, WGM = 8;

__host__ __device__ __forceinline__ int lds_byte(int r, int c) { const int st = (r >> 4) * 2 + (c >> 5), rr = r & 15, cc = c & 31, ob = rr * 64 + cc * 2; return st * 1024 + (ob ^ (((ob >> 9) & 1) << 5)); }
__host__ __device__ __forceinline__ void stage_rc(int b, int& R, int& C) { const int st = b / 1024, sb = b % 1024, swz = sb ^ (((sb >> 9) & 1) << 5); R = (st >> 1) * 16 + swz / 64; C = (st & 1) * 32 + (swz % 64) / 2; }
__host__ __device__ __forceinline__ int perm32(int rho) { const int n = rho >> 4, i = rho & 15; return 8 * (i >> 2) + 4 * n + (i & 3); }

struct Unit { int pm, pn, pb, po; };
struct Gemm { const bf16_t* A; const bf16_t* Bt; int M, N, K; };

struct StaticOrder {
    int nM, nN, nwg, G, c;
    __host__ __device__ void init(int M, int N, int G_, int c_) { nM = M / BM; nN = N / BM; nwg = nM * nN; G = G_; c = c_; }
    __host__ __device__ bool next(int i, Unit& u) const {
        const long L = (long)i * G + c; if (L >= nwg) return false;
        int wgid = (int)L; { const int q = nwg / NXCD, r = nwg % NXCD, xcd = wgid % NXCD, off = wgid / NXCD; wgid = (xcd < r ? xcd * (q + 1) : r * (q + 1) + (xcd - r) * q) + off; }
        const int nig = WGM * nN, gid = wgid / nig, fm = gid * WGM, gsz = (nM - fm) < WGM ? (nM - fm) : WGM;
        u.pm = fm + ((wgid % nig) % gsz); u.pn = (wgid % nig) / gsz; u.pb = u.pn; u.po = u.pm; return true;
    }
    __device__ __forceinline__ void a_ready(const Unit&) const {}
    __device__ __forceinline__ void done(const Unit&) const {}
};
template <int NT, bool A_REL> struct MoeOrder {
    int G, c, p0, nunits; const int* pexp; int l0;
    __device__ __forceinline__ bool next(int i, Unit& u) const {
        const int L = l0 + i * G + c; if (L >= nunits) return false;
        const int pl = L / NT, n = L - pl * NT, p = p0 + pl;
        const int e = __builtin_amdgcn_readfirstlane(pexp[p]);
        u.pm = A_REL ? pl : p; u.po = A_REL ? p : pl; u.pn = n; u.pb = e * NT + n; return true;
    }
    __device__ __forceinline__ void a_ready(const Unit&) const {}
    __device__ __forceinline__ void done(const Unit&) const {}
};

__device__ __forceinline__ unsigned cvt_pk_bf16(float lo, float hi) { unsigned r; asm volatile("v_cvt_pk_bf16_f32 %0, %1, %2" : "=v"(r) : "v"(lo), "v"(hi)); return r; }
typedef float f32x2 __attribute__((ext_vector_type(2)));
__device__ __forceinline__ f32x2 gelu_pk(f32x2 v) {
    const f32x2 av = __builtin_elementwise_abs(v), d = av * 0.2316418882f + 1.0f;
    f32x2 t; t.x = __builtin_amdgcn_rcpf(d.x); t.y = __builtin_amdgcn_rcpf(d.y);
    f32x2 q = t * 0.5307027145f + (-0.7265760135f); q = q * t + 0.7107068705f; q = q * t + (-0.142248368f); q = q * t + 0.127414796f; q = q * t;
    const f32x2 s = (v * v) * (-0.72134752044f);
    f32x2 e; e.x = __builtin_amdgcn_exp2f(s.x); e.y = __builtin_amdgcn_exp2f(s.y);
    const f32x2 m = v * (q * e), r = v - m;
    f32x2 o; o.x = v.x < 0.f ? m.x : r.x; o.y = v.y < 0.f ? m.y : r.y; return o;
}
__device__ __forceinline__ f32x4 gelu4(f32x4 v) { const f32x2 a = gelu_pk((f32x2){v[0], v[1]}), b = gelu_pk((f32x2){v[2], v[3]}); return (f32x4){a.x, a.y, b.x, b.y}; }
__device__ __forceinline__ float silu1(float x) { return x * __builtin_amdgcn_rcpf(1.0f + __builtin_amdgcn_exp2f(-1.4426950408889634f * x)); }
__device__ __forceinline__ u32x4 pack8(f32x4 v0, f32x4 v1) { u32x4 w; w.x = cvt_pk_bf16(v0[0], v0[1]); w.y = cvt_pk_bf16(v0[2], v0[3]); w.z = cvt_pk_bf16(v1[0], v1[1]); w.w = cvt_pk_bf16(v1[2], v1[3]); return w; }

__device__ __forceinline__ f32x2 swiglu_pk(f32x2 g, f32x2 u, float s) {
    const f32x2 t = g * (-1.4426950408889634f * s); f32x2 e; e.x = __builtin_amdgcn_exp2f(t.x); e.y = __builtin_amdgcn_exp2f(t.y);
    const f32x2 d = e + 1.0f; f32x2 r; r.x = __builtin_amdgcn_rcpf(d.x); r.y = __builtin_amdgcn_rcpf(d.y);
    return (g * u) * (r * (s * s));
}
struct EpiNull {
    static constexpr bool PERM = true, AFTER_DRAIN = false;
    __device__ __forceinline__ void operator()(const f32x4 (&acc)[2][2][4][2], const Unit&, int, int, int, int) const {}
};
struct EpiKeep {
    static constexpr bool PERM = true, AFTER_DRAIN = false;
    __device__ __forceinline__ void operator()(const f32x4 (&acc)[2][2][4][2], const Unit&, int, int, int, int) const {
#pragma unroll
        for (int ai = 0; ai < 2; ++ai)
#pragma unroll
            for (int bj = 0; bj < 2; ++bj)
#pragma unroll
                for (int m = 0; m < 4; ++m)
#pragma unroll
                    for (int n = 0; n < 2; ++n) asm volatile("" :: "v"(acc[ai][bj][m][n]));
    }
};
struct EpiBf16Plain {
    static constexpr bool PERM = true, AFTER_DRAIN = false;
    bf16_t* O; int ldc; float scale;
    __device__ __forceinline__ void operator()(const f32x4 (&acc)[2][2][4][2], const Unit& u, int wr, int wc, int fr, int fq) const {
        const int row0 = u.po * BM + wr * 64 + fr, col0 = u.pn * BM + wc * 32 + 8 * fq;
#pragma unroll
        for (int ai = 0; ai < 2; ++ai)
#pragma unroll
            for (int m = 0; m < 4; ++m) { bf16_t* rowp = O + (size_t)(row0 + ai * HALF + m * 16) * ldc + col0;
#pragma unroll
                for (int bj = 0; bj < 2; ++bj) *(u32x4*)(rowp + bj * HALF) = pack8(acc[ai][bj][m][0] * scale, acc[ai][bj][m][1] * scale); }
    }
};
struct EpiProj0 {
    static constexpr bool PERM = true, AFTER_DRAIN = false;
    bf16_t* O; int ldc; float qscale;
    __device__ __forceinline__ void operator()(const f32x4 (&acc)[2][2][4][2], const Unit& u, int wr, int wc, int fr, int fq) const {
        const int row0 = u.po * BM + wr * 64 + fr, col0 = u.pn * BM + wc * 32 + 8 * fq;
        const int mode = u.pn < 2 ? 0 : (u.pn == 2 ? 1 : 2);
#pragma unroll
        for (int ai = 0; ai < 2; ++ai)
#pragma unroll
            for (int m = 0; m < 4; ++m) { bf16_t* rowp = O + (size_t)(row0 + ai * HALF + m * 16) * ldc + col0;
#pragma unroll
                for (int bj = 0; bj < 2; ++bj) { f32x4 v0 = acc[ai][bj][m][0], v1 = acc[ai][bj][m][1];
                    if (mode == 2) { v0 = gelu4(v0); v1 = gelu4(v1); } else if (mode == 0) { v0 = v0 * qscale; v1 = v1 * qscale; }
                    *(u32x4*)(rowp + bj * HALF) = pack8(v0, v1); } }
    }
};
struct EpiResGate {
    static constexpr bool PERM = false, AFTER_DRAIN = false;
    const float* base; float* out; int ldc; const float* gate; int gate_ld; int rows_per_batch;
    __device__ __forceinline__ void operator()(const f32x4 (&acc)[2][2][4][2], const Unit& u, int wr, int wc, int fr, int fq) const {
        const int row0 = u.po * BM + wr * 64 + fr, col0 = u.pn * BM + wc * 32 + 4 * fq;
        const float* gp = gate + (size_t)((u.po * BM) / rows_per_batch) * gate_ld + col0;
        f32x4 gv[2][2];
#pragma unroll
        for (int bj = 0; bj < 2; ++bj)
#pragma unroll
            for (int n = 0; n < 2; ++n) gv[bj][n] = *(const f32x4*)(gp + bj * HALF + n * 16);
#pragma unroll
        for (int ai = 0; ai < 2; ++ai)
#pragma unroll
            for (int m = 0; m < 4; ++m) { const size_t off = (size_t)(row0 + ai * HALF + m * 16) * ldc + col0;
#pragma unroll
                for (int bj = 0; bj < 2; ++bj)
#pragma unroll
                    for (int n = 0; n < 2; ++n) { const f32x4 bs = *(const f32x4*)(base + off + bj * HALF + n * 16); *(f32x4*)(out + off + bj * HALF + n * 16) = bs + gv[bj][n] * acc[ai][bj][m][n]; } }
    }
};
template <bool BASE_F32> struct EpiResGateH {
    static constexpr bool PERM = true, AFTER_DRAIN = false;
    const void* base; bf16_t* out; int ldc; const float* gate; int gate_ld; int rows_per_batch; float ascale;
    __device__ __forceinline__ void operator()(const f32x4 (&acc)[2][2][4][2], const Unit& u, int wr, int wc, int fr, int fq) const {
        const int row0 = u.po * BM + wr * 64 + fr, col0 = u.pn * BM + wc * 32 + 8 * fq;
        const float* gp = gate + (size_t)((u.po * BM) / rows_per_batch) * gate_ld + col0;
        f32x4 gv[2][2];
#pragma unroll
        for (int bj = 0; bj < 2; ++bj)
#pragma unroll
            for (int n = 0; n < 2; ++n) gv[bj][n] = *(const f32x4*)(gp + bj * HALF + n * 4) * ascale;
#pragma unroll
        for (int ai = 0; ai < 2; ++ai) {
            f32x4 bf[BASE_F32 ? 4 : 1][2][2]; u32x4 bh[BASE_F32 ? 1 : 4][2];
#pragma unroll
            for (int m = 0; m < 4; ++m) { const size_t off = (size_t)(row0 + ai * HALF + m * 16) * ldc + col0;
#pragma unroll
                for (int bj = 0; bj < 2; ++bj) {
                    if (BASE_F32) { bf[m][bj][0] = *(const f32x4*)((const float*)base + off + bj * HALF); bf[m][bj][1] = *(const f32x4*)((const float*)base + off + bj * HALF + 4); }
                    else bh[m][bj] = *(const u32x4*)((const bf16_t*)base + off + bj * HALF); } }
            asm volatile("" ::: "memory");
#pragma unroll
            for (int m = 0; m < 4; ++m) { const size_t off = (size_t)(row0 + ai * HALF + m * 16) * ldc + col0;
#pragma unroll
                for (int bj = 0; bj < 2; ++bj) { f32x4 b0, b1;
                    if (BASE_F32) { b0 = bf[m][bj][0]; b1 = bf[m][bj][1]; }
                    else { const u32x4 w = bh[m][bj];
                        b0 = (f32x4){__uint_as_float(w.x << 16), __uint_as_float(w.x & 0xffff0000u), __uint_as_float(w.y << 16), __uint_as_float(w.y & 0xffff0000u)};
                        b1 = (f32x4){__uint_as_float(w.z << 16), __uint_as_float(w.z & 0xffff0000u), __uint_as_float(w.w << 16), __uint_as_float(w.w & 0xffff0000u)}; }
                    *(u32x4*)(out + off + bj * HALF) = pack8(b0 + gv[bj][0] * acc[ai][bj][m][0], b1 + gv[bj][1] * acc[ai][bj][m][1]); } }
            asm volatile("" ::: "memory");
        }
    }
};
struct EpiSwiGLU {
    static constexpr bool PERM = true, AFTER_DRAIN = false;
    bf16_t* O; int ldc;
    __device__ __forceinline__ void operator()(const f32x4 (&acc)[2][2][4][2], const Unit& u, int wr, int wc, int fr, int fq) const {
        const int row0 = u.po * BM + wr * 64 + fr, col0 = u.pn * HALF + wc * 32 + 8 * fq;
#pragma unroll
        for (int ai = 0; ai < 2; ++ai)
#pragma unroll
            for (int m = 0; m < 4; ++m) { bf16_t* rowp = O + (size_t)(row0 + ai * HALF + m * 16) * ldc + col0;
                f32x4 r0, r1;
#pragma unroll
                for (int j = 0; j < 4; j += 2) { const f32x2 a = swiglu_pk((f32x2){acc[ai][0][m][0][j], acc[ai][0][m][0][j + 1]}, (f32x2){acc[ai][1][m][0][j], acc[ai][1][m][0][j + 1]}, 1.0f);
                    const f32x2 b = swiglu_pk((f32x2){acc[ai][0][m][1][j], acc[ai][0][m][1][j + 1]}, (f32x2){acc[ai][1][m][1][j], acc[ai][1][m][1][j + 1]}, 1.0f);
                    r0[j] = a.x; r0[j + 1] = a.y; r1[j] = b.x; r1[j + 1] = b.y; }
                *(u32x4*)rowp = pack8(r0, r1); }
    }
};
__device__ __forceinline__ float clamp448(float x) { return __builtin_fminf(__builtin_fmaxf(x, -448.f), 448.f); }
__device__ __forceinline__ unsigned pack4_fp8(float a, float b, float c, float d) { int w = 0; w = __builtin_amdgcn_cvt_pk_fp8_f32(clamp448(a), clamp448(b), w, false); w = __builtin_amdgcn_cvt_pk_fp8_f32(clamp448(c), clamp448(d), w, true); return (unsigned)w; }
__device__ __forceinline__ unsigned pack4_i8(float a, float b, float c, float d) {
    const int ia = (int)__builtin_rintf(__builtin_fminf(__builtin_fmaxf(a, -127.f), 127.f)), ib = (int)__builtin_rintf(__builtin_fminf(__builtin_fmaxf(b, -127.f), 127.f)), ic = (int)__builtin_rintf(__builtin_fminf(__builtin_fmaxf(c, -127.f), 127.f)), id = (int)__builtin_rintf(__builtin_fminf(__builtin_fmaxf(d, -127.f), 127.f));
    return ((unsigned)ia & 0xffu) | (((unsigned)ib & 0xffu) << 8) | (((unsigned)ic & 0xffu) << 16) | ((unsigned)id << 24); }
struct EpiSwiGLU8 {
    static constexpr bool PERM = true, AFTER_DRAIN = false;
    unsigned char* O; int ldc; float s;
    __device__ __forceinline__ void operator()(const f32x4 (&acc)[2][2][4][2], const Unit& u, int wr, int wc, int fr, int fq) const {
        const int row0 = u.po * BM + wr * 64 + fr, col0 = u.pn * HALF + wc * 32 + 8 * fq;
#pragma unroll
        for (int ai = 0; ai < 2; ++ai)
#pragma unroll
            for (int m = 0; m < 4; ++m) { unsigned char* rowp = O + (size_t)(row0 + ai * HALF + m * 16) * ldc + col0;
                f32x4 r0, r1;
#pragma unroll
                for (int j = 0; j < 4; j += 2) { const f32x2 a = swiglu_pk((f32x2){acc[ai][0][m][0][j], acc[ai][0][m][0][j + 1]}, (f32x2){acc[ai][1][m][0][j], acc[ai][1][m][0][j + 1]}, s);
                    const f32x2 b = swiglu_pk((f32x2){acc[ai][0][m][1][j], acc[ai][0][m][1][j + 1]}, (f32x2){acc[ai][1][m][1][j], acc[ai][1][m][1][j + 1]}, s);
                    r0[j] = a.x; r0[j + 1] = a.y; r1[j] = b.x; r1[j + 1] = b.y; }
                u32x2 w; w.x = pack4_fp8(r0[0], r0[1], r0[2], r0[3]); w.y = pack4_fp8(r1[0], r1[1], r1[2], r1[3]); *(u32x2*)rowp = w;
                asm volatile("" ::: "memory"); }
    }
};
__device__ __forceinline__ void colscales(const unsigned* cm, int col0, f32x4 (&sv)[2][2]) {
#pragma unroll
    for (int bj = 0; bj < 2; ++bj)
#pragma unroll
        for (int n = 0; n < 2; ++n) { const u32x4 w = *(const u32x4*)(cm + col0 + bj * HALF + n * 4); sv[bj][n] = (f32x4){__uint_as_float(w.x), __uint_as_float(w.y), __uint_as_float(w.z), __uint_as_float(w.w)} * (1.0f / 127.0f); }
}
struct EpiSwiGLUI {
    static constexpr bool PERM = true, AFTER_DRAIN = false;
    bf16_t* O; int ldc; const float* sa; const unsigned* cm;
    __device__ __forceinline__ void operator()(const f32x4 (&acc)[2][2][4][2], const Unit& u, int wr, int wc, int fr, int fq) const {
        const int row0 = u.po * BM + wr * 64 + fr, col0 = u.pn * HALF + wc * 32 + 8 * fq;
        f32x4 sv[2][2]; colscales(cm, u.pn * BM + wc * 32 + 8 * fq, sv);
#pragma unroll
        for (int ai = 0; ai < 2; ++ai)
#pragma unroll
            for (int m = 0; m < 4; ++m) { const int row = row0 + ai * HALF + m * 16; bf16_t* rowp = O + (size_t)row * ldc + col0; const float s = sa[row];
                f32x4 r0, r1;
#pragma unroll
                for (int j = 0; j < 4; j += 2) { const v4i_t g0 = __builtin_bit_cast(v4i_t, acc[ai][0][m][0]), g1 = __builtin_bit_cast(v4i_t, acc[ai][0][m][1]), u0 = __builtin_bit_cast(v4i_t, acc[ai][1][m][0]), u1 = __builtin_bit_cast(v4i_t, acc[ai][1][m][1]);
                    const f32x2 a = swiglu_pk((f32x2){(float)g0[j] * sv[0][0][j], (float)g0[j + 1] * sv[0][0][j + 1]}, (f32x2){(float)u0[j] * sv[1][0][j], (float)u0[j + 1] * sv[1][0][j + 1]}, s);
                    const f32x2 b = swiglu_pk((f32x2){(float)g1[j] * sv[0][1][j], (float)g1[j + 1] * sv[0][1][j + 1]}, (f32x2){(float)u1[j] * sv[1][1][j], (float)u1[j + 1] * sv[1][1][j + 1]}, s);
                    r0[j] = a.x; r0[j + 1] = a.y; r1[j] = b.x; r1[j + 1] = b.y; }
                *(u32x4*)rowp = pack8(r0, r1);
                asm volatile("" ::: "memory"); }
    }
};
struct EpiSwiGLUI8 {
    static constexpr bool PERM = true, AFTER_DRAIN = false;
    unsigned char* O; int ldc; const float* sa; const unsigned* cm;
    __device__ __forceinline__ void operator()(const f32x4 (&acc)[2][2][4][2], const Unit& u, int wr, int wc, int fr, int fq) const {
        const int row0 = u.po * BM + wr * 64 + fr, col0 = u.pn * HALF + wc * 32 + 8 * fq;
        f32x4 sv[2][2]; colscales(cm, u.pn * BM + wc * 32 + 8 * fq, sv);
#pragma unroll
        for (int ai = 0; ai < 2; ++ai)
#pragma unroll
            for (int m = 0; m < 4; ++m) { const int row = row0 + ai * HALF + m * 16; unsigned char* rowp = O + (size_t)row * ldc + col0; const float s = sa[row];
                f32x4 r0, r1;
#pragma unroll
                for (int j = 0; j < 4; j += 2) { const v4i_t g0 = __builtin_bit_cast(v4i_t, acc[ai][0][m][0]), g1 = __builtin_bit_cast(v4i_t, acc[ai][0][m][1]), u0 = __builtin_bit_cast(v4i_t, acc[ai][1][m][0]), u1 = __builtin_bit_cast(v4i_t, acc[ai][1][m][1]);
                    const f32x2 a = swiglu_pk((f32x2){(float)g0[j] * sv[0][0][j], (float)g0[j + 1] * sv[0][0][j + 1]}, (f32x2){(float)u0[j] * sv[1][0][j], (float)u0[j + 1] * sv[1][0][j + 1]}, s);
                    const f32x2 b = swiglu_pk((f32x2){(float)g1[j] * sv[0][1][j], (float)g1[j + 1] * sv[0][1][j + 1]}, (f32x2){(float)u1[j] * sv[1][1][j], (float)u1[j + 1] * sv[1][1][j + 1]}, s);
                    r0[j] = a.x; r0[j + 1] = a.y; r1[j] = b.x; r1[j + 1] = b.y; }
                { u32x2 w; w.x = pack4_fp8(r0[0], r0[1], r0[2], r0[3]); w.y = pack4_fp8(r1[0], r1[1], r1[2], r1[3]); *(u32x2*)rowp = w; }
                asm volatile("" ::: "memory"); }
    }
};
struct EpiProj0I {
    static constexpr bool PERM = true, AFTER_DRAIN = false;
    bf16_t* O; int ldc; float qscale; const float* sa; const unsigned* cm;
    __device__ __forceinline__ void operator()(const f32x4 (&acc)[2][2][4][2], const Unit& u, int wr, int wc, int fr, int fq) const {
        const int row0 = u.po * BM + wr * 64 + fr, col0 = u.pn * BM + wc * 32 + 8 * fq; const float sw = (u.pn < 2 ? qscale : 1.0f);
        f32x4 sv[2][2]; colscales(cm, col0, sv);
        const bool act = u.pn >= 3;
#pragma unroll
        for (int ai = 0; ai < 2; ++ai)
#pragma unroll
            for (int m = 0; m < 4; ++m) { const int row = row0 + ai * HALF + m * 16; bf16_t* rowp = O + (size_t)row * ldc + col0; const float s = sa[row] * sw;
#pragma unroll
                for (int bj = 0; bj < 2; ++bj) { const v4i_t i0 = __builtin_bit_cast(v4i_t, acc[ai][bj][m][0]), i1 = __builtin_bit_cast(v4i_t, acc[ai][bj][m][1]);
                    f32x4 v0 = (f32x4){(float)i0[0], (float)i0[1], (float)i0[2], (float)i0[3]} * sv[bj][0] * s, v1 = (f32x4){(float)i1[0], (float)i1[1], (float)i1[2], (float)i1[3]} * sv[bj][1] * s;
                    if (act) { v0 = gelu4(v0); v1 = gelu4(v1); }
                    *(u32x4*)(rowp + bj * HALF) = pack8(v0, v1); } }
    }
};
struct EpiBf16PlainI {
    static constexpr bool PERM = true, AFTER_DRAIN = false;
    bf16_t* O; int ldc; const float* sa; const unsigned* cm;
    __device__ __forceinline__ void operator()(const f32x4 (&acc)[2][2][4][2], const Unit& u, int wr, int wc, int fr, int fq) const {
        const int row0 = u.po * BM + wr * 64 + fr, col0 = u.pn * BM + wc * 32 + 8 * fq;
        f32x4 sv[2][2]; colscales(cm, col0, sv);
#pragma unroll
        for (int ai = 0; ai < 2; ++ai)
#pragma unroll
            for (int m = 0; m < 4; ++m) { const int row = row0 + ai * HALF + m * 16; bf16_t* rowp = O + (size_t)row * ldc + col0; const float s = sa[row];
#pragma unroll
                for (int bj = 0; bj < 2; ++bj) { const v4i_t i0 = __builtin_bit_cast(v4i_t, acc[ai][bj][m][0]), i1 = __builtin_bit_cast(v4i_t, acc[ai][bj][m][1]);
                    *(u32x4*)(rowp + bj * HALF) = pack8((f32x4){(float)i0[0], (float)i0[1], (float)i0[2], (float)i0[3]} * sv[bj][0] * s, (f32x4){(float)i1[0], (float)i1[1], (float)i1[2], (float)i1[3]} * sv[bj][1] * s); } }
    }
};
struct EpiSwiGLU8I {
    static constexpr bool PERM = true, AFTER_DRAIN = false;
    unsigned char* O; int ldc; const float* sa; const float* swp;
    __device__ __forceinline__ void operator()(const f32x4 (&acc)[2][2][4][2], const Unit& u, int wr, int wc, int fr, int fq) const {
        const int row0 = u.po * BM + wr * 64 + fr, col0 = u.pn * HALF + wc * 32 + 8 * fq; const float sw = *swp;
#pragma unroll
        for (int ai = 0; ai < 2; ++ai)
#pragma unroll
            for (int m = 0; m < 4; ++m) { const int row = row0 + ai * HALF + m * 16; unsigned char* rowp = O + (size_t)row * ldc + col0; const float s = sa[row] * sw;
                f32x4 r0, r1;
#pragma unroll
                for (int j = 0; j < 4; j += 2) { const v4i_t g0 = __builtin_bit_cast(v4i_t, acc[ai][0][m][0]), g1 = __builtin_bit_cast(v4i_t, acc[ai][0][m][1]), u0 = __builtin_bit_cast(v4i_t, acc[ai][1][m][0]), u1 = __builtin_bit_cast(v4i_t, acc[ai][1][m][1]);
                    const f32x2 a = swiglu_pk((f32x2){(float)g0[j], (float)g0[j + 1]}, (f32x2){(float)u0[j], (float)u0[j + 1]}, s);
                    const f32x2 b = swiglu_pk((f32x2){(float)g1[j], (float)g1[j + 1]}, (f32x2){(float)u1[j], (float)u1[j + 1]}, s);
                    r0[j] = a.x; r0[j + 1] = a.y; r1[j] = b.x; r1[j + 1] = b.y; }
                u32x2 w; w.x = pack4_fp8(r0[0], r0[1], r0[2], r0[3]); w.y = pack4_fp8(r1[0], r1[1], r1[2], r1[3]); *(u32x2*)rowp = w;
                asm volatile("" ::: "memory"); }
    }
};
struct EpiQRope {
    static constexpr bool PERM = true, AFTER_DRAIN = false;
    bf16_t* O; int ldc; const float* ctab; const float* stab; float qscale; int seq_mask;
    __device__ __forceinline__ void operator()(const f32x4 (&acc)[2][2][4][2], const Unit& u, int wr, int wc, int fr, int fq) const {
        const int row0 = u.po * BM + wr * 64 + fr, col0 = u.pn * BM + wc * 32 + 8 * fq;
#pragma unroll
        for (int ai = 0; ai < 2; ++ai)
#pragma unroll
            for (int m = 0; m < 4; ++m) { const int row = row0 + ai * HALF + m * 16; bf16_t* rowp = O + (size_t)row * ldc + col0; const int pos = row & seq_mask;
#pragma unroll
                for (int bj = 0; bj < 2; ++bj) { f32x4 v0 = acc[ai][bj][m][0] * qscale, v1 = acc[ai][bj][m][1] * qscale;
                    const int off = (col0 + bj * HALF) % 96;
                    if (off >= 64) { const int i0 = (off - 64) >> 1; const f32x4 cs = *(const f32x4*)(ctab + pos * 16 + i0), sn = *(const f32x4*)(stab + pos * 16 + i0);
                        const f32x4 a = v0, b = v1;
                        v0[0] = a[0] * cs[0] - a[1] * sn[0]; v0[1] = a[0] * sn[0] + a[1] * cs[0]; v0[2] = a[2] * cs[1] - a[3] * sn[1]; v0[3] = a[2] * sn[1] + a[3] * cs[1];
                        v1[0] = b[0] * cs[2] - b[1] * sn[2]; v1[1] = b[0] * sn[2] + b[1] * cs[2]; v1[2] = b[2] * cs[3] - b[3] * sn[3]; v1[3] = b[2] * sn[3] + b[3] * cs[3]; }
                    *(u32x4*)(rowp + bj * HALF) = pack8(v0, v1); }
                asm volatile("" ::: "memory"); }
    }
};

#ifndef PG8_F8_ASM_STAGE
#define PG8_F8_ASM_STAGE 0
#endif
template <class Epi, class Sched, bool ALIGN_EPI = false, bool SP2 = false, bool F8 = false, bool I8 = false, bool PF = false>
__device__ __forceinline__ void gemm_phase(PG8_LAS unsigned char* lds, const Gemm g, const Sched& S, const Epi& E, const int wave_) {
    int tid_ = tid_from_wave(wave_); asm volatile("" : "+v"(tid_));
    const int tid = tid_, wid = __builtin_amdgcn_readfirstlane(tid >> 6), lane = tid & 63, wr = wid >> 2, wc = wid & 3, fr = lane & 15, fq = lane >> 4;
    const int K = g.K, nt = K / BK;
    unsigned voffA[2], voffB[2];
#pragma unroll
    for (int i = 0; i < 2; ++i) { int R, C; stage_rc(tid * 16 + i * 8192, R, C); const int Rb = Epi::PERM ? ((R & ~31) + perm32(R & 31)) : R;
        voffA[i] = (unsigned)(R * K + C) * 2u; voffB[i] = (unsigned)(Rb * K + C) * 2u; }
    const size_t kstep = (size_t)(BK * 2);
    const size_t hstep = (size_t)HALF * K * 2;
    const size_t tstep = 2 * hstep;
    const unsigned lds_a32 = (unsigned)(uintptr_t)lds;
    const unsigned ldsw = (unsigned)wid * 1024u;
    const int aoff = lds_byte(wr * 64 + fr, fq * 8), boff = lds_byte(wc * 32 + fr, fq * 8);
#define PG8_SA(b, h) (((b) * 2 + (h)) * HTB)
#define PG8_SB(b, h) ((4 + (b) * 2 + (h)) * HTB)
#define PG8_STAGE(bufoff, gbase, voff) do { _Pragma("unroll") for (int _i = 0; _i < 2; ++_i) { \
        if constexpr (F8 && PG8_F8_ASM_STAGE) { unsigned keep_; asm volatile("s_mov_b32 %0, m0\n\ts_mov_b32 m0, %3\n\ts_nop 0\n\tglobal_load_lds_dwordx4 %1, %2\n\ts_mov_b32 m0, %0" : "=&s"(keep_) : "v"((voff)[_i]), "s"((const char*)(gbase)), "s"((unsigned)__builtin_amdgcn_readfirstlane((int)(lds_a32 + (unsigned)(bufoff) + ldsw + (unsigned)(_i * 8192)))) : "memory"); } \
        else __builtin_amdgcn_global_load_lds((const unsigned*)((const char*)(gbase) + (voff)[_i]), (PG8_LAS unsigned*)(lds + (bufoff) + ldsw + _i * 8192), 16, 0, 0); } } while (0)
#define PG8_LDA(dst, b, h) do { _Pragma("unroll") for (int m = 0; m < 4; ++m) _Pragma("unroll") for (int k = 0; k < 2; ++k) dst[m][k] = *(const PG8_LAS bf16x8*)(lds + PG8_SA(b, h) + aoff + m * 2048 + k * 1024); } while (0)
#define PG8_LDB(dst, b, h) do { _Pragma("unroll") for (int n = 0; n < 2; ++n) _Pragma("unroll") for (int k = 0; k < 2; ++k) dst[n][k] = *(const PG8_LAS bf16x8*)(lds + PG8_SB(b, h) + boff + n * 2048 + k * 1024); } while (0)
#define PG8_MMA(ai, bj, At, Bt) do { __builtin_amdgcn_s_setprio(1); _Pragma("unroll") for (int m = 0; m < 4; ++m) _Pragma("unroll") for (int n = 0; n < 2; ++n) { \
        if constexpr (F8) { const v8i_t b8_ = __builtin_shufflevector(__builtin_bit_cast(v4i_t, Bt[n][0]), __builtin_bit_cast(v4i_t, Bt[n][1]), 0, 1, 2, 3, 4, 5, 6, 7), a8_ = __builtin_shufflevector(__builtin_bit_cast(v4i_t, At[m][0]), __builtin_bit_cast(v4i_t, At[m][1]), 0, 1, 2, 3, 4, 5, 6, 7); \
            asm volatile("v_mfma_f32_16x16x128_f8f6f4 %0, %1, %2, %0" : "+v"(acc[ai][bj][m][n]) : "v"(b8_), "v"(a8_)); } \
        else if constexpr (I8) { _Pragma("unroll") for (int k = 0; k < 2; ++k) acc[ai][bj][m][n] = __builtin_bit_cast(f32x4, __builtin_amdgcn_mfma_i32_16x16x64_i8(__builtin_bit_cast(v4i_t, Bt[n][k]), __builtin_bit_cast(v4i_t, At[m][k]), __builtin_bit_cast(v4i_t, acc[ai][bj][m][n]), 0, 0, 0)); } \
        else { _Pragma("unroll") for (int k = 0; k < 2; ++k) acc[ai][bj][m][n] = __builtin_amdgcn_mfma_f32_16x16x32_bf16(Bt[n][k], At[m][k], acc[ai][bj][m][n], 0, 0, 0); } } __builtin_amdgcn_s_setprio(0); } while (0)
#define PG8_MF(ai, bj, m, n, At, Bt) do { \
        if constexpr (F8) { const v8i_t b8_ = __builtin_shufflevector(__builtin_bit_cast(v4i_t, Bt[n][0]), __builtin_bit_cast(v4i_t, Bt[n][1]), 0, 1, 2, 3, 4, 5, 6, 7), a8_ = __builtin_shufflevector(__builtin_bit_cast(v4i_t, At[m][0]), __builtin_bit_cast(v4i_t, At[m][1]), 0, 1, 2, 3, 4, 5, 6, 7); \
            asm volatile("v_mfma_f32_16x16x128_f8f6f4 %0, %1, %2, %0" : "+v"(acc[ai][bj][m][n]) : "v"(b8_), "v"(a8_)); } \
        else if constexpr (I8) { _Pragma("unroll") for (int k = 0; k < 2; ++k) acc[ai][bj][m][n] = __builtin_bit_cast(f32x4, __builtin_amdgcn_mfma_i32_16x16x64_i8(__builtin_bit_cast(v4i_t, Bt[n][k]), __builtin_bit_cast(v4i_t, At[m][k]), __builtin_bit_cast(v4i_t, acc[ai][bj][m][n]), 0, 0, 0)); } \
        else { _Pragma("unroll") for (int k = 0; k < 2; ++k) acc[ai][bj][m][n] = __builtin_amdgcn_mfma_f32_16x16x32_bf16(Bt[n][k], At[m][k], acc[ai][bj][m][n], 0, 0, 0); } } while (0)
#define PG8_RA(dst, b, h, m, k) dst[m][k] = *(const PG8_LAS bf16x8*)(lds + PG8_SA(b, h) + aoff + (m) * 2048 + (k) * 1024)
#define PG8_RB(dst, b, h, n, k) dst[n][k] = *(const PG8_LAS bf16x8*)(lds + PG8_SB(b, h) + boff + (n) * 2048 + (k) * 1024)
#define PG8_X1(b) do { __builtin_amdgcn_s_setprio(1); \
        PG8_MF(0, 0, 0, 0, At, B0); PG8_RB(B1, b, 1, 0, 0); PG8_SCHED; PG8_MF(0, 0, 0, 1, At, B0); PG8_RB(B1, b, 1, 0, 1); PG8_SCHED; PG8_MF(0, 0, 1, 0, At, B0); PG8_RB(B1, b, 1, 1, 0); PG8_SCHED; PG8_MF(0, 0, 1, 1, At, B0); PG8_RB(B1, b, 1, 1, 1); PG8_SCHED; \
        PG8_MF(0, 0, 2, 0, At, B0); PG8_MF(0, 0, 2, 1, At, B0); PG8_MF(0, 0, 3, 0, At, B0); PG8_MF(0, 0, 3, 1, At, B0); PG8_SCHED; \
        PG8_MF(0, 1, 0, 0, At, B1); PG8_RA(At2, b, 1, 0, 0); PG8_SCHED; PG8_MF(0, 1, 0, 1, At, B1); PG8_RA(At2, b, 1, 0, 1); PG8_SCHED; PG8_MF(0, 1, 1, 0, At, B1); PG8_RA(At2, b, 1, 1, 0); PG8_SCHED; PG8_MF(0, 1, 1, 1, At, B1); PG8_RA(At2, b, 1, 1, 1); PG8_SCHED; \
        PG8_MF(0, 1, 2, 0, At, B1); PG8_RA(At2, b, 1, 2, 0); PG8_SCHED; PG8_MF(0, 1, 2, 1, At, B1); PG8_RA(At2, b, 1, 2, 1); PG8_SCHED; PG8_MF(0, 1, 3, 0, At, B1); PG8_RA(At2, b, 1, 3, 0); PG8_SCHED; PG8_MF(0, 1, 3, 1, At, B1); PG8_RA(At2, b, 1, 3, 1); PG8_SCHED; \
        __builtin_amdgcn_s_setprio(0); } while (0)
#define PG8_X2(b) do { __builtin_amdgcn_s_setprio(1); \
        PG8_MF(1, 0, 0, 0, At2, B0); PG8_RA(At, (b) ^ 1, 0, 0, 0); PG8_SCHED; PG8_MF(1, 0, 0, 1, At2, B0); PG8_RA(At, (b) ^ 1, 0, 0, 1); PG8_SCHED; PG8_MF(1, 0, 1, 0, At2, B0); PG8_RA(At, (b) ^ 1, 0, 1, 0); PG8_SCHED; PG8_MF(1, 0, 1, 1, At2, B0); PG8_RA(At, (b) ^ 1, 0, 1, 1); PG8_SCHED; \
        PG8_MF(1, 0, 2, 0, At2, B0); PG8_RA(At, (b) ^ 1, 0, 2, 0); PG8_SCHED; PG8_MF(1, 0, 2, 1, At2, B0); PG8_RA(At, (b) ^ 1, 0, 2, 1); PG8_SCHED; PG8_MF(1, 0, 3, 0, At2, B0); PG8_RA(At, (b) ^ 1, 0, 3, 0); PG8_SCHED; PG8_MF(1, 0, 3, 1, At2, B0); PG8_RA(At, (b) ^ 1, 0, 3, 1); PG8_SCHED; \
        PG8_MF(1, 1, 0, 0, At2, B1); PG8_RB(B0, (b) ^ 1, 0, 0, 0); PG8_SCHED; PG8_MF(1, 1, 0, 1, At2, B1); PG8_RB(B0, (b) ^ 1, 0, 0, 1); PG8_SCHED; PG8_MF(1, 1, 1, 0, At2, B1); PG8_RB(B0, (b) ^ 1, 0, 1, 0); PG8_SCHED; PG8_MF(1, 1, 1, 1, At2, B1); PG8_RB(B0, (b) ^ 1, 0, 1, 1); PG8_SCHED; \
        PG8_MF(1, 1, 2, 0, At2, B1); PG8_MF(1, 1, 2, 1, At2, B1); PG8_MF(1, 1, 3, 0, At2, B1); PG8_MF(1, 1, 3, 1, At2, B1); __builtin_amdgcn_s_setprio(0); } while (0)
#define PG8_WAIT_V(n) asm volatile("s_waitcnt vmcnt(" #n ")" ::: "memory")
#define PG8_WAIT_L(n) asm volatile("s_waitcnt lgkmcnt(" #n ")" ::: "memory")
#define PG8_BAR __builtin_amdgcn_s_barrier()
#define PG8_SCHED __builtin_amdgcn_sched_barrier(0)
    Unit cur, nxt; int ui = 0;
    if (!S.next(0, cur)) return;
    f32x4 acc[2][2][4][2];
#pragma unroll
    for (int a = 0; a < 2; ++a)
#pragma unroll
        for (int b = 0; b < 2; ++b)
#pragma unroll
            for (int m = 0; m < 4; ++m)
#pragma unroll
                for (int n = 0; n < 2; ++n) acc[a][b][m][n] = (f32x4){0.f, 0.f, 0.f, 0.f};
    bf16x8 At[4][2], B0[2][2], B1[2][2]; bf16x8 At2[PF ? 4 : 1][2];
    const char* cA = (const char*)g.A + (size_t)cur.pm * tstep; const char* cB = (const char*)g.Bt + (size_t)cur.pb * tstep;
    S.a_ready(cur);
    if constexpr (PF) {
        PG8_STAGE(PG8_SA(0, 0), cA, voffA); PG8_STAGE(PG8_SB(0, 0), cB, voffB); PG8_STAGE(PG8_SA(0, 1), cA + hstep, voffA); PG8_STAGE(PG8_SB(0, 1), cB + hstep, voffB);
        PG8_STAGE(PG8_SA(1, 0), cA + kstep, voffA); PG8_STAGE(PG8_SB(1, 0), cB + kstep, voffB);
        if (wr == 1) { PG8_STAGE(PG8_SA(1, 1), cA + hstep + kstep, voffA); PG8_STAGE(PG8_SB(1, 1), cB + hstep + kstep, voffB); }
        PG8_WAIT_V(8); PG8_BAR;
        PG8_LDA(At, 0, 0); PG8_LDB(B0, 0, 0); __builtin_amdgcn_s_waitcnt(0xC07F);
        if (wr == 1) PG8_BAR;
    } else
    if constexpr (SP2) {
        PG8_STAGE(PG8_SB(0, 0), cB, voffB); PG8_STAGE(PG8_SB(0, 1), cB + hstep, voffB); PG8_STAGE(PG8_SA(0, 0), cA, voffA); PG8_STAGE(PG8_SA(0, 1), cA + hstep, voffA);
        if (wr == 1) PG8_BAR;
        PG8_WAIT_V(2); PG8_BAR;
        PG8_STAGE(PG8_SB(1, 0), cB + kstep, voffB); PG8_STAGE(PG8_SA(1, 0), cA + kstep, voffA); PG8_STAGE(PG8_SB(1, 1), cB + hstep + kstep, voffB);
        PG8_WAIT_V(6); PG8_BAR;
    } else {
        PG8_STAGE(PG8_SB(0, 0), cB, voffB); PG8_STAGE(PG8_SA(0, 0), cA, voffA); PG8_STAGE(PG8_SB(0, 1), cB + hstep, voffB); PG8_STAGE(PG8_SA(0, 1), cA + hstep, voffA);
        if (wr == 1) PG8_BAR;
        PG8_WAIT_V(4); PG8_BAR;
        PG8_STAGE(PG8_SB(1, 0), cB + kstep, voffB); PG8_STAGE(PG8_SA(1, 0), cA + kstep, voffA); PG8_STAGE(PG8_SB(1, 1), cB + hstep + kstep, voffB);
        PG8_WAIT_V(6); PG8_BAR;
    }
    for (;;) {
        const bool has_next = S.next(ui + 1, nxt);
        const char* nA = has_next ? (const char*)g.A + (size_t)nxt.pm * tstep : cA; const char* nB = has_next ? (const char*)g.Bt + (size_t)nxt.pb * tstep : cB;
        for (int t = 0; t < nt; t += 2) {
            const bool last = (t == nt - 2);
            const char* a1 = cA + (size_t)(t + 1) * kstep;
            const char* a2 = last ? nA : cA + (size_t)(t + 2) * kstep; const char* b2 = last ? nB : cB + (size_t)(t + 2) * kstep;
            const char* a3 = a2 + kstep; const char* b3 = b2 + kstep;
            if (last && has_next) S.a_ready(nxt);
            if constexpr (PF) {
            PG8_STAGE(wr ? PG8_SA(0, 0) : PG8_SA(1, 1), wr ? a2 : a1 + hstep, voffA); PG8_STAGE(wr ? PG8_SB(0, 0) : PG8_SB(1, 1), wr ? b2 : cB + (size_t)(t + 1) * kstep + hstep, voffB);
            PG8_WAIT_V(8); PG8_BAR;
            PG8_X1(0); __builtin_amdgcn_s_waitcnt(0xC07F); PG8_BAR; PG8_SCHED;
            PG8_STAGE(wr ? PG8_SA(0, 1) : PG8_SA(0, 0), wr ? a2 + hstep : a2, voffA); PG8_STAGE(wr ? PG8_SB(0, 1) : PG8_SB(0, 0), wr ? b2 + hstep : b2, voffB);
            PG8_WAIT_V(8); PG8_BAR;
            PG8_X2(0); __builtin_amdgcn_s_waitcnt(0xC07F); PG8_BAR; PG8_SCHED;
            PG8_STAGE(wr ? PG8_SA(1, 0) : PG8_SA(0, 1), wr ? a3 : a2 + hstep, voffA); PG8_STAGE(wr ? PG8_SB(1, 0) : PG8_SB(0, 1), wr ? b3 : b2 + hstep, voffB);
            PG8_WAIT_V(8); PG8_BAR;
            PG8_X1(1); __builtin_amdgcn_s_waitcnt(0xC07F); PG8_BAR; PG8_SCHED;
            PG8_STAGE(wr ? PG8_SA(1, 1) : PG8_SA(1, 0), wr ? a3 + hstep : a3, voffA); PG8_STAGE(wr ? PG8_SB(1, 1) : PG8_SB(1, 0), wr ? b3 + hstep : b3, voffB);
            PG8_WAIT_V(8); PG8_BAR;
            PG8_X2(1); __builtin_amdgcn_s_waitcnt(0xC07F); PG8_BAR; PG8_SCHED;
            } else
            if constexpr (SP2) {
            PG8_LDB(B0, 0, 0); PG8_LDB(B1, 0, 1); PG8_SCHED; PG8_LDA(At, 0, 0); PG8_STAGE(PG8_SA(1, 1), a1 + hstep, voffA);
            PG8_WAIT_V(8); PG8_WAIT_L(0); PG8_BAR; PG8_MMA(0, 0, At, B0); PG8_MMA(0, 1, At, B1); PG8_BAR; PG8_SCHED;
            PG8_LDA(At, 0, 1); PG8_STAGE(PG8_SB(0, 0), b2, voffB); PG8_STAGE(PG8_SB(0, 1), b2 + hstep, voffB); PG8_STAGE(PG8_SA(0, 0), a2, voffA);
            PG8_WAIT_V(8); PG8_WAIT_L(0); PG8_BAR; PG8_MMA(1, 0, At, B0); PG8_MMA(1, 1, At, B1); PG8_BAR; PG8_SCHED;
            PG8_LDB(B0, 1, 0); PG8_LDB(B1, 1, 1); PG8_SCHED; PG8_LDA(At, 1, 0); PG8_STAGE(PG8_SA(0, 1), a2 + hstep, voffA);
            PG8_WAIT_V(8); PG8_WAIT_L(0); PG8_BAR; PG8_MMA(0, 0, At, B0); PG8_MMA(0, 1, At, B1); PG8_BAR; PG8_SCHED;
            PG8_LDA(At, 1, 1); PG8_STAGE(PG8_SB(1, 0), b3, voffB); PG8_STAGE(PG8_SB(1, 1), b3 + hstep, voffB); PG8_STAGE(PG8_SA(1, 0), a3, voffA);
            PG8_WAIT_V(8); PG8_WAIT_L(0); PG8_BAR; PG8_MMA(1, 0, At, B0); PG8_MMA(1, 1, At, B1); PG8_BAR; PG8_SCHED;
            } else {
            PG8_LDB(B0, 0, 0); PG8_SCHED; PG8_LDA(At, 0, 0); PG8_STAGE(PG8_SA(1, 1), a1 + hstep, voffA);
            PG8_WAIT_L(8); PG8_BAR; PG8_WAIT_L(0); PG8_MMA(0, 0, At, B0); PG8_BAR; PG8_SCHED;
            PG8_LDB(B1, 0, 1); PG8_STAGE(PG8_SB(0, 0), b2, voffB);
            PG8_BAR; PG8_WAIT_L(0); PG8_MMA(0, 1, At, B1); PG8_BAR;
            PG8_LDA(At, 0, 1); PG8_STAGE(PG8_SA(0, 0), a2, voffA);
            PG8_BAR; PG8_WAIT_L(0); PG8_MMA(1, 0, At, B0); PG8_BAR; PG8_SCHED;
            PG8_STAGE(PG8_SB(0, 1), b2 + hstep, voffB);
            PG8_WAIT_V(6); PG8_BAR; PG8_MMA(1, 1, At, B1); PG8_BAR;
            PG8_LDB(B0, 1, 0); PG8_SCHED; PG8_LDA(At, 1, 0); PG8_STAGE(PG8_SA(0, 1), a2 + hstep, voffA);
            PG8_WAIT_L(8); PG8_BAR; PG8_WAIT_L(0); PG8_MMA(0, 0, At, B0); PG8_BAR; PG8_SCHED;
            PG8_LDB(B1, 1, 1); PG8_STAGE(PG8_SB(1, 0), b3, voffB);
            PG8_BAR; PG8_WAIT_L(0); PG8_MMA(0, 1, At, B1); PG8_BAR;
            PG8_LDA(At, 1, 1); PG8_STAGE(PG8_SA(1, 0), a3, voffA);
            PG8_BAR; PG8_WAIT_L(0); PG8_MMA(1, 0, At, B0); PG8_BAR; PG8_SCHED;
            PG8_STAGE(PG8_SB(1, 1), b3 + hstep, voffB);
            PG8_WAIT_V(6); PG8_BAR; PG8_MMA(1, 1, At, B1); PG8_BAR;
            }
        }
        if constexpr (ALIGN_EPI) { if (wr == 0) PG8_BAR; }
        if constexpr (F8) asm volatile("s_nop 15\n\ts_nop 7" ::: "memory");
        if constexpr (!Epi::AFTER_DRAIN) { int t2_ = tid_from_wave(wave_); asm volatile("" : "+v"(t2_)); const int l2_ = t2_ & 63;
            E(acc, cur, wr, wc, l2_ & 15, l2_ >> 4); S.done(cur); }
        if (!has_next) break;
#pragma unroll
        for (int a = 0; a < 2; ++a)
#pragma unroll
            for (int b = 0; b < 2; ++b)
#pragma unroll
                for (int m = 0; m < 4; ++m)
#pragma unroll
                    for (int n = 0; n < 2; ++n) acc[a][b][m][n] = (f32x4){0.f, 0.f, 0.f, 0.f};
        cur = nxt; cA = nA; cB = nB; ++ui;
        if constexpr (ALIGN_EPI) { if (wr == 1) PG8_BAR; }
    }
    PG8_WAIT_V(0);
    if constexpr (!ALIGN_EPI) { if (wr == 0) PG8_BAR; }
    PG8_BAR;
    if constexpr (Epi::AFTER_DRAIN) { E.fused(acc, cur, wr, wc, fr, fq, lds, wid, lane); S.done(cur); }
#undef PG8_SA
#undef PG8_SB
#undef PG8_STAGE
#undef PG8_LDA
#undef PG8_LDB
#undef PG8_MMA
#undef PG8_MF
#undef PG8_RA
#undef PG8_RB
#undef PG8_X1
#undef PG8_X2
#undef PG8_WAIT_V
#undef PG8_WAIT_L
#undef PG8_BAR
#undef PG8_SCHED
}
}
#define GAS __attribute__((address_space(1)))
#define LAS __attribute__((address_space(3)))
typedef unsigned short bf16;
typedef unsigned v4u __attribute__((ext_vector_type(4)));
typedef float f32x4 __attribute__((ext_vector_type(4)));
typedef short bf16x8 __attribute__((ext_vector_type(8)));
typedef GAS unsigned gu32;
typedef GAS unsigned long long gu64;
#define RLX_AGENT __ATOMIC_RELAXED, __HIP_MEMORY_SCOPE_AGENT
#define LDS_WAIT() asm volatile("s_waitcnt lgkmcnt(0)" ::: "memory")
#define VM_WAIT() asm volatile("s_waitcnt vmcnt(0)" ::: "memory")
__device__ __forceinline__ unsigned long long rt() { return __builtin_amdgcn_s_memrealtime(); }

#define XB_TMO      128
#define XB_XCNT(j)  (256  + 64 * (j))
#define XB_XSUB(j)  (1280 + 64 * (j))
#define XB_XGEN(j)  (2304 + 64 * (j))
#define XB_TOP      3328
#define XB_TOPGEN   3392
#define XCD_BAR_WORDS 3456
#define XB_SPIN_CAP (1u << 18)

__device__ __forceinline__ unsigned xb_ld(unsigned* p)              { return __hip_atomic_load(p, __ATOMIC_RELAXED, __HIP_MEMORY_SCOPE_AGENT); }
__device__ __forceinline__ unsigned xb_add(unsigned* p, unsigned v) { return __hip_atomic_fetch_add(p, v, __ATOMIC_RELAXED, __HIP_MEMORY_SCOPE_AGENT); }
__device__ __forceinline__ unsigned xb_xcc_id() { return (unsigned)__builtin_amdgcn_s_getreg((3 << 11) | 20) & 0xFu; }
#define XB_SPIN(cond, bar) do { unsigned _sp = 0; while (cond) { __builtin_amdgcn_s_sleep(1); \
    if ((++_sp & 255u) == 0u) { if (xb_ld(&(bar)[XB_TMO])) break; if (_sp > XB_SPIN_CAP) { atomicAdd(&(bar)[XB_TMO], 1u); break; } } } } while (0)

struct XcdBarrier {
    unsigned* bar; unsigned x; int wave;
    volatile LAS unsigned* st;
};

__device__ __forceinline__ XcdBarrier xcd_barrier_post(unsigned* bar, volatile LAS unsigned* st, int wave) {
    XcdBarrier b; b.bar = bar; b.x = xb_xcc_id(); b.st = st; b.wave = wave;
    if (tid_from_wave(wave) == 0) (void)xb_add(&bar[XB_XCNT(b.x)], 1u);
    return b;
}
__device__ __forceinline__ void xcd_barrier_complete(unsigned* bar, unsigned x, unsigned& nloc, unsigned& nx) {
    const unsigned G = gridDim.x * gridDim.y * gridDim.z;
    unsigned sum, cnt, mine, sp = 0u;
    for (;;) {
        sum = 0u; cnt = 0u; mine = 0u;
#pragma unroll
        for (unsigned j = 0; j < 16; ++j) { const unsigned c = xb_ld(&bar[XB_XCNT(j)]); sum += c; cnt += (c > 0u) ? 1u : 0u; mine = (j == x) ? c : mine; }
        if (sum == G) break;
        __builtin_amdgcn_s_sleep(1);
        if ((++sp & 255u) == 0u) { if (xb_ld(&bar[XB_TMO])) break; if (sp > XB_SPIN_CAP) { atomicAdd(&bar[XB_TMO], 1u); break; } }
    }
    nloc = mine > 0u ? mine : 1u; nx = cnt > 0u ? cnt : 1u;
}

__device__ __forceinline__ void xcd_barrier(const XcdBarrier& b) {
    asm volatile("s_waitcnt vmcnt(0)" ::: "memory");
    __syncthreads();
    if (tid_from_wave(b.wave) == 0) {
        unsigned* bar = b.bar;
        __builtin_amdgcn_s_waitcnt(0);
        unsigned nloc = b.st[0], nx = b.st[1];
        if (nloc == 0u) { xcd_barrier_complete(bar, b.x, nloc, nx); b.st[0] = nloc; b.st[1] = nx; }
        const unsigned old = xb_add(&bar[XB_XSUB(b.x)], 1u);
        const unsigned gen = old / nloc;
        if (old + 1u == (gen + 1u) * nloc) {
            __builtin_amdgcn_fence(__ATOMIC_RELEASE, "agent");
            asm volatile("s_waitcnt vmcnt(0)" ::: "memory");
            const unsigned og = xb_add(&bar[XB_TOP], 1u);
            const unsigned tg = og / nx;
            if (og + 1u == (tg + 1u) * nx) xb_add(&bar[XB_TOPGEN], 1u);
            else XB_SPIN(xb_ld(&bar[XB_TOPGEN]) == tg, bar);
            __builtin_amdgcn_fence(__ATOMIC_ACQUIRE, "agent");
            xb_add(&bar[XB_XGEN(b.x)], 1u);
            asm volatile("s_waitcnt vmcnt(0)" ::: "memory");
        } else {
            XB_SPIN(xb_ld(&bar[XB_XGEN(b.x)]) == gen, bar);
            __builtin_amdgcn_fence(__ATOMIC_ACQUIRE, "agent");
            asm volatile("s_waitcnt vmcnt(0)" ::: "memory");
        }
    }
    __syncthreads();
}

namespace mla {
using bf16x8 = __attribute__((ext_vector_type(8))) short;
using s16x4 = __attribute__((ext_vector_type(4))) short;
using f32x16 = __attribute__((ext_vector_type(16))) float;
using u32x4 = __attribute__((ext_vector_type(4))) unsigned;
typedef __attribute__((address_space(3))) const char* lds_cptr;
constexpr int SEQ = 8192, NW = 8, QBLK = 32, QB = 256, KVBLK = 64, NSLOT = 3, KSLOT = 12288, VSLOT = 8192;
constexpr int QP = 768, KVP = 1024, PEP = 32, OP = 1024;
constexpr int LDS_K = 0, LDS_V = NSLOT * KSLOT, LDS_WS = LDS_V + NSLOT * VSLOT, LDS_OST = LDS_WS + NW * 64 * 4, LDS_TOTAL = LDS_OST + NW * 4096;
__device__ __forceinline__ int crow(int r, int hi) { return (r & 3) + 8 * (r >> 2) + 4 * hi; }
__device__ __forceinline__ void glds16(const void* gsrc, unsigned lds_dst) { unsigned keep;
    asm volatile("s_mov_b32 %0, m0\n\ts_mov_b32 m0, %2\n\ts_nop 0\n\tglobal_load_lds_dwordx4 %1, off\n\ts_mov_b32 m0, %0" : "=&s"(keep) : "v"(gsrc), "s"(lds_dst) : "memory"); }
__device__ __forceinline__ float max3f(float a, float b, float c) { float r; asm("v_max3_f32 %0, %1, %2, %3" : "=v"(r) : "v"(a), "v"(b), "v"(c)); return r; }
typedef float f32x2_t __attribute__((ext_vector_type(2))); typedef __bf16 bf16x2_t __attribute__((ext_vector_type(2)));
__device__ __forceinline__ unsigned cvtpk_s(float lo, float hi) { f32x2_t v = {lo, hi}; bf16x2_t b = __builtin_convertvector(v, bf16x2_t); return __builtin_bit_cast(unsigned, b); }
__device__ __forceinline__ void cmask(f32x16& p0, f32x16& p1, int jb, int qrel, int hi) {
    const float NEG = -INFINITY; const int kb = 64 * jb + 4 * hi;
#pragma unroll
    for (int r = 0; r < 16; ++r) { const int kv = kb + (r & 3) + 8 * (r >> 2); if (kv > qrel) p0[r] = NEG; if (kv + 32 > qrel) p1[r] = NEG; }
}
__device__ __forceinline__ float rowmax(const f32x16& p0, const f32x16& p1) {
    float a = max3f(p0[0], p0[1], p1[0]), b = max3f(p0[2], p0[3], p1[1]); a = max3f(a, p1[2], p1[3]);
#pragma unroll
    for (int r = 4; r < 16; r += 4) { a = max3f(a, p0[r], p0[r + 1]); b = max3f(b, p0[r + 2], p0[r + 3]); a = max3f(a, p1[r], p1[r + 1]); b = max3f(b, p1[r + 2], p1[r + 3]); }
    const float m = fmaxf(a, b);
    auto rr = __builtin_amdgcn_permlane32_swap(__float_as_uint(m), __float_as_uint(m), false, false);
    return fmaxf(__uint_as_float(rr[0]), __uint_as_float(rr[1]));
}
__device__ __forceinline__ void pv(f32x16* o, int vb, bf16x8 pa0, bf16x8 pa1, bf16x8 pa2, bf16x8 pa3) {
#pragma unroll
    for (int d0 = 0; d0 < 2; ++d0) { s16x4 lo[4], hi[4];
#pragma unroll
        for (int ks = 0; ks < 4; ++ks) {
            asm volatile("ds_read_b64_tr_b16 %0,%1 offset:%c2" : "=&v"(lo[ks]) : "v"(vb), "i"(d0 * 4096 + ks * 1024) : "memory");
            asm volatile("ds_read_b64_tr_b16 %0,%1 offset:%c2" : "=&v"(hi[ks]) : "v"(vb), "i"(d0 * 4096 + ks * 1024 + 512) : "memory"); }
        asm volatile("s_waitcnt lgkmcnt(0)" ::: "memory"); __builtin_amdgcn_sched_barrier(0);
#define MLA_PK(k) (bf16x8){lo[k][0], lo[k][1], lo[k][2], lo[k][3], hi[k][0], hi[k][1], hi[k][2], hi[k][3]}
        o[d0] = __builtin_amdgcn_mfma_f32_32x32x16_bf16(pa0, MLA_PK(0), o[d0], 0, 0, 0);
        o[d0] = __builtin_amdgcn_mfma_f32_32x32x16_bf16(pa1, MLA_PK(1), o[d0], 0, 0, 0);
        o[d0] = __builtin_amdgcn_mfma_f32_32x32x16_bf16(pa2, MLA_PK(2), o[d0], 0, 0, 0);
        o[d0] = __builtin_amdgcn_mfma_f32_32x32x16_bf16(pa3, MLA_PK(3), o[d0], 0, 0, 0);
#undef MLA_PK
    }
}
#define MLA_WAIT_BAR(N) asm volatile("s_waitcnt vmcnt(" #N ") lgkmcnt(0)\n\ts_barrier" ::: "memory")

__device__ __forceinline__ void unit(int b, int h, int qb, const unsigned short* Q, const unsigned short* KV, const unsigned short* KPE, unsigned short* O, char* shm, const int wave_) {
    int tid_ = tid_from_wave(wave_); asm volatile("" : "+v"(tid_));
    const int tid = tid_, lane = tid & 63, r32 = lane & 31, hi = lane >> 5; const int wid = __builtin_amdgcn_readfirstlane(tid >> 6);
    const long rowbase = (long)b * SEQ; const int q0 = qb * QB;
    const unsigned short* Qw = Q + (rowbase + q0 + wid * QBLK) * QP + h * 96;
    const unsigned short* Kh = KV + rowbase * KVP + h * 128; const unsigned short* Vh = Kh + 64; const unsigned short* Ph = KPE + rowbase * PEP;
    const unsigned lds0 = (unsigned)(uintptr_t)shm;
    __attribute__((address_space(3))) float* wsf = (__attribute__((address_space(3))) float*)((lds_cptr)shm + LDS_WS) + wid * 64;
    const unsigned short* ksrc = Kh + (long)lane * KVP + wid * 8;
    const unsigned short* psrc = Ph + (long)(32 * (wid & 1) + r32) * PEP + (wid >> 1) * 8;
    const unsigned short* vsrc = Vh + (long)(16 * (wid & 3) + (lane >> 2)) * KVP + (wid >> 2) * 32 + (lane & 3) * 8;
    const unsigned kdst = lds0 + LDS_K + wid * 1024, pdst = lds0 + LDS_K + (8 + (wid >> 1)) * 1024 + (wid & 1) * 512, vdst = lds0 + LDS_V + wid * 1024;
#define MLA_DMA(t, s) do { glds16(ksrc + (long)(t) * KVBLK * KVP, (unsigned)__builtin_amdgcn_readfirstlane(kdst + (s) * KSLOT)); \
        if (lane < 32) glds16(psrc + (long)(t) * KVBLK * PEP, (unsigned)__builtin_amdgcn_readfirstlane(pdst + (s) * KSLOT)); \
        glds16(vsrc + (long)(t) * KVBLK * KVP, (unsigned)__builtin_amdgcn_readfirstlane(vdst + (s) * VSLOT)); } while (0)
    const int vb0 = (int)(lds0 + LDS_V) + ((lane >> 4) & 1) * 32 + (lane & 3) * 8 + (4 * hi + ((lane & 15) >> 2)) * 64;
    const lds_cptr kp0 = (lds_cptr)shm + LDS_K + hi * 1024 + r32 * 16;
    const int NT = (q0 + QB) / KVBLK;
    bf16x8 qr[6];
#pragma unroll
    for (int d0 = 0; d0 < 6; ++d0) qr[d0] = *reinterpret_cast<const bf16x8*>(&Qw[(long)r32 * QP + d0 * 16 + hi * 8]);
    asm volatile("s_waitcnt vmcnt(0)" ::: "memory");
    MLA_DMA(0, 0); MLA_DMA(1, 1);
    float m = -INFINITY, l = 0.f; f32x16 o[2]; o[0] = f32x16{}; o[1] = f32x16{};
    const int qrel = wid * QBLK + r32;
    int slot = 0, slot2 = 2;
    for (int t = 0; t < NT; ++t) {
        if (t + 1 < NT) MLA_WAIT_BAR(3); else MLA_WAIT_BAR(0);
        if (t + 2 < NT) MLA_DMA(t + 2, slot2);
        f32x16 p0 = f32x16{}, p1 = f32x16{};
        { const lds_cptr kp = kp0 + slot * KSLOT;
#pragma unroll
          for (int d0 = 0; d0 < 6; ++d0) { const bf16x8 b0 = *(const __attribute__((address_space(3))) bf16x8*)(kp + d0 * 2048), b1 = *(const __attribute__((address_space(3))) bf16x8*)(kp + d0 * 2048 + 512);
              p0 = __builtin_amdgcn_mfma_f32_32x32x16_bf16(b0, qr[d0], p0, 0, 0, 0); p1 = __builtin_amdgcn_mfma_f32_32x32x16_bf16(b1, qr[d0], p1, 0, 0, 0); } }
        { const int jb = t - (NT - 4); if (jb >= 0) cmask(p0, p1, jb, qrel, hi); }
        const float rm = rowmax(p0, p1), mn = fmaxf(m, rm);
        if (__any(mn > m)) {
            const float al = __builtin_amdgcn_exp2f(m - mn); l *= al; m = mn;
            if (hi == 0) wsf[r32] = al;
            asm volatile("s_waitcnt lgkmcnt(0)" ::: "memory");
#pragma unroll
            for (int r = 0; r < 16; ++r) { const float f = wsf[crow(r, hi)]; o[0][r] *= f; o[1][r] *= f; }
        }
        float sacc = 0.f;
#pragma unroll
        for (int r = 0; r < 16; ++r) { p0[r] = __builtin_amdgcn_exp2f(p0[r] - m); p1[r] = __builtin_amdgcn_exp2f(p1[r] - m); sacc += p0[r] + p1[r]; }
        l += sacc;
        u32x4 pw0, pw1, pw2, pw3;
#define MLA_PKW(P, B) cvtpk_s(P[B], P[B + 1])
        pw0 = (u32x4){MLA_PKW(p0, 0), MLA_PKW(p0, 2), MLA_PKW(p0, 4), MLA_PKW(p0, 6)}; pw1 = (u32x4){MLA_PKW(p0, 8), MLA_PKW(p0, 10), MLA_PKW(p0, 12), MLA_PKW(p0, 14)};
        pw2 = (u32x4){MLA_PKW(p1, 0), MLA_PKW(p1, 2), MLA_PKW(p1, 4), MLA_PKW(p1, 6)}; pw3 = (u32x4){MLA_PKW(p1, 8), MLA_PKW(p1, 10), MLA_PKW(p1, 12), MLA_PKW(p1, 14)};
#undef MLA_PKW
        pv(o, vb0 + slot * VSLOT, __builtin_bit_cast(bf16x8, pw0), __builtin_bit_cast(bf16x8, pw1), __builtin_bit_cast(bf16x8, pw2), __builtin_bit_cast(bf16x8, pw3));
        slot = (slot == NSLOT - 1) ? 0 : slot + 1; slot2 = (slot2 == NSLOT - 1) ? 0 : slot2 + 1;
    }
    { auto rr = __builtin_amdgcn_permlane32_swap(__float_as_uint(l), __float_as_uint(l), false, false); l = __uint_as_float(rr[0]) + __uint_as_float(rr[1]); }
    if (hi == 0) wsf[32 + r32] = l; asm volatile("s_waitcnt lgkmcnt(0)" ::: "memory");
    float rli[16];
#pragma unroll
    for (int r = 0; r < 16; ++r) rli[r] = __builtin_amdgcn_rcpf(wsf[32 + crow(r, hi)]);
    unsigned short* Ow = O + (rowbase + q0 + wid * QBLK) * OP + 512 + h * 64;
    { __attribute__((address_space(3))) unsigned short* stg = (__attribute__((address_space(3))) unsigned short*)((lds_cptr)shm + LDS_OST) + wid * 2048;
#pragma unroll
      for (int r = 0; r < 16; ++r) { const int orow = crow(r, hi);
#pragma unroll
          for (int d0 = 0; d0 < 2; ++d0) stg[orow * 64 + d0 * 32 + r32] = (unsigned short)(cvtpk_s(o[d0][r] * rli[r], 0.f) & 0xffffu); }
      asm volatile("s_waitcnt lgkmcnt(0)" ::: "memory");
#pragma unroll
      for (int i = 0; i < 4; ++i) { const int row = i * 8 + (lane >> 3), ch = lane & 7; const u32x4 v = *(const __attribute__((address_space(3))) u32x4*)(stg + row * 64 + ch * 8); *(u32x4*)(Ow + (long)row * OP + ch * 8) = v; } }
    asm volatile("s_waitcnt vmcnt(0) lgkmcnt(0)\n\ts_barrier" ::: "memory");
#undef MLA_DMA
}

#define MLA_SB() __builtin_amdgcn_sched_barrier(0)
#define MLA_PIN(x) asm volatile("" : "+v"(x))
#define MLA_LDK(kp, d0, h) (*(const __attribute__((address_space(3))) bf16x8*)((kp) + (d0) * 2048 + (h) * 512))
#define MLA_E4(P, B) do { P[B] = __builtin_amdgcn_exp2f(P[B]); P[B + 1] = __builtin_amdgcn_exp2f(P[B + 1]); P[B + 2] = __builtin_amdgcn_exp2f(P[B + 2]); P[B + 3] = __builtin_amdgcn_exp2f(P[B + 3]); MLA_PIN(P); } while (0)
#define MLA_A4(P, B) do { sacc += P[B]; sacc += P[B + 1]; sacc += P[B + 2]; sacc += P[B + 3]; MLA_PIN(sacc); } while (0)
#define MLA_PK2(W, I, P, B) do { W[I] = cvtpk_s(P[B], P[B + 1]); W[I + 1] = cvtpk_s(P[B + 2], P[B + 3]); MLA_PIN(W); } while (0)
#define MLA_MF(C, K, Q) C = __builtin_amdgcn_mfma_f32_32x32x16_bf16(K, Q, C, 0, 0, 0)
#define MLA_MF0(C, K, Q) C = __builtin_amdgcn_mfma_f32_32x32x16_bf16(K, Q, negm, 0, 0, 0)
#define MLA_SOFT(P0, P1) do { float sacc = 0.f; \
    MLA_E4(P0, 0); MLA_E4(P0, 4); MLA_E4(P0, 8); MLA_E4(P0, 12); MLA_E4(P1, 0); MLA_E4(P1, 4); MLA_E4(P1, 8); MLA_E4(P1, 12); \
    MLA_A4(P0, 0); MLA_A4(P0, 4); MLA_A4(P0, 8); MLA_A4(P0, 12); MLA_A4(P1, 0); MLA_A4(P1, 4); MLA_A4(P1, 8); MLA_A4(P1, 12); \
    MLA_PK2(pw0, 0, P0, 0); MLA_PK2(pw0, 2, P0, 4); MLA_PK2(pw1, 0, P0, 8); MLA_PK2(pw1, 2, P0, 12); MLA_PK2(pw2, 0, P1, 0); MLA_PK2(pw2, 2, P1, 4); MLA_PK2(pw3, 0, P1, 8); MLA_PK2(pw3, 2, P1, 12); \
    l_reg += sacc; } while (0)
#define MLA_REF(C0, C1, RESC_O) do { const float rm_ = rowmax(C0, C1); \
    if (__builtin_expect(__any(rm_ > (float)THRL), 0)) { const float dl_ = fmaxf(rm_, 0.f); mhat += dl_; \
        _Pragma("unroll") for (int r = 0; r < 16; ++r) { C0[r] -= dl_; C1[r] -= dl_; } \
        _Pragma("unroll") for (int r = 0; r < 16; ++r) negm[r] = -mhat; MLA_PIN(negm); \
        const float f_ = __builtin_amdgcn_exp2f(-dl_); l_reg *= f_; \
        if (RESC_O) { if (hi == 0) wsf[r32] = f_; asm volatile("s_waitcnt lgkmcnt(0)" ::: "memory"); \
            _Pragma("unroll") for (int r = 0; r < 16; ++r) { const float g_ = wsf[crow(r, hi)]; o[0][r] *= g_; o[1][r] *= g_; } } } } while (0)
#define MLA_STEP(C0, C1, P0, P1, t, JB, WAITN, GK, GV) do { \
    MLA_WAIT_BAR(WAITN); \
    if (GK) { glds16(ksrc + (long)((t) + 3) * KVBLK * KVP, (unsigned)__builtin_amdgcn_readfirstlane(kdst + s0 * KSLOT)); \
              if (lane < 32) glds16(psrc + (long)((t) + 3) * KVBLK * PEP, (unsigned)__builtin_amdgcn_readfirstlane(pdst + s0 * KSLOT)); } \
    if (GV) { glds16(vsrc + (long)((t) + 2) * KVBLK * KVP, (unsigned)__builtin_amdgcn_readfirstlane(vdst + s2 * VSLOT)); } \
    { const lds_cptr kp = kp0 + s1 * KSLOT; float sacc = 0.f; bf16x8 ka0, ka1, kb0, kb1; \
      ka0 = MLA_LDK(kp, 0, 0); ka1 = MLA_LDK(kp, 0, 1); MLA_E4(P0, 0); MLA_E4(P0, 4); MLA_SB(); \
      kb0 = MLA_LDK(kp, 1, 0); kb1 = MLA_LDK(kp, 1, 1); \
      MLA_MF0(C0, ka0, qr[0]); MLA_E4(P0, 8); MLA_SB(); \
      MLA_MF0(C1, ka1, qr[0]); MLA_E4(P0, 12); MLA_A4(P0, 0); MLA_SB(); \
      ka0 = MLA_LDK(kp, 2, 0); ka1 = MLA_LDK(kp, 2, 1); \
      MLA_MF(C0, kb0, qr[1]); MLA_E4(P1, 0); MLA_A4(P0, 4); MLA_SB(); \
      MLA_MF(C1, kb1, qr[1]); MLA_E4(P1, 4); MLA_A4(P0, 8); MLA_PK2(pw0, 0, P0, 0); MLA_SB(); \
      kb0 = MLA_LDK(kp, 3, 0); kb1 = MLA_LDK(kp, 3, 1); \
      MLA_MF(C0, ka0, qr[2]); MLA_E4(P1, 8); MLA_A4(P0, 12); MLA_PK2(pw0, 2, P0, 4); MLA_SB(); \
      MLA_MF(C1, ka1, qr[2]); MLA_E4(P1, 12); MLA_A4(P1, 0); MLA_PK2(pw1, 0, P0, 8); MLA_SB(); \
      ka0 = MLA_LDK(kp, 4, 0); ka1 = MLA_LDK(kp, 4, 1); \
      MLA_MF(C0, kb0, qr[3]); MLA_A4(P1, 4); MLA_PK2(pw1, 2, P0, 12); MLA_SB(); \
      MLA_MF(C1, kb1, qr[3]); MLA_A4(P1, 8); MLA_PK2(pw2, 0, P1, 0); MLA_SB(); \
      kb0 = MLA_LDK(kp, 5, 0); kb1 = MLA_LDK(kp, 5, 1); \
      MLA_MF(C0, ka0, qr[4]); MLA_A4(P1, 12); MLA_PK2(pw2, 2, P1, 4); MLA_SB(); \
      MLA_MF(C1, ka1, qr[4]); MLA_PK2(pw3, 0, P1, 8); MLA_SB(); \
      MLA_MF(C0, kb0, qr[5]); MLA_PK2(pw3, 2, P1, 12); MLA_SB(); \
      MLA_MF(C1, kb1, qr[5]); MLA_SB(); \
      l_reg += sacc; } \
    pv(o, vb0 + s0 * VSLOT, __builtin_bit_cast(bf16x8, pw0), __builtin_bit_cast(bf16x8, pw1), __builtin_bit_cast(bf16x8, pw2), __builtin_bit_cast(bf16x8, pw3)); \
    if ((JB) >= 0) cmask(C0, C1, (JB), qrel, hi); \
    MLA_REF(C0, C1, true); \
    { const int s_ = s0; s0 = s1; s1 = s2; s2 = s_; } \
} while (0)

template <int THRL> __device__ __forceinline__ void unit_pipe(int b, int h, int qb, const unsigned short* Q, const unsigned short* KV, const unsigned short* KPE, unsigned short* O, char* shm, const int wave_) {
    int tid_ = tid_from_wave(wave_); asm volatile("" : "+v"(tid_));
    const int tid = tid_, lane = tid & 63, r32 = lane & 31, hi = lane >> 5; const int wid = __builtin_amdgcn_readfirstlane(tid >> 6);
    const long rowbase = (long)b * SEQ; const int q0 = qb * QB;
    const unsigned short* Qw = Q + (rowbase + q0 + wid * QBLK) * QP + h * 96;
    const unsigned short* Kh = KV + rowbase * KVP + h * 128; const unsigned short* Vh = Kh + 64; const unsigned short* Ph = KPE + rowbase * PEP;
    const unsigned lds0 = (unsigned)(uintptr_t)shm;
    __attribute__((address_space(3))) float* wsf = (__attribute__((address_space(3))) float*)((lds_cptr)shm + LDS_WS) + wid * 64;
    const unsigned short* ksrc = Kh + (long)lane * KVP + wid * 8;
    const unsigned short* psrc = Ph + (long)(32 * (wid & 1) + r32) * PEP + (wid >> 1) * 8;
    const unsigned short* vsrc = Vh + (long)(16 * (wid & 3) + (lane >> 2)) * KVP + (wid >> 2) * 32 + (lane & 3) * 8;
    const unsigned kdst = lds0 + LDS_K + wid * 1024, pdst = lds0 + LDS_K + (8 + (wid >> 1)) * 1024 + (wid & 1) * 512, vdst = lds0 + LDS_V + wid * 1024;
    const int vb0 = (int)(lds0 + LDS_V) + ((lane >> 4) & 1) * 32 + (lane & 3) * 8 + (4 * hi + ((lane & 15) >> 2)) * 64;
    const lds_cptr kp0 = (lds_cptr)shm + LDS_K + hi * 1024 + r32 * 16;
    const int NT = (q0 + QB) / KVBLK;
    bf16x8 qr[6];
#pragma unroll
    for (int d0 = 0; d0 < 6; ++d0) qr[d0] = *reinterpret_cast<const bf16x8*>(&Qw[(long)r32 * QP + d0 * 16 + hi * 8]);
    asm volatile("s_waitcnt vmcnt(0)" ::: "memory");
    glds16(ksrc, (unsigned)__builtin_amdgcn_readfirstlane(kdst)); if (lane < 32) glds16(psrc, (unsigned)__builtin_amdgcn_readfirstlane(pdst));
    glds16(ksrc + (long)KVBLK * KVP, (unsigned)__builtin_amdgcn_readfirstlane(kdst + KSLOT)); if (lane < 32) glds16(psrc + (long)KVBLK * PEP, (unsigned)__builtin_amdgcn_readfirstlane(pdst + KSLOT)); glds16(vsrc, (unsigned)__builtin_amdgcn_readfirstlane(vdst));
    glds16(ksrc + (long)2 * KVBLK * KVP, (unsigned)__builtin_amdgcn_readfirstlane(kdst + 2 * KSLOT)); if (lane < 32) glds16(psrc + (long)2 * KVBLK * PEP, (unsigned)__builtin_amdgcn_readfirstlane(pdst + 2 * KSLOT)); glds16(vsrc + (long)KVBLK * KVP, (unsigned)__builtin_amdgcn_readfirstlane(vdst + VSLOT));
    float mhat = 0.f, l_reg = 0.f; f32x16 o[2]; o[0] = f32x16{}; o[1] = f32x16{}; f32x16 negm = f32x16{}; MLA_PIN(negm);
    const int qrel = wid * QBLK + r32;
    f32x16 pA0, pA1, pB0, pB1; u32x4 pw0, pw1, pw2, pw3;
    int s0 = 0, s1 = 1, s2 = 2;
    MLA_WAIT_BAR(6);
    { const lds_cptr kp = kp0;
      pA0 = f32x16{}; pA1 = f32x16{};
#pragma unroll
      for (int d0 = 0; d0 < 6; ++d0) { const bf16x8 k0 = MLA_LDK(kp, d0, 0), k1 = MLA_LDK(kp, d0, 1); MLA_MF(pA0, k0, qr[d0]); MLA_MF(pA1, k1, qr[d0]); } }
    { const float rm_ = rowmax(pA0, pA1); mhat = rm_;
#pragma unroll
      for (int r = 0; r < 16; ++r) { pA0[r] -= rm_; pA1[r] -= rm_; negm[r] = -mhat; }
      MLA_PIN(negm); }
    int t = 0;
    MLA_STEP(pB0, pB1, pA0, pA1, t, -1, 3, true, true); ++t;
    for (; t + 1 <= NT - 6; t += 2) {
        MLA_STEP(pA0, pA1, pB0, pB1, t, -1, 3, true, true);
        MLA_STEP(pB0, pB1, pA0, pA1, t + 1, -1, 3, true, true);
    }
    MLA_STEP(pA0, pA1, pB0, pB1, t, 0, 3, true, true); ++t;
    MLA_STEP(pB0, pB1, pA0, pA1, t, 1, 3, true, true); ++t;
    MLA_STEP(pA0, pA1, pB0, pB1, t, 2, 3, false, true); ++t;
    MLA_STEP(pB0, pB1, pA0, pA1, t, 3, 1, false, false); ++t;
    MLA_WAIT_BAR(0);
    MLA_SOFT(pB0, pB1);
    pv(o, vb0 + s0 * VSLOT, __builtin_bit_cast(bf16x8, pw0), __builtin_bit_cast(bf16x8, pw1), __builtin_bit_cast(bf16x8, pw2), __builtin_bit_cast(bf16x8, pw3));
    { auto rr = __builtin_amdgcn_permlane32_swap(__float_as_uint(l_reg), __float_as_uint(l_reg), false, false); l_reg = __uint_as_float(rr[0]) + __uint_as_float(rr[1]); }
    if (hi == 0) wsf[32 + r32] = l_reg; asm volatile("s_waitcnt lgkmcnt(0)" ::: "memory");
    float rli[16];
#pragma unroll
    for (int r = 0; r < 16; ++r) rli[r] = __builtin_amdgcn_rcpf(wsf[32 + crow(r, hi)]);
    unsigned short* Ow = O + (rowbase + q0 + wid * QBLK) * OP + 512 + h * 64;
    { __attribute__((address_space(3))) unsigned short* stg = (__attribute__((address_space(3))) unsigned short*)((lds_cptr)shm + LDS_OST) + wid * 2048;
#pragma unroll
      for (int r = 0; r < 16; ++r) { const int orow = crow(r, hi);
#pragma unroll
          for (int d0 = 0; d0 < 2; ++d0) stg[orow * 64 + d0 * 32 + r32] = (unsigned short)(cvtpk_s(o[d0][r] * rli[r], 0.f) & 0xffffu); }
      asm volatile("s_waitcnt lgkmcnt(0)" ::: "memory");
#pragma unroll
      for (int i = 0; i < 4; ++i) { const int row = i * 8 + (lane >> 3), ch = lane & 7; const u32x4 v = *(const __attribute__((address_space(3))) u32x4*)(stg + row * 64 + ch * 8); *(u32x4*)(Ow + (long)row * OP + ch * 8) = v; } }
    asm volatile("s_waitcnt vmcnt(0) lgkmcnt(0)\n\ts_barrier" ::: "memory");
}

constexpr int S4_V = NSLOT * KSLOT, S4_WS = S4_V + 4 * VSLOT, S4_OST = S4_WS + NW * 64 * 4, S4_TOTAL = S4_OST + NW * 4096;
#define MLA_R1(C0, C1, P0, P1, kp) do { float sacc = 0.f; bf16x8 ka0, ka1, kb0, kb1; \
      ka0 = MLA_LDK(kp, 0, 0); ka1 = MLA_LDK(kp, 0, 1); MLA_E4(P0, 0); MLA_E4(P0, 4); MLA_SB(); \
      kb0 = MLA_LDK(kp, 1, 0); kb1 = MLA_LDK(kp, 1, 1); \
      MLA_MF0(C0, ka0, qr[0]); MLA_E4(P0, 8); MLA_SB(); \
      MLA_MF0(C1, ka1, qr[0]); MLA_E4(P0, 12); MLA_A4(P0, 0); MLA_SB(); \
      ka0 = MLA_LDK(kp, 2, 0); ka1 = MLA_LDK(kp, 2, 1); \
      MLA_MF(C0, kb0, qr[1]); MLA_E4(P1, 0); MLA_A4(P0, 4); MLA_SB(); \
      MLA_MF(C1, kb1, qr[1]); MLA_E4(P1, 4); MLA_A4(P0, 8); MLA_PK2(pw0, 0, P0, 0); MLA_SB(); \
      kb0 = MLA_LDK(kp, 3, 0); kb1 = MLA_LDK(kp, 3, 1); \
      MLA_MF(C0, ka0, qr[2]); MLA_E4(P1, 8); MLA_A4(P0, 12); MLA_PK2(pw0, 2, P0, 4); MLA_SB(); \
      MLA_MF(C1, ka1, qr[2]); MLA_E4(P1, 12); MLA_A4(P1, 0); MLA_PK2(pw1, 0, P0, 8); MLA_SB(); \
      ka0 = MLA_LDK(kp, 4, 0); ka1 = MLA_LDK(kp, 4, 1); \
      MLA_MF(C0, kb0, qr[3]); MLA_A4(P1, 4); MLA_PK2(pw1, 2, P0, 12); MLA_SB(); \
      MLA_MF(C1, kb1, qr[3]); MLA_A4(P1, 8); MLA_PK2(pw2, 0, P1, 0); MLA_SB(); \
      kb0 = MLA_LDK(kp, 5, 0); kb1 = MLA_LDK(kp, 5, 1); \
      MLA_MF(C0, ka0, qr[4]); MLA_A4(P1, 12); MLA_PK2(pw2, 2, P1, 4); MLA_SB(); \
      MLA_MF(C1, ka1, qr[4]); MLA_PK2(pw3, 0, P1, 8); MLA_SB(); \
      MLA_MF(C0, kb0, qr[5]); MLA_PK2(pw3, 2, P1, 12); MLA_SB(); \
      MLA_MF(C1, kb1, qr[5]); MLA_SB(); \
      l_reg += sacc; } while (0)
#define MLA_PVW(slot) pv(o, vb0 + (slot) * VSLOT, __builtin_bit_cast(bf16x8, pw0), __builtin_bit_cast(bf16x8, pw1), __builtin_bit_cast(bf16x8, pw2), __builtin_bit_cast(bf16x8, pw3))
#define MLA_DMA4(t, GK, GV) do { \
    if (GK) { glds16(ksrc + (long)((t) + 3) * KVBLK * KVP, (unsigned)__builtin_amdgcn_readfirstlane(kdst + s0 * KSLOT)); \
              if (lane < 32) glds16(psrc + (long)((t) + 3) * KVBLK * PEP, (unsigned)__builtin_amdgcn_readfirstlane(pdst + s0 * KSLOT)); } \
    if (GV) { glds16(vsrc + (long)((t) + 2) * KVBLK * KVP, (unsigned)__builtin_amdgcn_readfirstlane(vdst + (((t) + 2) & 3) * VSLOT)); } } while (0)
#define MLA_REFB(C0, C1) do { const float rm_ = rowmax(C0, C1); \
      if (__builtin_expect(__any(rm_ > (float)THRL), 0)) { const float dl_ = fmaxf(rm_, 0.f); mhat += dl_; \
          _Pragma("unroll") for (int r = 0; r < 16; ++r) { C0[r] -= dl_; C1[r] -= dl_; } \
          _Pragma("unroll") for (int r = 0; r < 16; ++r) negm[r] = -mhat; MLA_PIN(negm); \
          const float f_ = __builtin_amdgcn_exp2f(-dl_); l_reg *= f_; if (hi == 0) wsf[r32] = f_; resc = true; } } while (0)
#define MLA_RESCB() do { if (resc) { asm volatile("s_waitcnt lgkmcnt(0)" ::: "memory"); _Pragma("unroll") for (int r = 0; r < 16; ++r) { const float g_ = wsf[crow(r, hi)]; o[0][r] *= g_; o[1][r] *= g_; } resc = false; } } while (0)
#define MLA_STEPS(C0, C1, P0, P1, t, JB, WAITN, GK, GV, HASPV) do { \
    MLA_WAIT_BAR(WAITN); MLA_DMA4(t, GK, GV); \
    if (LATE) { if (HASPV) { MLA_PVW(((t) + 3) & 3); } MLA_RESCB(); } \
    { const lds_cptr kp = kp0 + s1 * KSLOT; MLA_R1(C0, C1, P0, P1, kp); } \
    if (!LATE) { MLA_PVW((t) & 3); } \
    if ((JB) >= 0) cmask(C0, C1, (JB), qrel, hi); \
    if (LATE) MLA_REFB(C0, C1); else MLA_REF(C0, C1, true); \
    { const int s_ = s0; s0 = s1; s1 = s2; s2 = s_; } } while (0)

template <int THRL, bool LATE> __device__ __forceinline__ void unit_stag(int b, int h, int qb, const unsigned short* Q, const unsigned short* KV, const unsigned short* KPE, unsigned short* O, char* shm, const int wave_) {
    int tid_ = tid_from_wave(wave_); asm volatile("" : "+v"(tid_));
    const int tid = tid_, lane = tid & 63, r32 = lane & 31, hi = lane >> 5; const int wid = __builtin_amdgcn_readfirstlane(tid >> 6);
    const long rowbase = (long)b * SEQ; const int q0 = qb * QB;
    const unsigned short* Qw = Q + (rowbase + q0 + wid * QBLK) * QP + h * 96;
    const unsigned short* Kh = KV + rowbase * KVP + h * 128; const unsigned short* Vh = Kh + 64; const unsigned short* Ph = KPE + rowbase * PEP;
    const unsigned lds0 = (unsigned)(uintptr_t)shm;
    __attribute__((address_space(3))) float* wsf = (__attribute__((address_space(3))) float*)((lds_cptr)shm + S4_WS) + wid * 64;
    const unsigned short* ksrc = Kh + (long)lane * KVP + wid * 8;
    const unsigned short* psrc = Ph + (long)(32 * (wid & 1) + r32) * PEP + (wid >> 1) * 8;
    const unsigned short* vsrc = Vh + (long)(16 * (wid & 3) + (lane >> 2)) * KVP + (wid >> 2) * 32 + (lane & 3) * 8;
    const unsigned kdst = lds0 + LDS_K + wid * 1024, pdst = lds0 + LDS_K + (8 + (wid >> 1)) * 1024 + (wid & 1) * 512, vdst = lds0 + S4_V + wid * 1024;
    const int vb0 = (int)(lds0 + S4_V) + ((lane >> 4) & 1) * 32 + (lane & 3) * 8 + (4 * hi + ((lane & 15) >> 2)) * 64;
    const lds_cptr kp0 = (lds_cptr)shm + LDS_K + hi * 1024 + r32 * 16;
    const int NT = (q0 + QB) / KVBLK;
    bf16x8 qr[6];
#pragma unroll
    for (int d0 = 0; d0 < 6; ++d0) qr[d0] = *reinterpret_cast<const bf16x8*>(&Qw[(long)r32 * QP + d0 * 16 + hi * 8]);
    asm volatile("s_waitcnt vmcnt(0)" ::: "memory");
    glds16(ksrc, (unsigned)__builtin_amdgcn_readfirstlane(kdst)); if (lane < 32) glds16(psrc, (unsigned)__builtin_amdgcn_readfirstlane(pdst));
    glds16(ksrc + (long)KVBLK * KVP, (unsigned)__builtin_amdgcn_readfirstlane(kdst + KSLOT)); if (lane < 32) glds16(psrc + (long)KVBLK * PEP, (unsigned)__builtin_amdgcn_readfirstlane(pdst + KSLOT)); glds16(vsrc, (unsigned)__builtin_amdgcn_readfirstlane(vdst));
    glds16(ksrc + (long)2 * KVBLK * KVP, (unsigned)__builtin_amdgcn_readfirstlane(kdst + 2 * KSLOT)); if (lane < 32) glds16(psrc + (long)2 * KVBLK * PEP, (unsigned)__builtin_amdgcn_readfirstlane(pdst + 2 * KSLOT)); glds16(vsrc + (long)KVBLK * KVP, (unsigned)__builtin_amdgcn_readfirstlane(vdst + VSLOT));
    float mhat = 0.f, l_reg = 0.f; f32x16 o[2]; o[0] = f32x16{}; o[1] = f32x16{}; f32x16 negm = f32x16{}; MLA_PIN(negm);
    const int qrel = wid * QBLK + r32; bool resc = false;
    f32x16 pA0, pA1, pB0, pB1; u32x4 pw0, pw1, pw2, pw3;
    int s0 = 0, s1 = 1, s2 = 2;
    MLA_WAIT_BAR(6);
    { const lds_cptr kp = kp0;
      pA0 = f32x16{}; pA1 = f32x16{};
#pragma unroll
      for (int d0 = 0; d0 < 6; ++d0) { const bf16x8 k0 = MLA_LDK(kp, d0, 0), k1 = MLA_LDK(kp, d0, 1); MLA_MF(pA0, k0, qr[d0]); MLA_MF(pA1, k1, qr[d0]); } }
    { const float rm_ = rowmax(pA0, pA1); mhat = rm_;
#pragma unroll
      for (int r = 0; r < 16; ++r) { pA0[r] -= rm_; pA1[r] -= rm_; negm[r] = -mhat; }
      MLA_PIN(negm); }
    int t = 0;
    MLA_STEPS(pB0, pB1, pA0, pA1, t, -1, 3, true, true, false); ++t;
    for (; t + 1 <= NT - 6; t += 2) {
        MLA_STEPS(pA0, pA1, pB0, pB1, t, -1, 3, true, true, true);
        MLA_STEPS(pB0, pB1, pA0, pA1, t + 1, -1, 3, true, true, true);
    }
    MLA_STEPS(pA0, pA1, pB0, pB1, t, 0, 3, true, true, true); ++t;
    MLA_STEPS(pB0, pB1, pA0, pA1, t, 1, 3, true, true, true); ++t;
    MLA_STEPS(pA0, pA1, pB0, pB1, t, 2, 3, false, true, true); ++t;
    MLA_STEPS(pB0, pB1, pA0, pA1, t, 3, 1, false, false, true); ++t;
    MLA_WAIT_BAR(0);
    if (LATE) { MLA_PVW((NT - 2) & 3); MLA_RESCB(); }
    MLA_SOFT(pB0, pB1);
    MLA_PVW((NT - 1) & 3);
    { auto rr = __builtin_amdgcn_permlane32_swap(__float_as_uint(l_reg), __float_as_uint(l_reg), false, false); l_reg = __uint_as_float(rr[0]) + __uint_as_float(rr[1]); }
    if (hi == 0) wsf[32 + r32] = l_reg; asm volatile("s_waitcnt lgkmcnt(0)" ::: "memory");
    float rli[16];
#pragma unroll
    for (int r = 0; r < 16; ++r) rli[r] = __builtin_amdgcn_rcpf(wsf[32 + crow(r, hi)]);
    unsigned short* Ow = O + (rowbase + q0 + wid * QBLK) * OP + 512 + h * 64;
    { __attribute__((address_space(3))) unsigned short* stg = (__attribute__((address_space(3))) unsigned short*)((lds_cptr)shm + S4_OST) + wid * 2048;
#pragma unroll
      for (int r = 0; r < 16; ++r) { const int orow = crow(r, hi);
#pragma unroll
          for (int d0 = 0; d0 < 2; ++d0) stg[orow * 64 + d0 * 32 + r32] = (unsigned short)(cvtpk_s(o[d0][r] * rli[r], 0.f) & 0xffffu); }
      asm volatile("s_waitcnt lgkmcnt(0)" ::: "memory");
#pragma unroll
      for (int i = 0; i < 4; ++i) { const int row = i * 8 + (lane >> 3), ch = lane & 7; const u32x4 v = *(const __attribute__((address_space(3))) u32x4*)(stg + row * 64 + ch * 8); *(u32x4*)(Ow + (long)row * OP + ch * 8) = v; } }
    asm volatile("s_waitcnt vmcnt(0) lgkmcnt(0)\n\ts_barrier" ::: "memory");
}
__device__ __forceinline__ void phase(char* lds, const unsigned short* Q, const unsigned short* KV, const unsigned short* KPE, unsigned short* O, int vcu, int G, const int wave_) {
    for (int v = vcu; v < 256; v += G) { const int s = v & 7, bh = v >> 3;
#pragma unroll 1
        for (int i = 0; i < 4; ++i) { const int qb = (i == 0) ? s : (i == 1) ? 15 - s : (i == 2) ? 16 + s : 31 - s; if (qb == 0) unit(bh >> 3, bh & 7, qb, Q, KV, KPE, O, lds, wave_); else if (wave_ < 4) unit_stag<8, false>(bh >> 3, bh & 7, qb, Q, KV, KPE, O, lds, wave_); else unit_stag<8, true>(bh >> 3, bh & 7, qb, Q, KV, KPE, O, lds, wave_); } }
}
#undef MLA_WAIT_BAR
}

namespace evm {
using bf16x8 = __attribute__((ext_vector_type(8))) short;
using s16x4 = __attribute__((ext_vector_type(4))) short;
using f32x16 = __attribute__((ext_vector_type(16))) float;
using u32x4 = __attribute__((ext_vector_type(4))) unsigned;
typedef __attribute__((address_space(3))) char* lds_ptr;
constexpr int PP = 1792, VNP = 1088;
constexpr int LDS_VT = 0, LDS_WS = 65536, LDS_OST = LDS_WS + 2048, LDS_TOTAL = 139264;
__device__ __forceinline__ s16x4 trr(int addr) { s16x4 v; asm volatile("ds_read_b64_tr_b16 %0,%1" : "=&v"(v) : "v"(addr) : "memory"); return v; }
#define EVM_TR(dst, addr, off) asm volatile("ds_read_b64_tr_b16 %0,%1 offset:%c2" : "=&v"(dst) : "v"(addr), "i"(off) : "memory")
__device__ __forceinline__ float bflo(unsigned u) { return __uint_as_float(u << 16); }
__device__ __forceinline__ float bfhi(unsigned u) { return __uint_as_float(u & 0xffff0000u); }

__device__ __forceinline__ void unit(int un, const unsigned short* proj, const float* sinks, const float* ln_g, const float* ln_b, const unsigned short* wsb, const float* b_s, unsigned short* mix, char* shm, const int wave_) {
    int tid_ = tid_from_wave(wave_); asm volatile("" : "+v"(tid_));
    const int tid = tid_, lane = tid & 63, r32 = lane & 31, hi = lane >> 5; const int wid = __builtin_amdgcn_readfirstlane(tid >> 6);
    const int row0 = un * 128, tblk = (un & 63) * 128, seq0 = row0 - tblk;
    const lds_ptr L = (lds_ptr)shm; const unsigned lds0 = (unsigned)(uintptr_t)shm;
    for (int i = 0; i < 16; ++i) { const int tl = wid * 16 + i, grow = row0 + tl;
        const u32x4 w = *(const u32x4*)(proj + (size_t)grow * PP + 1280 + lane * 8);
        float x[8] = {bflo(w.x), bfhi(w.x), bflo(w.y), bfhi(w.y), bflo(w.z), bfhi(w.z), bflo(w.w), bfhi(w.w)};
        float s = 0.f;
#pragma unroll
        for (int j = 0; j < 8; ++j) s += x[j];
#pragma unroll
        for (int o = 1; o < 64; o <<= 1) s += __shfl_xor(s, o);
        const float mu = s * (1.f / 512.f); float qq = 0.f;
#pragma unroll
        for (int j = 0; j < 8; ++j) { x[j] -= mu; qq += x[j] * x[j]; }
#pragma unroll
        for (int o = 1; o < 64; o <<= 1) qq += __shfl_xor(qq, o);
        const float rstd = 1.0f / sqrtf(qq * (1.f / 512.f) + 1e-6f);
        const f32x4 g0 = ((const f32x4*)ln_g)[lane * 2], g1 = ((const f32x4*)ln_g)[lane * 2 + 1], b0 = ((const f32x4*)ln_b)[lane * 2], b1 = ((const f32x4*)ln_b)[lane * 2 + 1];
        u32x4 ov; ov.x = pg8::cvt_pk_bf16(x[0] * rstd * g0.x + b0.x, x[1] * rstd * g0.y + b0.y); ov.y = pg8::cvt_pk_bf16(x[2] * rstd * g0.z + b0.z, x[3] * rstd * g0.w + b0.w);
        ov.z = pg8::cvt_pk_bf16(x[4] * rstd * g1.x + b1.x, x[5] * rstd * g1.y + b1.y); ov.w = pg8::cvt_pk_bf16(x[6] * rstd * g1.z + b1.z, x[7] * rstd * g1.w + b1.w);
        *(__attribute__((address_space(3))) u32x4*)(L + tl * VNP + lane * 16) = ov; }
    __syncthreads();
    { const int g = wid;
      const int trb = (int)lds0 + ((lane >> 4) & 1) * 32 + (lane & 3) * 8 + (8 * hi + ((lane & 15) >> 2)) * VNP + g * 128;
#pragma unroll 1
      for (int i = 0; i < 4; ++i) { f32x16 a0 = f32x16{}, a1 = f32x16{};
          for (int s = 0; s < 2 * i + 2; ++s) {
              const bf16x8 A = *(const bf16x8*)(wsb + ((size_t)(g * 128 + 32 * i + r32) * 128 + 16 * s + 8 * hi));
              const int ad = trb + s * 16 * VNP; s16x4 l0, h0, l1, h1;
              EVM_TR(l0, ad, 0); EVM_TR(h0, ad, 4 * VNP); EVM_TR(l1, ad, 64); EVM_TR(h1, ad, 64 + 4 * VNP);
              asm volatile("s_waitcnt lgkmcnt(0)" : "+v"(l0), "+v"(h0), "+v"(l1), "+v"(h1) :: "memory"); __builtin_amdgcn_sched_barrier(0);
              const bf16x8 B0 = (bf16x8){l0[0], l0[1], l0[2], l0[3], h0[0], h0[1], h0[2], h0[3]}, B1 = (bf16x8){l1[0], l1[1], l1[2], l1[3], h1[0], h1[1], h1[2], h1[3]};
              a0 = __builtin_amdgcn_mfma_f32_32x32x16_bf16(A, B0, a0, 0, 0, 0); a1 = __builtin_amdgcn_mfma_f32_32x32x16_bf16(A, B1, a1, 0, 0, 0); }
#pragma unroll
          for (int r = 0; r < 16; ++r) { const int t = 32 * i + (r & 3) + 8 * (r >> 2) + 4 * hi; const float bs = b_s[g * 128 + t];
              const unsigned short* up = proj + (size_t)(row0 + t) * PP + 768 + g * 64 + r32; unsigned short* op = mix + (size_t)(row0 + t) * 1024 + 512 + g * 64 + r32;
              const float u0 = __uint_as_float(((unsigned)up[0]) << 16), u1 = __uint_as_float(((unsigned)up[32]) << 16);
              op[0] = (unsigned short)(pg8::cvt_pk_bf16(u0 * (a0[r] + bs), 0.f) & 0xffffu); op[32] = (unsigned short)(pg8::cvt_pk_bf16(u1 * (a1[r] + bs), 0.f) & 0xffffu); } } }
    asm volatile("s_waitcnt vmcnt(0) lgkmcnt(0)" ::: "memory");
    __syncthreads();
    { const int h = wid, kvh = h >> 2; const bool first = (tblk == 0);
#pragma unroll
      for (int T = 0; T < 8; ++T) { const int jt = T & 3; if (first && jt < 2) continue;
          const unsigned short* src = proj + (size_t)(seq0 + tblk - 128 + 64 * jt + 16 * (wid & 3) + (lane >> 2)) * PP + 640 + (T >> 2) * 64 + (wid >> 2) * 32 + (lane & 3) * 8;
          mla::glds16(src, (unsigned)__builtin_amdgcn_readfirstlane(lds0 + LDS_VT + T * 8192 + wid * 1024)); }
      asm volatile("s_waitcnt vmcnt(0)\n\ts_barrier" ::: "memory");
      const float slope2 = __builtin_amdgcn_exp2f(-(float)(h + 1)) * 1.4426950408889634f, sink2 = sinks[h] * 1.4426950408889634f;
      const int vb0 = (int)(lds0 + LDS_VT) + ((lane >> 4) & 1) * 32 + (lane & 3) * 8 + (4 * hi + ((lane & 15) >> 2)) * 64 + kvh * 4 * 8192;
      __attribute__((address_space(3))) float* wsf = (__attribute__((address_space(3))) float*)(L + LDS_WS) + wid * 64;
      __attribute__((address_space(3))) unsigned short* stg = (__attribute__((address_space(3))) unsigned short*)(L + LDS_OST) + wid * 2048;
#pragma unroll 1
      for (int i = 0; i < 4; ++i) {
          bf16x8 qr[4];
#pragma unroll
          for (int d0 = 0; d0 < 4; ++d0) qr[d0] = *(const bf16x8*)(proj + (size_t)(row0 + 32 * i + r32) * PP + h * 64 + d0 * 16 + hi * 8);
          f32x16 S[5]; float mx = sink2;
#pragma unroll
          for (int jj = 0; jj < 5; ++jj) { const int j = i + jj; S[jj] = f32x16{};
              if (first && j < 4) continue;
              const unsigned short* kp = proj + (size_t)(seq0 + tblk - 128 + 32 * j + r32) * PP + 512 + kvh * 64 + hi * 8;
              bf16x8 kf[4];
#pragma unroll
              for (int d0 = 0; d0 < 4; ++d0) kf[d0] = *(const bf16x8*)(kp + d0 * 16);
#pragma unroll
              for (int d0 = 0; d0 < 4; ++d0) S[jj] = __builtin_amdgcn_mfma_f32_32x32x16_bf16(kf[d0], qr[d0], S[jj], 0, 0, 0);
#pragma unroll
              for (int r = 0; r < 16; ++r) { const int dist = (128 + 32 * i + r32) - (32 * j + (r & 3) + 8 * (r >> 2) + 4 * hi);
                  const float v = S[jj][r] - slope2 * (float)dist; const bool ok = dist >= 0 && dist < 128;
                  S[jj][r] = ok ? v : -INFINITY; mx = fmaxf(mx, S[jj][r]); } }
          { auto rr = __builtin_amdgcn_permlane32_swap(__float_as_uint(mx), __float_as_uint(mx), false, false); mx = fmaxf(__uint_as_float(rr[0]), __uint_as_float(rr[1])); }
          float l = 0.f; f32x16 o[2]; o[0] = f32x16{}; o[1] = f32x16{};
#pragma unroll
          for (int jj = 0; jj < 5; ++jj) { const int j = i + jj;
              if (first && j < 4) continue;
#pragma unroll
              for (int r = 0; r < 16; ++r) { S[jj][r] = __builtin_amdgcn_exp2f(S[jj][r] - mx); l += S[jj][r]; }
              u32x4 pw0, pw1;
              pw0 = (u32x4){mla::cvtpk_s(S[jj][0], S[jj][1]), mla::cvtpk_s(S[jj][2], S[jj][3]), mla::cvtpk_s(S[jj][4], S[jj][5]), mla::cvtpk_s(S[jj][6], S[jj][7])};
              pw1 = (u32x4){mla::cvtpk_s(S[jj][8], S[jj][9]), mla::cvtpk_s(S[jj][10], S[jj][11]), mla::cvtpk_s(S[jj][12], S[jj][13]), mla::cvtpk_s(S[jj][14], S[jj][15])};
              const int va = vb0 + (j >> 1) * 8192 + (j & 1) * 2048;
#pragma unroll
              for (int d0 = 0; d0 < 2; ++d0) { s16x4 l0, h0, l1, h1;
                  EVM_TR(l0, va, d0 * 4096); EVM_TR(h0, va, d0 * 4096 + 512); EVM_TR(l1, va, d0 * 4096 + 1024); EVM_TR(h1, va, d0 * 4096 + 1024 + 512);
                  asm volatile("s_waitcnt lgkmcnt(0)" : "+v"(l0), "+v"(h0), "+v"(l1), "+v"(h1) :: "memory"); __builtin_amdgcn_sched_barrier(0);
                  const bf16x8 V0 = (bf16x8){l0[0], l0[1], l0[2], l0[3], h0[0], h0[1], h0[2], h0[3]}, V1 = (bf16x8){l1[0], l1[1], l1[2], l1[3], h1[0], h1[1], h1[2], h1[3]};
                  o[d0] = __builtin_amdgcn_mfma_f32_32x32x16_bf16(__builtin_bit_cast(bf16x8, pw0), V0, o[d0], 0, 0, 0);
                  o[d0] = __builtin_amdgcn_mfma_f32_32x32x16_bf16(__builtin_bit_cast(bf16x8, pw1), V1, o[d0], 0, 0, 0); } }
          { auto rr = __builtin_amdgcn_permlane32_swap(__float_as_uint(l), __float_as_uint(l), false, false); l = __uint_as_float(rr[0]) + __uint_as_float(rr[1]); }
          l += __builtin_amdgcn_exp2f(sink2 - mx);
          if (hi == 0) wsf[r32] = l; asm volatile("s_waitcnt lgkmcnt(0)" ::: "memory");
#pragma unroll
          for (int r = 0; r < 16; ++r) { const int orow = (r & 3) + 8 * (r >> 2) + 4 * hi; const float rl = __builtin_amdgcn_rcpf(wsf[orow]);
#pragma unroll
              for (int d0 = 0; d0 < 2; ++d0) stg[orow * 64 + d0 * 32 + r32] = (unsigned short)(mla::cvtpk_s(o[d0][r] * rl, 0.f) & 0xffffu); }
          asm volatile("s_waitcnt lgkmcnt(0)" ::: "memory");
          unsigned short* Ow = mix + (size_t)(row0 + 32 * i) * 1024 + h * 64;
#pragma unroll
          for (int k = 0; k < 4; ++k) { const int row = k * 8 + (lane >> 3), ch = lane & 7; const u32x4 v = *(const __attribute__((address_space(3))) u32x4*)(stg + row * 64 + ch * 8); *(u32x4*)(Ow + (size_t)row * 1024 + ch * 8) = v; }
          asm volatile("s_waitcnt lgkmcnt(0)" ::: "memory");
      } }
    asm volatile("s_waitcnt vmcnt(0) lgkmcnt(0)" ::: "memory");
    __syncthreads();
}
#undef EVM_TR
}

constexpr int NWAVES = 8;
constexpr int BATCH = 4, SEQ = 8192, DM = 1024, NTOK = BATCH * SEQ;
constexpr int EVEN_IN = 1792, ODD_IN = 2336, ODD_IN_PAD = 2560, FF = 2816, FFE = 3584, NEXP = 8, ADA = 6144;
constexpr float NORM_EPS = 1e-6f, LOG2E = 1.4426950408889634f;
constexpr float QS_EVEN = 0.125f * LOG2E;
constexpr float QS_ODD = 0.10206207261596577f * LOG2E;
#ifndef MK_PER_PHASE
#define MK_PER_PHASE 0
#endif
constexpr int NPH = 20;
#ifndef MK_DUPMASK
#define MK_DUPMASK 0u
#endif
#ifndef MK_PROBE_NULLEPI
#define MK_PROBE_NULLEPI 0
#endif
#ifndef MK_CLKPH
#define MK_CLKPH -1
#endif
#define CLKW ((volatile LAS unsigned long long*)(lds0 + LDSCTL_OFF + 768))
#define CLK0(k) do { if (MK_CLKPH == (k) && wave_s == 0) { CLKW[0] = __builtin_amdgcn_s_memtime(); CLKW[1] = __builtin_amdgcn_s_memrealtime(); } } while (0)
#define CLK1(k) do { if (MK_CLKPH == (k) && wave_s == 0) { const unsigned long long c1_ = __builtin_amdgcn_s_memtime(), r1_ = __builtin_amdgcn_s_memrealtime(); CLKW[2] = (c1_ - CLKW[0]) * 100ull / (r1_ - CLKW[1]); } } while (0)
#define NREP(k) ((((unsigned)MK_DUPMASK >> (k)) & 1u) ? 2 : 1)

constexpr size_t MiB = 1u << 20, KiB = 1024;
constexpr size_t WS_CTL = 0, CTL_ZERO_BYTES = 128 * KiB;
constexpr size_t WS_MOD = 1 * MiB;
constexpr size_t WS_ROPEC = 1 * MiB + 256 * KiB, WS_ROPES = WS_ROPEC + 512 * KiB;
constexpr size_t WS_TOKE = 2 * MiB + 256 * KiB, WS_TOKG = WS_TOKE + 256 * KiB, WS_TOKS = WS_TOKG + 256 * KiB;
constexpr size_t WS_SA = 3 * MiB + 512 * KiB;
constexpr size_t WS_PEXP = WS_TOKS + 256 * KiB, WS_WSB = WS_PEXP + 64 * KiB;
constexpr size_t WS_WEGU = 4 * MiB;
constexpr size_t WS_WED = 60 * MiB;
constexpr float WSC_GU = 32.f, WSC_D = 64.f;
constexpr size_t WS_H = 88 * MiB;
constexpr size_t WS_HN = 152 * MiB;
constexpr size_t WS_PROJ = 216 * MiB;
constexpr size_t WS_MIX0 = 328 * MiB;
constexpr size_t WS_ACT = 216 * MiB;
constexpr size_t WS_QN = 376 * MiB, WS_KVN = 408 * MiB, WS_KPE = 424 * MiB, WS_MIX1 = 426 * MiB;
constexpr size_t WS_Q = 216 * MiB, WS_KV = 264 * MiB;
constexpr size_t WS_WNE = 490 * MiB;
constexpr size_t WS_WIN0 = WS_WNE, WS_WO0 = WS_WIN0 + 3584 * KiB, WS_WGU0 = WS_WO0 + 2 * MiB, WS_WD0 = WS_WGU0 + 11 * MiB, WS_WIN1 = WS_WD0 + 5632 * KiB,
                 WS_WQB = WS_WIN1 + 5 * MiB, WS_WKVB = WS_WQB + 768 * KiB, WS_WO1 = WS_WKVB + 512 * KiB, WS_WNE_END = WS_WO1 + 2 * MiB;
constexpr int MOE_ROWS = 264 * 256;
constexpr size_t WS_XS = 152 * MiB;
constexpr size_t WS_HN2 = 218 * MiB;
constexpr size_t WS_Y = 152 * MiB;
constexpr size_t WS_ACTE = 284 * MiB;
constexpr size_t WS_END = 522 * MiB;
static_assert(WS_WNE_END <= WS_END && WS_MIX1 + 64 * MiB <= WS_WNE && WS_ACTE + (size_t)MOE_ROWS * FFE <= WS_END && WS_WED + (size_t)8 * DM * FFE <= WS_H && WS_H + (size_t)NTOK * DM * 2 <= WS_HN
              && WS_XS + (size_t)MOE_ROWS * DM <= WS_HN2 && WS_HN2 + (size_t)NTOK * DM <= WS_ACTE && WS_Y + (size_t)MOE_ROWS * DM * 2 <= WS_ACTE && WS_ACT + (size_t)NTOK * FF * 2 <= WS_MIX0 + 64 * MiB, "d_ws map");
constexpr int CW_TMO = 0, CW_CODE = 1, CW_BAR = 4096, CW_CNT = 8192, CW_CUR = 9216, CW_CM0 = 16384, CW_CM1 = CW_CM0 + 2048, CW_CMG = CW_CM1 + 2560, CW_CM_END = CW_CMG + 5632;
static_assert(CW_CM_END * 4 <= (int)CTL_ZERO_BYTES, "control words inside the memset");
constexpr int RING_BYTES = 131072, LDS_BYTES = 147456, LDSCTL_OFF = LDS_BYTES - 1024, MISC_OFF = LDSCTL_OFF + 320;

typedef unsigned v2u __attribute__((ext_vector_type(2)));
__device__ __forceinline__ unsigned pk2(float lo, float hi) { return pg8::cvt_pk_bf16(lo, hi); }
__device__ __forceinline__ float bflo(unsigned u) { return __uint_as_float(u << 16); }
__device__ __forceinline__ float bfhi(unsigned u) { return __uint_as_float(u & 0xffff0000u); }
__device__ __forceinline__ float bf2f(bf16 h) { return __uint_as_float(((unsigned)h) << 16); }
__device__ __forceinline__ float wave_sum(float v) {
#pragma unroll
    for (int o = 1; o < 64; o <<= 1) v += __shfl_xor(v, o);
    return v;
}
__device__ __forceinline__ float rsqrt_f(float x) { return 1.0f / sqrtf(x); }

struct Ctx { LAS unsigned char* lds; int tid, lane, wave, vcu, G, gw, NGW; };

__device__ __forceinline__ void transpose_item(const float* W, int K, int N, bf16* WT, int row_base, bool pp, LAS float* scr, int kb, int nb, int lane) {
    const int k0 = 64 * kb, n0 = 32 * nb;
    float tv_[32];
#pragma unroll
    for (int i = 0; i < 32; ++i) tv_[i] = W[(size_t)(k0 + 2 * i + (lane >> 5)) * N + n0 + (lane & 31)];
#pragma unroll
    for (int i = 0; i < 32; ++i) scr[(2 * i + (lane >> 5)) * 33 + (lane & 31)] = tv_[i];
    LDS_WAIT(); asm volatile("" ::: "memory");
    const int c = lane & 7;
#pragma unroll
    for (int j = 0; j < 4; ++j) { const int n = (lane >> 3) + 8 * j; const LAS float* s = scr + (8 * c) * 33 + n;
        v4u o; o.x = pk2(s[0 * 33], s[1 * 33]); o.y = pk2(s[2 * 33], s[3 * 33]); o.z = pk2(s[4 * 33], s[5 * 33]); o.w = pk2(s[6 * 33], s[7 * 33]);
        const int nd = pp ? ((n < 16) ? 2 * n : 2 * (n - 16) + 1) : n;
        *(v4u*)(WT + (size_t)(row_base + nd) * K + k0 + 8 * c) = o; }
    LDS_WAIT(); asm volatile("" ::: "memory");
}
__device__ __forceinline__ void transpose_item8(const float* W, int K, int N, unsigned char* WT, int row_base, float sc, LAS float* scr, int kb, int nb, int lane) {
    const int k0 = 64 * kb, n0 = 32 * nb;
    f32x4 tv_[8];
#pragma unroll
    for (int i = 0; i < 8; ++i) tv_[i] = *(const f32x4*)(W + (size_t)(k0 + 8 * i + (lane >> 3)) * N + n0 + 4 * (lane & 7));
#pragma unroll
    for (int i = 0; i < 8; ++i) { LAS float* d = scr + (8 * i + (lane >> 3)) * 33 + 4 * (lane & 7); d[0] = tv_[i].x; d[1] = tv_[i].y; d[2] = tv_[i].z; d[3] = tv_[i].w; }
    LDS_WAIT(); asm volatile("" ::: "memory");
    const int c = lane & 7;
#pragma unroll
    for (int j = 0; j < 4; ++j) { const int n = (lane >> 3) + 8 * j; const LAS float* s = scr + (8 * c) * 33 + n;
        v2u o; o.x = pg8::pack4_fp8(s[0 * 33] * sc, s[1 * 33] * sc, s[2 * 33] * sc, s[3 * 33] * sc); o.y = pg8::pack4_fp8(s[4 * 33] * sc, s[5 * 33] * sc, s[6 * 33] * sc, s[7 * 33] * sc);
        *(v2u*)(WT + (size_t)(row_base + n) * K + k0 + 8 * c) = o; }
    LDS_WAIT(); asm volatile("" ::: "memory");
}
__device__ __forceinline__ void amax_item(const float* W, int N, unsigned* cm, int row_base, bool pp, int kb, int nb, int lane) {
    const int k0 = 64 * kb, n0 = 32 * nb; float mx = 0.f;
#pragma unroll
    for (int i = 0; i < 32; ++i) mx = fmaxf(mx, fabsf(W[(size_t)(k0 + 2 * i + (lane >> 5)) * N + n0 + (lane & 31)]));
    mx = fmaxf(mx, __shfl_xor(mx, 32));
    if (lane < 32) { const int n = lane, nd = pp ? ((n < 16) ? 2 * n : 2 * (n - 16) + 1) : n; atomicMax(cm + row_base + nd, __float_as_uint(mx)); }
}
__device__ __forceinline__ void transpose_item_i8(const float* W, int K, int N, unsigned char* WT, int row_base, const unsigned* cm, LAS float* scr, int kb, int nb, int lane, bool pp = false) {
    const int k0 = 64 * kb, n0 = 32 * nb;
    float tv_[32];
#pragma unroll
    for (int i = 0; i < 32; ++i) tv_[i] = W[(size_t)(k0 + 2 * i + (lane >> 5)) * N + n0 + (lane & 31)];
#pragma unroll
    for (int i = 0; i < 32; ++i) scr[(2 * i + (lane >> 5)) * 33 + (lane & 31)] = tv_[i];
    LDS_WAIT(); asm volatile("" ::: "memory");
    const int c = lane & 7;
#pragma unroll
    for (int j = 0; j < 4; ++j) { const int n = (lane >> 3) + 8 * j; const LAS float* s = scr + (8 * c) * 33 + n;
        const int nd = pp ? ((n < 16) ? 2 * n : 2 * (n - 16) + 1) : n;
        const float cmv = __uint_as_float(cm[row_base + nd]), qs = cmv > 0.f ? 127.f / cmv : 0.f;
        v2u o; o.x = pg8::pack4_i8(s[0 * 33] * qs, s[1 * 33] * qs, s[2 * 33] * qs, s[3 * 33] * qs); o.y = pg8::pack4_i8(s[4 * 33] * qs, s[5 * 33] * qs, s[6 * 33] * qs, s[7 * 33] * qs);
        *(v2u*)(WT + (size_t)(row_base + nd) * K + k0 + 8 * c) = o; }
    LDS_WAIT(); asm volatile("" ::: "memory");
}
struct In {
    const float *x, *c, *e_ada_w, *e_ada_b, *e_nmix_g, *e_w_in, *e_sinks, *e_ln_g, *e_ln_b, *e_w_s, *e_b_s, *e_w_o, *e_nffn_g, *e_wg, *e_wu, *e_wd,
                *o_ada_w, *o_ada_b, *o_nmix_g, *o_w_in, *o_conv_w, *o_qn_g, *o_w_qb, *o_kvn_g, *o_w_kvb, *o_w_o, *o_nffn_g, *o_rw, *o_rb, *o_xg, *o_xu, *o_xd, *fin_g;
};
struct TD8 { const float* W; unsigned char* WT; int K, N, k0, n0, half, inter; float sc; };
__device__ __forceinline__ TD8 td8_decode(int t, const In& I, unsigned char* ws) {
    TD8 d; const int m = t / 1792, rr = t % 1792, e = rr / 224, r2 = rr % 224;
    if (m < 2) { d.W = (m ? I.o_xu : I.o_xg) + (size_t)e * DM * FFE; d.WT = ws + WS_WEGU + (size_t)e * 7168 * DM; d.K = DM; d.N = FFE; d.k0 = 64 * (r2 / 14); d.n0 = 256 * (r2 % 14); d.half = m; d.inter = 1; d.sc = WSC_GU; }
    else { d.W = I.o_xd + (size_t)e * FFE * DM; d.WT = ws + WS_WED + (size_t)e * DM * FFE; d.K = FFE; d.N = DM; d.k0 = 64 * (r2 / 4); d.n0 = 256 * (r2 % 4); d.half = 0; d.inter = 0; d.sc = WSC_D; }
    return d;
}
__device__ __forceinline__ void expert_tiles8(const Ctx& C, const In& I, unsigned char* ws) {
    constexpr int TP = 260, NTILE = 3 * 1792;
    LAS float* const buf0 = (LAS float*)C.lds; LAS float* const buf1 = buf0 + 64 * TP;
    int tile = C.vcu; if (tile >= NTILE) return;
    TD8 d = td8_decode(tile, I, ws);
    f32x4 r[8];
#pragma unroll
    for (int i = 0; i < 8; ++i) r[i] = *(const f32x4*)(d.W + (size_t)(d.k0 + 8 * C.wave + i) * d.N + d.n0 + 4 * C.lane);
    for (int it = 0; ; ++it) {
        LAS float* const buf = (it & 1) ? buf1 : buf0;
#pragma unroll
        for (int i = 0; i < 8; ++i) *(LAS f32x4*)(buf + (8 * C.wave + i) * TP + 4 * C.lane) = r[i];
        const TD8 c = d; const int nxt = tile + C.G;
        if (nxt < NTILE) { d = td8_decode(nxt, I, ws);
#pragma unroll
            for (int i = 0; i < 8; ++i) r[i] = *(const f32x4*)(d.W + (size_t)(d.k0 + 8 * C.wave + i) * d.N + d.n0 + 4 * C.lane); }
        LDS_WAIT(); __syncthreads();
        { const int nl = 32 * C.wave + (C.lane & 31), kh = C.lane >> 5, n = c.n0 + nl;
          const LAS float* s = buf + (32 * kh) * TP + nl; float v[32];
#pragma unroll
          for (int j = 0; j < 32; ++j) v[j] = s[j * TP] * c.sc;
          v4u o0, o1;
          o0.x = pg8::pack4_fp8(v[0], v[1], v[2], v[3]); o0.y = pg8::pack4_fp8(v[4], v[5], v[6], v[7]); o0.z = pg8::pack4_fp8(v[8], v[9], v[10], v[11]); o0.w = pg8::pack4_fp8(v[12], v[13], v[14], v[15]);
          o1.x = pg8::pack4_fp8(v[16], v[17], v[18], v[19]); o1.y = pg8::pack4_fp8(v[20], v[21], v[22], v[23]); o1.z = pg8::pack4_fp8(v[24], v[25], v[26], v[27]); o1.w = pg8::pack4_fp8(v[28], v[29], v[30], v[31]);
          const int row = c.inter ? (256 * (n >> 7) + (n & 127) + 128 * c.half) : n;
          v4u* dst = (v4u*)(c.WT + (size_t)row * c.K + c.k0 + 32 * kh); dst[0] = o0; dst[1] = o1; }
        if (nxt >= NTILE) break;
        tile = nxt;
    }
    __syncthreads();
}
__device__ __forceinline__ void p0_prologue(const Ctx& C, const In& I, unsigned char* ws) {
    if (blockIdx.x < 192) {
        const int layer = blockIdx.x / 96, cb = blockIdx.x % 96, j0 = cb * 64 + 4 * (C.lane & 15), rsub = C.lane >> 4;
        const float* W = layer ? I.o_ada_w : I.e_ada_w; const float* Bv = layer ? I.o_ada_b : I.e_ada_b;
        f32x4 acc[4]; acc[0] = acc[1] = acc[2] = acc[3] = (f32x4){0.f, 0.f, 0.f, 0.f};
#pragma unroll 1
        for (int ch = 0; ch < 4; ++ch) { const int k0 = C.wave * 128 + ch * 32; f32x4 wv[8];
#pragma unroll
            for (int i = 0; i < 8; ++i) wv[i] = *(const f32x4*)(W + (size_t)(k0 + 4 * i + rsub) * ADA + j0);
#pragma unroll
            for (int i = 0; i < 8; ++i) { const int k = k0 + 4 * i + rsub;
#pragma unroll
                for (int bb = 0; bb < 4; ++bb) { const float cv = I.c[bb * DM + k]; acc[bb] += wv[i] * (cv / (1.f + __expf(-cv))); } } }
#pragma unroll
        for (int bb = 0; bb < 4; ++bb)
#pragma unroll
            for (int e = 0; e < 4; ++e) { float v = acc[bb][e]; v += __shfl_xor(v, 16); v += __shfl_xor(v, 32); acc[bb][e] = v; }
        LAS float* red = (LAS float*)C.lds;
        if (C.lane < 16) {
#pragma unroll
            for (int bb = 0; bb < 4; ++bb) *(LAS f32x4*)(red + (C.wave * 4 + bb) * 64 + 4 * C.lane) = acc[bb]; }
        __syncthreads();
        if (C.tid < 256) { const int bb = C.tid >> 6, col = C.tid & 63; float s = 0.f;
#pragma unroll
            for (int w = 0; w < 8; ++w) s += red[(w * 4 + bb) * 64 + col];
            ((float*)(ws + WS_MOD))[(size_t)(layer * BATCH + bb) * ADA + cb * 64 + col] = s + Bv[cb * 64 + col]; }
        __syncthreads();
    }
    {
        bf16* wsb = (bf16*)(ws + WS_WSB);
        for (int idx = blockIdx.x * 512 + C.tid; idx < 8 * 128 * 128; idx += C.G * 512) { const int t = (idx >> 7) & 127, sp = idx & 127; wsb[idx] = (bf16)(pk2((sp <= t) ? I.e_w_s[idx] : 0.f, 0.f) & 0xffffu); }
        float* ct = (float*)(ws + WS_ROPEC); float* st = (float*)(ws + WS_ROPES);
        for (int idx = blockIdx.x * 512 + C.tid; idx < SEQ * 16; idx += C.G * 512) { const int pos = idx >> 4, i = idx & 15;
            const double inv = (double)exp2f(-(float)i * (13.287712379549449f / 16.0f));
            const double rev = (double)((float)pos * (float)inv) * 0.15915494309189535;
            const float fr = (float)(rev - __builtin_rint(rev));
            ct[idx] = __builtin_amdgcn_cosf(fr); st[idx] = __builtin_amdgcn_sinf(fr); }
    }
    LAS float* scr = (LAS float*)(C.lds + C.wave * 16384);
    constexpr int I_IN0 = 16 * 56, I_O = 16 * 32, I_GU0 = 16 * 88, I_D0 = 44 * 32, I_IN1 = 16 * 73, I_QB = 8 * 24, I_KVB = 4 * 32, I_XG1 = 16 * 112, I_XD1 = 56 * 32;
    constexpr int NITEMS = I_IN0 + I_O + 2 * I_GU0 + I_D0 + I_IN1 + I_QB + I_KVB + I_O;
    for (int it = C.gw; it < NITEMS; it += C.NGW) {
        int r = it;
        if (r < I_IN0) { const int kb = r / 56, nb = r % 56; amax_item(I.e_w_in, EVEN_IN, (unsigned*)(ws + WS_CTL) + CW_CM0, nb * 32, false, kb, nb, C.lane); continue; } r -= I_IN0;
        if (r < I_O) { const int kb = r / 32, nb = r % 32; transpose_item(I.e_w_o, DM, DM, (bf16*)(ws + WS_WO0), nb * 32, false, scr, kb, nb, C.lane); continue; } r -= I_O;
        if (r < I_GU0) { const int kb = r / 88, nb = r % 88, n0 = nb * 32; amax_item(I.e_wg, FF, (unsigned*)(ws + WS_CTL) + CW_CMG, 256 * (n0 >> 7) + (n0 & 127), false, kb, nb, C.lane); continue; } r -= I_GU0;
        if (r < I_GU0) { const int kb = r / 88, nb = r % 88, n0 = nb * 32; amax_item(I.e_wu, FF, (unsigned*)(ws + WS_CTL) + CW_CMG, 256 * (n0 >> 7) + (n0 & 127) + 128, false, kb, nb, C.lane); continue; } r -= I_GU0;
        if (r < I_D0) { const int kb = r / 32, nb = r % 32; transpose_item8(I.e_wd, FF, DM, (unsigned char*)(ws + WS_WD0), nb * 32, WSC_D, scr, kb, nb, C.lane); continue; } r -= I_D0;
        if (r < I_IN1) { const int kb = r / 73, nb = r % 73; amax_item(I.o_w_in, ODD_IN, (unsigned*)(ws + WS_CTL) + CW_CM1, nb * 32, nb == 72, kb, nb, C.lane); continue; } r -= I_IN1;
        if (r < I_QB) { const int kb = r / 24, nb = r % 24; transpose_item(I.o_w_qb, 512, 768, (bf16*)(ws + WS_WQB), nb * 32, (nb % 3) == 2, scr, kb, nb, C.lane); continue; } r -= I_QB;
        if (r < I_KVB) { const int kb = r / 32, nb = r % 32; transpose_item(I.o_w_kvb, 256, 1024, (bf16*)(ws + WS_WKVB), nb * 32, false, scr, kb, nb, C.lane); continue; } r -= I_KVB;
        if (r < I_O) { const int kb = r / 32, nb = r % 32; transpose_item(I.o_w_o, DM, DM, (bf16*)(ws + WS_WO1), nb * 32, false, scr, kb, nb, C.lane); continue; } r -= I_O;
    }
    __syncthreads();
    expert_tiles8(C, I, ws);
}

__device__ __forceinline__ void unpack8(const v4u w, float (&x)[8]) { x[0] = bflo(w.x); x[1] = bfhi(w.x); x[2] = bflo(w.y); x[3] = bfhi(w.y); x[4] = bflo(w.z); x[5] = bfhi(w.z); x[6] = bflo(w.w); x[7] = bfhi(w.w); }
template <bool IN_F32> __device__ __forceinline__ void load_row16(const void* h, int m, int lane, float (&x)[2][8]) {
    if (IN_F32) { const f32x4* p = (const f32x4*)((const float*)h + (size_t)m * DM) + 2 * lane;
#pragma unroll
        for (int j = 0; j < 2; ++j) { const f32x4 a = p[128 * j], b = p[128 * j + 1]; x[j][0] = a.x; x[j][1] = a.y; x[j][2] = a.z; x[j][3] = a.w; x[j][4] = b.x; x[j][5] = b.y; x[j][6] = b.z; x[j][7] = b.w; } }
    else { const v4u* p = (const v4u*)((const bf16*)h + (size_t)m * DM) + lane;
#pragma unroll
        for (int j = 0; j < 2; ++j) unpack8(p[64 * j], x[j]); }
}
template <bool IN_F32, bool OUT8> __device__ __forceinline__ void modulate2(const Ctx& C, const void* h, const float* g, const float* shift, const float* scale, void* hn) {
    for (int m0 = 2 * C.gw; m0 < NTOK; m0 += 2 * C.NGW) {
        const int b = m0 >> 13;
        float x[2][2][8];
        load_row16<IN_F32>(h, m0, C.lane, x[0]); load_row16<IN_F32>(h, m0 + 1, C.lane, x[1]);
        float r[2];
#pragma unroll
        for (int rr = 0; rr < 2; ++rr) { float s = 0.f;
#pragma unroll
            for (int j = 0; j < 2; ++j)
#pragma unroll
                for (int k = 0; k < 8; ++k) s += x[rr][j][k] * x[rr][j][k];
            r[rr] = rsqrt_f(wave_sum(s) * (1.f / DM) + NORM_EPS); }
#pragma unroll
        for (int j = 0; j < 2; ++j) { const int c4 = 2 * C.lane + 128 * j;
            const f32x4 g0 = ((const f32x4*)g)[c4], g1 = ((const f32x4*)g)[c4 + 1], s0 = ((const f32x4*)(scale + (size_t)b * ADA))[c4], s1 = ((const f32x4*)(scale + (size_t)b * ADA))[c4 + 1],
                        h0 = ((const f32x4*)(shift + (size_t)b * ADA))[c4], h1 = ((const f32x4*)(shift + (size_t)b * ADA))[c4 + 1];
            const float mg[8] = {g0.x * (s0.x + 1.f), g0.y * (s0.y + 1.f), g0.z * (s0.z + 1.f), g0.w * (s0.w + 1.f), g1.x * (s1.x + 1.f), g1.y * (s1.y + 1.f), g1.z * (s1.z + 1.f), g1.w * (s1.w + 1.f)};
            const float sh[8] = {h0.x, h0.y, h0.z, h0.w, h1.x, h1.y, h1.z, h1.w};
#pragma unroll
            for (int rr = 0; rr < 2; ++rr) { float o[8];
#pragma unroll
                for (int k = 0; k < 8; ++k) o[k] = x[rr][j][k] * r[rr] * mg[k] + sh[k];
                if (OUT8) { v2u w; w.x = pg8::pack4_fp8(o[0], o[1], o[2], o[3]); w.y = pg8::pack4_fp8(o[4], o[5], o[6], o[7]); ((v2u*)((unsigned char*)hn + (size_t)(m0 + rr) * DM))[C.lane + 64 * j] = w; }
                else { v4u w; w.x = pk2(o[0], o[1]); w.y = pk2(o[2], o[3]); w.z = pk2(o[4], o[5]); w.w = pk2(o[6], o[7]); ((v4u*)((bf16*)hn + (size_t)(m0 + rr) * DM))[C.lane + 64 * j] = w; } } }
    }
}

template <bool IN_F32> __device__ __forceinline__ void modulate2_i8(const Ctx& C, const void* h, const float* g, const float* shift, const float* scale, unsigned char* hn, float* sa) {
    for (int m0 = 2 * C.gw; m0 < NTOK; m0 += 2 * C.NGW) {
        const int b = m0 >> 13;
        float x[2][2][8];
        load_row16<IN_F32>(h, m0, C.lane, x[0]); load_row16<IN_F32>(h, m0 + 1, C.lane, x[1]);
        float r[2];
#pragma unroll
        for (int rr = 0; rr < 2; ++rr) { float s = 0.f;
#pragma unroll
            for (int j = 0; j < 2; ++j)
#pragma unroll
                for (int k = 0; k < 8; ++k) s += x[rr][j][k] * x[rr][j][k];
            r[rr] = rsqrt_f(wave_sum(s) * (1.f / DM) + NORM_EPS); }
        float mx[2] = {0.f, 0.f};
#pragma unroll
        for (int j = 0; j < 2; ++j) { const int c4 = 2 * C.lane + 128 * j;
            const f32x4 g0 = ((const f32x4*)g)[c4], g1 = ((const f32x4*)g)[c4 + 1], s0 = ((const f32x4*)(scale + (size_t)b * ADA))[c4], s1 = ((const f32x4*)(scale + (size_t)b * ADA))[c4 + 1],
                        h0 = ((const f32x4*)(shift + (size_t)b * ADA))[c4], h1 = ((const f32x4*)(shift + (size_t)b * ADA))[c4 + 1];
            const float mg[8] = {g0.x * (s0.x + 1.f), g0.y * (s0.y + 1.f), g0.z * (s0.z + 1.f), g0.w * (s0.w + 1.f), g1.x * (s1.x + 1.f), g1.y * (s1.y + 1.f), g1.z * (s1.z + 1.f), g1.w * (s1.w + 1.f)};
            const float sh[8] = {h0.x, h0.y, h0.z, h0.w, h1.x, h1.y, h1.z, h1.w};
#pragma unroll
            for (int rr = 0; rr < 2; ++rr)
#pragma unroll
                for (int k = 0; k < 8; ++k) { x[rr][j][k] = x[rr][j][k] * r[rr] * mg[k] + sh[k]; mx[rr] = fmaxf(mx[rr], fabsf(x[rr][j][k])); } }
#pragma unroll
        for (int rr = 0; rr < 2; ++rr) {
#pragma unroll
            for (int o = 1; o < 64; o <<= 1) mx[rr] = fmaxf(mx[rr], __shfl_xor(mx[rr], o));
            const float qs = mx[rr] > 0.f ? 127.f / mx[rr] : 0.f;
            if (C.lane == 0) sa[m0 + rr] = mx[rr] * (1.f / 127.f);
#pragma unroll
            for (int j = 0; j < 2; ++j) { v2u w; w.x = pg8::pack4_i8(x[rr][j][0] * qs, x[rr][j][1] * qs, x[rr][j][2] * qs, x[rr][j][3] * qs); w.y = pg8::pack4_i8(x[rr][j][4] * qs, x[rr][j][5] * qs, x[rr][j][6] * qs, x[rr][j][7] * qs);
                ((v2u*)(hn + (size_t)(m0 + rr) * DM))[C.lane + 64 * j] = w; } }
    }
}

__device__ __forceinline__ void odd_pre(const Ctx& C, const bf16* proj, const float* conv_w, const float* qn_g, const float* kvn_g, const float* ctab, const float* stab,
                                        bf16* mix, bf16* qn, bf16* kvn, bf16* kpe) {
    for (int m0 = 2 * C.gw; m0 < NTOK; m0 += 2 * C.NGW) {
        const int pos0 = m0 & (SEQ - 1); const bf16* pr = proj + (size_t)m0 * ODD_IN_PAD; const int c0 = C.lane * 8;
        float z[4][8];
#pragma unroll
        for (int i = 0; i < 4; ++i) { const int dt = 2 - i;
            if (pos0 >= dt) { const bf16* p2 = pr - (ptrdiff_t)dt * ODD_IN_PAD; float a[8], xx[8]; unpack8(*(const v4u*)(p2 + 512 + c0), a); unpack8(*(const v4u*)(p2 + 1024 + c0), xx);
#pragma unroll
                for (int k = 0; k < 8; ++k) z[i][k] = a[k] * xx[k]; }
            else {
#pragma unroll
                for (int k = 0; k < 8; ++k) z[i][k] = 0.f; } }
        float cw[3][8];
#pragma unroll
        for (int jj = 0; jj < 3; ++jj) { const f32x4 w0 = *(const f32x4*)(conv_w + jj * 512 + c0), w1 = *(const f32x4*)(conv_w + jj * 512 + c0 + 4); cw[jj][0] = w0.x; cw[jj][1] = w0.y; cw[jj][2] = w0.z; cw[jj][3] = w0.w; cw[jj][4] = w1.x; cw[jj][5] = w1.y; cw[jj][6] = w1.z; cw[jj][7] = w1.w; }
#pragma unroll
        for (int rr = 0; rr < 2; ++rr) { const bf16* p1 = pr + (size_t)rr * ODD_IN_PAD; const int m = m0 + rr;
            float gb[8]; unpack8(*(const v4u*)(p1 + c0), gb); float y[8];
#pragma unroll
            for (int k = 0; k < 8; ++k) y[k] = gb[k] * (cw[0][k] * z[rr][k] + cw[1][k] * z[rr + 1][k] + cw[2][k] * z[rr + 2][k]);
            { v4u o; o.x = pk2(y[0], y[1]); o.y = pk2(y[2], y[3]); o.z = pk2(y[4], y[5]); o.w = pk2(y[6], y[7]); *(v4u*)(mix + (size_t)m * DM + c0) = o; }
            { float x[8]; unpack8(*(const v4u*)(p1 + 1536 + c0), x); float s = 0.f;
#pragma unroll
              for (int k = 0; k < 8; ++k) s += x[k] * x[k];
              const float r = rsqrt_f(wave_sum(s) * (1.f / 512.f) + NORM_EPS);
              const f32x4 g0 = *(const f32x4*)(qn_g + c0), g1 = *(const f32x4*)(qn_g + c0 + 4);
              v4u o; o.x = pk2(x[0] * r * g0.x, x[1] * r * g0.y); o.y = pk2(x[2] * r * g0.z, x[3] * r * g0.w); o.z = pk2(x[4] * r * g1.x, x[5] * r * g1.y); o.w = pk2(x[6] * r * g1.z, x[7] * r * g1.w);
              *(v4u*)(qn + (size_t)m * 512 + c0) = o; }
            { const v2u w = *(const v2u*)(p1 + 2048 + C.lane * 4); const float x[4] = {bflo(w.x), bfhi(w.x), bflo(w.y), bfhi(w.y)};
              const float s = (x[0] * x[0] + x[1] * x[1]) + (x[2] * x[2] + x[3] * x[3]);
              const float r = rsqrt_f(wave_sum(s) * (1.f / 256.f) + NORM_EPS);
              const f32x4 g0 = *(const f32x4*)(kvn_g + C.lane * 4);
              v2u o; o.x = pk2(x[0] * r * g0.x, x[1] * r * g0.y); o.y = pk2(x[2] * r * g0.z, x[3] * r * g0.w);
              *(v2u*)(kvn + (size_t)m * 256 + C.lane * 4) = o; }
            if (C.lane < 16) { const int pos = pos0 + rr; const unsigned w = *(const unsigned*)(p1 + 2304 + 2 * C.lane); const float x1 = bflo(w), x2 = bfhi(w), cs = ctab[pos * 16 + C.lane], sn = stab[pos * 16 + C.lane];
                *(unsigned*)(kpe + (size_t)m * 32 + 2 * C.lane) = pk2(x1 * cs - x2 * sn, x1 * sn + x2 * cs); } }
    }
}

__device__ __forceinline__ void modulate_route(const Ctx& C, const bf16* h, const float* g, const float* shift, const float* scale, const float* rw, const float* rb,
                                               unsigned char* hn, int* tok_e, float* tok_g, unsigned* counts) {
    volatile LAS unsigned* hist = (volatile LAS unsigned*)(C.lds + LDSCTL_OFF);
    f32x4 w[2][8][2];
#pragma unroll
    for (int j = 0; j < 2; ++j)
#pragma unroll
        for (int k = 0; k < 8; ++k) { const float* p = rw + (size_t)(512 * j + 8 * C.lane + k) * 8; w[j][k][0] = *(const f32x4*)p; w[j][k][1] = *(const f32x4*)(p + 4); }
    for (int m0 = 2 * C.gw; m0 < NTOK; m0 += 2 * C.NGW) {
        const int b = m0 >> 13;
        float x[2][2][8];
        load_row16<false>(h, m0, C.lane, x[0]); load_row16<false>(h, m0 + 1, C.lane, x[1]);
        float r[2];
#pragma unroll
        for (int rr = 0; rr < 2; ++rr) { float s = 0.f;
#pragma unroll
            for (int j = 0; j < 2; ++j)
#pragma unroll
                for (int k = 0; k < 8; ++k) s += x[rr][j][k] * x[rr][j][k];
            r[rr] = rsqrt_f(wave_sum(s) * (1.f / DM) + NORM_EPS); }
        f32x4 la[2], lb[2]; la[0] = la[1] = lb[0] = lb[1] = (f32x4){0.f, 0.f, 0.f, 0.f};
#pragma unroll
        for (int j = 0; j < 2; ++j) { const int c4 = 2 * C.lane + 128 * j;
            const f32x4 g0 = ((const f32x4*)g)[c4], g1 = ((const f32x4*)g)[c4 + 1], s0 = ((const f32x4*)(scale + (size_t)b * ADA))[c4], s1 = ((const f32x4*)(scale + (size_t)b * ADA))[c4 + 1],
                        h0 = ((const f32x4*)(shift + (size_t)b * ADA))[c4], h1 = ((const f32x4*)(shift + (size_t)b * ADA))[c4 + 1];
            const float mg[8] = {g0.x * (s0.x + 1.f), g0.y * (s0.y + 1.f), g0.z * (s0.z + 1.f), g0.w * (s0.w + 1.f), g1.x * (s1.x + 1.f), g1.y * (s1.y + 1.f), g1.z * (s1.z + 1.f), g1.w * (s1.w + 1.f)};
            const float sh[8] = {h0.x, h0.y, h0.z, h0.w, h1.x, h1.y, h1.z, h1.w};
#pragma unroll
            for (int rr = 0; rr < 2; ++rr) { float o[8];
#pragma unroll
                for (int k = 0; k < 8; ++k) { o[k] = x[rr][j][k] * r[rr] * mg[k] + sh[k]; la[rr] += w[j][k][0] * o[k]; lb[rr] += w[j][k][1] * o[k]; }
                v2u wv; wv.x = pg8::pack4_fp8(o[0], o[1], o[2], o[3]); wv.y = pg8::pack4_fp8(o[4], o[5], o[6], o[7]); ((v2u*)(hn + (size_t)(m0 + rr) * DM))[C.lane + 64 * j] = wv; } }
#pragma unroll
        for (int rr = 0; rr < 2; ++rr) { const int m = m0 + rr;
            float lg[8] = {la[rr].x, la[rr].y, la[rr].z, la[rr].w, lb[rr].x, lb[rr].y, lb[rr].z, lb[rr].w};
#pragma unroll
            for (int e = 0; e < 8; ++e) lg[e] = wave_sum(lg[e]) + rb[e];
            int e0 = 0; float v0 = lg[0];
#pragma unroll
            for (int e = 1; e < 8; ++e) if (lg[e] > v0) { v0 = lg[e]; e0 = e; }
            int e1 = -1; float v1 = -INFINITY;
#pragma unroll
            for (int e = 0; e < 8; ++e) if (e != e0 && lg[e] > v1) { v1 = lg[e]; e1 = e; }
            const float p1 = __expf(v1 - v0), g0 = 1.f / (1.f + p1), g1 = p1 * g0;
            if (C.lane == 0) { tok_e[2 * m] = e0; tok_e[2 * m + 1] = e1; tok_g[2 * m] = g0; tok_g[2 * m + 1] = g1;
                __hip_atomic_fetch_add((LAS unsigned*)&hist[e0], 1u, __ATOMIC_RELAXED, __HIP_MEMORY_SCOPE_WORKGROUP); __hip_atomic_fetch_add((LAS unsigned*)&hist[e1], 1u, __ATOMIC_RELAXED, __HIP_MEMORY_SCOPE_WORKGROUP); } }
    }
    LDS_WAIT(); __syncthreads();
    if (C.tid < 8) { const unsigned n = hist[C.tid]; if (n) __hip_atomic_fetch_add(counts + 64 * C.tid, n, __ATOMIC_RELAXED, __HIP_MEMORY_SCOPE_AGENT); }
    __syncthreads();
}

__device__ __forceinline__ void moe_pstart(const unsigned* counts, int (&pstart)[8], int (&pend)[8]) {
    int acc = 0;
#pragma unroll
    for (int e = 0; e < 8; ++e) { const int n = (int)__hip_atomic_load(counts + 64 * e, __ATOMIC_RELAXED, __HIP_MEMORY_SCOPE_AGENT); pstart[e] = acc; acc += (n + 255) >> 8; pend[e] = acc; }
}
__device__ __forceinline__ void moe_gather(const Ctx& C, const unsigned char* hn, const int* tok_e, const unsigned* counts, unsigned* cursor, int* tok_slot, unsigned char* xs, int* pexp) {
    int pstart[8], pend[8]; moe_pstart(counts, pstart, pend);
    if (blockIdx.x == 0 && C.tid < 273) { int e = 0;
#pragma unroll
        for (int k = 0; k < 7; ++k) e += (C.tid >= pend[k]) ? 1 : 0;
        pexp[C.tid] = (C.tid == 272) ? pend[7] : e; }
    for (int task = C.gw; task < NTOK / 16; task += C.NGW) {
        const int tok = task * 16 + (C.lane & 15); const bool act = C.lane < 16;
        const int e0 = act ? tok_e[2 * tok] : -1, e1 = act ? tok_e[2 * tok + 1] : -2;
        int s0 = 0, s1 = 0;
        const unsigned long long lt = (1ull << C.lane) - 1ull;
#pragma unroll
        for (int e = 0; e < 8; ++e) { const unsigned long long m0 = __ballot(e0 == e), m1 = __ballot(e1 == e); const int n0 = __popcll(m0), n1 = __popcll(m1);
            unsigned base = 0u; if (C.lane == 0 && (n0 + n1) > 0) base = __hip_atomic_fetch_add(cursor + 64 * e, (unsigned)(n0 + n1), __ATOMIC_RELAXED, __HIP_MEMORY_SCOPE_AGENT);
            base = (unsigned)__builtin_amdgcn_readfirstlane((int)base) + (unsigned)pstart[e] * 256u;
            if (e0 == e) s0 = (int)base + __popcll(m0 & lt); if (e1 == e) s1 = (int)base + n0 + __popcll(m1 & lt); }
        if (act) { tok_slot[2 * tok] = s0; tok_slot[2 * tok + 1] = s1; }
#pragma unroll 4
        for (int i = 0; i < 16; ++i) { const int d0 = __shfl(s0, i), d1 = __shfl(s1, i);
            const v4u a = ((const v4u*)(hn + (size_t)(task * 16 + i) * DM))[C.lane];
            ((v4u*)(xs + (size_t)d0 * DM))[C.lane] = a; ((v4u*)(xs + (size_t)d1 * DM))[C.lane] = a; }
    }
}

__device__ __forceinline__ void final_rows(int gw, int NGW, int lane, const bf16* h, float* out, const bf16* y, const int* tok_slot, const float* tok_g, const float* gate, const float* fin_g, int s_ready, int mode) {
    for (int m0 = 2 * gw; m0 < NTOK; m0 += 2 * NGW) {
        const int b = m0 >> 13;
        int sl[2][2]; bool sel[2];
#pragma unroll
        for (int rr = 0; rr < 2; ++rr) { sl[rr][0] = __builtin_amdgcn_readfirstlane(tok_slot[2 * (m0 + rr)]); sl[rr][1] = __builtin_amdgcn_readfirstlane(tok_slot[2 * (m0 + rr) + 1]);
            const bool ready = sl[rr][0] < s_ready && sl[rr][1] < s_ready; sel[rr] = mode ? !ready : ready; }
        if (!sel[0] && !sel[1]) continue;
        float v[2][2][8]; float r[2];
#pragma unroll
        for (int rr = 0; rr < 2; ++rr) { const int m = m0 + rr; const float g0 = tok_g[2 * m], g1 = tok_g[2 * m + 1];
            float hx[2][8], ya[2][8], yb[2][8];
            load_row16<false>(h, m, lane, hx); load_row16<false>(y, sl[rr][0], lane, ya); load_row16<false>(y, sl[rr][1], lane, yb);
            float s = 0.f;
#pragma unroll
            for (int j = 0; j < 2; ++j) { const int c4 = 2 * lane + 128 * j; const f32x4 t0 = ((const f32x4*)(gate + (size_t)b * ADA))[c4], t1 = ((const f32x4*)(gate + (size_t)b * ADA))[c4 + 1];
                const float gt[8] = {t0.x, t0.y, t0.z, t0.w, t1.x, t1.y, t1.z, t1.w};
#pragma unroll
                for (int k = 0; k < 8; ++k) { v[rr][j][k] = hx[j][k] + gt[k] * (g0 * ya[j][k] + g1 * yb[j][k]); s += v[rr][j][k] * v[rr][j][k]; } }
            r[rr] = s; }
#pragma unroll
        for (int rr = 0; rr < 2; ++rr) r[rr] = rsqrt_f(wave_sum(r[rr]) * (1.f / DM) + NORM_EPS);
#pragma unroll
        for (int rr = 0; rr < 2; ++rr) { if (!sel[rr]) continue;
#pragma unroll
            for (int j = 0; j < 2; ++j) { const int c4 = 2 * lane + 128 * j; const f32x4 f0 = ((const f32x4*)fin_g)[c4], f1 = ((const f32x4*)fin_g)[c4 + 1];
                f32x4* op = (f32x4*)(out + (size_t)(m0 + rr) * DM) + c4;
                op[0] = (f32x4){v[rr][j][0] * r[rr] * f0.x, v[rr][j][1] * r[rr] * f0.y, v[rr][j][2] * r[rr] * f0.z, v[rr][j][3] * r[rr] * f0.w};
                op[1] = (f32x4){v[rr][j][4] * r[rr] * f1.x, v[rr][j][5] * r[rr] * f1.y, v[rr][j][6] * r[rr] * f1.z, v[rr][j][7] * r[rr] * f1.w}; } }
    }
}

struct Args { In in; float* out; unsigned char* ws; int ph_lo, ph_hi; };
__global__ void __launch_bounds__(NWAVES * 64, 2) fwd(Args args) {
    extern __shared__ __attribute__((aligned(16))) unsigned char lds_raw[];
#define MKCTX() Ctx C; { int t_ = tid_from_wave(wave_s); asm volatile("" : "+v"(t_)); C.lds = (LAS unsigned char*)lds_raw; C.tid = t_; C.lane = t_ & 63; C.wave = __builtin_amdgcn_readfirstlane(t_ >> 6); \
        C.G = gridDim.x; const int bx_ = blockIdx.x; C.vcu = (C.G % 8 == 0) ? (bx_ % 8) * (C.G / 8) + bx_ / 8 : bx_; C.gw = C.vcu * NWAVES + C.wave; C.NGW = C.G * NWAVES; }
    LAS unsigned char* const lds0 = (LAS unsigned char*)lds_raw;
    const int wave_s = __builtin_amdgcn_readfirstlane((int)(threadIdx.x >> 6));
    unsigned char* ws = args.ws; const In& I = args.in;
    unsigned* ctl = (unsigned*)(ws + WS_CTL);
    for (int u = threadIdx.x; u < (LDS_BYTES - LDSCTL_OFF) / 4; u += NWAVES * 64) ((LAS unsigned*)(lds0 + LDSCTL_OFF))[u] = 0u;
    __syncthreads();
    XcdBarrier bar; bar.bar = ctl + CW_BAR; bar.x = 0; bar.st = nullptr; bar.wave = wave_s;
    if (!MK_PER_PHASE) bar = xcd_barrier_post(ctl + CW_BAR, (volatile LAS unsigned*)(lds0 + MISC_OFF) + 8, wave_s);
    const int lo = args.ph_lo, hi = args.ph_hi;
#define IN(k) (lo <= (k) && (k) < hi)
#define SEAM(k) do { if (!MK_PER_PHASE && IN(k) && IN((k) + 1)) xcd_barrier(bar); } while (0)

    bf16* const hbuf = (bf16*)(ws + WS_H);
    const float* mod0 = (const float*)(ws + WS_MOD); const float* mod1 = mod0 + BATCH * ADA;
    bf16* const HN = (bf16*)(ws + WS_HN); bf16* const PROJ = (bf16*)(ws + WS_PROJ); bf16* const MIX0 = (bf16*)(ws + WS_MIX0); bf16* const ACT = (bf16*)(ws + WS_ACT);
    bf16* const QN = (bf16*)(ws + WS_QN); bf16* const KVN = (bf16*)(ws + WS_KVN); bf16* const KPE = (bf16*)(ws + WS_KPE); bf16* const MIX1 = (bf16*)(ws + WS_MIX1);
    bf16* const Q = (bf16*)(ws + WS_Q); bf16* const KV = (bf16*)(ws + WS_KV); unsigned char* const HN2 = ws + WS_HN2; unsigned char* const XS = ws + WS_XS; unsigned char* const ACTE = ws + WS_ACTE; bf16* const YB = (bf16*)(ws + WS_Y);
    const float* ctab = (const float*)(ws + WS_ROPEC); const float* stab = (const float*)(ws + WS_ROPES);
    int* const pexp = (int*)(ws + WS_PEXP); int* tok_e = (int*)(ws + WS_TOKE); float* tok_g = (float*)(ws + WS_TOKG); int* tok_slot = (int*)(ws + WS_TOKS);

    if (IN(0)) for (int rep_ = 0; rep_ < NREP(0); ++rep_) { MKCTX(); p0_prologue(C, I, ws); } SEAM(0);
    if (IN(1)) for (int rep_ = 0; rep_ < NREP(1); ++rep_) { MKCTX(); modulate2_i8<true>(C, I.x, I.e_nmix_g, mod0 + 0 * DM, mod0 + 1 * DM, (unsigned char*)HN, (float*)(ws + WS_SA));
        { LAS float* scr = (LAS float*)(C.lds + C.wave * 16384);
          for (int it = C.gw; it < 16 * 56; it += C.NGW) { const int kb = it / 56, nb = it % 56; transpose_item_i8(I.e_w_in, DM, EVEN_IN, ws + WS_WIN0, nb * 32, ctl + CW_CM0, scr, kb, nb, C.lane); } } } SEAM(1);
    CLK0(2);
    if (IN(2)) for (int rep_ = 0; rep_ < NREP(2); ++rep_) { MKCTX(); pg8::Gemm g{HN, (const bf16*)(ws + WS_WIN0), NTOK, EVEN_IN, DM / 2}; pg8::StaticOrder S; S.init(NTOK, EVEN_IN, C.G, (int)blockIdx.x);
        pg8::EpiProj0I E{PROJ, EVEN_IN, QS_EVEN, (const float*)(ws + WS_SA), ctl + CW_CM0}; pg8::gemm_phase<pg8::EpiProj0I, pg8::StaticOrder, true, true, false, true>(C.lds, g, S, E, wave_s);
        { const int nwg = (NTOK / 256) * (EVEN_IN / 256), first_idle = nwg - 3 * C.G;
          const bool tail_ok = first_idle > 0 && first_idle < C.G;
          if (!tail_ok || (int)blockIdx.x >= first_idle) {
              LAS float* scr = (LAS float*)(C.lds + C.wave * 16384); const int wv = tail_ok ? ((int)blockIdx.x - first_idle) * NWAVES + C.wave : C.gw, nwv = tail_ok ? (C.G - first_idle) * NWAVES : C.NGW;
              for (int it = wv; it < 2 * 16 * 88; it += nwv) { const int half = it / (16 * 88), r = it % (16 * 88), kb = r / 88, nb = r % 88, n0 = nb * 32;
                  transpose_item_i8(half ? I.e_wu : I.e_wg, DM, FF, ws + WS_WGU0, 256 * (n0 >> 7) + (n0 & 127) + 128 * half, ctl + CW_CMG, scr, kb, nb, C.lane); }
              for (int it = wv; it < 16 * 73; it += nwv) { const int kb = it / 73, nb = it % 73; transpose_item_i8(I.o_w_in, DM, ODD_IN, ws + WS_WIN1, nb * 32, ctl + CW_CM1, scr, kb, nb, C.lane, nb == 72); } } }
    } CLK1(2); SEAM(2);
    if (IN(3)) for (int rep_ = 0; rep_ < NREP(3); ++rep_) { MKCTX(); for (int un = C.vcu; un < NTOK / 128; un += C.G) evm::unit(un, PROJ, I.e_sinks, I.e_ln_g, I.e_ln_b, (const bf16*)(ws + WS_WSB), I.e_b_s, MIX0, (char*)lds_raw, wave_s); } SEAM(3);
    CLK0(4);
    if (IN(4)) for (int rep_ = 0; rep_ < NREP(4); ++rep_) { MKCTX(); pg8::Gemm g{MIX0, (const bf16*)(ws + WS_WO0), NTOK, DM, DM}; pg8::StaticOrder S; S.init(NTOK, DM, C.G, (int)blockIdx.x);
        pg8::EpiResGateH<true> E{I.x, hbuf, DM, mod0 + 2 * DM, ADA, SEQ, 1.0f}; pg8::gemm_phase<pg8::EpiResGateH<true>, pg8::StaticOrder, true, true>(C.lds, g, S, E, wave_s); } CLK1(4); SEAM(4);
    if (IN(5)) for (int rep_ = 0; rep_ < NREP(5); ++rep_) { MKCTX(); modulate2_i8<false>(C, hbuf, I.e_nffn_g, mod0 + 3 * DM, mod0 + 4 * DM, (unsigned char*)HN, (float*)(ws + WS_SA)); } SEAM(5);
    CLK0(6);
    if (IN(6)) for (int rep_ = 0; rep_ < NREP(6); ++rep_) { MKCTX(); pg8::Gemm g{HN, (const bf16*)(ws + WS_WGU0), NTOK, 2 * FF, DM / 2}; pg8::StaticOrder S; S.init(NTOK, 2 * FF, C.G, (int)blockIdx.x);
        pg8::EpiSwiGLUI8 E{(unsigned char*)ACT, FF, (const float*)(ws + WS_SA), ctl + CW_CMG}; pg8::gemm_phase<pg8::EpiSwiGLUI8, pg8::StaticOrder, true, true, false, true>(C.lds, g, S, E, wave_s); } CLK1(6); SEAM(6);
    CLK0(7);
    if (IN(7)) for (int rep_ = 0; rep_ < NREP(7); ++rep_) { MKCTX(); pg8::Gemm g{ACT, (const bf16*)(ws + WS_WD0), NTOK, DM, FF / 2}; pg8::StaticOrder S; S.init(NTOK, DM, C.G, (int)blockIdx.x);
        pg8::EpiResGateH<false> E{hbuf, hbuf, DM, mod0 + 5 * DM, ADA, SEQ, 1.0f / WSC_D}; pg8::gemm_phase<pg8::EpiResGateH<false>, pg8::StaticOrder, true, true, true, false, true>(C.lds, g, S, E, wave_s); } CLK1(7); SEAM(7);
    if (IN(8)) for (int rep_ = 0; rep_ < NREP(8); ++rep_) { MKCTX(); modulate2_i8<false>(C, hbuf, I.o_nmix_g, mod1 + 0 * DM, mod1 + 1 * DM, (unsigned char*)HN, (float*)(ws + WS_SA)); } SEAM(8);
    CLK0(9);
    if (IN(9)) for (int rep_ = 0; rep_ < NREP(9); ++rep_) { MKCTX(); pg8::Gemm g{HN, (const bf16*)(ws + WS_WIN1), NTOK, ODD_IN_PAD, DM / 2}; pg8::StaticOrder S; S.init(NTOK, ODD_IN_PAD, C.G, (int)blockIdx.x);
        pg8::EpiBf16PlainI E{PROJ, ODD_IN_PAD, (const float*)(ws + WS_SA), ctl + CW_CM1}; pg8::gemm_phase<pg8::EpiBf16PlainI, pg8::StaticOrder, true, true, false, true>(C.lds, g, S, E, wave_s); } CLK1(9); SEAM(9);
    if (IN(10)) for (int rep_ = 0; rep_ < NREP(10); ++rep_) { MKCTX(); odd_pre(C, PROJ, I.o_conv_w, I.o_qn_g, I.o_kvn_g, ctab, stab, MIX1, QN, KVN, KPE); } SEAM(10);
    if (IN(11)) for (int rep_ = 0; rep_ < NREP(11); ++rep_) { MKCTX();
        { pg8::Gemm g{QN, (const bf16*)(ws + WS_WQB), NTOK, 768, 512}; pg8::StaticOrder S; S.init(NTOK, 768, C.G, (int)blockIdx.x);
          pg8::EpiQRope E{Q, 768, ctab, stab, QS_ODD, SEQ - 1}; pg8::gemm_phase<pg8::EpiQRope, pg8::StaticOrder, true, true>(C.lds, g, S, E, wave_s); }
        { pg8::Gemm g{KVN, (const bf16*)(ws + WS_WKVB), NTOK, 1024, 256}; pg8::StaticOrder S; S.init(NTOK, 1024, C.G, (int)blockIdx.x);
          pg8::EpiBf16Plain E{KV, 1024, 1.0f}; pg8::gemm_phase<pg8::EpiBf16Plain, pg8::StaticOrder, true, true>(C.lds, g, S, E, wave_s); }
    } SEAM(11);
    CLK0(12);
    if (IN(12)) for (int rep_ = 0; rep_ < NREP(12); ++rep_) { MKCTX(); mla::phase((char*)lds_raw, Q, KV, KPE, MIX1, C.vcu, C.G, wave_s); } CLK1(12); SEAM(12);
    if (IN(13)) for (int rep_ = 0; rep_ < NREP(13); ++rep_) { MKCTX(); pg8::Gemm g{MIX1, (const bf16*)(ws + WS_WO1), NTOK, DM, DM}; pg8::StaticOrder S; S.init(NTOK, DM, C.G, (int)blockIdx.x);
        pg8::EpiResGateH<false> E{hbuf, hbuf, DM, mod1 + 2 * DM, ADA, SEQ, 1.0f}; pg8::gemm_phase<pg8::EpiResGateH<false>, pg8::StaticOrder, true, true>(C.lds, g, S, E, wave_s); } SEAM(13);
    if (IN(14)) for (int rep_ = 0; rep_ < NREP(14); ++rep_) { MKCTX(); modulate_route(C, hbuf, I.o_nffn_g, mod1 + 3 * DM, mod1 + 4 * DM, I.o_rw, I.o_rb, HN2, tok_e, tok_g, ctl + CW_CNT); } SEAM(14);
    if (IN(15)) for (int rep_ = 0; rep_ < NREP(15); ++rep_) { MKCTX(); moe_gather(C, HN2, tok_e, ctl + CW_CNT, ctl + CW_CUR, tok_slot, XS, pexp); } SEAM(15);
    CLK0(16);
    if (IN(16)) for (int rep_ = 0; rep_ < NREP(16); ++rep_) { MKCTX();
        const int P = __builtin_amdgcn_readfirstlane(pexp[272]);
        pg8::MoeOrder<28, false> S{C.G, C.vcu, 0, P * 28, pexp, 0};
        pg8::Gemm g{(const bf16*)XS, (const bf16*)(ws + WS_WEGU), 0, 0, DM / 2};
#if MK_PROBE_NULLEPI
        if (rep_ == 1) { pg8::EpiNull E0; pg8::gemm_phase<pg8::EpiNull, pg8::MoeOrder<28, false>, true, true, true>(C.lds, g, S, E0, wave_s); } else
#endif
        { pg8::EpiSwiGLU8 E{ACTE, FFE, 1.0f / WSC_GU}; pg8::gemm_phase<pg8::EpiSwiGLU8, pg8::MoeOrder<28, false>, true, true, true, false, true>(C.lds, g, S, E, wave_s); }
    } CLK1(16); SEAM(16);
    CLK0(17);
    if (IN(17)) for (int rep_ = 0; rep_ < NREP(17); ++rep_) { MKCTX();
        const int P = __builtin_amdgcn_readfirstlane(pexp[272]); const int nfull = (P * 4 / C.G) * C.G;
        pg8::MoeOrder<4, false> S{C.G, C.vcu, 0, nfull, pexp, 0};
        pg8::Gemm g{(const bf16*)ACTE, (const bf16*)(ws + WS_WED), 0, 0, FFE / 2};
        pg8::EpiBf16Plain E{YB, DM, 1.0f / WSC_D}; pg8::gemm_phase<pg8::EpiBf16Plain, pg8::MoeOrder<4, false>, true, true, true, false, true>(C.lds, g, S, E, wave_s);
    } CLK1(17); SEAM(17);
    if (IN(18)) { MKCTX();
        const int P = __builtin_amdgcn_readfirstlane(pexp[272]); const int nfull = (P * 4 / C.G) * C.G, nleft = P * 4 - nfull;
        if (C.vcu < nleft) {
            pg8::MoeOrder<4, false> S{C.G, C.vcu, 0, P * 4, pexp, nfull};
            pg8::Gemm g{(const bf16*)ACTE, (const bf16*)(ws + WS_WED), 0, 0, FFE / 2};
            pg8::EpiBf16Plain E{YB, DM, 1.0f / WSC_D}; pg8::gemm_phase<pg8::EpiBf16Plain, pg8::MoeOrder<4, false>, true, true, true, false, true>(C.lds, g, S, E, wave_s);
        } else {
            final_rows((C.vcu - nleft) * NWAVES + C.wave, (C.G - nleft) * NWAVES, C.lane, hbuf, args.out, YB, tok_slot, tok_g, mod1 + 5 * DM, I.fin_g, (nfull / 4) * 256, 0);
        }
    } SEAM(18);
    if (IN(19)) { MKCTX();
        const int P = __builtin_amdgcn_readfirstlane(pexp[272]); const int nfull = (P * 4 / C.G) * C.G;
        final_rows(C.gw, C.NGW, C.lane, hbuf, args.out, YB, tok_slot, tok_g, mod1 + 5 * DM, I.fin_g, (nfull / 4) * 256, 1);
    }
    if (MK_CLKPH >= 0 && blockIdx.x == 0 && wave_s == 0) { const unsigned long long mhz_ = CLKW[2], r0_ = __builtin_amdgcn_s_memrealtime(); while (__builtin_amdgcn_s_memrealtime() - r0_ < mhz_ * 100ull) __builtin_amdgcn_s_sleep(8); }
#undef IN
#undef SEAM
}

extern "C" void kernel_launch(void* const* d_in, const int* in_sizes, int n_in, void* d_out, int out_size, void* d_ws, size_t ws_size, hipStream_t stream) {
    static int grid = 0;
    if (grid == 0) {
        if (n_in != 33 || in_sizes[0] != NTOK * DM || out_size != NTOK * DM || ws_size < WS_END) { fprintf(stderr, "kernel_launch: unexpected shapes (n_in %d, in0 %d, out %d, ws %zu < %zu); nothing launched\n", n_in, n_in > 0 ? in_sizes[0] : -1, out_size, ws_size, (size_t)WS_END); grid = -1; return; }
        int dev = 0, cus = 0, per_cu = 0;
        if (hipGetDevice(&dev) != hipSuccess || hipDeviceGetAttribute(&cus, hipDeviceAttributeMultiprocessorCount, dev) != hipSuccess) { grid = -1; return; }
        if (hipFuncSetAttribute((const void*)fwd, hipFuncAttributeMaxDynamicSharedMemorySize, LDS_BYTES) != hipSuccess) { fprintf(stderr, "kernel_launch: hipFuncSetAttribute failed\n"); grid = -1; return; }
        if (hipOccupancyMaxActiveBlocksPerMultiprocessor(&per_cu, (const void*)fwd, NWAVES * 64, LDS_BYTES) != hipSuccess || per_cu < 1) fprintf(stderr, "kernel_launch: occupancy query reports %d\n", per_cu);
        (void)hipGetLastError();
        grid = cus;
    }
    if (grid < 0) return;
    if (hipMemsetAsync((char*)d_ws + WS_CTL, 0, CTL_ZERO_BYTES, stream) != hipSuccess) return;
    Args a{};
    const float** ip = (const float**)&a.in;
    for (int i = 0; i < 33; ++i) ip[i] = (const float*)d_in[i];
    a.out = (float*)d_out; a.ws = (unsigned char*)d_ws;
#if MK_PER_PHASE
    for (int p = 0; p < NPH; ++p) { a.ph_lo = p; a.ph_hi = p + 1; hipLaunchKernelGGL(fwd, dim3(grid), dim3(NWAVES * 64), LDS_BYTES, stream, a); }
#else
    a.ph_lo = 0; a.ph_hi = NPH; hipLaunchKernelGGL(fwd, dim3(grid), dim3(NWAVES * 64), LDS_BYTES, stream, a);
#endif
}
```

```cpp
#include <hip/hip_runtime.h>
#include <cstdio>
#include <cstdint>
#include <cmath>
__device__ __forceinline__ int tid_from_wave(int wave) { unsigned l_; asm volatile("v_mbcnt_lo_u32_b32 %0, -1, 0\n\tv_mbcnt_hi_u32_b32 %0, -1, %0" : "=v"(l_)); return wave * 64 + (int)l_; }
namespace pg8 {
#define PG8_LAS __attribute__((address_space(3)))
typedef unsigned short bf16_t;
typedef short bf16x8 __attribute__((ext_vector_type(8)));
typedef float f32x4 __attribute__((ext_vector_type(4)));
typedef unsigned u32x4 __attribute__((ext_vector_type(4)));
typedef int v8i_t __attribute__((ext_vector_type(8)));
typedef int v4i_t __attribute__((ext_vector_type(4)));
typedef unsigned u32x2 __attribute__((ext_vector_type(2)));
constexpr int BM = 256, BK = 64, HALF = 128, HTB = HALF * BK * 2  , STAGE_BYTES = 8 * HTB, NXCD = 8, WGM = 8;

__host__ __device__ __forceinline__ int lds_byte(int r, int c) { const int st = (r >> 4) * 2 + (c >> 5), rr = r & 15, cc = c & 31, ob = rr * 64 + cc * 2; return st * 1024 + (ob ^ (((ob >> 9) & 1) << 5)); }
__host__ __device__ __forceinline__ void stage_rc(int b, int& R, int& C) { const int st = b / 1024, sb = b % 1024, swz = sb ^ (((sb >> 9) & 1) << 5); R = (st >> 1) * 16 + swz / 64; C = (st & 1) * 32 + (swz % 64) / 2; }
__host__ __device__ __forceinline__ int perm32(int rho) { const int n = rho >> 4, i = rho & 15; return 8 * (i >> 2) + 4 * n + (i & 3); }

struct Unit { int pm, pn, pb, po; };
struct Gemm { const bf16_t* A; const bf16_t* Bt; int M, N, K; };

struct StaticOrder {
    int nM, nN, nwg, G, c, skew;
    __host__ __device__ void init(int M, int N, int G_, int c_, int skew_ = 0) { nM = M / BM; nN = N / BM; nwg = nM * nN; G = G_; c = c_; skew = skew_; }
    __host__ __device__ bool next(int i, Unit& u) const {
        if (i > 0 && c < skew) return false;
        const long L = (i == 0) ? (long)c : (long)G + (long)(i - 1) * (G - skew) + (c - skew); if (L >= nwg) return false;
        int wgid = (int)L; { const int q = nwg / NXCD, r = nwg % NXCD, xcd = wgid % NXCD, off = wgid / NXCD; wgid = (xcd < r ? xcd * (q + 1) : r * (q + 1) + (xcd - r) * q) + off; }
        const int nig = WGM * nN, gid = wgid / nig, fm = gid * WGM, gsz = (nM - fm) < WGM ? (nM - fm) : WGM;
        u.pm = fm + ((wgid % nig) % gsz); u.pn = (wgid % nig) / gsz; u.pb = u.pn; u.po = u.pm; return true;
    }
    __device__ __forceinline__ void a_ready(const Unit&) const {}
    __device__ __forceinline__ void done(const Unit&) const {}
};
template <int NT, bool A_REL> struct MoeOrder {
    int G, c, p0, nunits; const int* pexp; int l0;
    __device__ __forceinline__ bool next(int i, Unit& u) const {
        const int L = l0 + i * G + c; if (L >= nunits) return false;
        const int pl = L / NT, n = L - pl * NT, p = p0 + pl;
        const int e = __builtin_amdgcn_readfirstlane(pexp[p]);
        u.pm = A_REL ? pl : p; u.po = A_REL ? p : pl; u.pn = n; u.pb = e * NT + n; return true;
    }
    __device__ __forceinline__ void a_ready(const Unit&) const {}
    __device__ __forceinline__ void done(const Unit&) const {}
};

__device__ __forceinline__ unsigned cvt_pk_bf16(float lo, float hi) { unsigned r; asm volatile("v_cvt_pk_bf16_f32 %0, %1, %2" : "=v"(r) : "v"(lo), "v"(hi)); return r; }
typedef float f32x2 __attribute__((ext_vector_type(2)));
__device__ __forceinline__ f32x2 gelu_pk(f32x2 v) {
    const f32x2 av = __builtin_elementwise_abs(v), d = av * 0.2316418882f + 1.0f;
    f32x2 t; t.x = __builtin_amdgcn_rcpf(d.x); t.y = __builtin_amdgcn_rcpf(d.y);
    f32x2 q = t * 0.5307027145f + (-0.7265760135f); q = q * t + 0.7107068705f; q = q * t + (-0.142248368f); q = q * t + 0.127414796f; q = q * t;
    const f32x2 s = (v * v) * (-0.72134752044f);
    f32x2 e; e.x = __builtin_amdgcn_exp2f(s.x); e.y = __builtin_amdgcn_exp2f(s.y);
    const f32x2 m = v * (q * e), r = v - m;
    f32x2 o; o.x = v.x < 0.f ? m.x : r.x; o.y = v.y < 0.f ? m.y : r.y; return o;
}
__device__ __forceinline__ f32x4 gelu4(f32x4 v) { const f32x2 a = gelu_pk((f32x2){v[0], v[1]}), b = gelu_pk((f32x2){v[2], v[3]}); return (f32x4){a.x, a.y, b.x, b.y}; }
__device__ __forceinline__ float silu1(float x) { return x * __builtin_amdgcn_rcpf(1.0f + __builtin_amdgcn_exp2f(-1.4426950408889634f * x)); }
__device__ __forceinline__ u32x4 pack8(f32x4 v0, f32x4 v1) { u32x4 w; w.x = cvt_pk_bf16(v0[0], v0[1]); w.y = cvt_pk_bf16(v0[2], v0[3]); w.z = cvt_pk_bf16(v1[0], v1[1]); w.w = cvt_pk_bf16(v1[2], v1[3]); return w; }

__device__ __forceinline__ f32x2 swiglu_pk(f32x2 g, f32x2 u, float s) {
    const f32x2 t = g * (-1.4426950408889634f * s); f32x2 e; e.x = __builtin_amdgcn_exp2f(t.x); e.y = __builtin_amdgcn_exp2f(t.y);
    const f32x2 d = e + 1.0f; f32x2 r; r.x = __builtin_amdgcn_rcpf(d.x); r.y = __builtin_amdgcn_rcpf(d.y);
    return (g * u) * (r * (s * s));
}
struct EpiNull {
    static constexpr bool PERM = true, AFTER_DRAIN = false;
    __device__ __forceinline__ void operator()(const f32x4 (&acc)[2][2][4][2], const Unit&, int, int, int, int) const {}
};
struct EpiKeep {
    static constexpr bool PERM = true, AFTER_DRAIN = false;
    __device__ __forceinline__ void operator()(const f32x4 (&acc)[2][2][4][2], const Unit&, int, int, int, int) const {
#pragma unroll
        for (int ai = 0; ai < 2; ++ai)
#pragma unroll
            for (int bj = 0; bj < 2; ++bj)
#pragma unroll
                for (int m = 0; m < 4; ++m)
#pragma unroll
                    for (int n = 0; n < 2; ++n) asm volatile("" :: "v"(acc[ai][bj][m][n]));
    }
};
struct EpiBf16Plain {
    static constexpr bool PERM = true, AFTER_DRAIN = false;
    bf16_t* O; int ldc; float scale;
    __device__ __forceinline__ void operator()(const f32x4 (&acc)[2][2][4][2], const Unit& u, int wr, int wc, int fr, int fq) const {
        const int row0 = u.po * BM + wr * 64 + fr, col0 = u.pn * BM + wc * 32 + 8 * fq;
#pragma unroll
        for (int ai = 0; ai < 2; ++ai)
#pragma unroll
            for (int m = 0; m < 4; ++m) { bf16_t* rowp = O + (size_t)(row0 + ai * HALF + m * 16) * ldc + col0;
#pragma unroll
                for (int bj = 0; bj < 2; ++bj) *(u32x4*)(rowp + bj * HALF) = pack8(acc[ai][bj][m][0] * scale, acc[ai][bj][m][1] * scale); }
    }
};
struct EpiProj0 {
    static constexpr bool PERM = true, AFTER_DRAIN = false;
    bf16_t* O; int ldc; float qscale;
    __device__ __forceinline__ void operator()(const f32x4 (&acc)[2][2][4][2], const Unit& u, int wr, int wc, int fr, int fq) const {
        const int row0 = u.po * BM + wr * 64 + fr, col0 = u.pn * BM + wc * 32 + 8 * fq;
        const int mode = u.pn < 2 ? 0 : (u.pn == 2 ? 1 : 2);
#pragma unroll
        for (int ai = 0; ai < 2; ++ai)
#pragma unroll
            for (int m = 0; m < 4; ++m) { bf16_t* rowp = O + (size_t)(row0 + ai * HALF + m * 16) * ldc + col0;
#pragma unroll
                for (int bj = 0; bj < 2; ++bj) { f32x4 v0 = acc[ai][bj][m][0], v1 = acc[ai][bj][m][1];
                    if (mode == 2) { v0 = gelu4(v0); v1 = gelu4(v1); } else if (mode == 0) { v0 = v0 * qscale; v1 = v1 * qscale; }
                    *(u32x4*)(rowp + bj * HALF) = pack8(v0, v1); } }
    }
};
struct EpiResGate {
    static constexpr bool PERM = false, AFTER_DRAIN = false;
    const float* base; float* out; int ldc; const float* gate; int gate_ld; int rows_per_batch;
    __device__ __forceinline__ void operator()(const f32x4 (&acc)[2][2][4][2], const Unit& u, int wr, int wc, int fr, int fq) const {
        const int row0 = u.po * BM + wr * 64 + fr, col0 = u.pn * BM + wc * 32 + 4 * fq;
        const float* gp = gate + (size_t)((u.po * BM) / rows_per_batch) * gate_ld + col0;
        f32x4 gv[2][2];
#pragma unroll
        for (int bj = 0; bj < 2; ++bj)
#pragma unroll
            for (int n = 0; n < 2; ++n) gv[bj][n] = *(const f32x4*)(gp + bj * HALF + n * 16);
#pragma unroll
        for (int ai = 0; ai < 2; ++ai)
#pragma unroll
            for (int m = 0; m < 4; ++m) { const size_t off = (size_t)(row0 + ai * HALF + m * 16) * ldc + col0;
#pragma unroll
                for (int bj = 0; bj < 2; ++bj)
#pragma unroll
                    for (int n = 0; n < 2; ++n) { const f32x4 bs = *(const f32x4*)(base + off + bj * HALF + n * 16); *(f32x4*)(out + off + bj * HALF + n * 16) = bs + gv[bj][n] * acc[ai][bj][m][n]; } }
    }
};
template <bool BASE_F32> struct EpiResGateH {
    static constexpr bool PERM = true, AFTER_DRAIN = false;
    const void* base; bf16_t* out; int ldc; const float* gate; int gate_ld; int rows_per_batch; float ascale;
    __device__ __forceinline__ void operator()(const f32x4 (&acc)[2][2][4][2], const Unit& u, int wr, int wc, int fr, int fq) const {
        const int row0 = u.po * BM + wr * 64 + fr, col0 = u.pn * BM + wc * 32 + 8 * fq;
        const float* gp = gate + (size_t)((u.po * BM) / rows_per_batch) * gate_ld + col0;
        f32x4 gv[2][2];
#pragma unroll
        for (int bj = 0; bj < 2; ++bj)
#pragma unroll
            for (int n = 0; n < 2; ++n) gv[bj][n] = *(const f32x4*)(gp + bj * HALF + n * 4) * ascale;
#pragma unroll
        for (int ai = 0; ai < 2; ++ai) {
            f32x4 bf[BASE_F32 ? 4 : 1][2][2]; u32x4 bh[BASE_F32 ? 1 : 4][2];
#pragma unroll
            for (int m = 0; m < 4; ++m) { const size_t off = (size_t)(row0 + ai * HALF + m * 16) * ldc + col0;
#pragma unroll
                for (int bj = 0; bj < 2; ++bj) {
                    if (BASE_F32) { bf[m][bj][0] = *(const f32x4*)((const float*)base + off + bj * HALF); bf[m][bj][1] = *(const f32x4*)((const float*)base + off + bj * HALF + 4); }
                    else bh[m][bj] = *(const u32x4*)((const bf16_t*)base + off + bj * HALF); } }
            asm volatile("" ::: "memory");
#pragma unroll
            for (int m = 0; m < 4; ++m) { const size_t off = (size_t)(row0 + ai * HALF + m * 16) * ldc + col0;
#pragma unroll
                for (int bj = 0; bj < 2; ++bj) { f32x4 b0, b1;
                    if (BASE_F32) { b0 = bf[m][bj][0]; b1 = bf[m][bj][1]; }
                    else { const u32x4 w = bh[m][bj];
                        b0 = (f32x4){__uint_as_float(w.x << 16), __uint_as_float(w.x & 0xffff0000u), __uint_as_float(w.y << 16), __uint_as_float(w.y & 0xffff0000u)};
                        b1 = (f32x4){__uint_as_float(w.z << 16), __uint_as_float(w.z & 0xffff0000u), __uint_as_float(w.w << 16), __uint_as_float(w.w & 0xffff0000u)}; }
                    *(u32x4*)(out + off + bj * HALF) = pack8(b0 + gv[bj][0] * acc[ai][bj][m][0], b1 + gv[bj][1] * acc[ai][bj][m][1]); } }
            asm volatile("" ::: "memory");
        }
    }
};
struct EpiSwiGLU {
    static constexpr bool PERM = true, AFTER_DRAIN = false;
    bf16_t* O; int ldc;
    __device__ __forceinline__ void operator()(const f32x4 (&acc)[2][2][4][2], const Unit& u, int wr, int wc, int fr, int fq) const {
        const int row0 = u.po * BM + wr * 64 + fr, col0 = u.pn * HALF + wc * 32 + 8 * fq;
#pragma unroll
        for (int ai = 0; ai < 2; ++ai)
#pragma unroll
            for (int m = 0; m < 4; ++m) { bf16_t* rowp = O + (size_t)(row0 + ai * HALF + m * 16) * ldc + col0;
                f32x4 r0, r1;
#pragma unroll
                for (int j = 0; j < 4; j += 2) { const f32x2 a = swiglu_pk((f32x2){acc[ai][0][m][0][j], acc[ai][0][m][0][j + 1]}, (f32x2){acc[ai][1][m][0][j], acc[ai][1][m][0][j + 1]}, 1.0f);
                    const f32x2 b = swiglu_pk((f32x2){acc[ai][0][m][1][j], acc[ai][0][m][1][j + 1]}, (f32x2){acc[ai][1][m][1][j], acc[ai][1][m][1][j + 1]}, 1.0f);
                    r0[j] = a.x; r0[j + 1] = a.y; r1[j] = b.x; r1[j + 1] = b.y; }
                *(u32x4*)rowp = pack8(r0, r1); }
    }
};
__device__ __forceinline__ float clamp448(float x) { return __builtin_fminf(__builtin_fmaxf(x, -448.f), 448.f); }
__device__ __forceinline__ unsigned pack4_fp8(float a, float b, float c, float d) { int w = 0; w = __builtin_amdgcn_cvt_pk_fp8_f32(clamp448(a), clamp448(b), w, false); w = __builtin_amdgcn_cvt_pk_fp8_f32(clamp448(c), clamp448(d), w, true); return (unsigned)w; }
__device__ __forceinline__ unsigned pack4_i8(float a, float b, float c, float d) {
    const int ia = (int)__builtin_rintf(__builtin_fminf(__builtin_fmaxf(a, -127.f), 127.f)), ib = (int)__builtin_rintf(__builtin_fminf(__builtin_fmaxf(b, -127.f), 127.f)), ic = (int)__builtin_rintf(__builtin_fminf(__builtin_fmaxf(c, -127.f), 127.f)), id = (int)__builtin_rintf(__builtin_fminf(__builtin_fmaxf(d, -127.f), 127.f));
    return ((unsigned)ia & 0xffu) | (((unsigned)ib & 0xffu) << 8) | (((unsigned)ic & 0xffu) << 16) | ((unsigned)id << 24); }
struct EpiSwiGLU8 {
    static constexpr bool PERM = true, AFTER_DRAIN = false;
    unsigned char* O; int ldc; float s;
    __device__ __forceinline__ void operator()(const f32x4 (&acc)[2][2][4][2], const Unit& u, int wr, int wc, int fr, int fq) const {
        const int row0 = u.po * BM + wr * 64 + fr, col0 = u.pn * HALF + wc * 32 + 8 * fq;
#pragma unroll
        for (int ai = 0; ai < 2; ++ai)
#pragma unroll
            for (int m = 0; m < 4; ++m) { unsigned char* rowp = O + (size_t)(row0 + ai * HALF + m * 16) * ldc + col0;
                f32x4 r0, r1;
#pragma unroll
                for (int j = 0; j < 4; j += 2) { const f32x2 a = swiglu_pk((f32x2){acc[ai][0][m][0][j], acc[ai][0][m][0][j + 1]}, (f32x2){acc[ai][1][m][0][j], acc[ai][1][m][0][j + 1]}, s);
                    const f32x2 b = swiglu_pk((f32x2){acc[ai][0][m][1][j], acc[ai][0][m][1][j + 1]}, (f32x2){acc[ai][1][m][1][j], acc[ai][1][m][1][j + 1]}, s);
                    r0[j] = a.x; r0[j + 1] = a.y; r1[j] = b.x; r1[j + 1] = b.y; }
                u32x2 w; w.x = pack4_fp8(r0[0], r0[1], r0[2], r0[3]); w.y = pack4_fp8(r1[0], r1[1], r1[2], r1[3]); *(u32x2*)rowp = w;
                asm volatile("" ::: "memory"); }
    }
};
__device__ __forceinline__ void colscales(const unsigned* cm, int col0, f32x4 (&sv)[2][2]) {
#pragma unroll
    for (int bj = 0; bj < 2; ++bj)
#pragma unroll
        for (int n = 0; n < 2; ++n) { const u32x4 w = *(const u32x4*)(cm + col0 + bj * HALF + n * 4); sv[bj][n] = (f32x4){__uint_as_float(w.x), __uint_as_float(w.y), __uint_as_float(w.z), __uint_as_float(w.w)} * (1.0f / 127.0f); }
}
struct EpiSwiGLUI {
    static constexpr bool PERM = true, AFTER_DRAIN = false;
    bf16_t* O; int ldc; const float* sa; const unsigned* cm;
    __device__ __forceinline__ void operator()(const f32x4 (&acc)[2][2][4][2], const Unit& u, int wr, int wc, int fr, int fq) const {
        const int row0 = u.po * BM + wr * 64 + fr, col0 = u.pn * HALF + wc * 32 + 8 * fq;
        f32x4 sv[2][2]; colscales(cm, u.pn * BM + wc * 32 + 8 * fq, sv);
#pragma unroll
        for (int ai = 0; ai < 2; ++ai)
#pragma unroll
            for (int m = 0; m < 4; ++m) { const int row = row0 + ai * HALF + m * 16; bf16_t* rowp = O + (size_t)row * ldc + col0; const float s = sa[row];
                f32x4 r0, r1;
#pragma unroll
                for (int j = 0; j < 4; j += 2) { const v4i_t g0 = __builtin_bit_cast(v4i_t, acc[ai][0][m][0]), g1 = __builtin_bit_cast(v4i_t, acc[ai][0][m][1]), u0 = __builtin_bit_cast(v4i_t, acc[ai][1][m][0]), u1 = __builtin_bit_cast(v4i_t, acc[ai][1][m][1]);
                    const f32x2 a = swiglu_pk((f32x2){(float)g0[j] * sv[0][0][j], (float)g0[j + 1] * sv[0][0][j + 1]}, (f32x2){(float)u0[j] * sv[1][0][j], (float)u0[j + 1] * sv[1][0][j + 1]}, s);
                    const f32x2 b = swiglu_pk((f32x2){(float)g1[j] * sv[0][1][j], (float)g1[j + 1] * sv[0][1][j + 1]}, (f32x2){(float)u1[j] * sv[1][1][j], (float)u1[j + 1] * sv[1][1][j + 1]}, s);
                    r0[j] = a.x; r0[j + 1] = a.y; r1[j] = b.x; r1[j + 1] = b.y; }
                *(u32x4*)rowp = pack8(r0, r1);
                asm volatile("" ::: "memory"); }
    }
};
struct EpiSwiGLUI8 {
    static constexpr bool PERM = true, AFTER_DRAIN = false;
    unsigned char* O; int ldc; const float* sa; const unsigned* cm;
    __device__ __forceinline__ void operator()(const f32x4 (&acc)[2][2][4][2], const Unit& u, int wr, int wc, int fr, int fq) const {
        const int row0 = u.po * BM + wr * 64 + fr, col0 = u.pn * HALF + wc * 32 + 8 * fq;
        f32x4 sv[2][2]; colscales(cm, u.pn * BM + wc * 32 + 8 * fq, sv);
#pragma unroll
        for (int ai = 0; ai < 2; ++ai)
#pragma unroll
            for (int m = 0; m < 4; ++m) { const int row = row0 + ai * HALF + m * 16; unsigned char* rowp = O + (size_t)row * ldc + col0; const float s = sa[row];
                f32x4 r0, r1;
#pragma unroll
                for (int j = 0; j < 4; j += 2) { const v4i_t g0 = __builtin_bit_cast(v4i_t, acc[ai][0][m][0]), g1 = __builtin_bit_cast(v4i_t, acc[ai][0][m][1]), u0 = __builtin_bit_cast(v4i_t, acc[ai][1][m][0]), u1 = __builtin_bit_cast(v4i_t, acc[ai][1][m][1]);
                    const f32x2 a = swiglu_pk((f32x2){(float)g0[j] * sv[0][0][j], (float)g0[j + 1] * sv[0][0][j + 1]}, (f32x2){(float)u0[j] * sv[1][0][j], (float)u0[j + 1] * sv[1][0][j + 1]}, s);
                    const f32x2 b = swiglu_pk((f32x2){(float)g1[j] * sv[0][1][j], (float)g1[j + 1] * sv[0][1][j + 1]}, (f32x2){(float)u1[j] * sv[1][1][j], (float)u1[j + 1] * sv[1][1][j + 1]}, s);
                    r0[j] = a.x; r0[j + 1] = a.y; r1[j] = b.x; r1[j + 1] = b.y; }
                { u32x2 w; w.x = pack4_fp8(r0[0], r0[1], r0[2], r0[3]); w.y = pack4_fp8(r1[0], r1[1], r1[2], r1[3]); *(u32x2*)rowp = w; }
                asm volatile("" ::: "memory"); }
    }
};
struct EpiProj0I {
    static constexpr bool PERM = true, AFTER_DRAIN = false;
    bf16_t* O; int ldc; float qscale; const float* sa; const unsigned* cm;
    __device__ __forceinline__ void operator()(const f32x4 (&acc)[2][2][4][2], const Unit& u, int wr, int wc, int fr, int fq) const {
        const int row0 = u.po * BM + wr * 64 + fr, col0 = u.pn * BM + wc * 32 + 8 * fq; const float sw = (u.pn < 2 ? qscale : 1.0f);
        f32x4 sv[2][2]; colscales(cm, col0, sv);
        const bool act = u.pn >= 3;
#pragma unroll
        for (int ai = 0; ai < 2; ++ai)
#pragma unroll
            for (int m = 0; m < 4; ++m) { const int row = row0 + ai * HALF + m * 16; bf16_t* rowp = O + (size_t)row * ldc + col0; const float s = sa[row] * sw;
#pragma unroll
                for (int bj = 0; bj < 2; ++bj) { const v4i_t i0 = __builtin_bit_cast(v4i_t, acc[ai][bj][m][0]), i1 = __builtin_bit_cast(v4i_t, acc[ai][bj][m][1]);
                    f32x4 v0 = (f32x4){(float)i0[0], (float)i0[1], (float)i0[2], (float)i0[3]} * sv[bj][0] * s, v1 = (f32x4){(float)i1[0], (float)i1[1], (float)i1[2], (float)i1[3]} * sv[bj][1] * s;
                    if (act) { v0 = gelu4(v0); v1 = gelu4(v1); }
                    *(u32x4*)(rowp + bj * HALF) = pack8(v0, v1); } }
    }
};
struct EpiBf16PlainI {
    static constexpr bool PERM = true, AFTER_DRAIN = false;
    bf16_t* O; int ldc; const float* sa; const unsigned* cm;
    __device__ __forceinline__ void operator()(const f32x4 (&acc)[2][2][4][2], const Unit& u, int wr, int wc, int fr, int fq) const {
        const int row0 = u.po * BM + wr * 64 + fr, col0 = u.pn * BM + wc * 32 + 8 * fq;
        f32x4 sv[2][2]; colscales(cm, col0, sv);
#pragma unroll
        for (int ai = 0; ai < 2; ++ai)
#pragma unroll
            for (int m = 0; m < 4; ++m) { const int row = row0 + ai * HALF + m * 16; bf16_t* rowp = O + (size_t)row * ldc + col0; const float s = sa[row];
#pragma unroll
                for (int bj = 0; bj < 2; ++bj) { const v4i_t i0 = __builtin_bit_cast(v4i_t, acc[ai][bj][m][0]), i1 = __builtin_bit_cast(v4i_t, acc[ai][bj][m][1]);
                    *(u32x4*)(rowp + bj * HALF) = pack8((f32x4){(float)i0[0], (float)i0[1], (float)i0[2], (float)i0[3]} * sv[bj][0] * s, (f32x4){(float)i1[0], (float)i1[1], (float)i1[2], (float)i1[3]} * sv[bj][1] * s); } }
    }
};
struct EpiSwiGLU8I {
    static constexpr bool PERM = true, AFTER_DRAIN = false;
    unsigned char* O; int ldc; const float* sa; const float* swp;
    __device__ __forceinline__ void operator()(const f32x4 (&acc)[2][2][4][2], const Unit& u, int wr, int wc, int fr, int fq) const {
        const int row0 = u.po * BM + wr * 64 + fr, col0 = u.pn * HALF + wc * 32 + 8 * fq; const float sw = *swp;
#pragma unroll
        for (int ai = 0; ai < 2; ++ai)
#pragma unroll
            for (int m = 0; m < 4; ++m) { const int row = row0 + ai * HALF + m * 16; unsigned char* rowp = O + (size_t)row * ldc + col0; const float s = sa[row] * sw;
                f32x4 r0, r1;
#pragma unroll
                for (int j = 0; j < 4; j += 2) { const v4i_t g0 = __builtin_bit_cast(v4i_t, acc[ai][0][m][0]), g1 = __builtin_bit_cast(v4i_t, acc[ai][0][m][1]), u0 = __builtin_bit_cast(v4i_t, acc[ai][1][m][0]), u1 = __builtin_bit_cast(v4i_t, acc[ai][1][m][1]);
                    const f32x2 a = swiglu_pk((f32x2){(float)g0[j], (float)g0[j + 1]}, (f32x2){(float)u0[j], (float)u0[j + 1]}, s);
                    const f32x2 b = swiglu_pk((f32x2){(float)g1[j], (float)g1[j + 1]}, (f32x2){(float)u1[j], (float)u1[j + 1]}, s);
                    r0[j] = a.x; r0[j + 1] = a.y; r1[j] = b.x; r1[j + 1] = b.y; }
                u32x2 w; w.x = pack4_fp8(r0[0], r0[1], r0[2], r0[3]); w.y = pack4_fp8(r1[0], r1[1], r1[2], r1[3]); *(u32x2*)rowp = w;
                asm volatile("" ::: "memory"); }
    }
};
struct EpiQRope {
    static constexpr bool PERM = true, AFTER_DRAIN = false;
    bf16_t* O; int ldc; const float* ctab; const float* stab; float qscale; int seq_mask;
    __device__ __forceinline__ void operator()(const f32x4 (&acc)[2][2][4][2], const Unit& u, int wr, int wc, int fr, int fq) const {
        const int row0 = u.po * BM + wr * 64 + fr, col0 = u.pn * BM + wc * 32 + 8 * fq;
#pragma unroll
        for (int ai = 0; ai < 2; ++ai)
#pragma unroll
            for (int m = 0; m < 4; ++m) { const int row = row0 + ai * HALF + m * 16; bf16_t* rowp = O + (size_t)row * ldc + col0; const int pos = row & seq_mask;
#pragma unroll
                for (int bj = 0; bj < 2; ++bj) { f32x4 v0 = acc[ai][bj][m][0] * qscale, v1 = acc[ai][bj][m][1] * qscale;
                    const int off = (col0 + bj * HALF) % 96;
                    if (off >= 64) { const int i0 = (off - 64) >> 1; const f32x4 cs = *(const f32x4*)(ctab + pos * 16 + i0), sn = *(const f32x4*)(stab + pos * 16 + i0);
                        const f32x4 a = v0, b = v1;
                        v0[0] = a[0] * cs[0] - a[1] * sn[0]; v0[1] = a[0] * sn[0] + a[1] * cs[0]; v0[2] = a[2] * cs[1] - a[3] * sn[1]; v0[3] = a[2] * sn[1] + a[3] * cs[1];
                        v1[0] = b[0] * cs[2] - b[1] * sn[2]; v1[1] = b[0] * sn[2] + b[1] * cs[2]; v1[2] = b[2] * cs[3] - b[3] * sn[3]; v1[3] = b[2] * sn[3] + b[3] * cs[3]; }
                    *(u32x4*)(rowp + bj * HALF) = pack8(v0, v1); }
                asm volatile("" ::: "memory"); }
    }
};

#ifndef PG8_F8_ASM_STAGE
#define PG8_F8_ASM_STAGE 0
#endif
template <class Epi, class Sched, bool ALIGN_EPI = false, bool SP2 = false, bool F8 = false, bool I8 = false, bool PF = false>
__device__ __forceinline__ void gemm_phase(PG8_LAS unsigned char* lds, const Gemm g, const Sched& S, const Epi& E, const int wave_) {
    int tid_ = tid_from_wave(wave_); asm volatile("" : "+v"(tid_));
    const int tid = tid_, wid = __builtin_amdgcn_readfirstlane(tid >> 6), lane = tid & 63, wr = wid >> 2, wc = wid & 3, fr = lane & 15, fq = lane >> 4;
    const int K = g.K, nt = K / BK;
    unsigned voffA[2], voffB[2];
#pragma unroll
    for (int i = 0; i < 2; ++i) { int R, C; stage_rc(tid * 16 + i * 8192, R, C); const int Rb = Epi::PERM ? ((R & ~31) + perm32(R & 31)) : R;
        voffA[i] = (unsigned)(R * K + C) * 2u; voffB[i] = (unsigned)(Rb * K + C) * 2u; }
    const size_t kstep = (size_t)(BK * 2);
    const size_t hstep = (size_t)HALF * K * 2;
    const size_t tstep = 2 * hstep;
    const unsigned lds_a32 = (unsigned)(uintptr_t)lds;
    const unsigned ldsw = (unsigned)wid * 1024u;
    const int aoff = lds_byte(wr * 64 + fr, fq * 8), boff = lds_byte(wc * 32 + fr, fq * 8);
#define PG8_SA(b, h) (((b) * 2 + (h)) * HTB)
#define PG8_SB(b, h) ((4 + (b) * 2 + (h)) * HTB)
#define PG8_STAGE(bufoff, gbase, voff) do { _Pragma("unroll") for (int _i = 0; _i < 2; ++_i) { \
        if constexpr (F8 && PG8_F8_ASM_STAGE) { unsigned keep_; asm volatile("s_mov_b32 %0, m0\n\ts_mov_b32 m0, %3\n\ts_nop 0\n\tglobal_load_lds_dwordx4 %1, %2\n\ts_mov_b32 m0, %0" : "=&s"(keep_) : "v"((voff)[_i]), "s"((const char*)(gbase)), "s"((unsigned)__builtin_amdgcn_readfirstlane((int)(lds_a32 + (unsigned)(bufoff) + ldsw + (unsigned)(_i * 8192)))) : "memory"); } \
        else __builtin_amdgcn_global_load_lds((const unsigned*)((const char*)(gbase) + (voff)[_i]), (PG8_LAS unsigned*)(lds + (bufoff) + ldsw + _i * 8192), 16, 0, 0); } } while (0)
#define PG8_LDA(dst, b, h) do { _Pragma("unroll") for (int m = 0; m < 4; ++m) _Pragma("unroll") for (int k = 0; k < 2; ++k) dst[m][k] = *(const PG8_LAS bf16x8*)(lds + PG8_SA(b, h) + aoff + m * 2048 + k * 1024); } while (0)
#define PG8_LDB(dst, b, h) do { _Pragma("unroll") for (int n = 0; n < 2; ++n) _Pragma("unroll") for (int k = 0; k < 2; ++k) dst[n][k] = *(const PG8_LAS bf16x8*)(lds + PG8_SB(b, h) + boff + n * 2048 + k * 1024); } while (0)
#define PG8_MMA(ai, bj, At, Bt) do { __builtin_amdgcn_s_setprio(1); _Pragma("unroll") for (int m = 0; m < 4; ++m) _Pragma("unroll") for (int n = 0; n < 2; ++n) { \
        if constexpr (F8) { const v8i_t b8_ = __builtin_shufflevector(__builtin_bit_cast(v4i_t, Bt[n][0]), __builtin_bit_cast(v4i_t, Bt[n][1]), 0, 1, 2, 3, 4, 5, 6, 7), a8_ = __builtin_shufflevector(__builtin_bit_cast(v4i_t, At[m][0]), __builtin_bit_cast(v4i_t, At[m][1]), 0, 1, 2, 3, 4, 5, 6, 7); \
            asm volatile("v_mfma_f32_16x16x128_f8f6f4 %0, %1, %2, %0" : "+v"(acc[ai][bj][m][n]) : "v"(b8_), "v"(a8_)); } \
        else if constexpr (I8) { _Pragma("unroll") for (int k = 0; k < 2; ++k) acc[ai][bj][m][n] = __builtin_bit_cast(f32x4, __builtin_amdgcn_mfma_i32_16x16x64_i8(__builtin_bit_cast(v4i_t, Bt[n][k]), __builtin_bit_cast(v4i_t, At[m][k]), __builtin_bit_cast(v4i_t, acc[ai][bj][m][n]), 0, 0, 0)); } \
        else { _Pragma("unroll") for (int k = 0; k < 2; ++k) acc[ai][bj][m][n] = __builtin_amdgcn_mfma_f32_16x16x32_bf16(Bt[n][k], At[m][k], acc[ai][bj][m][n], 0, 0, 0); } } __builtin_amdgcn_s_setprio(0); } while (0)
#define PG8_MF(ai, bj, m, n, At, Bt) do { \
        if constexpr (F8) { const v8i_t b8_ = __builtin_shufflevector(__builtin_bit_cast(v4i_t, Bt[n][0]), __builtin_bit_cast(v4i_t, Bt[n][1]), 0, 1, 2, 3, 4, 5, 6, 7), a8_ = __builtin_shufflevector(__builtin_bit_cast(v4i_t, At[m][0]), __builtin_bit_cast(v4i_t, At[m][1]), 0, 1, 2, 3, 4, 5, 6, 7); \
            asm volatile("v_mfma_f32_16x16x128_f8f6f4 %0, %1, %2, %0" : "+v"(acc[ai][bj][m][n]) : "v"(b8_), "v"(a8_)); } \
        else if constexpr (I8) { _Pragma("unroll") for (int k = 0; k < 2; ++k) acc[ai][bj][m][n] = __builtin_bit_cast(f32x4, __builtin_amdgcn_mfma_i32_16x16x64_i8(__builtin_bit_cast(v4i_t, Bt[n][k]), __builtin_bit_cast(v4i_t, At[m][k]), __builtin_bit_cast(v4i_t, acc[ai][bj][m][n]), 0, 0, 0)); } \
        else { _Pragma("unroll") for (int k = 0; k < 2; ++k) acc[ai][bj][m][n] = __builtin_amdgcn_mfma_f32_16x16x32_bf16(Bt[n][k], At[m][k], acc[ai][bj][m][n], 0, 0, 0); } } while (0)
#define PG8_RA(dst, b, h, m, k) dst[m][k] = *(const PG8_LAS bf16x8*)(lds + PG8_SA(b, h) + aoff + (m) * 2048 + (k) * 1024)
#define PG8_RB(dst, b, h, n, k) dst[n][k] = *(const PG8_LAS bf16x8*)(lds + PG8_SB(b, h) + boff + (n) * 2048 + (k) * 1024)
#define PG8_X1(b) do { __builtin_amdgcn_s_setprio(1); \
        PG8_MF(0, 0, 0, 0, At, B0); PG8_RB(B1, b, 1, 0, 0); PG8_SCHED; PG8_MF(0, 0, 0, 1, At, B0); PG8_RB(B1, b, 1, 0, 1); PG8_SCHED; PG8_MF(0, 0, 1, 0, At, B0); PG8_RB(B1, b, 1, 1, 0); PG8_SCHED; PG8_MF(0, 0, 1, 1, At, B0); PG8_RB(B1, b, 1, 1, 1); PG8_SCHED; \
        PG8_MF(0, 0, 2, 0, At, B0); PG8_MF(0, 0, 2, 1, At, B0); PG8_MF(0, 0, 3, 0, At, B0); PG8_MF(0, 0, 3, 1, At, B0); PG8_SCHED; \
        PG8_MF(0, 1, 0, 0, At, B1); PG8_RA(At2, b, 1, 0, 0); PG8_SCHED; PG8_MF(0, 1, 0, 1, At, B1); PG8_RA(At2, b, 1, 0, 1); PG8_SCHED; PG8_MF(0, 1, 1, 0, At, B1); PG8_RA(At2, b, 1, 1, 0); PG8_SCHED; PG8_MF(0, 1, 1, 1, At, B1); PG8_RA(At2, b, 1, 1, 1); PG8_SCHED; \
        PG8_MF(0, 1, 2, 0, At, B1); PG8_RA(At2, b, 1, 2, 0); PG8_SCHED; PG8_MF(0, 1, 2, 1, At, B1); PG8_RA(At2, b, 1, 2, 1); PG8_SCHED; PG8_MF(0, 1, 3, 0, At, B1); PG8_RA(At2, b, 1, 3, 0); PG8_SCHED; PG8_MF(0, 1, 3, 1, At, B1); PG8_RA(At2, b, 1, 3, 1); PG8_SCHED; \
        __builtin_amdgcn_s_setprio(0); } while (0)
#define PG8_X2(b) do { __builtin_amdgcn_s_setprio(1); \
        PG8_MF(1, 0, 0, 0, At2, B0); PG8_RA(At, (b) ^ 1, 0, 0, 0); PG8_SCHED; PG8_MF(1, 0, 0, 1, At2, B0); PG8_RA(At, (b) ^ 1, 0, 0, 1); PG8_SCHED; PG8_MF(1, 0, 1, 0, At2, B0); PG8_RA(At, (b) ^ 1, 0, 1, 0); PG8_SCHED; PG8_MF(1, 0, 1, 1, At2, B0); PG8_RA(At, (b) ^ 1, 0, 1, 1); PG8_SCHED; \
        PG8_MF(1, 0, 2, 0, At2, B0); PG8_RA(At, (b) ^ 1, 0, 2, 0); PG8_SCHED; PG8_MF(1, 0, 2, 1, At2, B0); PG8_RA(At, (b) ^ 1, 0, 2, 1); PG8_SCHED; PG8_MF(1, 0, 3, 0, At2, B0); PG8_RA(At, (b) ^ 1, 0, 3, 0); PG8_SCHED; PG8_MF(1, 0, 3, 1, At2, B0); PG8_RA(At, (b) ^ 1, 0, 3, 1); PG8_SCHED; \
        PG8_MF(1, 1, 0, 0, At2, B1); PG8_RB(B0, (b) ^ 1, 0, 0, 0); PG8_SCHED; PG8_MF(1, 1, 0, 1, At2, B1); PG8_RB(B0, (b) ^ 1, 0, 0, 1); PG8_SCHED; PG8_MF(1, 1, 1, 0, At2, B1); PG8_RB(B0, (b) ^ 1, 0, 1, 0); PG8_SCHED; PG8_MF(1, 1, 1, 1, At2, B1); PG8_RB(B0, (b) ^ 1, 0, 1, 1); PG8_SCHED; \
        PG8_MF(1, 1, 2, 0, At2, B1); PG8_MF(1, 1, 2, 1, At2, B1); PG8_MF(1, 1, 3, 0, At2, B1); PG8_MF(1, 1, 3, 1, At2, B1); __builtin_amdgcn_s_setprio(0); } while (0)
#define PG8_WAIT_V(n) asm volatile("s_waitcnt vmcnt(" #n ")" ::: "memory")
#define PG8_WAIT_L(n) asm volatile("s_waitcnt lgkmcnt(" #n ")" ::: "memory")
#define PG8_BAR __builtin_amdgcn_s_barrier()
#define PG8_SCHED __builtin_amdgcn_sched_barrier(0)
    Unit cur, nxt; int ui = 0;
    if (!S.next(0, cur)) return;
    f32x4 acc[2][2][4][2];
#pragma unroll
    for (int a = 0; a < 2; ++a)
#pragma unroll
        for (int b = 0; b < 2; ++b)
#pragma unroll
            for (int m = 0; m < 4; ++m)
#pragma unroll
                for (int n = 0; n < 2; ++n) acc[a][b][m][n] = (f32x4){0.f, 0.f, 0.f, 0.f};
    bf16x8 At[4][2], B0[2][2], B1[2][2]; bf16x8 At2[PF ? 4 : 1][2];
    const char* cA = (const char*)g.A + (size_t)cur.pm * tstep; const char* cB = (const char*)g.Bt + (size_t)cur.pb * tstep;
    S.a_ready(cur);
    if constexpr (PF) {
        PG8_STAGE(PG8_SA(0, 0), cA, voffA); PG8_STAGE(PG8_SB(0, 0), cB, voffB); PG8_STAGE(PG8_SA(0, 1), cA + hstep, voffA); PG8_STAGE(PG8_SB(0, 1), cB + hstep, voffB);
        PG8_STAGE(PG8_SA(1, 0), cA + kstep, voffA); PG8_STAGE(PG8_SB(1, 0), cB + kstep, voffB);
        if (wr == 1) { PG8_STAGE(PG8_SA(1, 1), cA + hstep + kstep, voffA); PG8_STAGE(PG8_SB(1, 1), cB + hstep + kstep, voffB); }
        PG8_WAIT_V(8); PG8_BAR;
        PG8_LDA(At, 0, 0); PG8_LDB(B0, 0, 0); __builtin_amdgcn_s_waitcnt(0xC07F);
        if (wr == 1) PG8_BAR;
    } else
    if constexpr (SP2) {
        PG8_STAGE(PG8_SB(0, 0), cB, voffB); PG8_STAGE(PG8_SB(0, 1), cB + hstep, voffB); PG8_STAGE(PG8_SA(0, 0), cA, voffA); PG8_STAGE(PG8_SA(0, 1), cA + hstep, voffA);
        if (wr == 1) PG8_BAR;
        PG8_WAIT_V(2); PG8_BAR;
        PG8_STAGE(PG8_SB(1, 0), cB + kstep, voffB); PG8_STAGE(PG8_SA(1, 0), cA + kstep, voffA); PG8_STAGE(PG8_SB(1, 1), cB + hstep + kstep, voffB);
        PG8_WAIT_V(6); PG8_BAR;
    } else {
        PG8_STAGE(PG8_SB(0, 0), cB, voffB); PG8_STAGE(PG8_SA(0, 0), cA, voffA); PG8_STAGE(PG8_SB(0, 1), cB + hstep, voffB); PG8_STAGE(PG8_SA(0, 1), cA + hstep, voffA);
        if (wr == 1) PG8_BAR;
        PG8_WAIT_V(4); PG8_BAR;
        PG8_STAGE(PG8_SB(1, 0), cB + kstep, voffB); PG8_STAGE(PG8_SA(1, 0), cA + kstep, voffA); PG8_STAGE(PG8_SB(1, 1), cB + hstep + kstep, voffB);
        PG8_WAIT_V(6); PG8_BAR;
    }
    for (;;) {
        const bool has_next = S.next(ui + 1, nxt);
        const char* nA = has_next ? (const char*)g.A + (size_t)nxt.pm * tstep : cA; const char* nB = has_next ? (const char*)g.Bt + (size_t)nxt.pb * tstep : cB;
        for (int t = 0; t < nt; t += 2) {
            const bool last = (t == nt - 2);
            const char* a1 = cA + (size_t)(t + 1) * kstep;
            const char* a2 = last ? nA : cA + (size_t)(t + 2) * kstep; const char* b2 = last ? nB : cB + (size_t)(t + 2) * kstep;
            const char* a3 = a2 + kstep; const char* b3 = b2 + kstep;
            if (last && has_next) S.a_ready(nxt);
            if constexpr (PF) {
            PG8_STAGE(wr ? PG8_SA(0, 0) : PG8_SA(1, 1), wr ? a2 : a1 + hstep, voffA); PG8_STAGE(wr ? PG8_SB(0, 0) : PG8_SB(1, 1), wr ? b2 : cB + (size_t)(t + 1) * kstep + hstep, voffB);
            PG8_WAIT_V(8); PG8_BAR;
            PG8_X1(0); __builtin_amdgcn_s_waitcnt(0xC07F); PG8_BAR; PG8_SCHED;
            PG8_STAGE(wr ? PG8_SA(0, 1) : PG8_SA(0, 0), wr ? a2 + hstep : a2, voffA); PG8_STAGE(wr ? PG8_SB(0, 1) : PG8_SB(0, 0), wr ? b2 + hstep : b2, voffB);
            PG8_WAIT_V(8); PG8_BAR;
            PG8_X2(0); __builtin_amdgcn_s_waitcnt(0xC07F); PG8_BAR; PG8_SCHED;
            PG8_STAGE(wr ? PG8_SA(1, 0) : PG8_SA(0, 1), wr ? a3 : a2 + hstep, voffA); PG8_STAGE(wr ? PG8_SB(1, 0) : PG8_SB(0, 1), wr ? b3 : b2 + hstep, voffB);
            PG8_WAIT_V(8); PG8_BAR;
            PG8_X1(1); __builtin_amdgcn_s_waitcnt(0xC07F); PG8_BAR; PG8_SCHED;
            PG8_STAGE(wr ? PG8_SA(1, 1) : PG8_SA(1, 0), wr ? a3 + hstep : a3, voffA); PG8_STAGE(wr ? PG8_SB(1, 1) : PG8_SB(1, 0), wr ? b3 + hstep : b3, voffB);
            PG8_WAIT_V(8); PG8_BAR;
            PG8_X2(1); __builtin_amdgcn_s_waitcnt(0xC07F); PG8_BAR; PG8_SCHED;
            } else
            if constexpr (SP2) {
            PG8_LDB(B0, 0, 0); PG8_LDB(B1, 0, 1); PG8_SCHED; PG8_LDA(At, 0, 0); PG8_STAGE(PG8_SA(1, 1), a1 + hstep, voffA);
            PG8_WAIT_V(8); PG8_WAIT_L(0); PG8_BAR; PG8_MMA(0, 0, At, B0); PG8_MMA(0, 1, At, B1); PG8_BAR; PG8_SCHED;
            PG8_LDA(At, 0, 1); PG8_STAGE(PG8_SB(0, 0), b2, voffB); PG8_STAGE(PG8_SB(0, 1), b2 + hstep, voffB); PG8_STAGE(PG8_SA(0, 0), a2, voffA);
            PG8_WAIT_V(8); PG8_WAIT_L(0); PG8_BAR; PG8_MMA(1, 0, At, B0); PG8_MMA(1, 1, At, B1); PG8_BAR; PG8_SCHED;
            PG8_LDB(B0, 1, 0); PG8_LDB(B1, 1, 1); PG8_SCHED; PG8_LDA(At, 1, 0); PG8_STAGE(PG8_SA(0, 1), a2 + hstep, voffA);
            PG8_WAIT_V(8); PG8_WAIT_L(0); PG8_BAR; PG8_MMA(0, 0, At, B0); PG8_MMA(0, 1, At, B1); PG8_BAR; PG8_SCHED;
            PG8_LDA(At, 1, 1); PG8_STAGE(PG8_SB(1, 0), b3, voffB); PG8_STAGE(PG8_SB(1, 1), b3 + hstep, voffB); PG8_STAGE(PG8_SA(1, 0), a3, voffA);
            PG8_WAIT_V(8); PG8_WAIT_L(0); PG8_BAR; PG8_MMA(1, 0, At, B0); PG8_MMA(1, 1, At, B1); PG8_BAR; PG8_SCHED;
            } else {
            PG8_LDB(B0, 0, 0); PG8_SCHED; PG8_LDA(At, 0, 0); PG8_STAGE(PG8_SA(1, 1), a1 + hstep, voffA);
            PG8_WAIT_L(8); PG8_BAR; PG8_WAIT_L(0); PG8_MMA(0, 0, At, B0); PG8_BAR; PG8_SCHED;
            PG8_LDB(B1, 0, 1); PG8_STAGE(PG8_SB(0, 0), b2, voffB);
            PG8_BAR; PG8_WAIT_L(0); PG8_MMA(0, 1, At, B1); PG8_BAR;
            PG8_LDA(At, 0, 1); PG8_STAGE(PG8_SA(0, 0), a2, voffA);
            PG8_BAR; PG8_WAIT_L(0); PG8_MMA(1, 0, At, B0); PG8_BAR; PG8_SCHED;
            PG8_STAGE(PG8_SB(0, 1), b2 + hstep, voffB);
            PG8_WAIT_V(6); PG8_BAR; PG8_MMA(1, 1, At, B1); PG8_BAR;
            PG8_LDB(B0, 1, 0); PG8_SCHED; PG8_LDA(At, 1, 0); PG8_STAGE(PG8_SA(0, 1), a2 + hstep, voffA);
            PG8_WAIT_L(8); PG8_BAR; PG8_WAIT_L(0); PG8_MMA(0, 0, At, B0); PG8_BAR; PG8_SCHED;
            PG8_LDB(B1, 1, 1); PG8_STAGE(PG8_SB(1, 0), b3, voffB);
            PG8_BAR; PG8_WAIT_L(0); PG8_MMA(0, 1, At, B1); PG8_BAR;
            PG8_LDA(At, 1, 1); PG8_STAGE(PG8_SA(1, 0), a3, voffA);
            PG8_BAR; PG8_WAIT_L(0); PG8_MMA(1, 0, At, B0); PG8_BAR; PG8_SCHED;
            PG8_STAGE(PG8_SB(1, 1), b3 + hstep, voffB);
            PG8_WAIT_V(6); PG8_BAR; PG8_MMA(1, 1, At, B1); PG8_BAR;
            }
        }
        if constexpr (ALIGN_EPI) { if (wr == 0) PG8_BAR; }
        if constexpr (F8) asm volatile("s_nop 15\n\ts_nop 7" ::: "memory");
        if constexpr (!Epi::AFTER_DRAIN) { int t2_ = tid_from_wave(wave_); asm volatile("" : "+v"(t2_)); const int l2_ = t2_ & 63;
            E(acc, cur, wr, wc, l2_ & 15, l2_ >> 4); S.done(cur); }
        if (!has_next) break;
#pragma unroll
        for (int a = 0; a < 2; ++a)
#pragma unroll
            for (int b = 0; b < 2; ++b)
#pragma unroll
                for (int m = 0; m < 4; ++m)
#pragma unroll
                    for (int n = 0; n < 2; ++n) acc[a][b][m][n] = (f32x4){0.f, 0.f, 0.f, 0.f};
        cur = nxt; cA = nA; cB = nB; ++ui;
        if constexpr (ALIGN_EPI) { if (wr == 1) PG8_BAR; }
    }
    PG8_WAIT_V(0);
    if constexpr (!ALIGN_EPI) { if (wr == 0) PG8_BAR; }
    PG8_BAR;
    if constexpr (Epi::AFTER_DRAIN) { E.fused(acc, cur, wr, wc, fr, fq, lds, wid, lane); S.done(cur); }
#undef PG8_SA
#undef PG8_SB
#undef PG8_STAGE
#undef PG8_LDA
#undef PG8_LDB
#undef PG8_MMA
#undef PG8_MF
#undef PG8_RA
#undef PG8_RB
#undef PG8_X1
#undef PG8_X2
#undef PG8_WAIT_V
#undef PG8_WAIT_L
#undef PG8_BAR
#undef PG8_SCHED
}
}
#define GAS __attribute__((address_space(1)))
#define LAS __attribute__((address_space(3)))
typedef unsigned short bf16;
typedef unsigned v4u __attribute__((ext_vector_type(4)));
typedef float f32x4 __attribute__((ext_vector_type(4)));
typedef short bf16x8 __attribute__((ext_vector_type(8)));
typedef GAS unsigned gu32;
typedef GAS unsigned long long gu64;
#define RLX_AGENT __ATOMIC_RELAXED, __HIP_MEMORY_SCOPE_AGENT
#define LDS_WAIT() asm volatile("s_waitcnt lgkmcnt(0)" ::: "memory")
#define VM_WAIT() asm volatile("s_waitcnt vmcnt(0)" ::: "memory")
__device__ __forceinline__ unsigned long long rt() { return __builtin_amdgcn_s_memrealtime(); }

#define XB_TMO      128
#define XB_XCNT(j)  (256  + 64 * (j))
#define XB_XSUB(j)  (1280 + 64 * (j))
#define XB_XGEN(j)  (2304 + 64 * (j))
#define XB_TOP      3328
#define XB_TOPGEN   3392
#define XCD_BAR_WORDS 3456
#define XB_SPIN_CAP (1u << 18)

__device__ __forceinline__ unsigned xb_ld(unsigned* p)              { return __hip_atomic_load(p, __ATOMIC_RELAXED, __HIP_MEMORY_SCOPE_AGENT); }
__device__ __forceinline__ unsigned xb_add(unsigned* p, unsigned v) { return __hip_atomic_fetch_add(p, v, __ATOMIC_RELAXED, __HIP_MEMORY_SCOPE_AGENT); }
__device__ __forceinline__ unsigned xb_xcc_id() { return (unsigned)__builtin_amdgcn_s_getreg((3 << 11) | 20) & 0xFu; }
#define XB_SPIN(cond, bar) do { unsigned _sp = 0; while (cond) { __builtin_amdgcn_s_sleep(1); \
    if ((++_sp & 255u) == 0u) { if (xb_ld(&(bar)[XB_TMO])) break; if (_sp > XB_SPIN_CAP) { atomicAdd(&(bar)[XB_TMO], 1u); break; } } } } while (0)

struct XcdBarrier {
    unsigned* bar; unsigned x; int wave;
    volatile LAS unsigned* st;
};

__device__ __forceinline__ XcdBarrier xcd_barrier_post(unsigned* bar, volatile LAS unsigned* st, int wave) {
    XcdBarrier b; b.bar = bar; b.x = xb_xcc_id(); b.st = st; b.wave = wave;
    if (tid_from_wave(wave) == 0) (void)xb_add(&bar[XB_XCNT(b.x)], 1u);
    return b;
}
__device__ __forceinline__ void xcd_barrier_complete(unsigned* bar, unsigned x, unsigned& nloc, unsigned& nx) {
    const unsigned G = gridDim.x * gridDim.y * gridDim.z;
    unsigned sum, cnt, mine, sp = 0u;
    for (;;) {
        sum = 0u; cnt = 0u; mine = 0u;
#pragma unroll
        for (unsigned j = 0; j < 16; ++j) { const unsigned c = xb_ld(&bar[XB_XCNT(j)]); sum += c; cnt += (c > 0u) ? 1u : 0u; mine = (j == x) ? c : mine; }
        if (sum == G) break;
        __builtin_amdgcn_s_sleep(1);
        if ((++sp & 255u) == 0u) { if (xb_ld(&bar[XB_TMO])) break; if (sp > XB_SPIN_CAP) { atomicAdd(&bar[XB_TMO], 1u); break; } }
    }
    nloc = mine > 0u ? mine : 1u; nx = cnt > 0u ? cnt : 1u;
}

__device__ __forceinline__ void xcd_barrier(const XcdBarrier& b) {
    asm volatile("s_waitcnt vmcnt(0)" ::: "memory");
    __syncthreads();
    if (tid_from_wave(b.wave) == 0) {
        unsigned* bar = b.bar;
        __builtin_amdgcn_s_waitcnt(0);
        unsigned nloc = b.st[0], nx = b.st[1];
        if (nloc == 0u) { xcd_barrier_complete(bar, b.x, nloc, nx); b.st[0] = nloc; b.st[1] = nx; }
        const unsigned old = xb_add(&bar[XB_XSUB(b.x)], 1u);
        const unsigned gen = old / nloc;
        if (old + 1u == (gen + 1u) * nloc) {
            __builtin_amdgcn_fence(__ATOMIC_RELEASE, "agent");
            asm volatile("s_waitcnt vmcnt(0)" ::: "memory");
            const unsigned og = xb_add(&bar[XB_TOP], 1u);
            const unsigned tg = og / nx;
            if (og + 1u == (tg + 1u) * nx) xb_add(&bar[XB_TOPGEN], 1u);
            else XB_SPIN(xb_ld(&bar[XB_TOPGEN]) == tg, bar);
            __builtin_amdgcn_fence(__ATOMIC_ACQUIRE, "agent");
            xb_add(&bar[XB_XGEN(b.x)], 1u);
            asm volatile("s_waitcnt vmcnt(0)" ::: "memory");
        } else {
            XB_SPIN(xb_ld(&bar[XB_XGEN(b.x)]) == gen, bar);
            __builtin_amdgcn_fence(__ATOMIC_ACQUIRE, "agent");
            asm volatile("s_waitcnt vmcnt(0)" ::: "memory");
        }
    }
    __syncthreads();
}

namespace mla {
using bf16x8 = __attribute__((ext_vector_type(8))) short;
using s16x4 = __attribute__((ext_vector_type(4))) short;
using f32x16 = __attribute__((ext_vector_type(16))) float;
using u32x4 = __attribute__((ext_vector_type(4))) unsigned;
typedef __attribute__((address_space(3))) const char* lds_cptr;
constexpr int SEQ = 8192, NW = 8, QBLK = 32, QB = 256, KVBLK = 64, NSLOT = 3, KSLOT = 12288, VSLOT = 8192;
constexpr int QP = 768, KVP = 1024, PEP = 32, OP = 1024;
constexpr int LDS_K = 0, LDS_V = NSLOT * KSLOT, LDS_WS = LDS_V + NSLOT * VSLOT, LDS_OST = LDS_WS + NW * 64 * 4, LDS_TOTAL = LDS_OST + NW * 4096;
__device__ __forceinline__ int crow(int r, int hi) { return (r & 3) + 8 * (r >> 2) + 4 * hi; }
__device__ __forceinline__ void glds16(const void* gsrc, unsigned lds_dst) { unsigned keep;
    asm volatile("s_mov_b32 %0, m0\n\ts_mov_b32 m0, %2\n\ts_nop 0\n\tglobal_load_lds_dwordx4 %1, off\n\ts_mov_b32 m0, %0" : "=&s"(keep) : "v"(gsrc), "s"(lds_dst) : "memory"); }
__device__ __forceinline__ float max3f(float a, float b, float c) { float r; asm("v_max3_f32 %0, %1, %2, %3" : "=v"(r) : "v"(a), "v"(b), "v"(c)); return r; }
typedef float f32x2_t __attribute__((ext_vector_type(2))); typedef __bf16 bf16x2_t __attribute__((ext_vector_type(2)));
__device__ __forceinline__ unsigned cvtpk_s(float lo, float hi) { f32x2_t v = {lo, hi}; bf16x2_t b = __builtin_convertvector(v, bf16x2_t); return __builtin_bit_cast(unsigned, b); }
__device__ __forceinline__ void cmask(f32x16& p0, f32x16& p1, int jb, int qrel, int hi) {
    const float NEG = -INFINITY; const int kb = 64 * jb + 4 * hi;
#pragma unroll
    for (int r = 0; r < 16; ++r) { const int kv = kb + (r & 3) + 8 * (r >> 2); if (kv > qrel) p0[r] = NEG; if (kv + 32 > qrel) p1[r] = NEG; }
}
__device__ __forceinline__ float rowmax(const f32x16& p0, const f32x16& p1) {
    float a = max3f(p0[0], p0[1], p1[0]), b = max3f(p0[2], p0[3], p1[1]); a = max3f(a, p1[2], p1[3]);
#pragma unroll
    for (int r = 4; r < 16; r += 4) { a = max3f(a, p0[r], p0[r + 1]); b = max3f(b, p0[r + 2], p0[r + 3]); a = max3f(a, p1[r], p1[r + 1]); b = max3f(b, p1[r + 2], p1[r + 3]); }
    const float m = fmaxf(a, b);
    auto rr = __builtin_amdgcn_permlane32_swap(__float_as_uint(m), __float_as_uint(m), false, false);
    return fmaxf(__uint_as_float(rr[0]), __uint_as_float(rr[1]));
}
__device__ __forceinline__ void pv(f32x16* o, int vb, bf16x8 pa0, bf16x8 pa1, bf16x8 pa2, bf16x8 pa3) {
#pragma unroll
    for (int d0 = 0; d0 < 2; ++d0) { s16x4 lo[4], hi[4];
#pragma unroll
        for (int ks = 0; ks < 4; ++ks) {
            asm volatile("ds_read_b64_tr_b16 %0,%1 offset:%c2" : "=&v"(lo[ks]) : "v"(vb), "i"(d0 * 4096 + ks * 1024) : "memory");
            asm volatile("ds_read_b64_tr_b16 %0,%1 offset:%c2" : "=&v"(hi[ks]) : "v"(vb), "i"(d0 * 4096 + ks * 1024 + 512) : "memory"); }
        asm volatile("s_waitcnt lgkmcnt(0)" ::: "memory"); __builtin_amdgcn_sched_barrier(0);
#define MLA_PK(k) (bf16x8){lo[k][0], lo[k][1], lo[k][2], lo[k][3], hi[k][0], hi[k][1], hi[k][2], hi[k][3]}
        o[d0] = __builtin_amdgcn_mfma_f32_32x32x16_bf16(pa0, MLA_PK(0), o[d0], 0, 0, 0);
        o[d0] = __builtin_amdgcn_mfma_f32_32x32x16_bf16(pa1, MLA_PK(1), o[d0], 0, 0, 0);
        o[d0] = __builtin_amdgcn_mfma_f32_32x32x16_bf16(pa2, MLA_PK(2), o[d0], 0, 0, 0);
        o[d0] = __builtin_amdgcn_mfma_f32_32x32x16_bf16(pa3, MLA_PK(3), o[d0], 0, 0, 0);
#undef MLA_PK
    }
}
#define MLA_WAIT_BAR(N) asm volatile("s_waitcnt vmcnt(" #N ") lgkmcnt(0)\n\ts_barrier" ::: "memory")

__device__ __forceinline__ void unit(int b, int h, int qb, const unsigned short* Q, const unsigned short* KV, const unsigned short* KPE, unsigned short* O, char* shm, const int wave_) {
    int tid_ = tid_from_wave(wave_); asm volatile("" : "+v"(tid_));
    const int tid = tid_, lane = tid & 63, r32 = lane & 31, hi = lane >> 5; const int wid = __builtin_amdgcn_readfirstlane(tid >> 6);
    const long rowbase = (long)b * SEQ; const int q0 = qb * QB;
    const unsigned short* Qw = Q + (rowbase + q0 + wid * QBLK) * QP + h * 96;
    const unsigned short* Kh = KV + rowbase * KVP + h * 128; const unsigned short* Vh = Kh + 64; const unsigned short* Ph = KPE + rowbase * PEP;
    const unsigned lds0 = (unsigned)(uintptr_t)shm;
    __attribute__((address_space(3))) float* wsf = (__attribute__((address_space(3))) float*)((lds_cptr)shm + LDS_WS) + wid * 64;
    const unsigned short* ksrc = Kh + (long)lane * KVP + wid * 8;
    const unsigned short* psrc = Ph + (long)(32 * (wid & 1) + r32) * PEP + (wid >> 1) * 8;
    const unsigned short* vsrc = Vh + (long)(16 * (wid & 3) + (lane >> 2)) * KVP + (wid >> 2) * 32 + (lane & 3) * 8;
    const unsigned kdst = lds0 + LDS_K + wid * 1024, pdst = lds0 + LDS_K + (8 + (wid >> 1)) * 1024 + (wid & 1) * 512, vdst = lds0 + LDS_V + wid * 1024;
#define MLA_DMA(t, s) do { glds16(ksrc + (long)(t) * KVBLK * KVP, (unsigned)__builtin_amdgcn_readfirstlane(kdst + (s) * KSLOT)); \
        if (lane < 32) glds16(psrc + (long)(t) * KVBLK * PEP, (unsigned)__builtin_amdgcn_readfirstlane(pdst + (s) * KSLOT)); \
        glds16(vsrc + (long)(t) * KVBLK * KVP, (unsigned)__builtin_amdgcn_readfirstlane(vdst + (s) * VSLOT)); } while (0)
    const int vb0 = (int)(lds0 + LDS_V) + ((lane >> 4) & 1) * 32 + (lane & 3) * 8 + (4 * hi + ((lane & 15) >> 2)) * 64;
    const lds_cptr kp0 = (lds_cptr)shm + LDS_K + hi * 1024 + r32 * 16;
    const int NT = (q0 + QB) / KVBLK;
    bf16x8 qr[6];
#pragma unroll
    for (int d0 = 0; d0 < 6; ++d0) qr[d0] = *reinterpret_cast<const bf16x8*>(&Qw[(long)r32 * QP + d0 * 16 + hi * 8]);
    asm volatile("s_waitcnt vmcnt(0)" ::: "memory");
    MLA_DMA(0, 0); MLA_DMA(1, 1);
    float m = -INFINITY, l = 0.f; f32x16 o[2]; o[0] = f32x16{}; o[1] = f32x16{};
    const int qrel = wid * QBLK + r32;
    int slot = 0, slot2 = 2;
    for (int t = 0; t < NT; ++t) {
        if (t + 1 < NT) MLA_WAIT_BAR(3); else MLA_WAIT_BAR(0);
        if (t + 2 < NT) MLA_DMA(t + 2, slot2);
        f32x16 p0 = f32x16{}, p1 = f32x16{};
        { const lds_cptr kp = kp0 + slot * KSLOT;
#pragma unroll
          for (int d0 = 0; d0 < 6; ++d0) { const bf16x8 b0 = *(const __attribute__((address_space(3))) bf16x8*)(kp + d0 * 2048), b1 = *(const __attribute__((address_space(3))) bf16x8*)(kp + d0 * 2048 + 512);
              p0 = __builtin_amdgcn_mfma_f32_32x32x16_bf16(b0, qr[d0], p0, 0, 0, 0); p1 = __builtin_amdgcn_mfma_f32_32x32x16_bf16(b1, qr[d0], p1, 0, 0, 0); } }
        { const int jb = t - (NT - 4); if (jb >= 0) cmask(p0, p1, jb, qrel, hi); }
        const float rm = rowmax(p0, p1), mn = fmaxf(m, rm);
        if (__any(mn > m)) {
            const float al = __builtin_amdgcn_exp2f(m - mn); l *= al; m = mn;
            if (hi == 0) wsf[r32] = al;
            asm volatile("s_waitcnt lgkmcnt(0)" ::: "memory");
#pragma unroll
            for (int r = 0; r < 16; ++r) { const float f = wsf[crow(r, hi)]; o[0][r] *= f; o[1][r] *= f; }
        }
        float sacc = 0.f;
#pragma unroll
        for (int r = 0; r < 16; ++r) { p0[r] = __builtin_amdgcn_exp2f(p0[r] - m); p1[r] = __builtin_amdgcn_exp2f(p1[r] - m); sacc += p0[r] + p1[r]; }
        l += sacc;
        u32x4 pw0, pw1, pw2, pw3;
#define MLA_PKW(P, B) cvtpk_s(P[B], P[B + 1])
        pw0 = (u32x4){MLA_PKW(p0, 0), MLA_PKW(p0, 2), MLA_PKW(p0, 4), MLA_PKW(p0, 6)}; pw1 = (u32x4){MLA_PKW(p0, 8), MLA_PKW(p0, 10), MLA_PKW(p0, 12), MLA_PKW(p0, 14)};
        pw2 = (u32x4){MLA_PKW(p1, 0), MLA_PKW(p1, 2), MLA_PKW(p1, 4), MLA_PKW(p1, 6)}; pw3 = (u32x4){MLA_PKW(p1, 8), MLA_PKW(p1, 10), MLA_PKW(p1, 12), MLA_PKW(p1, 14)};
#undef MLA_PKW
        pv(o, vb0 + slot * VSLOT, __builtin_bit_cast(bf16x8, pw0), __builtin_bit_cast(bf16x8, pw1), __builtin_bit_cast(bf16x8, pw2), __builtin_bit_cast(bf16x8, pw3));
        slot = (slot == NSLOT - 1) ? 0 : slot + 1; slot2 = (slot2 == NSLOT - 1) ? 0 : slot2 + 1;
    }
    { auto rr = __builtin_amdgcn_permlane32_swap(__float_as_uint(l), __float_as_uint(l), false, false); l = __uint_as_float(rr[0]) + __uint_as_float(rr[1]); }
    if (hi == 0) wsf[32 + r32] = l; asm volatile("s_waitcnt lgkmcnt(0)" ::: "memory");
    float rli[16];
#pragma unroll
    for (int r = 0; r < 16; ++r) rli[r] = __builtin_amdgcn_rcpf(wsf[32 + crow(r, hi)]);
    unsigned short* Ow = O + (rowbase + q0 + wid * QBLK) * OP + 512 + h * 64;
    { __attribute__((address_space(3))) unsigned short* stg = (__attribute__((address_space(3))) unsigned short*)((lds_cptr)shm + LDS_OST) + wid * 2048;
#pragma unroll
      for (int r = 0; r < 16; ++r) { const int orow = crow(r, hi);
#pragma unroll
          for (int d0 = 0; d0 < 2; ++d0) stg[orow * 64 + d0 * 32 + r32] = (unsigned short)(cvtpk_s(o[d0][r] * rli[r], 0.f) & 0xffffu); }
      asm volatile("s_waitcnt lgkmcnt(0)" ::: "memory");
#pragma unroll
      for (int i = 0; i < 4; ++i) { const int row = i * 8 + (lane >> 3), ch = lane & 7; const u32x4 v = *(const __attribute__((address_space(3))) u32x4*)(stg + row * 64 + ch * 8); *(u32x4*)(Ow + (long)row * OP + ch * 8) = v; } }
    asm volatile("s_waitcnt vmcnt(0) lgkmcnt(0)\n\ts_barrier" ::: "memory");
#undef MLA_DMA
}

#define MLA_SB() __builtin_amdgcn_sched_barrier(0)
#define MLA_PIN(x) asm volatile("" : "+v"(x))
#define MLA_LDK(kp, d0, h) (*(const __attribute__((address_space(3))) bf16x8*)((kp) + (d0) * 2048 + (h) * 512))
#define MLA_E4(P, B) do { P[B] = __builtin_amdgcn_exp2f(P[B]); P[B + 1] = __builtin_amdgcn_exp2f(P[B + 1]); P[B + 2] = __builtin_amdgcn_exp2f(P[B + 2]); P[B + 3] = __builtin_amdgcn_exp2f(P[B + 3]); MLA_PIN(P); } while (0)
#define MLA_A4(P, B) do { sacc += P[B]; sacc += P[B + 1]; sacc += P[B + 2]; sacc += P[B + 3]; MLA_PIN(sacc); } while (0)
#define MLA_PK2(W, I, P, B) do { W[I] = cvtpk_s(P[B], P[B + 1]); W[I + 1] = cvtpk_s(P[B + 2], P[B + 3]); MLA_PIN(W); } while (0)
#define MLA_MF(C, K, Q) C = __builtin_amdgcn_mfma_f32_32x32x16_bf16(K, Q, C, 0, 0, 0)
#define MLA_MF0(C, K, Q) C = __builtin_amdgcn_mfma_f32_32x32x16_bf16(K, Q, negm, 0, 0, 0)
#define MLA_SOFT(P0, P1) do { float sacc = 0.f; \
    MLA_E4(P0, 0); MLA_E4(P0, 4); MLA_E4(P0, 8); MLA_E4(P0, 12); MLA_E4(P1, 0); MLA_E4(P1, 4); MLA_E4(P1, 8); MLA_E4(P1, 12); \
    MLA_A4(P0, 0); MLA_A4(P0, 4); MLA_A4(P0, 8); MLA_A4(P0, 12); MLA_A4(P1, 0); MLA_A4(P1, 4); MLA_A4(P1, 8); MLA_A4(P1, 12); \
    MLA_PK2(pw0, 0, P0, 0); MLA_PK2(pw0, 2, P0, 4); MLA_PK2(pw1, 0, P0, 8); MLA_PK2(pw1, 2, P0, 12); MLA_PK2(pw2, 0, P1, 0); MLA_PK2(pw2, 2, P1, 4); MLA_PK2(pw3, 0, P1, 8); MLA_PK2(pw3, 2, P1, 12); \
    l_reg += sacc; } while (0)
#define MLA_REF(C0, C1, RESC_O) do { const float rm_ = rowmax(C0, C1); \
    if (__builtin_expect(__any(rm_ > (float)THRL), 0)) { const float dl_ = fmaxf(rm_, 0.f); mhat += dl_; \
        _Pragma("unroll") for (int r = 0; r < 16; ++r) { C0[r] -= dl_; C1[r] -= dl_; } \
        _Pragma("unroll") for (int r = 0; r < 16; ++r) negm[r] = -mhat; MLA_PIN(negm); \
        const float f_ = __builtin_amdgcn_exp2f(-dl_); l_reg *= f_; \
        if (RESC_O) { if (hi == 0) wsf[r32] = f_; asm volatile("s_waitcnt lgkmcnt(0)" ::: "memory"); \
            _Pragma("unroll") for (int r = 0; r < 16; ++r) { const float g_ = wsf[crow(r, hi)]; o[0][r] *= g_; o[1][r] *= g_; } } } } while (0)
#define MLA_STEP(C0, C1, P0, P1, t, JB, WAITN, GK, GV) do { \
    MLA_WAIT_BAR(WAITN); \
    if (GK) { glds16(ksrc + (long)((t) + 3) * KVBLK * KVP, (unsigned)__builtin_amdgcn_readfirstlane(kdst + s0 * KSLOT)); \
              if (lane < 32) glds16(psrc + (long)((t) + 3) * KVBLK * PEP, (unsigned)__builtin_amdgcn_readfirstlane(pdst + s0 * KSLOT)); } \
    if (GV) { glds16(vsrc + (long)((t) + 2) * KVBLK * KVP, (unsigned)__builtin_amdgcn_readfirstlane(vdst + s2 * VSLOT)); } \
    { const lds_cptr kp = kp0 + s1 * KSLOT; float sacc = 0.f; bf16x8 ka0, ka1, kb0, kb1; \
      ka0 = MLA_LDK(kp, 0, 0); ka1 = MLA_LDK(kp, 0, 1); MLA_E4(P0, 0); MLA_E4(P0, 4); MLA_SB(); \
      kb0 = MLA_LDK(kp, 1, 0); kb1 = MLA_LDK(kp, 1, 1); \
      MLA_MF0(C0, ka0, qr[0]); MLA_E4(P0, 8); MLA_SB(); \
      MLA_MF0(C1, ka1, qr[0]); MLA_E4(P0, 12); MLA_A4(P0, 0); MLA_SB(); \
      ka0 = MLA_LDK(kp, 2, 0); ka1 = MLA_LDK(kp, 2, 1); \
      MLA_MF(C0, kb0, qr[1]); MLA_E4(P1, 0); MLA_A4(P0, 4); MLA_SB(); \
      MLA_MF(C1, kb1, qr[1]); MLA_E4(P1, 4); MLA_A4(P0, 8); MLA_PK2(pw0, 0, P0, 0); MLA_SB(); \
      kb0 = MLA_LDK(kp, 3, 0); kb1 = MLA_LDK(kp, 3, 1); \
      MLA_MF(C0, ka0, qr[2]); MLA_E4(P1, 8); MLA_A4(P0, 12); MLA_PK2(pw0, 2, P0, 4); MLA_SB(); \
      MLA_MF(C1, ka1, qr[2]); MLA_E4(P1, 12); MLA_A4(P1, 0); MLA_PK2(pw1, 0, P0, 8); MLA_SB(); \
      ka0 = MLA_LDK(kp, 4, 0); ka1 = MLA_LDK(kp, 4, 1); \
      MLA_MF(C0, kb0, qr[3]); MLA_A4(P1, 4); MLA_PK2(pw1, 2, P0, 12); MLA_SB(); \
      MLA_MF(C1, kb1, qr[3]); MLA_A4(P1, 8); MLA_PK2(pw2, 0, P1, 0); MLA_SB(); \
      kb0 = MLA_LDK(kp, 5, 0); kb1 = MLA_LDK(kp, 5, 1); \
      MLA_MF(C0, ka0, qr[4]); MLA_A4(P1, 12); MLA_PK2(pw2, 2, P1, 4); MLA_SB(); \
      MLA_MF(C1, ka1, qr[4]); MLA_PK2(pw3, 0, P1, 8); MLA_SB(); \
      MLA_MF(C0, kb0, qr[5]); MLA_PK2(pw3, 2, P1, 12); MLA_SB(); \
      MLA_MF(C1, kb1, qr[5]); MLA_SB(); \
      l_reg += sacc; } \
    pv(o, vb0 + s0 * VSLOT, __builtin_bit_cast(bf16x8, pw0), __builtin_bit_cast(bf16x8, pw1), __builtin_bit_cast(bf16x8, pw2), __builtin_bit_cast(bf16x8, pw3)); \
    if ((JB) >= 0) cmask(C0, C1, (JB), qrel, hi); \
    MLA_REF(C0, C1, true); \
    { const int s_ = s0; s0 = s1; s1 = s2; s2 = s_; } \
} while (0)

template <int THRL> __device__ __forceinline__ void unit_pipe(int b, int h, int qb, const unsigned short* Q, const unsigned short* KV, const unsigned short* KPE, unsigned short* O, char* shm, const int wave_) {
    int tid_ = tid_from_wave(wave_); asm volatile("" : "+v"(tid_));
    const int tid = tid_, lane = tid & 63, r32 = lane & 31, hi = lane >> 5; const int wid = __builtin_amdgcn_readfirstlane(tid >> 6);
    const long rowbase = (long)b * SEQ; const int q0 = qb * QB;
    const unsigned short* Qw = Q + (rowbase + q0 + wid * QBLK) * QP + h * 96;
    const unsigned short* Kh = KV + rowbase * KVP + h * 128; const unsigned short* Vh = Kh + 64; const unsigned short* Ph = KPE + rowbase * PEP;
    const unsigned lds0 = (unsigned)(uintptr_t)shm;
    __attribute__((address_space(3))) float* wsf = (__attribute__((address_space(3))) float*)((lds_cptr)shm + LDS_WS) + wid * 64;
    const unsigned short* ksrc = Kh + (long)lane * KVP + wid * 8;
    const unsigned short* psrc = Ph + (long)(32 * (wid & 1) + r32) * PEP + (wid >> 1) * 8;
    const unsigned short* vsrc = Vh + (long)(16 * (wid & 3) + (lane >> 2)) * KVP + (wid >> 2) * 32 + (lane & 3) * 8;
    const unsigned kdst = lds0 + LDS_K + wid * 1024, pdst = lds0 + LDS_K + (8 + (wid >> 1)) * 1024 + (wid & 1) * 512, vdst = lds0 + LDS_V + wid * 1024;
    const int vb0 = (int)(lds0 + LDS_V) + ((lane >> 4) & 1) * 32 + (lane & 3) * 8 + (4 * hi + ((lane & 15) >> 2)) * 64;
    const lds_cptr kp0 = (lds_cptr)shm + LDS_K + hi * 1024 + r32 * 16;
    const int NT = (q0 + QB) / KVBLK;
    bf16x8 qr[6];
#pragma unroll
    for (int d0 = 0; d0 < 6; ++d0) qr[d0] = *reinterpret_cast<const bf16x8*>(&Qw[(long)r32 * QP + d0 * 16 + hi * 8]);
    asm volatile("s_waitcnt vmcnt(0)" ::: "memory");
    glds16(ksrc, (unsigned)__builtin_amdgcn_readfirstlane(kdst)); if (lane < 32) glds16(psrc, (unsigned)__builtin_amdgcn_readfirstlane(pdst));
    glds16(ksrc + (long)KVBLK * KVP, (unsigned)__builtin_amdgcn_readfirstlane(kdst + KSLOT)); if (lane < 32) glds16(psrc + (long)KVBLK * PEP, (unsigned)__builtin_amdgcn_readfirstlane(pdst + KSLOT)); glds16(vsrc, (unsigned)__builtin_amdgcn_readfirstlane(vdst));
    glds16(ksrc + (long)2 * KVBLK * KVP, (unsigned)__builtin_amdgcn_readfirstlane(kdst + 2 * KSLOT)); if (lane < 32) glds16(psrc + (long)2 * KVBLK * PEP, (unsigned)__builtin_amdgcn_readfirstlane(pdst + 2 * KSLOT)); glds16(vsrc + (long)KVBLK * KVP, (unsigned)__builtin_amdgcn_readfirstlane(vdst + VSLOT));
    float mhat = 0.f, l_reg = 0.f; f32x16 o[2]; o[0] = f32x16{}; o[1] = f32x16{}; f32x16 negm = f32x16{}; MLA_PIN(negm);
    const int qrel = wid * QBLK + r32;
    f32x16 pA0, pA1, pB0, pB1; u32x4 pw0, pw1, pw2, pw3;
    int s0 = 0, s1 = 1, s2 = 2;
    MLA_WAIT_BAR(6);
    { const lds_cptr kp = kp0;
      pA0 = f32x16{}; pA1 = f32x16{};
#pragma unroll
      for (int d0 = 0; d0 < 6; ++d0) { const bf16x8 k0 = MLA_LDK(kp, d0, 0), k1 = MLA_LDK(kp, d0, 1); MLA_MF(pA0, k0, qr[d0]); MLA_MF(pA1, k1, qr[d0]); } }
    { const float rm_ = rowmax(pA0, pA1); mhat = rm_;
#pragma unroll
      for (int r = 0; r < 16; ++r) { pA0[r] -= rm_; pA1[r] -= rm_; negm[r] = -mhat; }
      MLA_PIN(negm); }
    int t = 0;
    MLA_STEP(pB0, pB1, pA0, pA1, t, -1, 3, true, true); ++t;
    for (; t + 1 <= NT - 6; t += 2) {
        MLA_STEP(pA0, pA1, pB0, pB1, t, -1, 3, true, true);
        MLA_STEP(pB0, pB1, pA0, pA1, t + 1, -1, 3, true, true);
    }
    MLA_STEP(pA0, pA1, pB0, pB1, t, 0, 3, true, true); ++t;
    MLA_STEP(pB0, pB1, pA0, pA1, t, 1, 3, true, true); ++t;
    MLA_STEP(pA0, pA1, pB0, pB1, t, 2, 3, false, true); ++t;
    MLA_STEP(pB0, pB1, pA0, pA1, t, 3, 1, false, false); ++t;
    MLA_WAIT_BAR(0);
    MLA_SOFT(pB0, pB1);
    pv(o, vb0 + s0 * VSLOT, __builtin_bit_cast(bf16x8, pw0), __builtin_bit_cast(bf16x8, pw1), __builtin_bit_cast(bf16x8, pw2), __builtin_bit_cast(bf16x8, pw3));
    { auto rr = __builtin_amdgcn_permlane32_swap(__float_as_uint(l_reg), __float_as_uint(l_reg), false, false); l_reg = __uint_as_float(rr[0]) + __uint_as_float(rr[1]); }
    if (hi == 0) wsf[32 + r32] = l_reg; asm volatile("s_waitcnt lgkmcnt(0)" ::: "memory");
    float rli[16];
#pragma unroll
    for (int r = 0; r < 16; ++r) rli[r] = __builtin_amdgcn_rcpf(wsf[32 + crow(r, hi)]);
    unsigned short* Ow = O + (rowbase + q0 + wid * QBLK) * OP + 512 + h * 64;
    { __attribute__((address_space(3))) unsigned short* stg = (__attribute__((address_space(3))) unsigned short*)((lds_cptr)shm + LDS_OST) + wid * 2048;
#pragma unroll
      for (int r = 0; r < 16; ++r) { const int orow = crow(r, hi);
#pragma unroll
          for (int d0 = 0; d0 < 2; ++d0) stg[orow * 64 + d0 * 32 + r32] = (unsigned short)(cvtpk_s(o[d0][r] * rli[r], 0.f) & 0xffffu); }
      asm volatile("s_waitcnt lgkmcnt(0)" ::: "memory");
#pragma unroll
      for (int i = 0; i < 4; ++i) { const int row = i * 8 + (lane >> 3), ch = lane & 7; const u32x4 v = *(const __attribute__((address_space(3))) u32x4*)(stg + row * 64 + ch * 8); *(u32x4*)(Ow + (long)row * OP + ch * 8) = v; } }
    asm volatile("s_waitcnt vmcnt(0) lgkmcnt(0)\n\ts_barrier" ::: "memory");
}

constexpr int S4_V = NSLOT * KSLOT, S4_WS = S4_V + 4 * VSLOT, S4_OST = S4_WS + NW * 64 * 4, S4_TOTAL = S4_OST + NW * 4096;
#define MLA_R1(C0, C1, P0, P1, kp) do { float sacc = 0.f; bf16x8 ka0, ka1, kb0, kb1; \
      ka0 = MLA_LDK(kp, 0, 0); ka1 = MLA_LDK(kp, 0, 1); MLA_E4(P0, 0); MLA_E4(P0, 4); MLA_SB(); \
      kb0 = MLA_LDK(kp, 1, 0); kb1 = MLA_LDK(kp, 1, 1); \
      MLA_MF0(C0, ka0, qr[0]); MLA_E4(P0, 8); MLA_SB(); \
      MLA_MF0(C1, ka1, qr[0]); MLA_E4(P0, 12); MLA_A4(P0, 0); MLA_SB(); \
      ka0 = MLA_LDK(kp, 2, 0); ka1 = MLA_LDK(kp, 2, 1); \
      MLA_MF(C0, kb0, qr[1]); MLA_E4(P1, 0); MLA_A4(P0, 4); MLA_SB(); \
      MLA_MF(C1, kb1, qr[1]); MLA_E4(P1, 4); MLA_A4(P0, 8); MLA_PK2(pw0, 0, P0, 0); MLA_SB(); \
      kb0 = MLA_LDK(kp, 3, 0); kb1 = MLA_LDK(kp, 3, 1); \
      MLA_MF(C0, ka0, qr[2]); MLA_E4(P1, 8); MLA_A4(P0, 12); MLA_PK2(pw0, 2, P0, 4); MLA_SB(); \
      MLA_MF(C1, ka1, qr[2]); MLA_E4(P1, 12); MLA_A4(P1, 0); MLA_PK2(pw1, 0, P0, 8); MLA_SB(); \
      ka0 = MLA_LDK(kp, 4, 0); ka1 = MLA_LDK(kp, 4, 1); \
      MLA_MF(C0, kb0, qr[3]); MLA_A4(P1, 4); MLA_PK2(pw1, 2, P0, 12); MLA_SB(); \
      MLA_MF(C1, kb1, qr[3]); MLA_A4(P1, 8); MLA_PK2(pw2, 0, P1, 0); MLA_SB(); \
      kb0 = MLA_LDK(kp, 5, 0); kb1 = MLA_LDK(kp, 5, 1); \
      MLA_MF(C0, ka0, qr[4]); MLA_A4(P1, 12); MLA_PK2(pw2, 2, P1, 4); MLA_SB(); \
      MLA_MF(C1, ka1, qr[4]); MLA_PK2(pw3, 0, P1, 8); MLA_SB(); \
      MLA_MF(C0, kb0, qr[5]); MLA_PK2(pw3, 2, P1, 12); MLA_SB(); \
      MLA_MF(C1, kb1, qr[5]); MLA_SB(); \
      l_reg += sacc; } while (0)
#define MLA_PVW(slot) pv(o, vb0 + (slot) * VSLOT, __builtin_bit_cast(bf16x8, pw0), __builtin_bit_cast(bf16x8, pw1), __builtin_bit_cast(bf16x8, pw2), __builtin_bit_cast(bf16x8, pw3))
#define MLA_DMA4(t, GK, GV) do { \
    if (GK) { glds16(ksrc + (long)((t) + 3) * KVBLK * KVP, (unsigned)__builtin_amdgcn_readfirstlane(kdst + s0 * KSLOT)); \
              if (lane < 32) glds16(psrc + (long)((t) + 3) * KVBLK * PEP, (unsigned)__builtin_amdgcn_readfirstlane(pdst + s0 * KSLOT)); } \
    if (GV) { glds16(vsrc + (long)((t) + 2) * KVBLK * KVP, (unsigned)__builtin_amdgcn_readfirstlane(vdst + (((t) + 2) & 3) * VSLOT)); } } while (0)
#define MLA_REFB(C0, C1) do { const float rm_ = rowmax(C0, C1); \
      if (__builtin_expect(__any(rm_ > (float)THRL), 0)) { const float dl_ = fmaxf(rm_, 0.f); mhat += dl_; \
          _Pragma("unroll") for (int r = 0; r < 16; ++r) { C0[r] -= dl_; C1[r] -= dl_; } \
          _Pragma("unroll") for (int r = 0; r < 16; ++r) negm[r] = -mhat; MLA_PIN(negm); \
          const float f_ = __builtin_amdgcn_exp2f(-dl_); l_reg *= f_; if (hi == 0) wsf[r32] = f_; resc = true; } } while (0)
#define MLA_RESCB() do { if (resc) { asm volatile("s_waitcnt lgkmcnt(0)" ::: "memory"); _Pragma("unroll") for (int r = 0; r < 16; ++r) { const float g_ = wsf[crow(r, hi)]; o[0][r] *= g_; o[1][r] *= g_; } resc = false; } } while (0)
#define MLA_STEPS(C0, C1, P0, P1, t, JB, WAITN, GK, GV, HASPV) do { \
    MLA_WAIT_BAR(WAITN); MLA_DMA4(t, GK, GV); \
    if (LATE) { if (HASPV) { MLA_PVW(((t) + 3) & 3); } MLA_RESCB(); } \
    { const lds_cptr kp = kp0 + s1 * KSLOT; MLA_R1(C0, C1, P0, P1, kp); } \
    if (!LATE) { MLA_PVW((t) & 3); } \
    if ((JB) >= 0) cmask(C0, C1, (JB), qrel, hi); \
    if (LATE) MLA_REFB(C0, C1); else MLA_REF(C0, C1, true); \
    { const int s_ = s0; s0 = s1; s1 = s2; s2 = s_; } } while (0)

template <int THRL, bool LATE> __device__ __forceinline__ void unit_stag(int b, int h, int qb, const unsigned short* Q, const unsigned short* KV, const unsigned short* KPE, unsigned short* O, char* shm, const int wave_) {
    int tid_ = tid_from_wave(wave_); asm volatile("" : "+v"(tid_));
    const int tid = tid_, lane = tid & 63, r32 = lane & 31, hi = lane >> 5; const int wid = __builtin_amdgcn_readfirstlane(tid >> 6);
    const long rowbase = (long)b * SEQ; const int q0 = qb * QB;
    const unsigned short* Qw = Q + (rowbase + q0 + wid * QBLK) * QP + h * 96;
    const unsigned short* Kh = KV + rowbase * KVP + h * 128; const unsigned short* Vh = Kh + 64; const unsigned short* Ph = KPE + rowbase * PEP;
    const unsigned lds0 = (unsigned)(uintptr_t)shm;
    __attribute__((address_space(3))) float* wsf = (__attribute__((address_space(3))) float*)((lds_cptr)shm + S4_WS) + wid * 64;
    const unsigned short* ksrc = Kh + (long)lane * KVP + wid * 8;
    const unsigned short* psrc = Ph + (long)(32 * (wid & 1) + r32) * PEP + (wid >> 1) * 8;
    const unsigned short* vsrc = Vh + (long)(16 * (wid & 3) + (lane >> 2)) * KVP + (wid >> 2) * 32 + (lane & 3) * 8;
    const unsigned kdst = lds0 + LDS_K + wid * 1024, pdst = lds0 + LDS_K + (8 + (wid >> 1)) * 1024 + (wid & 1) * 512, vdst = lds0 + S4_V + wid * 1024;
    const int vb0 = (int)(lds0 + S4_V) + ((lane >> 4) & 1) * 32 + (lane & 3) * 8 + (4 * hi + ((lane & 15) >> 2)) * 64;
    const lds_cptr kp0 = (lds_cptr)shm + LDS_K + hi * 1024 + r32 * 16;
    const int NT = (q0 + QB) / KVBLK;
    bf16x8 qr[6];
#pragma unroll
    for (int d0 = 0; d0 < 6; ++d0) qr[d0] = *reinterpret_cast<const bf16x8*>(&Qw[(long)r32 * QP + d0 * 16 + hi * 8]);
    asm volatile("s_waitcnt vmcnt(0)" ::: "memory");
    glds16(ksrc, (unsigned)__builtin_amdgcn_readfirstlane(kdst)); if (lane < 32) glds16(psrc, (unsigned)__builtin_amdgcn_readfirstlane(pdst));
    glds16(ksrc + (long)KVBLK * KVP, (unsigned)__builtin_amdgcn_readfirstlane(kdst + KSLOT)); if (lane < 32) glds16(psrc + (long)KVBLK * PEP, (unsigned)__builtin_amdgcn_readfirstlane(pdst + KSLOT)); glds16(vsrc, (unsigned)__builtin_amdgcn_readfirstlane(vdst));
    glds16(ksrc + (long)2 * KVBLK * KVP, (unsigned)__builtin_amdgcn_readfirstlane(kdst + 2 * KSLOT)); if (lane < 32) glds16(psrc + (long)2 * KVBLK * PEP, (unsigned)__builtin_amdgcn_readfirstlane(pdst + 2 * KSLOT)); glds16(vsrc + (long)KVBLK * KVP, (unsigned)__builtin_amdgcn_readfirstlane(vdst + VSLOT));
    float mhat = 0.f, l_reg = 0.f; f32x16 o[2]; o[0] = f32x16{}; o[1] = f32x16{}; f32x16 negm = f32x16{}; MLA_PIN(negm);
    const int qrel = wid * QBLK + r32; bool resc = false;
    f32x16 pA0, pA1, pB0, pB1; u32x4 pw0, pw1, pw2, pw3;
    int s0 = 0, s1 = 1, s2 = 2;
    MLA_WAIT_BAR(6);
    { const lds_cptr kp = kp0;
      pA0 = f32x16{}; pA1 = f32x16{};
#pragma unroll
      for (int d0 = 0; d0 < 6; ++d0) { const bf16x8 k0 = MLA_LDK(kp, d0, 0), k1 = MLA_LDK(kp, d0, 1); MLA_MF(pA0, k0, qr[d0]); MLA_MF(pA1, k1, qr[d0]); } }
    { const float rm_ = rowmax(pA0, pA1); mhat = rm_;
#pragma unroll
      for (int r = 0; r < 16; ++r) { pA0[r] -= rm_; pA1[r] -= rm_; negm[r] = -mhat; }
      MLA_PIN(negm); }
    int t = 0;
    MLA_STEPS(pB0, pB1, pA0, pA1, t, -1, 3, true, true, false); ++t;
    for (; t + 1 <= NT - 6; t += 2) {
        MLA_STEPS(pA0, pA1, pB0, pB1, t, -1, 3, true, true, true);
        MLA_STEPS(pB0, pB1, pA0, pA1, t + 1, -1, 3, true, true, true);
    }
    MLA_STEPS(pA0, pA1, pB0, pB1, t, 0, 3, true, true, true); ++t;
    MLA_STEPS(pB0, pB1, pA0, pA1, t, 1, 3, true, true, true); ++t;
    MLA_STEPS(pA0, pA1, pB0, pB1, t, 2, 3, false, true, true); ++t;
    MLA_STEPS(pB0, pB1, pA0, pA1, t, 3, 1, false, false, true); ++t;
    MLA_WAIT_BAR(0);
    if (LATE) { MLA_PVW((NT - 2) & 3); MLA_RESCB(); }
    MLA_SOFT(pB0, pB1);
    MLA_PVW((NT - 1) & 3);
    { auto rr = __builtin_amdgcn_permlane32_swap(__float_as_uint(l_reg), __float_as_uint(l_reg), false, false); l_reg = __uint_as_float(rr[0]) + __uint_as_float(rr[1]); }
    if (hi == 0) wsf[32 + r32] = l_reg; asm volatile("s_waitcnt lgkmcnt(0)" ::: "memory");
    float rli[16];
#pragma unroll
    for (int r = 0; r < 16; ++r) rli[r] = __builtin_amdgcn_rcpf(wsf[32 + crow(r, hi)]);
    unsigned short* Ow = O + (rowbase + q0 + wid * QBLK) * OP + 512 + h * 64;
    { __attribute__((address_space(3))) unsigned short* stg = (__attribute__((address_space(3))) unsigned short*)((lds_cptr)shm + S4_OST) + wid * 2048;
#pragma unroll
      for (int r = 0; r < 16; ++r) { const int orow = crow(r, hi);
#pragma unroll
          for (int d0 = 0; d0 < 2; ++d0) stg[orow * 64 + d0 * 32 + r32] = (unsigned short)(cvtpk_s(o[d0][r] * rli[r], 0.f) & 0xffffu); }
      asm volatile("s_waitcnt lgkmcnt(0)" ::: "memory");
#pragma unroll
      for (int i = 0; i < 4; ++i) { const int row = i * 8 + (lane >> 3), ch = lane & 7; const u32x4 v = *(const __attribute__((address_space(3))) u32x4*)(stg + row * 64 + ch * 8); *(u32x4*)(Ow + (long)row * OP + ch * 8) = v; } }
    asm volatile("s_waitcnt vmcnt(0) lgkmcnt(0)\n\ts_barrier" ::: "memory");
}
__device__ __forceinline__ void phase(char* lds, const unsigned short* Q, const unsigned short* KV, const unsigned short* KPE, unsigned short* O, int vcu, int G, const int wave_) {
    for (int v = vcu; v < 256; v += G) { const int s = v & 7, bh = v >> 3;
#pragma unroll 1
        for (int i = 0; i < 4; ++i) { const int qb = (i == 0) ? s : (i == 1) ? 15 - s : (i == 2) ? 16 + s : 31 - s; if (qb == 0) unit(bh >> 3, bh & 7, qb, Q, KV, KPE, O, lds, wave_); else if (wave_ < 4) unit_stag<8, false>(bh >> 3, bh & 7, qb, Q, KV, KPE, O, lds, wave_); else unit_stag<8, true>(bh >> 3, bh & 7, qb, Q, KV, KPE, O, lds, wave_); } }
}
#undef MLA_WAIT_BAR
}

namespace evm {
using bf16x8 = __attribute__((ext_vector_type(8))) short;
using s16x4 = __attribute__((ext_vector_type(4))) short;
using f32x16 = __attribute__((ext_vector_type(16))) float;
using u32x4 = __attribute__((ext_vector_type(4))) unsigned;
typedef __attribute__((address_space(3))) char* lds_ptr;
constexpr int PP = 1792, VNP = 1088;
constexpr int LDS_VT = 0, LDS_WS = 65536, LDS_OST = LDS_WS + 2048, LDS_TOTAL = 139264;
__device__ __forceinline__ s16x4 trr(int addr) { s16x4 v; asm volatile("ds_read_b64_tr_b16 %0,%1" : "=&v"(v) : "v"(addr) : "memory"); return v; }
#define EVM_TR(dst, addr, off) asm volatile("ds_read_b64_tr_b16 %0,%1 offset:%c2" : "=&v"(dst) : "v"(addr), "i"(off) : "memory")
__device__ __forceinline__ float bflo(unsigned u) { return __uint_as_float(u << 16); }
__device__ __forceinline__ float bfhi(unsigned u) { return __uint_as_float(u & 0xffff0000u); }

__device__ __forceinline__ void unit(int un, const unsigned short* proj, const float* sinks, const float* ln_g, const float* ln_b, const unsigned short* wsb, const float* b_s, unsigned short* mix, char* shm, const int wave_) {
    int tid_ = tid_from_wave(wave_); asm volatile("" : "+v"(tid_));
    const int tid = tid_, lane = tid & 63, r32 = lane & 31, hi = lane >> 5; const int wid = __builtin_amdgcn_readfirstlane(tid >> 6);
    const int row0 = un * 128, tblk = (un & 63) * 128, seq0 = row0 - tblk;
    const lds_ptr L = (lds_ptr)shm; const unsigned lds0 = (unsigned)(uintptr_t)shm;
    for (int i = 0; i < 16; ++i) { const int tl = wid * 16 + i, grow = row0 + tl;
        const u32x4 w = *(const u32x4*)(proj + (size_t)grow * PP + 1280 + lane * 8);
        float x[8] = {bflo(w.x), bfhi(w.x), bflo(w.y), bfhi(w.y), bflo(w.z), bfhi(w.z), bflo(w.w), bfhi(w.w)};
        float s = 0.f;
#pragma unroll
        for (int j = 0; j < 8; ++j) s += x[j];
#pragma unroll
        for (int o = 1; o < 64; o <<= 1) s += __shfl_xor(s, o);
        const float mu = s * (1.f / 512.f); float qq = 0.f;
#pragma unroll
        for (int j = 0; j < 8; ++j) { x[j] -= mu; qq += x[j] * x[j]; }
#pragma unroll
        for (int o = 1; o < 64; o <<= 1) qq += __shfl_xor(qq, o);
        const float rstd = 1.0f / sqrtf(qq * (1.f / 512.f) + 1e-6f);
        const f32x4 g0 = ((const f32x4*)ln_g)[lane * 2], g1 = ((const f32x4*)ln_g)[lane * 2 + 1], b0 = ((const f32x4*)ln_b)[lane * 2], b1 = ((const f32x4*)ln_b)[lane * 2 + 1];
        u32x4 ov; ov.x = pg8::cvt_pk_bf16(x[0] * rstd * g0.x + b0.x, x[1] * rstd * g0.y + b0.y); ov.y = pg8::cvt_pk_bf16(x[2] * rstd * g0.z + b0.z, x[3] * rstd * g0.w + b0.w);
        ov.z = pg8::cvt_pk_bf16(x[4] * rstd * g1.x + b1.x, x[5] * rstd * g1.y + b1.y); ov.w = pg8::cvt_pk_bf16(x[6] * rstd * g1.z + b1.z, x[7] * rstd * g1.w + b1.w);
        *(__attribute__((address_space(3))) u32x4*)(L + tl * VNP + lane * 16) = ov; }
    __syncthreads();
    { const int g = wid;
      const int trb = (int)lds0 + ((lane >> 4) & 1) * 32 + (lane & 3) * 8 + (8 * hi + ((lane & 15) >> 2)) * VNP + g * 128;
#pragma unroll 1
      for (int i = 0; i < 4; ++i) { f32x16 a0 = f32x16{}, a1 = f32x16{};
          for (int s = 0; s < 2 * i + 2; ++s) {
              const bf16x8 A = *(const bf16x8*)(wsb + ((size_t)(g * 128 + 32 * i + r32) * 128 + 16 * s + 8 * hi));
              const int ad = trb + s * 16 * VNP; s16x4 l0, h0, l1, h1;
              EVM_TR(l0, ad, 0); EVM_TR(h0, ad, 4 * VNP); EVM_TR(l1, ad, 64); EVM_TR(h1, ad, 64 + 4 * VNP);
              asm volatile("s_waitcnt lgkmcnt(0)" : "+v"(l0), "+v"(h0), "+v"(l1), "+v"(h1) :: "memory"); __builtin_amdgcn_sched_barrier(0);
              const bf16x8 B0 = (bf16x8){l0[0], l0[1], l0[2], l0[3], h0[0], h0[1], h0[2], h0[3]}, B1 = (bf16x8){l1[0], l1[1], l1[2], l1[3], h1[0], h1[1], h1[2], h1[3]};
              a0 = __builtin_amdgcn_mfma_f32_32x32x16_bf16(A, B0, a0, 0, 0, 0); a1 = __builtin_amdgcn_mfma_f32_32x32x16_bf16(A, B1, a1, 0, 0, 0); }
#pragma unroll
          for (int r = 0; r < 16; ++r) { const int t = 32 * i + (r & 3) + 8 * (r >> 2) + 4 * hi; const float bs = b_s[g * 128 + t];
              const unsigned short* up = proj + (size_t)(row0 + t) * PP + 768 + g * 64 + r32; unsigned short* op = mix + (size_t)(row0 + t) * 1024 + 512 + g * 64 + r32;
              const float u0 = __uint_as_float(((unsigned)up[0]) << 16), u1 = __uint_as_float(((unsigned)up[32]) << 16);
              op[0] = (unsigned short)(pg8::cvt_pk_bf16(u0 * (a0[r] + bs), 0.f) & 0xffffu); op[32] = (unsigned short)(pg8::cvt_pk_bf16(u1 * (a1[r] + bs), 0.f) & 0xffffu); } } }
    asm volatile("s_waitcnt vmcnt(0) lgkmcnt(0)" ::: "memory");
    __syncthreads();
    { const int h = wid, kvh = h >> 2; const bool first = (tblk == 0);
#pragma unroll
      for (int T = 0; T < 8; ++T) { const int jt = T & 3; if (first && jt < 2) continue;
          const unsigned short* src = proj + (size_t)(seq0 + tblk - 128 + 64 * jt + 16 * (wid & 3) + (lane >> 2)) * PP + 640 + (T >> 2) * 64 + (wid >> 2) * 32 + (lane & 3) * 8;
          mla::glds16(src, (unsigned)__builtin_amdgcn_readfirstlane(lds0 + LDS_VT + T * 8192 + wid * 1024)); }
      asm volatile("s_waitcnt vmcnt(0)\n\ts_barrier" ::: "memory");
      const float slope2 = __builtin_amdgcn_exp2f(-(float)(h + 1)) * 1.4426950408889634f, sink2 = sinks[h] * 1.4426950408889634f;
      const int vb0 = (int)(lds0 + LDS_VT) + ((lane >> 4) & 1) * 32 + (lane & 3) * 8 + (4 * hi + ((lane & 15) >> 2)) * 64 + kvh * 4 * 8192;
      __attribute__((address_space(3))) float* wsf = (__attribute__((address_space(3))) float*)(L + LDS_WS) + wid * 64;
      __attribute__((address_space(3))) unsigned short* stg = (__attribute__((address_space(3))) unsigned short*)(L + LDS_OST) + wid * 2048;
#pragma unroll 1
      for (int i = 0; i < 4; ++i) {
          bf16x8 qr[4];
#pragma unroll
          for (int d0 = 0; d0 < 4; ++d0) qr[d0] = *(const bf16x8*)(proj + (size_t)(row0 + 32 * i + r32) * PP + h * 64 + d0 * 16 + hi * 8);
          f32x16 S[5]; float mx = sink2;
#pragma unroll
          for (int jj = 0; jj < 5; ++jj) { const int j = i + jj; S[jj] = f32x16{};
              if (first && j < 4) continue;
              const unsigned short* kp = proj + (size_t)(seq0 + tblk - 128 + 32 * j + r32) * PP + 512 + kvh * 64 + hi * 8;
              bf16x8 kf[4];
#pragma unroll
              for (int d0 = 0; d0 < 4; ++d0) kf[d0] = *(const bf16x8*)(kp + d0 * 16);
#pragma unroll
              for (int d0 = 0; d0 < 4; ++d0) S[jj] = __builtin_amdgcn_mfma_f32_32x32x16_bf16(kf[d0], qr[d0], S[jj], 0, 0, 0);
#pragma unroll
              for (int r = 0; r < 16; ++r) { const int dist = (128 + 32 * i + r32) - (32 * j + (r & 3) + 8 * (r >> 2) + 4 * hi);
                  const float v = S[jj][r] - slope2 * (float)dist; const bool ok = dist >= 0 && dist < 128;
                  S[jj][r] = ok ? v : -INFINITY; mx = fmaxf(mx, S[jj][r]); } }
          { auto rr = __builtin_amdgcn_permlane32_swap(__float_as_uint(mx), __float_as_uint(mx), false, false); mx = fmaxf(__uint_as_float(rr[0]), __uint_as_float(rr[1])); }
          float l = 0.f; f32x16 o[2]; o[0] = f32x16{}; o[1] = f32x16{};
#pragma unroll
          for (int jj = 0; jj < 5; ++jj) { const int j = i + jj;
              if (first && j < 4) continue;
#pragma unroll
              for (int r = 0; r < 16; ++r) { S[jj][r] = __builtin_amdgcn_exp2f(S[jj][r] - mx); l += S[jj][r]; }
              u32x4 pw0, pw1;
              pw0 = (u32x4){mla::cvtpk_s(S[jj][0], S[jj][1]), mla::cvtpk_s(S[jj][2], S[jj][3]), mla::cvtpk_s(S[jj][4], S[jj][5]), mla::cvtpk_s(S[jj][6], S[jj][7])};
              pw1 = (u32x4){mla::cvtpk_s(S[jj][8], S[jj][9]), mla::cvtpk_s(S[jj][10], S[jj][11]), mla::cvtpk_s(S[jj][12], S[jj][13]), mla::cvtpk_s(S[jj][14], S[jj][15])};
              const int va = vb0 + (j >> 1) * 8192 + (j & 1) * 2048;
#pragma unroll
              for (int d0 = 0; d0 < 2; ++d0) { s16x4 l0, h0, l1, h1;
                  EVM_TR(l0, va, d0 * 4096); EVM_TR(h0, va, d0 * 4096 + 512); EVM_TR(l1, va, d0 * 4096 + 1024); EVM_TR(h1, va, d0 * 4096 + 1024 + 512);
                  asm volatile("s_waitcnt lgkmcnt(0)" : "+v"(l0), "+v"(h0), "+v"(l1), "+v"(h1) :: "memory"); __builtin_amdgcn_sched_barrier(0);
                  const bf16x8 V0 = (bf16x8){l0[0], l0[1], l0[2], l0[3], h0[0], h0[1], h0[2], h0[3]}, V1 = (bf16x8){l1[0], l1[1], l1[2], l1[3], h1[0], h1[1], h1[2], h1[3]};
                  o[d0] = __builtin_amdgcn_mfma_f32_32x32x16_bf16(__builtin_bit_cast(bf16x8, pw0), V0, o[d0], 0, 0, 0);
                  o[d0] = __builtin_amdgcn_mfma_f32_32x32x16_bf16(__builtin_bit_cast(bf16x8, pw1), V1, o[d0], 0, 0, 0); } }
          { auto rr = __builtin_amdgcn_permlane32_swap(__float_as_uint(l), __float_as_uint(l), false, false); l = __uint_as_float(rr[0]) + __uint_as_float(rr[1]); }
          l += __builtin_amdgcn_exp2f(sink2 - mx);
          if (hi == 0) wsf[r32] = l; asm volatile("s_waitcnt lgkmcnt(0)" ::: "memory");
#pragma unroll
          for (int r = 0; r < 16; ++r) { const int orow = (r & 3) + 8 * (r >> 2) + 4 * hi; const float rl = __builtin_amdgcn_rcpf(wsf[orow]);
#pragma unroll
              for (int d0 = 0; d0 < 2; ++d0) stg[orow * 64 + d0 * 32 + r32] = (unsigned short)(mla::cvtpk_s(o[d0][r] * rl, 0.f) & 0xffffu); }
          asm volatile("s_waitcnt lgkmcnt(0)" ::: "memory");
          unsigned short* Ow = mix + (size_t)(row0 + 32 * i) * 1024 + h * 64;
#pragma unroll
          for (int k = 0; k < 4; ++k) { const int row = k * 8 + (lane >> 3), ch = lane & 7; const u32x4 v = *(const __attribute__((address_space(3))) u32x4*)(stg + row * 64 + ch * 8); *(u32x4*)(Ow + (size_t)row * 1024 + ch * 8) = v; }
          asm volatile("s_waitcnt lgkmcnt(0)" ::: "memory");
      } }
    asm volatile("s_waitcnt vmcnt(0) lgkmcnt(0)" ::: "memory");
    __syncthreads();
}
#undef EVM_TR
}

constexpr int NWAVES = 8;
constexpr int BATCH = 4, SEQ = 8192, DM = 1024, NTOK = BATCH * SEQ;
constexpr int EVEN_IN = 1792, ODD_IN = 2336, ODD_IN_PAD = 2560, FF = 2816, FFE = 3584, NEXP = 8, ADA = 6144;
constexpr float NORM_EPS = 1e-6f, LOG2E = 1.4426950408889634f;
constexpr float QS_EVEN = 0.125f * LOG2E;
constexpr float QS_ODD = 0.10206207261596577f * LOG2E;
#ifndef MK_PER_PHASE
#define MK_PER_PHASE 0
#endif
constexpr int NPH = 20;
#ifndef MK_DUPMASK
#define MK_DUPMASK 0u
#endif
#ifndef MK_PROBE_NULLEPI
#define MK_PROBE_NULLEPI 0
#endif
#ifndef MK_CLKPH
#define MK_CLKPH -1
#endif
#define CLKW ((volatile LAS unsigned long long*)(lds0 + LDSCTL_OFF + 768))
#define CLK0(k) do { if (MK_CLKPH == (k) && wave_s == 0) { CLKW[0] = __builtin_amdgcn_s_memtime(); CLKW[1] = __builtin_amdgcn_s_memrealtime(); } } while (0)
#define CLK1(k) do { if (MK_CLKPH == (k) && wave_s == 0) { const unsigned long long c1_ = __builtin_amdgcn_s_memtime(), r1_ = __builtin_amdgcn_s_memrealtime(); CLKW[2] = (c1_ - CLKW[0]) * 100ull / (r1_ - CLKW[1]); } } while (0)
#define NREP(k) ((((unsigned)MK_DUPMASK >> (k)) & 1u) ? 2 : 1)

constexpr size_t MiB = 1u << 20, KiB = 1024;
constexpr size_t WS_CTL = 0, CTL_ZERO_BYTES = 128 * KiB;
constexpr size_t WS_MOD = 1 * MiB;
constexpr size_t WS_ROPEC = 1 * MiB + 256 * KiB, WS_ROPES = WS_ROPEC + 512 * KiB;
constexpr size_t WS_TOKE = 2 * MiB + 256 * KiB, WS_TOKG = WS_TOKE + 256 * KiB, WS_TOKS = WS_TOKG + 256 * KiB;
constexpr size_t WS_SA = 3 * MiB + 512 * KiB;
constexpr size_t WS_PEXP = WS_TOKS + 256 * KiB, WS_WSB = WS_PEXP + 64 * KiB;
constexpr size_t WS_WEGU = 4 * MiB;
constexpr size_t WS_WED = 60 * MiB;
constexpr float WSC_GU = 32.f, WSC_D = 64.f;
constexpr size_t WS_H = 88 * MiB;
constexpr size_t WS_HN = 152 * MiB;
constexpr size_t WS_PROJ = 216 * MiB;
constexpr size_t WS_MIX0 = 328 * MiB;
constexpr size_t WS_ACT = 216 * MiB;
constexpr size_t WS_QN = 376 * MiB, WS_KVN = 408 * MiB, WS_KPE = 424 * MiB, WS_MIX1 = 426 * MiB;
constexpr size_t WS_Q = 216 * MiB, WS_KV = 264 * MiB;
constexpr size_t WS_WNE = 490 * MiB;
constexpr size_t WS_WIN0 = WS_WNE, WS_WO0 = WS_WIN0 + 3584 * KiB, WS_WGU0 = WS_WO0 + 2 * MiB, WS_WD0 = WS_WGU0 + 11 * MiB, WS_WIN1 = WS_WD0 + 5632 * KiB,
                 WS_WQB = WS_WIN1 + 5 * MiB, WS_WKVB = WS_WQB + 768 * KiB, WS_WO1 = WS_WKVB + 512 * KiB, WS_WNE_END = WS_WO1 + 2 * MiB;
constexpr int MOE_ROWS = 264 * 256;
constexpr size_t WS_XS = 152 * MiB;
constexpr size_t WS_HN2 = 218 * MiB;
constexpr size_t WS_Y = 152 * MiB;
constexpr size_t WS_ACTE = 284 * MiB;
constexpr size_t WS_END = 522 * MiB;
static_assert(WS_WNE_END <= WS_END && WS_MIX1 + 64 * MiB <= WS_WNE && WS_ACTE + (size_t)MOE_ROWS * FFE <= WS_END && WS_WED + (size_t)8 * DM * FFE <= WS_H && WS_H + (size_t)NTOK * DM * 2 <= WS_HN
              && WS_XS + (size_t)MOE_ROWS * DM <= WS_HN2 && WS_HN2 + (size_t)NTOK * DM <= WS_ACTE && WS_Y + (size_t)MOE_ROWS * DM * 2 <= WS_ACTE && WS_ACT + (size_t)NTOK * FF * 2 <= WS_MIX0 + 64 * MiB, "d_ws map");
constexpr int CW_TMO = 0, CW_CODE = 1, CW_BAR = 4096, CW_CNT = 8192, CW_CUR = 9216, CW_CM0 = 16384, CW_CM1 = CW_CM0 + 2048, CW_CMG = CW_CM1 + 2560, CW_CM_END = CW_CMG + 5632;
static_assert(CW_CM_END * 4 <= (int)CTL_ZERO_BYTES, "control words inside the memset");
constexpr int RING_BYTES = 131072, LDS_BYTES = 147456, LDSCTL_OFF = LDS_BYTES - 1024, MISC_OFF = LDSCTL_OFF + 320;

typedef unsigned v2u __attribute__((ext_vector_type(2)));
__device__ __forceinline__ unsigned pk2(float lo, float hi) { return pg8::cvt_pk_bf16(lo, hi); }
__device__ __forceinline__ float bflo(unsigned u) { return __uint_as_float(u << 16); }
__device__ __forceinline__ float bfhi(unsigned u) { return __uint_as_float(u & 0xffff0000u); }
__device__ __forceinline__ float bf2f(bf16 h) { return __uint_as_float(((unsigned)h) << 16); }
__device__ __forceinline__ float wave_sum(float v) {
#pragma unroll
    for (int o = 1; o < 64; o <<= 1) v += __shfl_xor(v, o);
    return v;
}
__device__ __forceinline__ float rsqrt_f(float x) { return 1.0f / sqrtf(x); }

struct Ctx { LAS unsigned char* lds; int tid, lane, wave, vcu, G, gw, NGW; };

__device__ __forceinline__ void transpose_item(const float* W, int K, int N, bf16* WT, int row_base, bool pp, LAS float* scr, int kb, int nb, int lane) {
    const int k0 = 64 * kb, n0 = 32 * nb;
    float tv_[32];
#pragma unroll
    for (int i = 0; i < 32; ++i) tv_[i] = W[(size_t)(k0 + 2 * i + (lane >> 5)) * N + n0 + (lane & 31)];
#pragma unroll
    for (int i = 0; i < 32; ++i) scr[(2 * i + (lane >> 5)) * 33 + (lane & 31)] = tv_[i];
    LDS_WAIT(); asm volatile("" ::: "memory");
    const int c = lane & 7;
#pragma unroll
    for (int j = 0; j < 4; ++j) { const int n = (lane >> 3) + 8 * j; const LAS float* s = scr + (8 * c) * 33 + n;
        v4u o; o.x = pk2(s[0 * 33], s[1 * 33]); o.y = pk2(s[2 * 33], s[3 * 33]); o.z = pk2(s[4 * 33], s[5 * 33]); o.w = pk2(s[6 * 33], s[7 * 33]);
        const int nd = pp ? ((n < 16) ? 2 * n : 2 * (n - 16) + 1) : n;
        *(v4u*)(WT + (size_t)(row_base + nd) * K + k0 + 8 * c) = o; }
    LDS_WAIT(); asm volatile("" ::: "memory");
}
__device__ __forceinline__ void transpose_item8(const float* W, int K, int N, unsigned char* WT, int row_base, float sc, LAS float* scr, int kb, int nb, int lane) {
    const int k0 = 64 * kb, n0 = 32 * nb;
    f32x4 tv_[8];
#pragma unroll
    for (int i = 0; i < 8; ++i) tv_[i] = *(const f32x4*)(W + (size_t)(k0 + 8 * i + (lane >> 3)) * N + n0 + 4 * (lane & 7));
#pragma unroll
    for (int i = 0; i < 8; ++i) { LAS float* d = scr + (8 * i + (lane >> 3)) * 33 + 4 * (lane & 7); d[0] = tv_[i].x; d[1] = tv_[i].y; d[2] = tv_[i].z; d[3] = tv_[i].w; }
    LDS_WAIT(); asm volatile("" ::: "memory");
    const int c = lane & 7;
#pragma unroll
    for (int j = 0; j < 4; ++j) { const int n = (lane >> 3) + 8 * j; const LAS float* s = scr + (8 * c) * 33 + n;
        v2u o; o.x = pg8::pack4_fp8(s[0 * 33] * sc, s[1 * 33] * sc, s[2 * 33] * sc, s[3 * 33] * sc); o.y = pg8::pack4_fp8(s[4 * 33] * sc, s[5 * 33] * sc, s[6 * 33] * sc, s[7 * 33] * sc);
        *(v2u*)(WT + (size_t)(row_base + n) * K + k0 + 8 * c) = o; }
    LDS_WAIT(); asm volatile("" ::: "memory");
}
__device__ __forceinline__ void amax_item(const float* W, int N, unsigned* cm, int row_base, bool pp, int kb, int nb, int lane) {
    const int k0 = 64 * kb, n0 = 32 * nb; float mx = 0.f;
#pragma unroll
    for (int i = 0; i < 32; ++i) mx = fmaxf(mx, fabsf(W[(size_t)(k0 + 2 * i + (lane >> 5)) * N + n0 + (lane & 31)]));
    mx = fmaxf(mx, __shfl_xor(mx, 32));
    if (lane < 32) { const int n = lane, nd = pp ? ((n < 16) ? 2 * n : 2 * (n - 16) + 1) : n; atomicMax(cm + row_base + nd, __float_as_uint(mx)); }
}
__device__ __forceinline__ void transpose_item_i8(const float* W, int K, int N, unsigned char* WT, int row_base, const unsigned* cm, LAS float* scr, int kb, int nb, int lane, bool pp = false) {
    const int k0 = 64 * kb, n0 = 32 * nb;
    float tv_[32];
#pragma unroll
    for (int i = 0; i < 32; ++i) tv_[i] = W[(size_t)(k0 + 2 * i + (lane >> 5)) * N + n0 + (lane & 31)];
#pragma unroll
    for (int i = 0; i < 32; ++i) scr[(2 * i + (lane >> 5)) * 33 + (lane & 31)] = tv_[i];
    LDS_WAIT(); asm volatile("" ::: "memory");
    const int c = lane & 7;
#pragma unroll
    for (int j = 0; j < 4; ++j) { const int n = (lane >> 3) + 8 * j; const LAS float* s = scr + (8 * c) * 33 + n;
        const int nd = pp ? ((n < 16) ? 2 * n : 2 * (n - 16) + 1) : n;
        const float cmv = __uint_as_float(cm[row_base + nd]), qs = cmv > 0.f ? 127.f / cmv : 0.f;
        v2u o; o.x = pg8::pack4_i8(s[0 * 33] * qs, s[1 * 33] * qs, s[2 * 33] * qs, s[3 * 33] * qs); o.y = pg8::pack4_i8(s[4 * 33] * qs, s[5 * 33] * qs, s[6 * 33] * qs, s[7 * 33] * qs);
        *(v2u*)(WT + (size_t)(row_base + nd) * K + k0 + 8 * c) = o; }
    LDS_WAIT(); asm volatile("" ::: "memory");
}
struct In {
    const float *x, *c, *e_ada_w, *e_ada_b, *e_nmix_g, *e_w_in, *e_sinks, *e_ln_g, *e_ln_b, *e_w_s, *e_b_s, *e_w_o, *e_nffn_g, *e_wg, *e_wu, *e_wd,
                *o_ada_w, *o_ada_b, *o_nmix_g, *o_w_in, *o_conv_w, *o_qn_g, *o_w_qb, *o_kvn_g, *o_w_kvb, *o_w_o, *o_nffn_g, *o_rw, *o_rb, *o_xg, *o_xu, *o_xd, *fin_g;
};
struct TD8 { const float* W; unsigned char* WT; int K, N, k0, n0, half, inter; float sc; };
__device__ __forceinline__ TD8 td8_decode(int t, const In& I, unsigned char* ws) {
    TD8 d; const int m = t / 1792, rr = t % 1792, e = rr / 224, r2 = rr % 224;
    if (m < 2) { d.W = (m ? I.o_xu : I.o_xg) + (size_t)e * DM * FFE; d.WT = ws + WS_WEGU + (size_t)e * 7168 * DM; d.K = DM; d.N = FFE; d.k0 = 64 * (r2 / 14); d.n0 = 256 * (r2 % 14); d.half = m; d.inter = 1; d.sc = WSC_GU; }
    else { d.W = I.o_xd + (size_t)e * FFE * DM; d.WT = ws + WS_WED + (size_t)e * DM * FFE; d.K = FFE; d.N = DM; d.k0 = 64 * (r2 / 4); d.n0 = 256 * (r2 % 4); d.half = 0; d.inter = 0; d.sc = WSC_D; }
    return d;
}
__device__ __forceinline__ void expert_tiles8(const Ctx& C, const In& I, unsigned char* ws) {
    constexpr int TP = 260, NTILE = 3 * 1792;
    LAS float* const buf0 = (LAS float*)C.lds; LAS float* const buf1 = buf0 + 64 * TP;
    int tile = C.vcu; if (tile >= NTILE) return;
    TD8 d = td8_decode(tile, I, ws);
    f32x4 r[8];
#pragma unroll
    for (int i = 0; i < 8; ++i) r[i] = *(const f32x4*)(d.W + (size_t)(d.k0 + 8 * C.wave + i) * d.N + d.n0 + 4 * C.lane);
    for (int it = 0; ; ++it) {
        LAS float* const buf = (it & 1) ? buf1 : buf0;
#pragma unroll
        for (int i = 0; i < 8; ++i) *(LAS f32x4*)(buf + (8 * C.wave + i) * TP + 4 * C.lane) = r[i];
        const TD8 c = d; const int nxt = tile + C.G;
        if (nxt < NTILE) { d = td8_decode(nxt, I, ws);
#pragma unroll
            for (int i = 0; i < 8; ++i) r[i] = *(const f32x4*)(d.W + (size_t)(d.k0 + 8 * C.wave + i) * d.N + d.n0 + 4 * C.lane); }
        LDS_WAIT(); __syncthreads();
        { const int nl = 32 * C.wave + (C.lane & 31), kh = C.lane >> 5, n = c.n0 + nl;
          const LAS float* s = buf + (32 * kh) * TP + nl; float v[32];
#pragma unroll
          for (int j = 0; j < 32; ++j) v[j] = s[j * TP] * c.sc;
          v4u o0, o1;
          o0.x = pg8::pack4_fp8(v[0], v[1], v[2], v[3]); o0.y = pg8::pack4_fp8(v[4], v[5], v[6], v[7]); o0.z = pg8::pack4_fp8(v[8], v[9], v[10], v[11]); o0.w = pg8::pack4_fp8(v[12], v[13], v[14], v[15]);
          o1.x = pg8::pack4_fp8(v[16], v[17], v[18], v[19]); o1.y = pg8::pack4_fp8(v[20], v[21], v[22], v[23]); o1.z = pg8::pack4_fp8(v[24], v[25], v[26], v[27]); o1.w = pg8::pack4_fp8(v[28], v[29], v[30], v[31]);
          const int row = c.inter ? (256 * (n >> 7) + (n & 127) + 128 * c.half) : n;
          v4u* dst = (v4u*)(c.WT + (size_t)row * c.K + c.k0 + 32 * kh); dst[0] = o0; dst[1] = o1; }
        if (nxt >= NTILE) break;
        tile = nxt;
    }
    __syncthreads();
}
__device__ __forceinline__ void p0_prologue(const Ctx& C, const In& I, unsigned char* ws) {
    if (blockIdx.x < 192) {
        const int layer = blockIdx.x / 96, cb = blockIdx.x % 96, j0 = cb * 64 + 4 * (C.lane & 15), rsub = C.lane >> 4;
        const float* W = layer ? I.o_ada_w : I.e_ada_w; const float* Bv = layer ? I.o_ada_b : I.e_ada_b;
        f32x4 acc[4]; acc[0] = acc[1] = acc[2] = acc[3] = (f32x4){0.f, 0.f, 0.f, 0.f};
#pragma unroll 1
        for (int ch = 0; ch < 4; ++ch) { const int k0 = C.wave * 128 + ch * 32; f32x4 wv[8];
#pragma unroll
            for (int i = 0; i < 8; ++i) wv[i] = *(const f32x4*)(W + (size_t)(k0 + 4 * i + rsub) * ADA + j0);
#pragma unroll
            for (int i = 0; i < 8; ++i) { const int k = k0 + 4 * i + rsub;
#pragma unroll
                for (int bb = 0; bb < 4; ++bb) { const float cv = I.c[bb * DM + k]; acc[bb] += wv[i] * (cv / (1.f + __expf(-cv))); } } }
#pragma unroll
        for (int bb = 0; bb < 4; ++bb)
#pragma unroll
            for (int e = 0; e < 4; ++e) { float v = acc[bb][e]; v += __shfl_xor(v, 16); v += __shfl_xor(v, 32); acc[bb][e] = v; }
        LAS float* red = (LAS float*)C.lds;
        if (C.lane < 16) {
#pragma unroll
            for (int bb = 0; bb < 4; ++bb) *(LAS f32x4*)(red + (C.wave * 4 + bb) * 64 + 4 * C.lane) = acc[bb]; }
        __syncthreads();
        if (C.tid < 256) { const int bb = C.tid >> 6, col = C.tid & 63; float s = 0.f;
#pragma unroll
            for (int w = 0; w < 8; ++w) s += red[(w * 4 + bb) * 64 + col];
            ((float*)(ws + WS_MOD))[(size_t)(layer * BATCH + bb) * ADA + cb * 64 + col] = s + Bv[cb * 64 + col]; }
        __syncthreads();
    }
    {
        bf16* wsb = (bf16*)(ws + WS_WSB);
        for (int idx = blockIdx.x * 512 + C.tid; idx < 8 * 128 * 128; idx += C.G * 512) { const int t = (idx >> 7) & 127, sp = idx & 127; wsb[idx] = (bf16)(pk2((sp <= t) ? I.e_w_s[idx] : 0.f, 0.f) & 0xffffu); }
        float* ct = (float*)(ws + WS_ROPEC); float* st = (float*)(ws + WS_ROPES);
        for (int idx = blockIdx.x * 512 + C.tid; idx < SEQ * 16; idx += C.G * 512) { const int pos = idx >> 4, i = idx & 15;
            const double inv = (double)exp2f(-(float)i * (13.287712379549449f / 16.0f));
            const double rev = (double)((float)pos * (float)inv) * 0.15915494309189535;
            const float fr = (float)(rev - __builtin_rint(rev));
            ct[idx] = __builtin_amdgcn_cosf(fr); st[idx] = __builtin_amdgcn_sinf(fr); }
    }
    LAS float* scr = (LAS float*)(C.lds + C.wave * 16384);
    constexpr int I_IN0 = 16 * 56, I_O = 16 * 32, I_GU0 = 16 * 88, I_D0 = 44 * 32, I_IN1 = 16 * 73, I_QB = 8 * 24, I_KVB = 4 * 32, I_XG1 = 16 * 112, I_XD1 = 56 * 32;
    constexpr int NITEMS = I_IN0 + I_O + 2 * I_GU0 + I_D0 + I_IN1 + I_QB + I_KVB + I_O;
    for (int it = C.gw; it < NITEMS; it += C.NGW) {
        int r = it;
        if (r < I_IN0) { const int kb = r / 56, nb = r % 56; amax_item(I.e_w_in, EVEN_IN, (unsigned*)(ws + WS_CTL) + CW_CM0, nb * 32, false, kb, nb, C.lane); continue; } r -= I_IN0;
        if (r < I_O) { const int kb = r / 32, nb = r % 32; transpose_item(I.e_w_o, DM, DM, (bf16*)(ws + WS_WO0), nb * 32, false, scr, kb, nb, C.lane); continue; } r -= I_O;
        if (r < I_GU0) { const int kb = r / 88, nb = r % 88, n0 = nb * 32; amax_item(I.e_wg, FF, (unsigned*)(ws + WS_CTL) + CW_CMG, 256 * (n0 >> 7) + (n0 & 127), false, kb, nb, C.lane); continue; } r -= I_GU0;
        if (r < I_GU0) { const int kb = r / 88, nb = r % 88, n0 = nb * 32; amax_item(I.e_wu, FF, (unsigned*)(ws + WS_CTL) + CW_CMG, 256 * (n0 >> 7) + (n0 & 127) + 128, false, kb, nb, C.lane); continue; } r -= I_GU0;
        if (r < I_D0) { const int kb = r / 32, nb = r % 32; transpose_item8(I.e_wd, FF, DM, (unsigned char*)(ws + WS_WD0), nb * 32, WSC_D, scr, kb, nb, C.lane); continue; } r -= I_D0;
        if (r < I_IN1) { const int kb = r / 73, nb = r % 73; amax_item(I.o_w_in, ODD_IN, (unsigned*)(ws + WS_CTL) + CW_CM1, nb * 32, nb == 72, kb, nb, C.lane); continue; } r -= I_IN1;
        if (r < I_QB) { const int kb = r / 24, nb = r % 24; transpose_item(I.o_w_qb, 512, 768, (bf16*)(ws + WS_WQB), nb * 32, (nb % 3) == 2, scr, kb, nb, C.lane); continue; } r -= I_QB;
        if (r < I_KVB) { const int kb = r / 32, nb = r % 32; transpose_item(I.o_w_kvb, 256, 1024, (bf16*)(ws + WS_WKVB), nb * 32, false, scr, kb, nb, C.lane); continue; } r -= I_KVB;
        if (r < I_O) { const int kb = r / 32, nb = r % 32; transpose_item(I.o_w_o, DM, DM, (bf16*)(ws + WS_WO1), nb * 32, false, scr, kb, nb, C.lane); continue; } r -= I_O;
    }
    __syncthreads();
    expert_tiles8(C, I, ws);
}

__device__ __forceinline__ void unpack8(const v4u w, float (&x)[8]) { x[0] = bflo(w.x); x[1] = bfhi(w.x); x[2] = bflo(w.y); x[3] = bfhi(w.y); x[4] = bflo(w.z); x[5] = bfhi(w.z); x[6] = bflo(w.w); x[7] = bfhi(w.w); }
template <bool IN_F32> __device__ __forceinline__ void load_row16(const void* h, int m, int lane, float (&x)[2][8]) {
    if (IN_F32) { const f32x4* p = (const f32x4*)((const float*)h + (size_t)m * DM) + 2 * lane;
#pragma unroll
        for (int j = 0; j < 2; ++j) { const f32x4 a = p[128 * j], b = p[128 * j + 1]; x[j][0] = a.x; x[j][1] = a.y; x[j][2] = a.z; x[j][3] = a.w; x[j][4] = b.x; x[j][5] = b.y; x[j][6] = b.z; x[j][7] = b.w; } }
    else { const v4u* p = (const v4u*)((const bf16*)h + (size_t)m * DM) + lane;
#pragma unroll
        for (int j = 0; j < 2; ++j) unpack8(p[64 * j], x[j]); }
}
template <bool IN_F32, bool OUT8> __device__ __forceinline__ void modulate2(const Ctx& C, const void* h, const float* g, const float* shift, const float* scale, void* hn) {
    for (int m0 = 2 * C.gw; m0 < NTOK; m0 += 2 * C.NGW) {
        const int b = m0 >> 13;
        float x[2][2][8];
        load_row16<IN_F32>(h, m0, C.lane, x[0]); load_row16<IN_F32>(h, m0 + 1, C.lane, x[1]);
        float r[2];
#pragma unroll
        for (int rr = 0; rr < 2; ++rr) { float s = 0.f;
#pragma unroll
            for (int j = 0; j < 2; ++j)
#pragma unroll
                for (int k = 0; k < 8; ++k) s += x[rr][j][k] * x[rr][j][k];
            r[rr] = rsqrt_f(wave_sum(s) * (1.f / DM) + NORM_EPS); }
#pragma unroll
        for (int j = 0; j < 2; ++j) { const int c4 = 2 * C.lane + 128 * j;
            const f32x4 g0 = ((const f32x4*)g)[c4], g1 = ((const f32x4*)g)[c4 + 1], s0 = ((const f32x4*)(scale + (size_t)b * ADA))[c4], s1 = ((const f32x4*)(scale + (size_t)b * ADA))[c4 + 1],
                        h0 = ((const f32x4*)(shift + (size_t)b * ADA))[c4], h1 = ((const f32x4*)(shift + (size_t)b * ADA))[c4 + 1];
            const float mg[8] = {g0.x * (s0.x + 1.f), g0.y * (s0.y + 1.f), g0.z * (s0.z + 1.f), g0.w * (s0.w + 1.f), g1.x * (s1.x + 1.f), g1.y * (s1.y + 1.f), g1.z * (s1.z + 1.f), g1.w * (s1.w + 1.f)};
            const float sh[8] = {h0.x, h0.y, h0.z, h0.w, h1.x, h1.y, h1.z, h1.w};
#pragma unroll
            for (int rr = 0; rr < 2; ++rr) { float o[8];
#pragma unroll
                for (int k = 0; k < 8; ++k) o[k] = x[rr][j][k] * r[rr] * mg[k] + sh[k];
                if (OUT8) { v2u w; w.x = pg8::pack4_fp8(o[0], o[1], o[2], o[3]); w.y = pg8::pack4_fp8(o[4], o[5], o[6], o[7]); ((v2u*)((unsigned char*)hn + (size_t)(m0 + rr) * DM))[C.lane + 64 * j] = w; }
                else { v4u w; w.x = pk2(o[0], o[1]); w.y = pk2(o[2], o[3]); w.z = pk2(o[4], o[5]); w.w = pk2(o[6], o[7]); ((v4u*)((bf16*)hn + (size_t)(m0 + rr) * DM))[C.lane + 64 * j] = w; } } }
    }
}

template <bool IN_F32> __device__ __forceinline__ void modulate2_i8(const Ctx& C, const void* h, const float* g, const float* shift, const float* scale, unsigned char* hn, float* sa) {
    for (int m0 = 2 * C.gw; m0 < NTOK; m0 += 2 * C.NGW) {
        const int b = m0 >> 13;
        float x[2][2][8];
        load_row16<IN_F32>(h, m0, C.lane, x[0]); load_row16<IN_F32>(h, m0 + 1, C.lane, x[1]);
        float r[2];
#pragma unroll
        for (int rr = 0; rr < 2; ++rr) { float s = 0.f;
#pragma unroll
            for (int j = 0; j < 2; ++j)
#pragma unroll
                for (int k = 0; k < 8; ++k) s += x[rr][j][k] * x[rr][j][k];
            r[rr] = rsqrt_f(wave_sum(s) * (1.f / DM) + NORM_EPS); }
        float mx[2] = {0.f, 0.f};
#pragma unroll
        for (int j = 0; j < 2; ++j) { const int c4 = 2 * C.lane + 128 * j;
            const f32x4 g0 = ((const f32x4*)g)[c4], g1 = ((const f32x4*)g)[c4 + 1], s0 = ((const f32x4*)(scale + (size_t)b * ADA))[c4], s1 = ((const f32x4*)(scale + (size_t)b * ADA))[c4 + 1],
                        h0 = ((const f32x4*)(shift + (size_t)b * ADA))[c4], h1 = ((const f32x4*)(shift + (size_t)b * ADA))[c4 + 1];
            const float mg[8] = {g0.x * (s0.x + 1.f), g0.y * (s0.y + 1.f), g0.z * (s0.z + 1.f), g0.w * (s0.w + 1.f), g1.x * (s1.x + 1.f), g1.y * (s1.y + 1.f), g1.z * (s1.z + 1.f), g1.w * (s1.w + 1.f)};
            const float sh[8] = {h0.x, h0.y, h0.z, h0.w, h1.x, h1.y, h1.z, h1.w};
#pragma unroll
            for (int rr = 0; rr < 2; ++rr)
#pragma unroll
                for (int k = 0; k < 8; ++k) { x[rr][j][k] = x[rr][j][k] * r[rr] * mg[k] + sh[k]; mx[rr] = fmaxf(mx[rr], fabsf(x[rr][j][k])); } }
#pragma unroll
        for (int rr = 0; rr < 2; ++rr) {
#pragma unroll
            for (int o = 1; o < 64; o <<= 1) mx[rr] = fmaxf(mx[rr], __shfl_xor(mx[rr], o));
            const float qs = mx[rr] > 0.f ? 127.f / mx[rr] : 0.f;
            if (C.lane == 0) sa[m0 + rr] = mx[rr] * (1.f / 127.f);
#pragma unroll
            for (int j = 0; j < 2; ++j) { v2u w; w.x = pg8::pack4_i8(x[rr][j][0] * qs, x[rr][j][1] * qs, x[rr][j][2] * qs, x[rr][j][3] * qs); w.y = pg8::pack4_i8(x[rr][j][4] * qs, x[rr][j][5] * qs, x[rr][j][6] * qs, x[rr][j][7] * qs);
                ((v2u*)(hn + (size_t)(m0 + rr) * DM))[C.lane + 64 * j] = w; } }
    }
}

__device__ __forceinline__ void odd_pre(const Ctx& C, const bf16* proj, const float* conv_w, const float* qn_g, const float* kvn_g, const float* ctab, const float* stab,
                                        bf16* mix, bf16* qn, bf16* kvn, bf16* kpe) {
    for (int m0 = 2 * C.gw; m0 < NTOK; m0 += 2 * C.NGW) {
        const int pos0 = m0 & (SEQ - 1); const bf16* pr = proj + (size_t)m0 * ODD_IN_PAD; const int c0 = C.lane * 8;
        float z[4][8];
#pragma unroll
        for (int i = 0; i < 4; ++i) { const int dt = 2 - i;
            if (pos0 >= dt) { const bf16* p2 = pr - (ptrdiff_t)dt * ODD_IN_PAD; float a[8], xx[8]; unpack8(*(const v4u*)(p2 + 512 + c0), a); unpack8(*(const v4u*)(p2 + 1024 + c0), xx);
#pragma unroll
                for (int k = 0; k < 8; ++k) z[i][k] = a[k] * xx[k]; }
            else {
#pragma unroll
                for (int k = 0; k < 8; ++k) z[i][k] = 0.f; } }
        float cw[3][8];
#pragma unroll
        for (int jj = 0; jj < 3; ++jj) { const f32x4 w0 = *(const f32x4*)(conv_w + jj * 512 + c0), w1 = *(const f32x4*)(conv_w + jj * 512 + c0 + 4); cw[jj][0] = w0.x; cw[jj][1] = w0.y; cw[jj][2] = w0.z; cw[jj][3] = w0.w; cw[jj][4] = w1.x; cw[jj][5] = w1.y; cw[jj][6] = w1.z; cw[jj][7] = w1.w; }
#pragma unroll
        for (int rr = 0; rr < 2; ++rr) { const bf16* p1 = pr + (size_t)rr * ODD_IN_PAD; const int m = m0 + rr;
            float gb[8]; unpack8(*(const v4u*)(p1 + c0), gb); float y[8];
#pragma unroll
            for (int k = 0; k < 8; ++k) y[k] = gb[k] * (cw[0][k] * z[rr][k] + cw[1][k] * z[rr + 1][k] + cw[2][k] * z[rr + 2][k]);
            { v4u o; o.x = pk2(y[0], y[1]); o.y = pk2(y[2], y[3]); o.z = pk2(y[4], y[5]); o.w = pk2(y[6], y[7]); *(v4u*)(mix + (size_t)m * DM + c0) = o; }
            { float x[8]; unpack8(*(const v4u*)(p1 + 1536 + c0), x); float s = 0.f;
#pragma unroll
              for (int k = 0; k < 8; ++k) s += x[k] * x[k];
              const float r = rsqrt_f(wave_sum(s) * (1.f / 512.f) + NORM_EPS);
              const f32x4 g0 = *(const f32x4*)(qn_g + c0), g1 = *(const f32x4*)(qn_g + c0 + 4);
              v4u o; o.x = pk2(x[0] * r * g0.x, x[1] * r * g0.y); o.y = pk2(x[2] * r * g0.z, x[3] * r * g0.w); o.z = pk2(x[4] * r * g1.x, x[5] * r * g1.y); o.w = pk2(x[6] * r * g1.z, x[7] * r * g1.w);
              *(v4u*)(qn + (size_t)m * 512 + c0) = o; }
            { const v2u w = *(const v2u*)(p1 + 2048 + C.lane * 4); const float x[4] = {bflo(w.x), bfhi(w.x), bflo(w.y), bfhi(w.y)};
              const float s = (x[0] * x[0] + x[1] * x[1]) + (x[2] * x[2] + x[3] * x[3]);
              const float r = rsqrt_f(wave_sum(s) * (1.f / 256.f) + NORM_EPS);
              const f32x4 g0 = *(const f32x4*)(kvn_g + C.lane * 4);
              v2u o; o.x = pk2(x[0] * r * g0.x, x[1] * r * g0.y); o.y = pk2(x[2] * r * g0.z, x[3] * r * g0.w);
              *(v2u*)(kvn + (size_t)m * 256 + C.lane * 4) = o; }
            if (C.lane < 16) { const int pos = pos0 + rr; const unsigned w = *(const unsigned*)(p1 + 2304 + 2 * C.lane); const float x1 = bflo(w), x2 = bfhi(w), cs = ctab[pos * 16 + C.lane], sn = stab[pos * 16 + C.lane];
                *(unsigned*)(kpe + (size_t)m * 32 + 2 * C.lane) = pk2(x1 * cs - x2 * sn, x1 * sn + x2 * cs); } }
    }
}

__device__ __forceinline__ void modulate_route(const Ctx& C, const bf16* h, const float* g, const float* shift, const float* scale, const float* rw, const float* rb,
                                               unsigned char* hn, int* tok_e, float* tok_g, unsigned* counts) {
    volatile LAS unsigned* hist = (volatile LAS unsigned*)(C.lds + LDSCTL_OFF);
    f32x4 w[2][8][2];
#pragma unroll
    for (int j = 0; j < 2; ++j)
#pragma unroll
        for (int k = 0; k < 8; ++k) { const float* p = rw + (size_t)(512 * j + 8 * C.lane + k) * 8; w[j][k][0] = *(const f32x4*)p; w[j][k][1] = *(const f32x4*)(p + 4); }
    for (int m0 = 2 * C.gw; m0 < NTOK; m0 += 2 * C.NGW) {
        const int b = m0 >> 13;
        float x[2][2][8];
        load_row16<false>(h, m0, C.lane, x[0]); load_row16<false>(h, m0 + 1, C.lane, x[1]);
        float r[2];
#pragma unroll
        for (int rr = 0; rr < 2; ++rr) { float s = 0.f;
#pragma unroll
            for (int j = 0; j < 2; ++j)
#pragma unroll
                for (int k = 0; k < 8; ++k) s += x[rr][j][k] * x[rr][j][k];
            r[rr] = rsqrt_f(wave_sum(s) * (1.f / DM) + NORM_EPS); }
        f32x4 la[2], lb[2]; la[0] = la[1] = lb[0] = lb[1] = (f32x4){0.f, 0.f, 0.f, 0.f};
#pragma unroll
        for (int j = 0; j < 2; ++j) { const int c4 = 2 * C.lane + 128 * j;
            const f32x4 g0 = ((const f32x4*)g)[c4], g1 = ((const f32x4*)g)[c4 + 1], s0 = ((const f32x4*)(scale + (size_t)b * ADA))[c4], s1 = ((const f32x4*)(scale + (size_t)b * ADA))[c4 + 1],
                        h0 = ((const f32x4*)(shift + (size_t)b * ADA))[c4], h1 = ((const f32x4*)(shift + (size_t)b * ADA))[c4 + 1];
            const float mg[8] = {g0.x * (s0.x + 1.f), g0.y * (s0.y + 1.f), g0.z * (s0.z + 1.f), g0.w * (s0.w + 1.f), g1.x * (s1.x + 1.f), g1.y * (s1.y + 1.f), g1.z * (s1.z + 1.f), g1.w * (s1.w + 1.f)};
            const float sh[8] = {h0.x, h0.y, h0.z, h0.w, h1.x, h1.y, h1.z, h1.w};
#pragma unroll
            for (int rr = 0; rr < 2; ++rr) { float o[8];
#pragma unroll
                for (int k = 0; k < 8; ++k) { o[k] = x[rr][j][k] * r[rr] * mg[k] + sh[k]; la[rr] += w[j][k][0] * o[k]; lb[rr] += w[j][k][1] * o[k]; }
                v2u wv; wv.x = pg8::pack4_fp8(o[0], o[1], o[2], o[3]); wv.y = pg8::pack4_fp8(o[4], o[5], o[6], o[7]); ((v2u*)(hn + (size_t)(m0 + rr) * DM))[C.lane + 64 * j] = wv; } }
#pragma unroll
        for (int rr = 0; rr < 2; ++rr) { const int m = m0 + rr;
            float lg[8] = {la[rr].x, la[rr].y, la[rr].z, la[rr].w, lb[rr].x, lb[rr].y, lb[rr].z, lb[rr].w};
#pragma unroll
            for (int e = 0; e < 8; ++e) lg[e] = wave_sum(lg[e]) + rb[e];
            int e0 = 0; float v0 = lg[0];
#pragma unroll
            for (int e = 1; e < 8; ++e) if (lg[e] > v0) { v0 = lg[e]; e0 = e; }
            int e1 = -1; float v1 = -INFINITY;
#pragma unroll
            for (int e = 0; e < 8; ++e) if (e != e0 && lg[e] > v1) { v1 = lg[e]; e1 = e; }
            const float p1 = __expf(v1 - v0), g0 = 1.f / (1.f + p1), g1 = p1 * g0;
            if (C.lane == 0) { tok_e[2 * m] = e0; tok_e[2 * m + 1] = e1; tok_g[2 * m] = g0; tok_g[2 * m + 1] = g1;
                __hip_atomic_fetch_add((LAS unsigned*)&hist[e0], 1u, __ATOMIC_RELAXED, __HIP_MEMORY_SCOPE_WORKGROUP); __hip_atomic_fetch_add((LAS unsigned*)&hist[e1], 1u, __ATOMIC_RELAXED, __HIP_MEMORY_SCOPE_WORKGROUP); } }
    }
    LDS_WAIT(); __syncthreads();
    if (C.tid < 8) { const unsigned n = hist[C.tid]; if (n) __hip_atomic_fetch_add(counts + 64 * C.tid, n, __ATOMIC_RELAXED, __HIP_MEMORY_SCOPE_AGENT); }
    __syncthreads();
}

__device__ __forceinline__ void moe_pstart(const unsigned* counts, int (&pstart)[8], int (&pend)[8]) {
    int acc = 0;
#pragma unroll
    for (int e = 0; e < 8; ++e) { const int n = (int)__hip_atomic_load(counts + 64 * e, __ATOMIC_RELAXED, __HIP_MEMORY_SCOPE_AGENT); pstart[e] = acc; acc += (n + 255) >> 8; pend[e] = acc; }
}
__device__ __forceinline__ void moe_gather(const Ctx& C, const unsigned char* hn, const int* tok_e, const unsigned* counts, unsigned* cursor, int* tok_slot, unsigned char* xs, int* pexp) {
    int pstart[8], pend[8]; moe_pstart(counts, pstart, pend);
    if (blockIdx.x == 0 && C.tid < 273) { int e = 0;
#pragma unroll
        for (int k = 0; k < 7; ++k) e += (C.tid >= pend[k]) ? 1 : 0;
        pexp[C.tid] = (C.tid == 272) ? pend[7] : e; }
    for (int task = C.gw; task < NTOK / 16; task += C.NGW) {
        const int tok = task * 16 + (C.lane & 15); const bool act = C.lane < 16;
        const int e0 = act ? tok_e[2 * tok] : -1, e1 = act ? tok_e[2 * tok + 1] : -2;
        int s0 = 0, s1 = 0;
        const unsigned long long lt = (1ull << C.lane) - 1ull;
#pragma unroll
        for (int e = 0; e < 8; ++e) { const unsigned long long m0 = __ballot(e0 == e), m1 = __ballot(e1 == e); const int n0 = __popcll(m0), n1 = __popcll(m1);
            unsigned base = 0u; if (C.lane == 0 && (n0 + n1) > 0) base = __hip_atomic_fetch_add(cursor + 64 * e, (unsigned)(n0 + n1), __ATOMIC_RELAXED, __HIP_MEMORY_SCOPE_AGENT);
            base = (unsigned)__builtin_amdgcn_readfirstlane((int)base) + (unsigned)pstart[e] * 256u;
            if (e0 == e) s0 = (int)base + __popcll(m0 & lt); if (e1 == e) s1 = (int)base + n0 + __popcll(m1 & lt); }
        if (act) { tok_slot[2 * tok] = s0; tok_slot[2 * tok + 1] = s1; }
#pragma unroll 4
        for (int i = 0; i < 16; ++i) { const int d0 = __shfl(s0, i), d1 = __shfl(s1, i);
            const v4u a = ((const v4u*)(hn + (size_t)(task * 16 + i) * DM))[C.lane];
            ((v4u*)(xs + (size_t)d0 * DM))[C.lane] = a; ((v4u*)(xs + (size_t)d1 * DM))[C.lane] = a; }
    }
}

__device__ __forceinline__ void final_rows(int gw, int NGW, int lane, const bf16* h, float* out, const bf16* y, const int* tok_slot, const float* tok_g, const float* gate, const float* fin_g, int s_ready, int mode) {
    for (int m0 = 2 * gw; m0 < NTOK; m0 += 2 * NGW) {
        const int b = m0 >> 13;
        int sl[2][2]; bool sel[2];
#pragma unroll
        for (int rr = 0; rr < 2; ++rr) { sl[rr][0] = __builtin_amdgcn_readfirstlane(tok_slot[2 * (m0 + rr)]); sl[rr][1] = __builtin_amdgcn_readfirstlane(tok_slot[2 * (m0 + rr) + 1]);
            const bool ready = sl[rr][0] < s_ready && sl[rr][1] < s_ready; sel[rr] = mode ? !ready : ready; }
        if (!sel[0] && !sel[1]) continue;
        float v[2][2][8]; float r[2];
#pragma unroll
        for (int rr = 0; rr < 2; ++rr) { const int m = m0 + rr; const float g0 = tok_g[2 * m], g1 = tok_g[2 * m + 1];
            float hx[2][8], ya[2][8], yb[2][8];
            load_row16<false>(h, m, lane, hx); load_row16<false>(y, sl[rr][0], lane, ya); load_row16<false>(y, sl[rr][1], lane, yb);
            float s = 0.f;
#pragma unroll
            for (int j = 0; j < 2; ++j) { const int c4 = 2 * lane + 128 * j; const f32x4 t0 = ((const f32x4*)(gate + (size_t)b * ADA))[c4], t1 = ((const f32x4*)(gate + (size_t)b * ADA))[c4 + 1];
                const float gt[8] = {t0.x, t0.y, t0.z, t0.w, t1.x, t1.y, t1.z, t1.w};
#pragma unroll
                for (int k = 0; k < 8; ++k) { v[rr][j][k] = hx[j][k] + gt[k] * (g0 * ya[j][k] + g1 * yb[j][k]); s += v[rr][j][k] * v[rr][j][k]; } }
            r[rr] = s; }
#pragma unroll
        for (int rr = 0; rr < 2; ++rr) r[rr] = rsqrt_f(wave_sum(r[rr]) * (1.f / DM) + NORM_EPS);
#pragma unroll
        for (int rr = 0; rr < 2; ++rr) { if (!sel[rr]) continue;
#pragma unroll
            for (int j = 0; j < 2; ++j) { const int c4 = 2 * lane + 128 * j; const f32x4 f0 = ((const f32x4*)fin_g)[c4], f1 = ((const f32x4*)fin_g)[c4 + 1];
                f32x4* op = (f32x4*)(out + (size_t)(m0 + rr) * DM) + c4;
                op[0] = (f32x4){v[rr][j][0] * r[rr] * f0.x, v[rr][j][1] * r[rr] * f0.y, v[rr][j][2] * r[rr] * f0.z, v[rr][j][3] * r[rr] * f0.w};
                op[1] = (f32x4){v[rr][j][4] * r[rr] * f1.x, v[rr][j][5] * r[rr] * f1.y, v[rr][j][6] * r[rr] * f1.z, v[rr][j][7] * r[rr] * f1.w}; } }
    }
}

struct Args { In in; float* out; unsigned char* ws; int ph_lo, ph_hi; };
__global__ void __launch_bounds__(NWAVES * 64, 2) fwd(Args args) {
    extern __shared__ __attribute__((aligned(16))) unsigned char lds_raw[];
#define MKCTX() Ctx C; { int t_ = tid_from_wave(wave_s); asm volatile("" : "+v"(t_)); C.lds = (LAS unsigned char*)lds_raw; C.tid = t_; C.lane = t_ & 63; C.wave = __builtin_amdgcn_readfirstlane(t_ >> 6); \
        C.G = gridDim.x; const int bx_ = blockIdx.x; C.vcu = (C.G % 8 == 0) ? (bx_ % 8) * (C.G / 8) + bx_ / 8 : bx_; C.gw = C.vcu * NWAVES + C.wave; C.NGW = C.G * NWAVES; }
    LAS unsigned char* const lds0 = (LAS unsigned char*)lds_raw;
    const int wave_s = __builtin_amdgcn_readfirstlane((int)(threadIdx.x >> 6));
    unsigned char* ws = args.ws; const In& I = args.in;
    unsigned* ctl = (unsigned*)(ws + WS_CTL);
    for (int u = threadIdx.x; u < (LDS_BYTES - LDSCTL_OFF) / 4; u += NWAVES * 64) ((LAS unsigned*)(lds0 + LDSCTL_OFF))[u] = 0u;
    __syncthreads();
    XcdBarrier bar; bar.bar = ctl + CW_BAR; bar.x = 0; bar.st = nullptr; bar.wave = wave_s;
    if (!MK_PER_PHASE) bar = xcd_barrier_post(ctl + CW_BAR, (volatile LAS unsigned*)(lds0 + MISC_OFF) + 8, wave_s);
    const int lo = args.ph_lo, hi = args.ph_hi;
#define IN(k) (lo <= (k) && (k) < hi)
#define SEAM(k) do { if (!MK_PER_PHASE && IN(k) && IN((k) + 1)) xcd_barrier(bar); } while (0)

    bf16* const hbuf = (bf16*)(ws + WS_H);
    const float* mod0 = (const float*)(ws + WS_MOD); const float* mod1 = mod0 + BATCH * ADA;
    bf16* const HN = (bf16*)(ws + WS_HN); bf16* const PROJ = (bf16*)(ws + WS_PROJ); bf16* const MIX0 = (bf16*)(ws + WS_MIX0); bf16* const ACT = (bf16*)(ws + WS_ACT);
    bf16* const QN = (bf16*)(ws + WS_QN); bf16* const KVN = (bf16*)(ws + WS_KVN); bf16* const KPE = (bf16*)(ws + WS_KPE); bf16* const MIX1 = (bf16*)(ws + WS_MIX1);
    bf16* const Q = (bf16*)(ws + WS_Q); bf16* const KV = (bf16*)(ws + WS_KV); unsigned char* const HN2 = ws + WS_HN2; unsigned char* const XS = ws + WS_XS; unsigned char* const ACTE = ws + WS_ACTE; bf16* const YB = (bf16*)(ws + WS_Y);
    const float* ctab = (const float*)(ws + WS_ROPEC); const float* stab = (const float*)(ws + WS_ROPES);
    int* const pexp = (int*)(ws + WS_PEXP); int* tok_e = (int*)(ws + WS_TOKE); float* tok_g = (float*)(ws + WS_TOKG); int* tok_slot = (int*)(ws + WS_TOKS);

    if (IN(0)) for (int rep_ = 0; rep_ < NREP(0); ++rep_) { MKCTX(); p0_prologue(C, I, ws); } SEAM(0);
    if (IN(1)) for (int rep_ = 0; rep_ < NREP(1); ++rep_) { MKCTX(); modulate2_i8<true>(C, I.x, I.e_nmix_g, mod0 + 0 * DM, mod0 + 1 * DM, (unsigned char*)HN, (float*)(ws + WS_SA));
        { LAS float* scr = (LAS float*)(C.lds + C.wave * 16384);
          for (int it = C.gw; it < 16 * 56; it += C.NGW) { const int kb = it / 56, nb = it % 56; transpose_item_i8(I.e_w_in, DM, EVEN_IN, ws + WS_WIN0, nb * 32, ctl + CW_CM0, scr, kb, nb, C.lane); } } } SEAM(1);
    CLK0(2);
    if (IN(2)) for (int rep_ = 0; rep_ < NREP(2); ++rep_) { MKCTX(); pg8::Gemm g{HN, (const bf16*)(ws + WS_WIN0), NTOK, EVEN_IN, DM / 2}; pg8::StaticOrder S; S.init(NTOK, EVEN_IN, C.G, (int)blockIdx.x);
        pg8::EpiProj0I E{PROJ, EVEN_IN, QS_EVEN, (const float*)(ws + WS_SA), ctl + CW_CM0}; pg8::gemm_phase<pg8::EpiProj0I, pg8::StaticOrder, true, true, false, true>(C.lds, g, S, E, wave_s);
        { const int nwg = (NTOK / 256) * (EVEN_IN / 256), first_idle = nwg - 3 * C.G;
          const bool tail_ok = first_idle > 0 && first_idle < C.G;
          if (!tail_ok || (int)blockIdx.x >= first_idle) {
              LAS float* scr = (LAS float*)(C.lds + C.wave * 16384); const int wv = tail_ok ? ((int)blockIdx.x - first_idle) * NWAVES + C.wave : C.gw, nwv = tail_ok ? (C.G - first_idle) * NWAVES : C.NGW;
              for (int it = wv; it < 2 * 16 * 88; it += nwv) { const int half = it / (16 * 88), r = it % (16 * 88), kb = r / 88, nb = r % 88, n0 = nb * 32;
                  transpose_item_i8(half ? I.e_wu : I.e_wg, DM, FF, ws + WS_WGU0, 256 * (n0 >> 7) + (n0 & 127) + 128 * half, ctl + CW_CMG, scr, kb, nb, C.lane); }
              for (int it = wv; it < 16 * 73; it += nwv) { const int kb = it / 73, nb = it % 73; transpose_item_i8(I.o_w_in, DM, ODD_IN, ws + WS_WIN1, nb * 32, ctl + CW_CM1, scr, kb, nb, C.lane, nb == 72); } } }
    } CLK1(2); SEAM(2);
    if (IN(3)) for (int rep_ = 0; rep_ < NREP(3); ++rep_) { MKCTX(); for (int un = C.vcu; un < NTOK / 128; un += C.G) evm::unit(un, PROJ, I.e_sinks, I.e_ln_g, I.e_ln_b, (const bf16*)(ws + WS_WSB), I.e_b_s, MIX0, (char*)lds_raw, wave_s); } SEAM(3);
    CLK0(4);
    if (IN(4)) for (int rep_ = 0; rep_ < NREP(4); ++rep_) { MKCTX(); pg8::Gemm g{MIX0, (const bf16*)(ws + WS_WO0), NTOK, DM, DM}; pg8::StaticOrder S; S.init(NTOK, DM, C.G, (int)blockIdx.x);
        pg8::EpiResGateH<true> E{I.x, hbuf, DM, mod0 + 2 * DM, ADA, SEQ, 1.0f}; pg8::gemm_phase<pg8::EpiResGateH<true>, pg8::StaticOrder, true, true>(C.lds, g, S, E, wave_s); } CLK1(4); SEAM(4);
    if (IN(5)) for (int rep_ = 0; rep_ < NREP(5); ++rep_) { MKCTX(); modulate2_i8<false>(C, hbuf, I.e_nffn_g, mod0 + 3 * DM, mod0 + 4 * DM, (unsigned char*)HN, (float*)(ws + WS_SA)); } SEAM(5);
    CLK0(6);
    if (IN(6)) for (int rep_ = 0; rep_ < NREP(6); ++rep_) { MKCTX(); pg8::Gemm g{HN, (const bf16*)(ws + WS_WGU0), NTOK, 2 * FF, DM / 2}; pg8::StaticOrder S; S.init(NTOK, 2 * FF, C.G, (int)blockIdx.x);
        pg8::EpiSwiGLUI8 E{(unsigned char*)ACT, FF, (const float*)(ws + WS_SA), ctl + CW_CMG}; pg8::gemm_phase<pg8::EpiSwiGLUI8, pg8::StaticOrder, true, true, false, true>(C.lds, g, S, E, wave_s); } CLK1(6); SEAM(6);
    CLK0(7);
    if (IN(7)) for (int rep_ = 0; rep_ < NREP(7); ++rep_) { MKCTX(); pg8::Gemm g{ACT, (const bf16*)(ws + WS_WD0), NTOK, DM, FF / 2}; pg8::StaticOrder S; S.init(NTOK, DM, C.G, (int)blockIdx.x);
        pg8::EpiResGateH<false> E{hbuf, hbuf, DM, mod0 + 5 * DM, ADA, SEQ, 1.0f / WSC_D}; pg8::gemm_phase<pg8::EpiResGateH<false>, pg8::StaticOrder, true, true, true>(C.lds, g, S, E, wave_s); } CLK1(7); SEAM(7);
    if (IN(8)) for (int rep_ = 0; rep_ < NREP(8); ++rep_) { MKCTX(); modulate2_i8<false>(C, hbuf, I.o_nmix_g, mod1 + 0 * DM, mod1 + 1 * DM, (unsigned char*)HN, (float*)(ws + WS_SA)); } SEAM(8);
    CLK0(9);
    if (IN(9)) for (int rep_ = 0; rep_ < NREP(9); ++rep_) { MKCTX(); pg8::Gemm g{HN, (const bf16*)(ws + WS_WIN1), NTOK, ODD_IN_PAD, DM / 2}; pg8::StaticOrder S; S.init(NTOK, ODD_IN_PAD, C.G, (int)blockIdx.x);
        pg8::EpiBf16PlainI E{PROJ, ODD_IN_PAD, (const float*)(ws + WS_SA), ctl + CW_CM1}; pg8::gemm_phase<pg8::EpiBf16PlainI, pg8::StaticOrder, true, true, false, true>(C.lds, g, S, E, wave_s); } CLK1(9); SEAM(9);
    if (IN(10)) for (int rep_ = 0; rep_ < NREP(10); ++rep_) { MKCTX(); odd_pre(C, PROJ, I.o_conv_w, I.o_qn_g, I.o_kvn_g, ctab, stab, MIX1, QN, KVN, KPE); } SEAM(10);
    if (IN(11)) for (int rep_ = 0; rep_ < NREP(11); ++rep_) { MKCTX();
        { pg8::Gemm g{QN, (const bf16*)(ws + WS_WQB), NTOK, 768, 512}; pg8::StaticOrder S; S.init(NTOK, 768, C.G, (int)blockIdx.x);
          pg8::EpiQRope E{Q, 768, ctab, stab, QS_ODD, SEQ - 1}; pg8::gemm_phase<pg8::EpiQRope, pg8::StaticOrder, true, true>(C.lds, g, S, E, wave_s); }
        { pg8::Gemm g{KVN, (const bf16*)(ws + WS_WKVB), NTOK, 1024, 256}; pg8::StaticOrder S; S.init(NTOK, 1024, C.G, (int)blockIdx.x, (C.G == 256) ? 128 : 0);
          pg8::EpiBf16Plain E{KV, 1024, 1.0f}; pg8::gemm_phase<pg8::EpiBf16Plain, pg8::StaticOrder, true, true>(C.lds, g, S, E, wave_s); }
    } SEAM(11);
    CLK0(12);
    if (IN(12)) for (int rep_ = 0; rep_ < NREP(12); ++rep_) { MKCTX(); mla::phase((char*)lds_raw, Q, KV, KPE, MIX1, C.vcu, C.G, wave_s); } CLK1(12); SEAM(12);
    if (IN(13)) for (int rep_ = 0; rep_ < NREP(13); ++rep_) { MKCTX(); pg8::Gemm g{MIX1, (const bf16*)(ws + WS_WO1), NTOK, DM, DM}; pg8::StaticOrder S; S.init(NTOK, DM, C.G, (int)blockIdx.x);
        pg8::EpiResGateH<false> E{hbuf, hbuf, DM, mod1 + 2 * DM, ADA, SEQ, 1.0f}; pg8::gemm_phase<pg8::EpiResGateH<false>, pg8::StaticOrder, true, true>(C.lds, g, S, E, wave_s); } SEAM(13);
    if (IN(14)) for (int rep_ = 0; rep_ < NREP(14); ++rep_) { MKCTX(); modulate_route(C, hbuf, I.o_nffn_g, mod1 + 3 * DM, mod1 + 4 * DM, I.o_rw, I.o_rb, HN2, tok_e, tok_g, ctl + CW_CNT); } SEAM(14);
    if (IN(15)) for (int rep_ = 0; rep_ < NREP(15); ++rep_) { MKCTX(); moe_gather(C, HN2, tok_e, ctl + CW_CNT, ctl + CW_CUR, tok_slot, XS, pexp); } SEAM(15);
    CLK0(16);
    if (IN(16)) for (int rep_ = 0; rep_ < NREP(16); ++rep_) { MKCTX();
        const int P = __builtin_amdgcn_readfirstlane(pexp[272]);
        pg8::MoeOrder<28, false> S{C.G, C.vcu, 0, P * 28, pexp, 0};
        pg8::Gemm g{(const bf16*)XS, (const bf16*)(ws + WS_WEGU), 0, 0, DM / 2};
#if MK_PROBE_NULLEPI
        if (rep_ == 1) { pg8::EpiNull E0; pg8::gemm_phase<pg8::EpiNull, pg8::MoeOrder<28, false>, true, true, true>(C.lds, g, S, E0, wave_s); } else
#endif
        { pg8::EpiSwiGLU8 E{ACTE, FFE, 1.0f / WSC_GU}; pg8::gemm_phase<pg8::EpiSwiGLU8, pg8::MoeOrder<28, false>, true, true, true, false, true>(C.lds, g, S, E, wave_s); }
    } CLK1(16); SEAM(16);
    CLK0(17);
    if (IN(17)) for (int rep_ = 0; rep_ < NREP(17); ++rep_) { MKCTX();
        const int P = __builtin_amdgcn_readfirstlane(pexp[272]); const int nfull = (P * 4 / C.G) * C.G;
        pg8::MoeOrder<4, false> S{C.G, C.vcu, 0, nfull, pexp, 0};
        pg8::Gemm g{(const bf16*)ACTE, (const bf16*)(ws + WS_WED), 0, 0, FFE / 2};
        pg8::EpiBf16Plain E{YB, DM, 1.0f / WSC_D}; pg8::gemm_phase<pg8::EpiBf16Plain, pg8::MoeOrder<4, false>, true, true, true>(C.lds, g, S, E, wave_s);
    } CLK1(17); SEAM(17);
    if (IN(18)) { MKCTX();
        const int P = __builtin_amdgcn_readfirstlane(pexp[272]); const int nfull = (P * 4 / C.G) * C.G, nleft = P * 4 - nfull;
        if (C.vcu < nleft) {
            pg8::MoeOrder<4, false> S{C.G, C.vcu, 0, P * 4, pexp, nfull};
            pg8::Gemm g{(const bf16*)ACTE, (const bf16*)(ws + WS_WED), 0, 0, FFE / 2};
            pg8::EpiBf16Plain E{YB, DM, 1.0f / WSC_D}; pg8::gemm_phase<pg8::EpiBf16Plain, pg8::MoeOrder<4, false>, true, true, true>(C.lds, g, S, E, wave_s);
        } else {
            final_rows((C.vcu - nleft) * NWAVES + C.wave, (C.G - nleft) * NWAVES, C.lane, hbuf, args.out, YB, tok_slot, tok_g, mod1 + 5 * DM, I.fin_g, (nfull / 4) * 256, 0);
        }
    } SEAM(18);
    if (IN(19)) { MKCTX();
        const int P = __builtin_amdgcn_readfirstlane(pexp[272]); const int nfull = (P * 4 / C.G) * C.G;
        final_rows(C.gw, C.NGW, C.lane, hbuf, args.out, YB, tok_slot, tok_g, mod1 + 5 * DM, I.fin_g, (nfull / 4) * 256, 1);
    }
    if (MK_CLKPH >= 0 && blockIdx.x == 0 && wave_s == 0) { const unsigned long long mhz_ = CLKW[2], r0_ = __builtin_amdgcn_s_memrealtime(); while (__builtin_amdgcn_s_memrealtime() - r0_ < mhz_ * 100ull) __builtin_amdgcn_s_sleep(8); }
#undef IN
#undef SEAM
}

extern "C" void kernel_launch(void* const* d_in, const int* in_sizes, int n_in, void* d_out, int out_size, void* d_ws, size_t ws_size, hipStream_t stream) {
    static int grid = 0;
    if (grid == 0) {
        if (n_in != 33 || in_sizes[0] != NTOK * DM || out_size != NTOK * DM || ws_size < WS_END) { fprintf(stderr, "kernel_launch: unexpected shapes (n_in %d, in0 %d, out %d, ws %zu < %zu); nothing launched\n", n_in, n_in > 0 ? in_sizes[0] : -1, out_size, ws_size, (size_t)WS_END); grid = -1; return; }
        int dev = 0, cus = 0, per_cu = 0;
        if (hipGetDevice(&dev) != hipSuccess || hipDeviceGetAttribute(&cus, hipDeviceAttributeMultiprocessorCount, dev) != hipSuccess) { grid = -1; return; }
        if (hipFuncSetAttribute((const void*)fwd, hipFuncAttributeMaxDynamicSharedMemorySize, LDS_BYTES) != hipSuccess) { fprintf(stderr, "kernel_launch: hipFuncSetAttribute failed\n"); grid = -1; return; }
        if (hipOccupancyMaxActiveBlocksPerMultiprocessor(&per_cu, (const void*)fwd, NWAVES * 64, LDS_BYTES) != hipSuccess || per_cu < 1) fprintf(stderr, "kernel_launch: occupancy query reports %d\n", per_cu);
        (void)hipGetLastError();
        grid = cus;
    }
    if (grid < 0) return;
    if (hipMemsetAsync((char*)d_ws + WS_CTL, 0, CTL_ZERO_BYTES, stream) != hipSuccess) return;
    Args a{};
    const float** ip = (const float**)&a.in;
    for (int i = 0; i < 33; ++i) ip[i] = (const float*)d_in[i];
    a.out = (float*)d_out; a.ws = (unsigned char*)d_ws;
#if MK_PER_PHASE
    for (int p = 0; p < NPH; ++p) { a.ph_lo = p; a.ph_hi = p + 1; hipLaunchKernelGGL(fwd, dim3(grid), dim3(NWAVES * 64), LDS_BYTES, stream, a); }
#else
    a.ph_lo = 0; a.ph_hi = NPH; hipLaunchKernelGGL(fwd, dim3(grid), dim3(NWAVES * 64), LDS_BYTES, stream, a);
#endif
}
```

```cpp
#include <hip/hip_runtime.h>
#include <cstdio>
#include <cstdint>
#include <cmath>
__device__ __forceinline__ int tid_from_wave(int wave) { unsigned l_; asm volatile("v_mbcnt_lo_u32_b32 %0, -1, 0\n\tv_mbcnt_hi_u32_b32 %0, -1, %0" : "=v"(l_)); return wave * 64 + (int)l_; }
namespace pg8 {
#define PG8_LAS __attribute__((address_space(3)))
typedef unsigned short bf16_t;
typedef short bf16x8 __attribute__((ext_vector_type(8)));
typedef float f32x4 __attribute__((ext_vector_type(4)));
typedef unsigned u32x4 __attribute__((ext_vector_type(4)));
typedef int v8i_t __attribute__((ext_vector_type(8)));
typedef int v4i_t __attribute__((ext_vector_type(4)));
typedef unsigned u32x2 __attribute__((ext_vector_type(2)));
constexpr int BM = 256, BK = 64, HALF = 128, HTB = HALF * BK * 2  , STAGE_BYTES = 8 * HTB, NXCD = 8, WGM = 8;

__host__ __device__ __forceinline__ int lds_byte(int r, int c) { const int st = (r >> 4) * 2 + (c >> 5), rr = r & 15, cc = c & 31, ob = rr * 64 + cc * 2; return st * 1024 + (ob ^ (((ob >> 9) & 1) << 5)); }
__host__ __device__ __forceinline__ void stage_rc(int b, int& R, int& C) { const int st = b / 1024, sb = b % 1024, swz = sb ^ (((sb >> 9) & 1) << 5); R = (st >> 1) * 16 + swz / 64; C = (st & 1) * 32 + (swz % 64) / 2; }
__host__ __device__ __forceinline__ int perm32(int rho) { const int n = rho >> 4, i = rho & 15; return 8 * (i >> 2) + 4 * n + (i & 3); }

struct Unit { int pm, pn, pb, po; };
struct Gemm { const bf16_t* A; const bf16_t* Bt; int M, N, K; };

struct StaticOrder {
    int nM, nN, nwg, G, c, skew;
    __host__ __device__ void init(int M, int N, int G_, int c_, int skew_ = 0) { nM = M / BM; nN = N / BM; nwg = nM * nN; G = G_; c = c_; skew = skew_; }
    __host__ __device__ bool next(int i, Unit& u) const {
        if (i > 0 && c < skew) return false;
        const long L = (i == 0) ? (long)c : (long)G + (long)(i - 1) * (G - skew) + (c - skew); if (L >= nwg) return false;
        int wgid = (int)L; { const int q = nwg / NXCD, r = nwg % NXCD, xcd = wgid % NXCD, off = wgid / NXCD; wgid = (xcd < r ? xcd * (q + 1) : r * (q + 1) + (xcd - r) * q) + off; }
        const int nig = WGM * nN, gid = wgid / nig, fm = gid * WGM, gsz = (nM - fm) < WGM ? (nM - fm) : WGM;
        u.pm = fm + ((wgid % nig) % gsz); u.pn = (wgid % nig) / gsz; u.pb = u.pn; u.po = u.pm; return true;
    }
    __device__ __forceinline__ void a_ready(const Unit&) const {}
    __device__ __forceinline__ void done(const Unit&) const {}
};
template <int NT, bool A_REL> struct MoeOrder {
    int G, c, p0, nunits; const int* pexp; int l0;
    __device__ __forceinline__ bool next(int i, Unit& u) const {
        const int L = l0 + i * G + c; if (L >= nunits) return false;
        const int pl = L / NT, n = L - pl * NT, p = p0 + pl;
        const int e = __builtin_amdgcn_readfirstlane(pexp[p]);
        u.pm = A_REL ? pl : p; u.po = A_REL ? p : pl; u.pn = n; u.pb = e * NT + n; return true;
    }
    __device__ __forceinline__ void a_ready(const Unit&) const {}
    __device__ __forceinline__ void done(const Unit&) const {}
};

__device__ __forceinline__ unsigned cvt_pk_bf16(float lo, float hi) { unsigned r; asm volatile("v_cvt_pk_bf16_f32 %0, %1, %2" : "=v"(r) : "v"(lo), "v"(hi)); return r; }
typedef float f32x2 __attribute__((ext_vector_type(2)));
__device__ __forceinline__ f32x2 gelu_pk(f32x2 v) {
    const f32x2 av = __builtin_elementwise_abs(v), d = av * 0.2316418882f + 1.0f;
    f32x2 t; t.x = __builtin_amdgcn_rcpf(d.x); t.y = __builtin_amdgcn_rcpf(d.y);
    f32x2 q = t * 0.5307027145f + (-0.7265760135f); q = q * t + 0.7107068705f; q = q * t + (-0.142248368f); q = q * t + 0.127414796f; q = q * t;
    const f32x2 s = (v * v) * (-0.72134752044f);
    f32x2 e; e.x = __builtin_amdgcn_exp2f(s.x); e.y = __builtin_amdgcn_exp2f(s.y);
    const f32x2 m = v * (q * e), r = v - m;
    f32x2 o; o.x = v.x < 0.f ? m.x : r.x; o.y = v.y < 0.f ? m.y : r.y; return o;
}
__device__ __forceinline__ f32x4 gelu4(f32x4 v) { const f32x2 a = gelu_pk((f32x2){v[0], v[1]}), b = gelu_pk((f32x2){v[2], v[3]}); return (f32x4){a.x, a.y, b.x, b.y}; }
__device__ __forceinline__ float silu1(float x) { return x * __builtin_amdgcn_rcpf(1.0f + __builtin_amdgcn_exp2f(-1.4426950408889634f * x)); }
__device__ __forceinline__ u32x4 pack8(f32x4 v0, f32x4 v1) { u32x4 w; w.x = cvt_pk_bf16(v0[0], v0[1]); w.y = cvt_pk_bf16(v0[2], v0[3]); w.z = cvt_pk_bf16(v1[0], v1[1]); w.w = cvt_pk_bf16(v1[2], v1[3]); return w; }

__device__ __forceinline__ f32x2 swiglu_pk(f32x2 g, f32x2 u, float s) {
    const f32x2 t = g * (-1.4426950408889634f * s); f32x2 e; e.x = __builtin_amdgcn_exp2f(t.x); e.y = __builtin_amdgcn_exp2f(t.y);
    const f32x2 d = e + 1.0f; f32x2 r; r.x = __builtin_amdgcn_rcpf(d.x); r.y = __builtin_amdgcn_rcpf(d.y);
    return (g * u) * (r * (s * s));
}
struct EpiNull {
    static constexpr bool PERM = true, AFTER_DRAIN = false;
    __device__ __forceinline__ void operator()(const f32x4 (&acc)[2][2][4][2], const Unit&, int, int, int, int) const {}
};
struct EpiKeep {
    static constexpr bool PERM = true, AFTER_DRAIN = false;
    __device__ __forceinline__ void operator()(const f32x4 (&acc)[2][2][4][2], const Unit&, int, int, int, int) const {
#pragma unroll
        for (int ai = 0; ai < 2; ++ai)
#pragma unroll
            for (int bj = 0; bj < 2; ++bj)
#pragma unroll
                for (int m = 0; m < 4; ++m)
#pragma unroll
                    for (int n = 0; n < 2; ++n) asm volatile("" :: "v"(acc[ai][bj][m][n]));
    }
};
struct EpiBf16Plain {
    static constexpr bool PERM = true, AFTER_DRAIN = false;
    bf16_t* O; int ldc; float scale;
    __device__ __forceinline__ void operator()(const f32x4 (&acc)[2][2][4][2], const Unit& u, int wr, int wc, int fr, int fq) const {
        const int row0 = u.po * BM + wr * 64 + fr, col0 = u.pn * BM + wc * 32 + 8 * fq;
#pragma unroll
        for (int ai = 0; ai < 2; ++ai)
#pragma unroll
            for (int m = 0; m < 4; ++m) { bf16_t* rowp = O + (size_t)(row0 + ai * HALF + m * 16) * ldc + col0;
#pragma unroll
                for (int bj = 0; bj < 2; ++bj) *(u32x4*)(rowp + bj * HALF) = pack8(acc[ai][bj][m][0] * scale, acc[ai][bj][m][1] * scale); }
    }
};
struct EpiProj0 {
    static constexpr bool PERM = true, AFTER_DRAIN = false;
    bf16_t* O; int ldc; float qscale;
    __device__ __forceinline__ void operator()(const f32x4 (&acc)[2][2][4][2], const Unit& u, int wr, int wc, int fr, int fq) const {
        const int row0 = u.po * BM + wr * 64 + fr, col0 = u.pn * BM + wc * 32 + 8 * fq;
        const int mode = u.pn < 2 ? 0 : (u.pn == 2 ? 1 : 2);
#pragma unroll
        for (int ai = 0; ai < 2; ++ai)
#pragma unroll
            for (int m = 0; m < 4; ++m) { bf16_t* rowp = O + (size_t)(row0 + ai * HALF + m * 16) * ldc + col0;
#pragma unroll
                for (int bj = 0; bj < 2; ++bj) { f32x4 v0 = acc[ai][bj][m][0], v1 = acc[ai][bj][m][1];
                    if (mode == 2) { v0 = gelu4(v0); v1 = gelu4(v1); } else if (mode == 0) { v0 = v0 * qscale; v1 = v1 * qscale; }
                    *(u32x4*)(rowp + bj * HALF) = pack8(v0, v1); } }
    }
};
struct EpiResGate {
    static constexpr bool PERM = false, AFTER_DRAIN = false;
    const float* base; float* out; int ldc; const float* gate; int gate_ld; int rows_per_batch;
    __device__ __forceinline__ void operator()(const f32x4 (&acc)[2][2][4][2], const Unit& u, int wr, int wc, int fr, int fq) const {
        const int row0 = u.po * BM + wr * 64 + fr, col0 = u.pn * BM + wc * 32 + 4 * fq;
        const float* gp = gate + (size_t)((u.po * BM) / rows_per_batch) * gate_ld + col0;
        f32x4 gv[2][2];
#pragma unroll
        for (int bj = 0; bj < 2; ++bj)
#pragma unroll
            for (int n = 0; n < 2; ++n) gv[bj][n] = *(const f32x4*)(gp + bj * HALF + n * 16);
#pragma unroll
        for (int ai = 0; ai < 2; ++ai)
#pragma unroll
            for (int m = 0; m < 4; ++m) { const size_t off = (size_t)(row0 + ai * HALF + m * 16) * ldc + col0;
#pragma unroll
                for (int bj = 0; bj < 2; ++bj)
#pragma unroll
                    for (int n = 0; n < 2; ++n) { const f32x4 bs = *(const f32x4*)(base + off + bj * HALF + n * 16); *(f32x4*)(out + off + bj * HALF + n * 16) = bs + gv[bj][n] * acc[ai][bj][m][n]; } }
    }
};
template <bool BASE_F32> struct EpiResGateH {
    static constexpr bool PERM = true, AFTER_DRAIN = false;
    const void* base; bf16_t* out; int ldc; const float* gate; int gate_ld; int rows_per_batch; float ascale;
    __device__ __forceinline__ void operator()(const f32x4 (&acc)[2][2][4][2], const Unit& u, int wr, int wc, int fr, int fq) const {
        const int row0 = u.po * BM + wr * 64 + fr, col0 = u.pn * BM + wc * 32 + 8 * fq;
        const float* gp = gate + (size_t)((u.po * BM) / rows_per_batch) * gate_ld + col0;
        f32x4 gv[2][2];
#pragma unroll
        for (int bj = 0; bj < 2; ++bj)
#pragma unroll
            for (int n = 0; n < 2; ++n) gv[bj][n] = *(const f32x4*)(gp + bj * HALF + n * 4) * ascale;
#pragma unroll
        for (int ai = 0; ai < 2; ++ai) {
            f32x4 bf[BASE_F32 ? 4 : 1][2][2]; u32x4 bh[BASE_F32 ? 1 : 4][2];
#pragma unroll
            for (int m = 0; m < 4; ++m) { const size_t off = (size_t)(row0 + ai * HALF + m * 16) * ldc + col0;
#pragma unroll
                for (int bj = 0; bj < 2; ++bj) {
                    if (BASE_F32) { bf[m][bj][0] = *(const f32x4*)((const float*)base + off + bj * HALF); bf[m][bj][1] = *(const f32x4*)((const float*)base + off + bj * HALF + 4); }
                    else bh[m][bj] = *(const u32x4*)((const bf16_t*)base + off + bj * HALF); } }
            asm volatile("" ::: "memory");
#pragma unroll
            for (int m = 0; m < 4; ++m) { const size_t off = (size_t)(row0 + ai * HALF + m * 16) * ldc + col0;
#pragma unroll
                for (int bj = 0; bj < 2; ++bj) { f32x4 b0, b1;
                    if (BASE_F32) { b0 = bf[m][bj][0]; b1 = bf[m][bj][1]; }
                    else { const u32x4 w = bh[m][bj];
                        b0 = (f32x4){__uint_as_float(w.x << 16), __uint_as_float(w.x & 0xffff0000u), __uint_as_float(w.y << 16), __uint_as_float(w.y & 0xffff0000u)};
                        b1 = (f32x4){__uint_as_float(w.z << 16), __uint_as_float(w.z & 0xffff0000u), __uint_as_float(w.w << 16), __uint_as_float(w.w & 0xffff0000u)}; }
                    *(u32x4*)(out + off + bj * HALF) = pack8(b0 + gv[bj][0] * acc[ai][bj][m][0], b1 + gv[bj][1] * acc[ai][bj][m][1]); } }
            asm volatile("" ::: "memory");
        }
    }
};
struct EpiSwiGLU {
    static constexpr bool PERM = true, AFTER_DRAIN = false;
    bf16_t* O; int ldc;
    __device__ __forceinline__ void operator()(const f32x4 (&acc)[2][2][4][2], const Unit& u, int wr, int wc, int fr, int fq) const {
        const int row0 = u.po * BM + wr * 64 + fr, col0 = u.pn * HALF + wc * 32 + 8 * fq;
#pragma unroll
        for (int ai = 0; ai < 2; ++ai)
#pragma unroll
            for (int m = 0; m < 4; ++m) { bf16_t* rowp = O + (size_t)(row0 + ai * HALF + m * 16) * ldc + col0;
                f32x4 r0, r1;
#pragma unroll
                for (int j = 0; j < 4; j += 2) { const f32x2 a = swiglu_pk((f32x2){acc[ai][0][m][0][j], acc[ai][0][m][0][j + 1]}, (f32x2){acc[ai][1][m][0][j], acc[ai][1][m][0][j + 1]}, 1.0f);
                    const f32x2 b = swiglu_pk((f32x2){acc[ai][0][m][1][j], acc[ai][0][m][1][j + 1]}, (f32x2){acc[ai][1][m][1][j], acc[ai][1][m][1][j + 1]}, 1.0f);
                    r0[j] = a.x; r0[j + 1] = a.y; r1[j] = b.x; r1[j + 1] = b.y; }
                *(u32x4*)rowp = pack8(r0, r1); }
    }
};
__device__ __forceinline__ float clamp448(float x) { return __builtin_fminf(__builtin_fmaxf(x, -448.f), 448.f); }
__device__ __forceinline__ unsigned pack4_fp8(float a, float b, float c, float d) { int w = 0; w = __builtin_amdgcn_cvt_pk_fp8_f32(clamp448(a), clamp448(b), w, false); w = __builtin_amdgcn_cvt_pk_fp8_f32(clamp448(c), clamp448(d), w, true); return (unsigned)w; }
__device__ __forceinline__ unsigned pack4_i8(float a, float b, float c, float d) {
    const int ia = (int)__builtin_rintf(__builtin_fminf(__builtin_fmaxf(a, -127.f), 127.f)), ib = (int)__builtin_rintf(__builtin_fminf(__builtin_fmaxf(b, -127.f), 127.f)), ic = (int)__builtin_rintf(__builtin_fminf(__builtin_fmaxf(c, -127.f), 127.f)), id = (int)__builtin_rintf(__builtin_fminf(__builtin_fmaxf(d, -127.f), 127.f));
    return ((unsigned)ia & 0xffu) | (((unsigned)ib & 0xffu) << 8) | (((unsigned)ic & 0xffu) << 16) | ((unsigned)id << 24); }
struct EpiSwiGLU8 {
    static constexpr bool PERM = true, AFTER_DRAIN = false;
    unsigned char* O; int ldc; float s;
    __device__ __forceinline__ void operator()(const f32x4 (&acc)[2][2][4][2], const Unit& u, int wr, int wc, int fr, int fq) const {
        const int row0 = u.po * BM + wr * 64 + fr, col0 = u.pn * HALF + wc * 32 + 8 * fq;
#pragma unroll
        for (int ai = 0; ai < 2; ++ai)
#pragma unroll
            for (int m = 0; m < 4; ++m) { unsigned char* rowp = O + (size_t)(row0 + ai * HALF + m * 16) * ldc + col0;
                f32x4 r0, r1;
#pragma unroll
                for (int j = 0; j < 4; j += 2) { const f32x2 a = swiglu_pk((f32x2){acc[ai][0][m][0][j], acc[ai][0][m][0][j + 1]}, (f32x2){acc[ai][1][m][0][j], acc[ai][1][m][0][j + 1]}, s);
                    const f32x2 b = swiglu_pk((f32x2){acc[ai][0][m][1][j], acc[ai][0][m][1][j + 1]}, (f32x2){acc[ai][1][m][1][j], acc[ai][1][m][1][j + 1]}, s);
                    r0[j] = a.x; r0[j + 1] = a.y; r1[j] = b.x; r1[j + 1] = b.y; }
                u32x2 w; w.x = pack4_fp8(r0[0], r0[1], r0[2], r0[3]); w.y = pack4_fp8(r1[0], r1[1], r1[2], r1[3]); *(u32x2*)rowp = w;
                asm volatile("" ::: "memory"); }
    }
};
__device__ __forceinline__ void colscales(const unsigned* cm, int col0, f32x4 (&sv)[2][2]) {
#pragma unroll
    for (int bj = 0; bj < 2; ++bj)
#pragma unroll
        for (int n = 0; n < 2; ++n) { const u32x4 w = *(const u32x4*)(cm + col0 + bj * HALF + n * 4); sv[bj][n] = (f32x4){__uint_as_float(w.x), __uint_as_float(w.y), __uint_as_float(w.z), __uint_as_float(w.w)} * (1.0f / 127.0f); }
}
struct EpiSwiGLUI {
    static constexpr bool PERM = true, AFTER_DRAIN = false;
    bf16_t* O; int ldc; const float* sa; const unsigned* cm;
    __device__ __forceinline__ void operator()(const f32x4 (&acc)[2][2][4][2], const Unit& u, int wr, int wc, int fr, int fq) const {
        const int row0 = u.po * BM + wr * 64 + fr, col0 = u.pn * HALF + wc * 32 + 8 * fq;
        f32x4 sv[2][2]; colscales(cm, u.pn * BM + wc * 32 + 8 * fq, sv);
#pragma unroll
        for (int ai = 0; ai < 2; ++ai)
#pragma unroll
            for (int m = 0; m < 4; ++m) { const int row = row0 + ai * HALF + m * 16; bf16_t* rowp = O + (size_t)row * ldc + col0; const float s = sa[row];
                f32x4 r0, r1;
#pragma unroll
                for (int j = 0; j < 4; j += 2) { const v4i_t g0 = __builtin_bit_cast(v4i_t, acc[ai][0][m][0]), g1 = __builtin_bit_cast(v4i_t, acc[ai][0][m][1]), u0 = __builtin_bit_cast(v4i_t, acc[ai][1][m][0]), u1 = __builtin_bit_cast(v4i_t, acc[ai][1][m][1]);
                    const f32x2 a = swiglu_pk((f32x2){(float)g0[j] * sv[0][0][j], (float)g0[j + 1] * sv[0][0][j + 1]}, (f32x2){(float)u0[j] * sv[1][0][j], (float)u0[j + 1] * sv[1][0][j + 1]}, s);
                    const f32x2 b = swiglu_pk((f32x2){(float)g1[j] * sv[0][1][j], (float)g1[j + 1] * sv[0][1][j + 1]}, (f32x2){(float)u1[j] * sv[1][1][j], (float)u1[j + 1] * sv[1][1][j + 1]}, s);
                    r0[j] = a.x; r0[j + 1] = a.y; r1[j] = b.x; r1[j + 1] = b.y; }
                *(u32x4*)rowp = pack8(r0, r1);
                asm volatile("" ::: "memory"); }
    }
};
struct EpiSwiGLUI8 {
    static constexpr bool PERM = true, AFTER_DRAIN = false;
    unsigned char* O; int ldc; const float* sa; const unsigned* cm;
    __device__ __forceinline__ void operator()(const f32x4 (&acc)[2][2][4][2], const Unit& u, int wr, int wc, int fr, int fq) const {
        const int row0 = u.po * BM + wr * 64 + fr, col0 = u.pn * HALF + wc * 32 + 8 * fq;
        f32x4 sv[2][2]; colscales(cm, u.pn * BM + wc * 32 + 8 * fq, sv);
#pragma unroll
        for (int ai = 0; ai < 2; ++ai)
#pragma unroll
            for (int m = 0; m < 4; ++m) { const int row = row0 + ai * HALF + m * 16; unsigned char* rowp = O + (size_t)row * ldc + col0; const float s = sa[row];
                f32x4 r0, r1;
#pragma unroll
                for (int j = 0; j < 4; j += 2) { const v4i_t g0 = __builtin_bit_cast(v4i_t, acc[ai][0][m][0]), g1 = __builtin_bit_cast(v4i_t, acc[ai][0][m][1]), u0 = __builtin_bit_cast(v4i_t, acc[ai][1][m][0]), u1 = __builtin_bit_cast(v4i_t, acc[ai][1][m][1]);
                    const f32x2 a = swiglu_pk((f32x2){(float)g0[j] * sv[0][0][j], (float)g0[j + 1] * sv[0][0][j + 1]}, (f32x2){(float)u0[j] * sv[1][0][j], (float)u0[j + 1] * sv[1][0][j + 1]}, s);
                    const f32x2 b = swiglu_pk((f32x2){(float)g1[j] * sv[0][1][j], (float)g1[j + 1] * sv[0][1][j + 1]}, (f32x2){(float)u1[j] * sv[1][1][j], (float)u1[j + 1] * sv[1][1][j + 1]}, s);
                    r0[j] = a.x; r0[j + 1] = a.y; r1[j] = b.x; r1[j + 1] = b.y; }
                { u32x2 w; w.x = pack4_fp8(r0[0], r0[1], r0[2], r0[3]); w.y = pack4_fp8(r1[0], r1[1], r1[2], r1[3]); *(u32x2*)rowp = w; }
                asm volatile("" ::: "memory"); }
    }
};
struct EpiProj0I {
    static constexpr bool PERM = true, AFTER_DRAIN = false;
    bf16_t* O; int ldc; float qscale; const float* sa; const unsigned* cm;
    __device__ __forceinline__ void operator()(const f32x4 (&acc)[2][2][4][2], const Unit& u, int wr, int wc, int fr, int fq) const {
        const int row0 = u.po * BM + wr * 64 + fr, col0 = u.pn * BM + wc * 32 + 8 * fq; const float sw = (u.pn < 2 ? qscale : 1.0f);
        f32x4 sv[2][2]; colscales(cm, col0, sv);
        const bool act = u.pn >= 3;
#pragma unroll
        for (int ai = 0; ai < 2; ++ai)
#pragma unroll
            for (int m = 0; m < 4; ++m) { const int row = row0 + ai * HALF + m * 16; bf16_t* rowp = O + (size_t)row * ldc + col0; const float s = sa[row] * sw;
#pragma unroll
                for (int bj = 0; bj < 2; ++bj) { const v4i_t i0 = __builtin_bit_cast(v4i_t, acc[ai][bj][m][0]), i1 = __builtin_bit_cast(v4i_t, acc[ai][bj][m][1]);
                    f32x4 v0 = (f32x4){(float)i0[0], (float)i0[1], (float)i0[2], (float)i0[3]} * sv[bj][0] * s, v1 = (f32x4){(float)i1[0], (float)i1[1], (float)i1[2], (float)i1[3]} * sv[bj][1] * s;
                    if (act) { v0 = gelu4(v0); v1 = gelu4(v1); }
                    *(u32x4*)(rowp + bj * HALF) = pack8(v0, v1); } }
    }
};
struct EpiBf16PlainI {
    static constexpr bool PERM = true, AFTER_DRAIN = false;
    bf16_t* O; int ldc; const float* sa; const unsigned* cm;
    __device__ __forceinline__ void operator()(const f32x4 (&acc)[2][2][4][2], const Unit& u, int wr, int wc, int fr, int fq) const {
        const int row0 = u.po * BM + wr * 64 + fr, col0 = u.pn * BM + wc * 32 + 8 * fq;
        f32x4 sv[2][2]; colscales(cm, col0, sv);
#pragma unroll
        for (int ai = 0; ai < 2; ++ai)
#pragma unroll
            for (int m = 0; m < 4; ++m) { const int row = row0 + ai * HALF + m * 16; bf16_t* rowp = O + (size_t)row * ldc + col0; const float s = sa[row];
#pragma unroll
                for (int bj = 0; bj < 2; ++bj) { const v4i_t i0 = __builtin_bit_cast(v4i_t, acc[ai][bj][m][0]), i1 = __builtin_bit_cast(v4i_t, acc[ai][bj][m][1]);
                    *(u32x4*)(rowp + bj * HALF) = pack8((f32x4){(float)i0[0], (float)i0[1], (float)i0[2], (float)i0[3]} * sv[bj][0] * s, (f32x4){(float)i1[0], (float)i1[1], (float)i1[2], (float)i1[3]} * sv[bj][1] * s); } }
    }
};
struct EpiSwiGLU8I {
    static constexpr bool PERM = true, AFTER_DRAIN = false;
    unsigned char* O; int ldc; const float* sa; const float* swp;
    __device__ __forceinline__ void operator()(const f32x4 (&acc)[2][2][4][2], const Unit& u, int wr, int wc, int fr, int fq) const {
        const int row0 = u.po * BM + wr * 64 + fr, col0 = u.pn * HALF + wc * 32 + 8 * fq; const float sw = *swp;
#pragma unroll
        for (int ai = 0; ai < 2; ++ai)
#pragma unroll
            for (int m = 0; m < 4; ++m) { const int row = row0 + ai * HALF + m * 16; unsigned char* rowp = O + (size_t)row * ldc + col0; const float s = sa[row] * sw;
                f32x4 r0, r1;
#pragma unroll
                for (int j = 0; j < 4; j += 2) { const v4i_t g0 = __builtin_bit_cast(v4i_t, acc[ai][0][m][0]), g1 = __builtin_bit_cast(v4i_t, acc[ai][0][m][1]), u0 = __builtin_bit_cast(v4i_t, acc[ai][1][m][0]), u1 = __builtin_bit_cast(v4i_t, acc[ai][1][m][1]);
                    const f32x2 a = swiglu_pk((f32x2){(float)g0[j], (float)g0[j + 1]}, (f32x2){(float)u0[j], (float)u0[j + 1]}, s);
                    const f32x2 b = swiglu_pk((f32x2){(float)g1[j], (float)g1[j + 1]}, (f32x2){(float)u1[j], (float)u1[j + 1]}, s);
                    r0[j] = a.x; r0[j + 1] = a.y; r1[j] = b.x; r1[j + 1] = b.y; }
                u32x2 w; w.x = pack4_fp8(r0[0], r0[1], r0[2], r0[3]); w.y = pack4_fp8(r1[0], r1[1], r1[2], r1[3]); *(u32x2*)rowp = w;
                asm volatile("" ::: "memory"); }
    }
};
struct EpiQRope {
    static constexpr bool PERM = true, AFTER_DRAIN = false;
    bf16_t* O; int ldc; const float* ctab; const float* stab; float qscale; int seq_mask;
    __device__ __forceinline__ void operator()(const f32x4 (&acc)[2][2][4][2], const Unit& u, int wr, int wc, int fr, int fq) const {
        const int row0 = u.po * BM + wr * 64 + fr, col0 = u.pn * BM + wc * 32 + 8 * fq;
#pragma unroll
        for (int ai = 0; ai < 2; ++ai)
#pragma unroll
            for (int m = 0; m < 4; ++m) { const int row = row0 + ai * HALF + m * 16; bf16_t* rowp = O + (size_t)row * ldc + col0; const int pos = row & seq_mask;
#pragma unroll
                for (int bj = 0; bj < 2; ++bj) { f32x4 v0 = acc[ai][bj][m][0] * qscale, v1 = acc[ai][bj][m][1] * qscale;
                    const int off = (col0 + bj * HALF) % 96;
                    if (off >= 64) { const int i0 = (off - 64) >> 1; const f32x4 cs = *(const f32x4*)(ctab + pos * 16 + i0), sn = *(const f32x4*)(stab + pos * 16 + i0);
                        const f32x4 a = v0, b = v1;
                        v0[0] = a[0] * cs[0] - a[1] * sn[0]; v0[1] = a[0] * sn[0] + a[1] * cs[0]; v0[2] = a[2] * cs[1] - a[3] * sn[1]; v0[3] = a[2] * sn[1] + a[3] * cs[1];
                        v1[0] = b[0] * cs[2] - b[1] * sn[2]; v1[1] = b[0] * sn[2] + b[1] * cs[2]; v1[2] = b[2] * cs[3] - b[3] * sn[3]; v1[3] = b[2] * sn[3] + b[3] * cs[3]; }
                    *(u32x4*)(rowp + bj * HALF) = pack8(v0, v1); }
                asm volatile("" ::: "memory"); }
    }
};

#ifndef PG8_F8_ASM_STAGE
#define PG8_F8_ASM_STAGE 0
#endif
template <class Epi, class Sched, bool ALIGN_EPI = false, bool SP2 = false, bool F8 = false, bool I8 = false, bool PF = false>
__device__ __forceinline__ void gemm_phase(PG8_LAS unsigned char* lds, const Gemm g, const Sched& S, const Epi& E, const int wave_) {
    int tid_ = tid_from_wave(wave_); asm volatile("" : "+v"(tid_));
    const int tid = tid_, wid = __builtin_amdgcn_readfirstlane(tid >> 6), lane = tid & 63, wr = wid >> 2, wc = wid & 3, fr = lane & 15, fq = lane >> 4;
    const int K = g.K, nt = K / BK;
    unsigned voffA[2], voffB[2];
#pragma unroll
    for (int i = 0; i < 2; ++i) { int R, C; stage_rc(tid * 16 + i * 8192, R, C); const int Rb = Epi::PERM ? ((R & ~31) + perm32(R & 31)) : R;
        voffA[i] = (unsigned)(R * K + C) * 2u; voffB[i] = (unsigned)(Rb * K + C) * 2u; }
    const size_t kstep = (size_t)(BK * 2);
    const size_t hstep = (size_t)HALF * K * 2;
    const size_t tstep = 2 * hstep;
    const unsigned lds_a32 = (unsigned)(uintptr_t)lds;
    const unsigned ldsw = (unsigned)wid * 1024u;
    const int aoff = lds_byte(wr * 64 + fr, fq * 8), boff = lds_byte(wc * 32 + fr, fq * 8);
#define PG8_SA(b, h) (((b) * 2 + (h)) * HTB)
#define PG8_SB(b, h) ((4 + (b) * 2 + (h)) * HTB)
#define PG8_STAGE(bufoff, gbase, voff) do { _Pragma("unroll") for (int _i = 0; _i < 2; ++_i) { \
        if constexpr (F8 && PG8_F8_ASM_STAGE) { unsigned keep_; asm volatile("s_mov_b32 %0, m0\n\ts_mov_b32 m0, %3\n\ts_nop 0\n\tglobal_load_lds_dwordx4 %1, %2\n\ts_mov_b32 m0, %0" : "=&s"(keep_) : "v"((voff)[_i]), "s"((const char*)(gbase)), "s"((unsigned)__builtin_amdgcn_readfirstlane((int)(lds_a32 + (unsigned)(bufoff) + ldsw + (unsigned)(_i * 8192)))) : "memory"); } \
        else __builtin_amdgcn_global_load_lds((const unsigned*)((const char*)(gbase) + (voff)[_i]), (PG8_LAS unsigned*)(lds + (bufoff) + ldsw + _i * 8192), 16, 0, 0); } } while (0)
#define PG8_LDA(dst, b, h) do { _Pragma("unroll") for (int m = 0; m < 4; ++m) _Pragma("unroll") for (int k = 0; k < 2; ++k) dst[m][k] = *(const PG8_LAS bf16x8*)(lds + PG8_SA(b, h) + aoff + m * 2048 + k * 1024); } while (0)
#define PG8_LDB(dst, b, h) do { _Pragma("unroll") for (int n = 0; n < 2; ++n) _Pragma("unroll") for (int k = 0; k < 2; ++k) dst[n][k] = *(const PG8_LAS bf16x8*)(lds + PG8_SB(b, h) + boff + n * 2048 + k * 1024); } while (0)
#define PG8_MMA(ai, bj, At, Bt) do { __builtin_amdgcn_s_setprio(1); _Pragma("unroll") for (int m = 0; m < 4; ++m) _Pragma("unroll") for (int n = 0; n < 2; ++n) { \
        if constexpr (F8) { const v8i_t b8_ = __builtin_shufflevector(__builtin_bit_cast(v4i_t, Bt[n][0]), __builtin_bit_cast(v4i_t, Bt[n][1]), 0, 1, 2, 3, 4, 5, 6, 7), a8_ = __builtin_shufflevector(__builtin_bit_cast(v4i_t, At[m][0]), __builtin_bit_cast(v4i_t, At[m][1]), 0, 1, 2, 3, 4, 5, 6, 7); \
            asm volatile("v_mfma_f32_16x16x128_f8f6f4 %0, %1, %2, %0" : "+v"(acc[ai][bj][m][n]) : "v"(b8_), "v"(a8_)); } \
        else if constexpr (I8) { _Pragma("unroll") for (int k = 0; k < 2; ++k) acc[ai][bj][m][n] = __builtin_bit_cast(f32x4, __builtin_amdgcn_mfma_i32_16x16x64_i8(__builtin_bit_cast(v4i_t, Bt[n][k]), __builtin_bit_cast(v4i_t, At[m][k]), __builtin_bit_cast(v4i_t, acc[ai][bj][m][n]), 0, 0, 0)); } \
        else { _Pragma("unroll") for (int k = 0; k < 2; ++k) acc[ai][bj][m][n] = __builtin_amdgcn_mfma_f32_16x16x32_bf16(Bt[n][k], At[m][k], acc[ai][bj][m][n], 0, 0, 0); } } __builtin_amdgcn_s_setprio(0); } while (0)
#define PG8_MF(ai, bj, m, n, At, Bt) do { \
        if constexpr (F8) { const v8i_t b8_ = __builtin_shufflevector(__builtin_bit_cast(v4i_t, Bt[n][0]), __builtin_bit_cast(v4i_t, Bt[n][1]), 0, 1, 2, 3, 4, 5, 6, 7), a8_ = __builtin_shufflevector(__builtin_bit_cast(v4i_t, At[m][0]), __builtin_bit_cast(v4i_t, At[m][1]), 0, 1, 2, 3, 4, 5, 6, 7); \
            asm volatile("v_mfma_f32_16x16x128_f8f6f4 %0, %1, %2, %0" : "+v"(acc[ai][bj][m][n]) : "v"(b8_), "v"(a8_)); } \
        else if constexpr (I8) { _Pragma("unroll") for (int k = 0; k < 2; ++k) acc[ai][bj][m][n] = __builtin_bit_cast(f32x4, __builtin_amdgcn_mfma_i32_16x16x64_i8(__builtin_bit_cast(v4i_t, Bt[n][k]), __builtin_bit_cast(v4i_t, At[m][k]), __builtin_bit_cast(v4i_t, acc[ai][bj][m][n]), 0, 0, 0)); } \
        else { _Pragma("unroll") for (int k = 0; k < 2; ++k) acc[ai][bj][m][n] = __builtin_amdgcn_mfma_f32_16x16x32_bf16(Bt[n][k], At[m][k], acc[ai][bj][m][n], 0, 0, 0); } } while (0)
#define PG8_RA(dst, b, h, m, k) dst[m][k] = *(const PG8_LAS bf16x8*)(lds + PG8_SA(b, h) + aoff + (m) * 2048 + (k) * 1024)
#define PG8_RB(dst, b, h, n, k) dst[n][k] = *(const PG8_LAS bf16x8*)(lds + PG8_SB(b, h) + boff + (n) * 2048 + (k) * 1024)
#define PG8_X1(b) do { __builtin_amdgcn_s_setprio(1); \
        PG8_MF(0, 0, 0, 0, At, B0); PG8_RB(B1, b, 1, 0, 0); PG8_SCHED; PG8_MF(0, 0, 0, 1, At, B0); PG8_RB(B1, b, 1, 0, 1); PG8_SCHED; PG8_MF(0, 0, 1, 0, At, B0); PG8_RB(B1, b, 1, 1, 0); PG8_SCHED; PG8_MF(0, 0, 1, 1, At, B0); PG8_RB(B1, b, 1, 1, 1); PG8_SCHED; \
        PG8_MF(0, 0, 2, 0, At, B0); PG8_MF(0, 0, 2, 1, At, B0); PG8_MF(0, 0, 3, 0, At, B0); PG8_MF(0, 0, 3, 1, At, B0); PG8_SCHED; \
        PG8_MF(0, 1, 0, 0, At, B1); PG8_RA(At2, b, 1, 0, 0); PG8_SCHED; PG8_MF(0, 1, 0, 1, At, B1); PG8_RA(At2, b, 1, 0, 1); PG8_SCHED; PG8_MF(0, 1, 1, 0, At, B1); PG8_RA(At2, b, 1, 1, 0); PG8_SCHED; PG8_MF(0, 1, 1, 1, At, B1); PG8_RA(At2, b, 1, 1, 1); PG8_SCHED; \
        PG8_MF(0, 1, 2, 0, At, B1); PG8_RA(At2, b, 1, 2, 0); PG8_SCHED; PG8_MF(0, 1, 2, 1, At, B1); PG8_RA(At2, b, 1, 2, 1); PG8_SCHED; PG8_MF(0, 1, 3, 0, At, B1); PG8_RA(At2, b, 1, 3, 0); PG8_SCHED; PG8_MF(0, 1, 3, 1, At, B1); PG8_RA(At2, b, 1, 3, 1); PG8_SCHED; \
        __builtin_amdgcn_s_setprio(0); } while (0)
#define PG8_X2(b) do { __builtin_amdgcn_s_setprio(1); \
        PG8_MF(1, 0, 0, 0, At2, B0); PG8_RA(At, (b) ^ 1, 0, 0, 0); PG8_SCHED; PG8_MF(1, 0, 0, 1, At2, B0); PG8_RA(At, (b) ^ 1, 0, 0, 1); PG8_SCHED; PG8_MF(1, 0, 1, 0, At2, B0); PG8_RA(At, (b) ^ 1, 0, 1, 0); PG8_SCHED; PG8_MF(1, 0, 1, 1, At2, B0); PG8_RA(At, (b) ^ 1, 0, 1, 1); PG8_SCHED; \
        PG8_MF(1, 0, 2, 0, At2, B0); PG8_RA(At, (b) ^ 1, 0, 2, 0); PG8_SCHED; PG8_MF(1, 0, 2, 1, At2, B0); PG8_RA(At, (b) ^ 1, 0, 2, 1); PG8_SCHED; PG8_MF(1, 0, 3, 0, At2, B0); PG8_RA(At, (b) ^ 1, 0, 3, 0); PG8_SCHED; PG8_MF(1, 0, 3, 1, At2, B0); PG8_RA(At, (b) ^ 1, 0, 3, 1); PG8_SCHED; \
        PG8_MF(1, 1, 0, 0, At2, B1); PG8_RB(B0, (b) ^ 1, 0, 0, 0); PG8_SCHED; PG8_MF(1, 1, 0, 1, At2, B1); PG8_RB(B0, (b) ^ 1, 0, 0, 1); PG8_SCHED; PG8_MF(1, 1, 1, 0, At2, B1); PG8_RB(B0, (b) ^ 1, 0, 1, 0); PG8_SCHED; PG8_MF(1, 1, 1, 1, At2, B1); PG8_RB(B0, (b) ^ 1, 0, 1, 1); PG8_SCHED; \
        PG8_MF(1, 1, 2, 0, At2, B1); PG8_MF(1, 1, 2, 1, At2, B1); PG8_MF(1, 1, 3, 0, At2, B1); PG8_MF(1, 1, 3, 1, At2, B1); __builtin_amdgcn_s_setprio(0); } while (0)
#define PG8_WAIT_V(n) asm volatile("s_waitcnt vmcnt(" #n ")" ::: "memory")
#define PG8_WAIT_L(n) asm volatile("s_waitcnt lgkmcnt(" #n ")" ::: "memory")
#define PG8_BAR __builtin_amdgcn_s_barrier()
#define PG8_SCHED __builtin_amdgcn_sched_barrier(0)
    Unit cur, nxt; int ui = 0;
    if (!S.next(0, cur)) return;
    f32x4 acc[2][2][4][2];
#pragma unroll
    for (int a = 0; a < 2; ++a)
#pragma unroll
        for (int b = 0; b < 2; ++b)
#pragma unroll
            for (int m = 0; m < 4; ++m)
#pragma unroll
                for (int n = 0; n < 2; ++n) acc[a][b][m][n] = (f32x4){0.f, 0.f, 0.f, 0.f};
    bf16x8 At[4][2], B0[2][2], B1[2][2]; bf16x8 At2[PF ? 4 : 1][2];
    const char* cA = (const char*)g.A + (size_t)cur.pm * tstep; const char* cB = (const char*)g.Bt + (size_t)cur.pb * tstep;
    S.a_ready(cur);
    if constexpr (PF) {
        PG8_STAGE(PG8_SA(0, 0), cA, voffA); PG8_STAGE(PG8_SB(0, 0), cB, voffB); PG8_STAGE(PG8_SA(0, 1), cA + hstep, voffA); PG8_STAGE(PG8_SB(0, 1), cB + hstep, voffB);
        PG8_STAGE(PG8_SA(1, 0), cA + kstep, voffA); PG8_STAGE(PG8_SB(1, 0), cB + kstep, voffB);
        if (wr == 1) { PG8_STAGE(PG8_SA(1, 1), cA + hstep + kstep, voffA); PG8_STAGE(PG8_SB(1, 1), cB + hstep + kstep, voffB); }
        PG8_WAIT_V(8); PG8_BAR;
        PG8_LDA(At, 0, 0); PG8_LDB(B0, 0, 0); __builtin_amdgcn_s_waitcnt(0xC07F);
        if (wr == 1) PG8_BAR;
    } else
    if constexpr (SP2) {
        PG8_STAGE(PG8_SB(0, 0), cB, voffB); PG8_STAGE(PG8_SB(0, 1), cB + hstep, voffB); PG8_STAGE(PG8_SA(0, 0), cA, voffA); PG8_STAGE(PG8_SA(0, 1), cA + hstep, voffA);
        if (wr == 1) PG8_BAR;
        PG8_WAIT_V(2); PG8_BAR;
        PG8_STAGE(PG8_SB(1, 0), cB + kstep, voffB); PG8_STAGE(PG8_SA(1, 0), cA + kstep, voffA); PG8_STAGE(PG8_SB(1, 1), cB + hstep + kstep, voffB);
        PG8_WAIT_V(6); PG8_BAR;
    } else {
        PG8_STAGE(PG8_SB(0, 0), cB, voffB); PG8_STAGE(PG8_SA(0, 0), cA, voffA); PG8_STAGE(PG8_SB(0, 1), cB + hstep, voffB); PG8_STAGE(PG8_SA(0, 1), cA + hstep, voffA);
        if (wr == 1) PG8_BAR;
        PG8_WAIT_V(4); PG8_BAR;
        PG8_STAGE(PG8_SB(1, 0), cB + kstep, voffB); PG8_STAGE(PG8_SA(1, 0), cA + kstep, voffA); PG8_STAGE(PG8_SB(1, 1), cB + hstep + kstep, voffB);
        PG8_WAIT_V(6); PG8_BAR;
    }
    for (;;) {
        const bool has_next = S.next(ui + 1, nxt);
        const char* nA = has_next ? (const char*)g.A + (size_t)nxt.pm * tstep : cA; const char* nB = has_next ? (const char*)g.Bt + (size_t)nxt.pb * tstep : cB;
        for (int t = 0; t < nt; t += 2) {
            const bool last = (t == nt - 2);
            const char* a1 = cA + (size_t)(t + 1) * kstep;
            const char* a2 = last ? nA : cA + (size_t)(t + 2) * kstep; const char* b2 = last ? nB : cB + (size_t)(t + 2) * kstep;
            const char* a3 = a2 + kstep; const char* b3 = b2 + kstep;
            if (last && has_next) S.a_ready(nxt);
            if constexpr (PF) {
            PG8_STAGE(wr ? PG8_SA(0, 0) : PG8_SA(1, 1), wr ? a2 : a1 + hstep, voffA); PG8_STAGE(wr ? PG8_SB(0, 0) : PG8_SB(1, 1), wr ? b2 : cB + (size_t)(t + 1) * kstep + hstep, voffB);
            PG8_WAIT_V(8); PG8_BAR;
            PG8_X1(0); __builtin_amdgcn_s_waitcnt(0xC07F); PG8_BAR; PG8_SCHED;
            PG8_STAGE(wr ? PG8_SA(0, 1) : PG8_SA(0, 0), wr ? a2 + hstep : a2, voffA); PG8_STAGE(wr ? PG8_SB(0, 1) : PG8_SB(0, 0), wr ? b2 + hstep : b2, voffB);
            PG8_WAIT_V(8); PG8_BAR;
            PG8_X2(0); __builtin_amdgcn_s_waitcnt(0xC07F); PG8_BAR; PG8_SCHED;
            PG8_STAGE(wr ? PG8_SA(1, 0) : PG8_SA(0, 1), wr ? a3 : a2 + hstep, voffA); PG8_STAGE(wr ? PG8_SB(1, 0) : PG8_SB(0, 1), wr ? b3 : b2 + hstep, voffB);
            PG8_WAIT_V(8); PG8_BAR;
            PG8_X1(1); __builtin_amdgcn_s_waitcnt(0xC07F); PG8_BAR; PG8_SCHED;
            PG8_STAGE(wr ? PG8_SA(1, 1) : PG8_SA(1, 0), wr ? a3 + hstep : a3, voffA); PG8_STAGE(wr ? PG8_SB(1, 1) : PG8_SB(1, 0), wr ? b3 + hstep : b3, voffB);
            PG8_WAIT_V(8); PG8_BAR;
            PG8_X2(1); __builtin_amdgcn_s_waitcnt(0xC07F); PG8_BAR; PG8_SCHED;
            } else
            if constexpr (SP2) {
            PG8_LDB(B0, 0, 0); PG8_LDB(B1, 0, 1); PG8_SCHED; PG8_LDA(At, 0, 0); PG8_STAGE(PG8_SA(1, 1), a1 + hstep, voffA);
            PG8_WAIT_V(8); PG8_WAIT_L(0); PG8_BAR; PG8_MMA(0, 0, At, B0); PG8_MMA(0, 1, At, B1); PG8_BAR; PG8_SCHED;
            PG8_LDA(At, 0, 1); PG8_STAGE(PG8_SB(0, 0), b2, voffB); PG8_STAGE(PG8_SB(0, 1), b2 + hstep, voffB); PG8_STAGE(PG8_SA(0, 0), a2, voffA);
            PG8_WAIT_V(8); PG8_WAIT_L(0); PG8_BAR; PG8_MMA(1, 0, At, B0); PG8_MMA(1, 1, At, B1); PG8_BAR; PG8_SCHED;
            PG8_LDB(B0, 1, 0); PG8_LDB(B1, 1, 1); PG8_SCHED; PG8_LDA(At, 1, 0); PG8_STAGE(PG8_SA(0, 1), a2 + hstep, voffA);
            PG8_WAIT_V(8); PG8_WAIT_L(0); PG8_BAR; PG8_MMA(0, 0, At, B0); PG8_MMA(0, 1, At, B1); PG8_BAR; PG8_SCHED;
            PG8_LDA(At, 1, 1); PG8_STAGE(PG8_SB(1, 0), b3, voffB); PG8_STAGE(PG8_SB(1, 1), b3 + hstep, voffB); PG8_STAGE(PG8_SA(1, 0), a3, voffA);
            PG8_WAIT_V(8); PG8_WAIT_L(0); PG8_BAR; PG8_MMA(1, 0, At, B0); PG8_MMA(1, 1, At, B1); PG8_BAR; PG8_SCHED;
            } else {
            PG8_LDB(B0, 0, 0); PG8_SCHED; PG8_LDA(At, 0, 0); PG8_STAGE(PG8_SA(1, 1), a1 + hstep, voffA);
            PG8_WAIT_L(8); PG8_BAR; PG8_WAIT_L(0); PG8_MMA(0, 0, At, B0); PG8_BAR; PG8_SCHED;
            PG8_LDB(B1, 0, 1); PG8_STAGE(PG8_SB(0, 0), b2, voffB);
            PG8_BAR; PG8_WAIT_L(0); PG8_MMA(0, 1, At, B1); PG8_BAR;
            PG8_LDA(At, 0, 1); PG8_STAGE(PG8_SA(0, 0), a2, voffA);
            PG8_BAR; PG8_WAIT_L(0); PG8_MMA(1, 0, At, B0); PG8_BAR; PG8_SCHED;
            PG8_STAGE(PG8_SB(0, 1), b2 + hstep, voffB);
            PG8_WAIT_V(6); PG8_BAR; PG8_MMA(1, 1, At, B1); PG8_BAR;
            PG8_LDB(B0, 1, 0); PG8_SCHED; PG8_LDA(At, 1, 0); PG8_STAGE(PG8_SA(0, 1), a2 + hstep, voffA);
            PG8_WAIT_L(8); PG8_BAR; PG8_WAIT_L(0); PG8_MMA(0, 0, At, B0); PG8_BAR; PG8_SCHED;
            PG8_LDB(B1, 1, 1); PG8_STAGE(PG8_SB(1, 0), b3, voffB);
            PG8_BAR; PG8_WAIT_L(0); PG8_MMA(0, 1, At, B1); PG8_BAR;
            PG8_LDA(At, 1, 1); PG8_STAGE(PG8_SA(1, 0), a3, voffA);
            PG8_BAR; PG8_WAIT_L(0); PG8_MMA(1, 0, At, B0); PG8_BAR; PG8_SCHED;
            PG8_STAGE(PG8_SB(1, 1), b3 + hstep, voffB);
            PG8_WAIT_V(6); PG8_BAR; PG8_MMA(1, 1, At, B1); PG8_BAR;
            }
        }
        if constexpr (ALIGN_EPI) { if (wr == 0) PG8_BAR; }
        if constexpr (F8) asm volatile("s_nop 15\n\ts_nop 7" ::: "memory");
        if constexpr (!Epi::AFTER_DRAIN) { int t2_ = tid_from_wave(wave_); asm volatile("" : "+v"(t2_)); const int l2_ = t2_ & 63;
            E(acc, cur, wr, wc, l2_ & 15, l2_ >> 4); S.done(cur); }
        if (!has_next) break;
#pragma unroll
        for (int a = 0; a < 2; ++a)
#pragma unroll
            for (int b = 0; b < 2; ++b)
#pragma unroll
                for (int m = 0; m < 4; ++m)
#pragma unroll
                    for (int n = 0; n < 2; ++n) acc[a][b][m][n] = (f32x4){0.f, 0.f, 0.f, 0.f};
        cur = nxt; cA = nA; cB = nB; ++ui;
        if constexpr (ALIGN_EPI) { if (wr == 1) PG8_BAR; }
    }
    PG8_WAIT_V(0);
    if constexpr (!ALIGN_EPI) { if (wr == 0) PG8_BAR; }
    PG8_BAR;
    if constexpr (Epi::AFTER_DRAIN) { E.fused(acc, cur, wr, wc, fr, fq, lds, wid, lane); S.done(cur); }
#undef PG8_SA
#undef PG8_SB
#undef PG8_STAGE
#undef PG8_LDA
#undef PG8_LDB
#undef PG8_MMA
#undef PG8_MF
#undef PG8_RA
#undef PG8_RB
#undef PG8_X1
#undef PG8_X2
#undef PG8_WAIT_V
#undef PG8_WAIT_L
#undef PG8_BAR
#undef PG8_SCHED
}
}
#define GAS __attribute__((address_space(1)))
#define LAS __attribute__((address_space(3)))
typedef unsigned short bf16;
typedef unsigned v4u __attribute__((ext_vector_type(4)));
typedef float f32x4 __attribute__((ext_vector_type(4)));
typedef short bf16x8 __attribute__((ext_vector_type(8)));
typedef GAS unsigned gu32;
typedef GAS unsigned long long gu64;
#define RLX_AGENT __ATOMIC_RELAXED, __HIP_MEMORY_SCOPE_AGENT
#define LDS_WAIT() asm volatile("s_waitcnt lgkmcnt(0)" ::: "memory")
#define VM_WAIT() asm volatile("s_waitcnt vmcnt(0)" ::: "memory")
__device__ __forceinline__ unsigned long long rt() { return __builtin_amdgcn_s_memrealtime(); }

#define XB_TMO      128
#define XB_XCNT(j)  (256  + 64 * (j))
#define XB_XSUB(j)  (1280 + 64 * (j))
#define XB_XGEN(j)  (2304 + 64 * (j))
#define XB_TOP      3328
#define XB_TOPGEN   3392
#define XCD_BAR_WORDS 3456
#define XB_SPIN_CAP (1u << 18)

__device__ __forceinline__ unsigned xb_ld(unsigned* p)              { return __hip_atomic_load(p, __ATOMIC_RELAXED, __HIP_MEMORY_SCOPE_AGENT); }
__device__ __forceinline__ unsigned xb_add(unsigned* p, unsigned v) { return __hip_atomic_fetch_add(p, v, __ATOMIC_RELAXED, __HIP_MEMORY_SCOPE_AGENT); }
__device__ __forceinline__ unsigned xb_xcc_id() { return (unsigned)__builtin_amdgcn_s_getreg((3 << 11) | 20) & 0xFu; }
#define XB_SPIN(cond, bar) do { unsigned _sp = 0; while (cond) { __builtin_amdgcn_s_sleep(1); \
    if ((++_sp & 255u) == 0u) { if (xb_ld(&(bar)[XB_TMO])) break; if (_sp > XB_SPIN_CAP) { atomicAdd(&(bar)[XB_TMO], 1u); break; } } } } while (0)

struct XcdBarrier {
    unsigned* bar; unsigned x; int wave;
    volatile LAS unsigned* st;
};

__device__ __forceinline__ XcdBarrier xcd_barrier_post(unsigned* bar, volatile LAS unsigned* st, int wave) {
    XcdBarrier b; b.bar = bar; b.x = xb_xcc_id(); b.st = st; b.wave = wave;
    if (tid_from_wave(wave) == 0) (void)xb_add(&bar[XB_XCNT(b.x)], 1u);
    return b;
}
__device__ __forceinline__ void xcd_barrier_complete(unsigned* bar, unsigned x, unsigned& nloc, unsigned& nx) {
    const unsigned G = gridDim.x * gridDim.y * gridDim.z;
    unsigned sum, cnt, mine, sp = 0u;
    for (;;) {
        sum = 0u; cnt = 0u; mine = 0u;
#pragma unroll
        for (unsigned j = 0; j < 16; ++j) { const unsigned c = xb_ld(&bar[XB_XCNT(j)]); sum += c; cnt += (c > 0u) ? 1u : 0u; mine = (j == x) ? c : mine; }
        if (sum == G) break;
        __builtin_amdgcn_s_sleep(1);
        if ((++sp & 255u) == 0u) { if (xb_ld(&bar[XB_TMO])) break; if (sp > XB_SPIN_CAP) { atomicAdd(&bar[XB_TMO], 1u); break; } }
    }
    nloc = mine > 0u ? mine : 1u; nx = cnt > 0u ? cnt : 1u;
}

__device__ __forceinline__ void xcd_barrier(const XcdBarrier& b) {
    asm volatile("s_waitcnt vmcnt(0)" ::: "memory");
    __syncthreads();
    if (tid_from_wave(b.wave) == 0) {
        unsigned* bar = b.bar;
        __builtin_amdgcn_s_waitcnt(0);
        unsigned nloc = b.st[0], nx = b.st[1];
        if (nloc == 0u) { xcd_barrier_complete(bar, b.x, nloc, nx); b.st[0] = nloc; b.st[1] = nx; }
        const unsigned old = xb_add(&bar[XB_XSUB(b.x)], 1u);
        const unsigned gen = old / nloc;
        if (old + 1u == (gen + 1u) * nloc) {
            __builtin_amdgcn_fence(__ATOMIC_RELEASE, "agent");
            asm volatile("s_waitcnt vmcnt(0)" ::: "memory");
            const unsigned og = xb_add(&bar[XB_TOP], 1u);
            const unsigned tg = og / nx;
            if (og + 1u == (tg + 1u) * nx) xb_add(&bar[XB_TOPGEN], 1u);
            else XB_SPIN(xb_ld(&bar[XB_TOPGEN]) == tg, bar);
            __builtin_amdgcn_fence(__ATOMIC_ACQUIRE, "agent");
            xb_add(&bar[XB_XGEN(b.x)], 1u);
            asm volatile("s_waitcnt vmcnt(0)" ::: "memory");
        } else {
            XB_SPIN(xb_ld(&bar[XB_XGEN(b.x)]) == gen, bar);
            __builtin_amdgcn_fence(__ATOMIC_ACQUIRE, "agent");
            asm volatile("s_waitcnt vmcnt(0)" ::: "memory");
        }
    }
    __syncthreads();
}

namespace mla {
using bf16x8 = __attribute__((ext_vector_type(8))) short;
using s16x4 = __attribute__((ext_vector_type(4))) short;
using f32x16 = __attribute__((ext_vector_type(16))) float;
using u32x4 = __attribute__((ext_vector_type(4))) unsigned;
typedef __attribute__((address_space(3))) const char* lds_cptr;
constexpr int SEQ = 8192, NW = 8, QBLK = 32, QB = 256, KVBLK = 64, NSLOT = 3, KSLOT = 12288, VSLOT = 8192;
constexpr int QP = 768, KVP = 1024, PEP = 32, OP = 1024;
constexpr int LDS_K = 0, LDS_V = NSLOT * KSLOT, LDS_WS = LDS_V + NSLOT * VSLOT, LDS_OST = LDS_WS + NW * 64 * 4, LDS_TOTAL = LDS_OST + NW * 4096;
__device__ __forceinline__ int crow(int r, int hi) { return (r & 3) + 8 * (r >> 2) + 4 * hi; }
__device__ __forceinline__ void glds16(const void* gsrc, unsigned lds_dst) { unsigned keep;
    asm volatile("s_mov_b32 %0, m0\n\ts_mov_b32 m0, %2\n\ts_nop 0\n\tglobal_load_lds_dwordx4 %1, off\n\ts_mov_b32 m0, %0" : "=&s"(keep) : "v"(gsrc), "s"(lds_dst) : "memory"); }
__device__ __forceinline__ float max3f(float a, float b, float c) { float r; asm("v_max3_f32 %0, %1, %2, %3" : "=v"(r) : "v"(a), "v"(b), "v"(c)); return r; }
typedef float f32x2_t __attribute__((ext_vector_type(2))); typedef __bf16 bf16x2_t __attribute__((ext_vector_type(2)));
__device__ __forceinline__ unsigned cvtpk_s(float lo, float hi) { f32x2_t v = {lo, hi}; bf16x2_t b = __builtin_convertvector(v, bf16x2_t); return __builtin_bit_cast(unsigned, b); }
__device__ __forceinline__ void cmask(f32x16& p0, f32x16& p1, int jb, int qrel, int hi) {
    const float NEG = -INFINITY; const int kb = 64 * jb + 4 * hi;
#pragma unroll
    for (int r = 0; r < 16; ++r) { const int kv = kb + (r & 3) + 8 * (r >> 2); if (kv > qrel) p0[r] = NEG; if (kv + 32 > qrel) p1[r] = NEG; }
}
__device__ __forceinline__ float rowmax(const f32x16& p0, const f32x16& p1) {
    float a = max3f(p0[0], p0[1], p1[0]), b = max3f(p0[2], p0[3], p1[1]); a = max3f(a, p1[2], p1[3]);
#pragma unroll
    for (int r = 4; r < 16; r += 4) { a = max3f(a, p0[r], p0[r + 1]); b = max3f(b, p0[r + 2], p0[r + 3]); a = max3f(a, p1[r], p1[r + 1]); b = max3f(b, p1[r + 2], p1[r + 3]); }
    const float m = fmaxf(a, b);
    auto rr = __builtin_amdgcn_permlane32_swap(__float_as_uint(m), __float_as_uint(m), false, false);
    return fmaxf(__uint_as_float(rr[0]), __uint_as_float(rr[1]));
}
__device__ __forceinline__ void pv(f32x16* o, int vb, bf16x8 pa0, bf16x8 pa1, bf16x8 pa2, bf16x8 pa3) {
#pragma unroll
    for (int d0 = 0; d0 < 2; ++d0) { s16x4 lo[4], hi[4];
#pragma unroll
        for (int ks = 0; ks < 4; ++ks) {
            asm volatile("ds_read_b64_tr_b16 %0,%1 offset:%c2" : "=&v"(lo[ks]) : "v"(vb), "i"(d0 * 4096 + ks * 1024) : "memory");
            asm volatile("ds_read_b64_tr_b16 %0,%1 offset:%c2" : "=&v"(hi[ks]) : "v"(vb), "i"(d0 * 4096 + ks * 1024 + 512) : "memory"); }
        asm volatile("s_waitcnt lgkmcnt(0)" ::: "memory"); __builtin_amdgcn_sched_barrier(0);
#define MLA_PK(k) (bf16x8){lo[k][0], lo[k][1], lo[k][2], lo[k][3], hi[k][0], hi[k][1], hi[k][2], hi[k][3]}
        o[d0] = __builtin_amdgcn_mfma_f32_32x32x16_bf16(pa0, MLA_PK(0), o[d0], 0, 0, 0);
        o[d0] = __builtin_amdgcn_mfma_f32_32x32x16_bf16(pa1, MLA_PK(1), o[d0], 0, 0, 0);
        o[d0] = __builtin_amdgcn_mfma_f32_32x32x16_bf16(pa2, MLA_PK(2), o[d0], 0, 0, 0);
        o[d0] = __builtin_amdgcn_mfma_f32_32x32x16_bf16(pa3, MLA_PK(3), o[d0], 0, 0, 0);
#undef MLA_PK
    }
}
#define MLA_WAIT_BAR(N) asm volatile("s_waitcnt vmcnt(" #N ") lgkmcnt(0)\n\ts_barrier" ::: "memory")

__device__ __forceinline__ void unit(int b, int h, int qb, const unsigned short* Q, const unsigned short* KV, const unsigned short* KPE, unsigned short* O, char* shm, const int wave_) {
    int tid_ = tid_from_wave(wave_); asm volatile("" : "+v"(tid_));
    const int tid = tid_, lane = tid & 63, r32 = lane & 31, hi = lane >> 5; const int wid = __builtin_amdgcn_readfirstlane(tid >> 6);
    const long rowbase = (long)b * SEQ; const int q0 = qb * QB;
    const unsigned short* Qw = Q + (rowbase + q0 + wid * QBLK) * QP + h * 96;
    const unsigned short* Kh = KV + rowbase * KVP + h * 128; const unsigned short* Vh = Kh + 64; const unsigned short* Ph = KPE + rowbase * PEP;
    const unsigned lds0 = (unsigned)(uintptr_t)shm;
    __attribute__((address_space(3))) float* wsf = (__attribute__((address_space(3))) float*)((lds_cptr)shm + LDS_WS) + wid * 64;
    const unsigned short* ksrc = Kh + (long)lane * KVP + wid * 8;
    const unsigned short* psrc = Ph + (long)(32 * (wid & 1) + r32) * PEP + (wid >> 1) * 8;
    const unsigned short* vsrc = Vh + (long)(16 * (wid & 3) + (lane >> 2)) * KVP + (wid >> 2) * 32 + (lane & 3) * 8;
    const unsigned kdst = lds0 + LDS_K + wid * 1024, pdst = lds0 + LDS_K + (8 + (wid >> 1)) * 1024 + (wid & 1) * 512, vdst = lds0 + LDS_V + wid * 1024;
#define MLA_DMA(t, s) do { glds16(ksrc + (long)(t) * KVBLK * KVP, (unsigned)__builtin_amdgcn_readfirstlane(kdst + (s) * KSLOT)); \
        if (lane < 32) glds16(psrc + (long)(t) * KVBLK * PEP, (unsigned)__builtin_amdgcn_readfirstlane(pdst + (s) * KSLOT)); \
        glds16(vsrc + (long)(t) * KVBLK * KVP, (unsigned)__builtin_amdgcn_readfirstlane(vdst + (s) * VSLOT)); } while (0)
    const int vb0 = (int)(lds0 + LDS_V) + ((lane >> 4) & 1) * 32 + (lane & 3) * 8 + (4 * hi + ((lane & 15) >> 2)) * 64;
    const lds_cptr kp0 = (lds_cptr)shm + LDS_K + hi * 1024 + r32 * 16;
    const int NT = (q0 + QB) / KVBLK;
    bf16x8 qr[6];
#pragma unroll
    for (int d0 = 0; d0 < 6; ++d0) qr[d0] = *reinterpret_cast<const bf16x8*>(&Qw[(long)r32 * QP + d0 * 16 + hi * 8]);
    asm volatile("s_waitcnt vmcnt(0)" ::: "memory");
    MLA_DMA(0, 0); MLA_DMA(1, 1);
    float m = -INFINITY, l = 0.f; f32x16 o[2]; o[0] = f32x16{}; o[1] = f32x16{};
    const int qrel = wid * QBLK + r32;
    int slot = 0, slot2 = 2;
    for (int t = 0; t < NT; ++t) {
        if (t + 1 < NT) MLA_WAIT_BAR(3); else MLA_WAIT_BAR(0);
        if (t + 2 < NT) MLA_DMA(t + 2, slot2);
        f32x16 p0 = f32x16{}, p1 = f32x16{};
        { const lds_cptr kp = kp0 + slot * KSLOT;
#pragma unroll
          for (int d0 = 0; d0 < 6; ++d0) { const bf16x8 b0 = *(const __attribute__((address_space(3))) bf16x8*)(kp + d0 * 2048), b1 = *(const __attribute__((address_space(3))) bf16x8*)(kp + d0 * 2048 + 512);
              p0 = __builtin_amdgcn_mfma_f32_32x32x16_bf16(b0, qr[d0], p0, 0, 0, 0); p1 = __builtin_amdgcn_mfma_f32_32x32x16_bf16(b1, qr[d0], p1, 0, 0, 0); } }
        { const int jb = t - (NT - 4); if (jb >= 0) cmask(p0, p1, jb, qrel, hi); }
        const float rm = rowmax(p0, p1), mn = fmaxf(m, rm);
        if (__any(mn > m)) {
            const float al = __builtin_amdgcn_exp2f(m - mn); l *= al; m = mn;
            if (hi == 0) wsf[r32] = al;
            asm volatile("s_waitcnt lgkmcnt(0)" ::: "memory");
#pragma unroll
            for (int r = 0; r < 16; ++r) { const float f = wsf[crow(r, hi)]; o[0][r] *= f; o[1][r] *= f; }
        }
        float sacc = 0.f;
#pragma unroll
        for (int r = 0; r < 16; ++r) { p0[r] = __builtin_amdgcn_exp2f(p0[r] - m); p1[r] = __builtin_amdgcn_exp2f(p1[r] - m); sacc += p0[r] + p1[r]; }
        l += sacc;
        u32x4 pw0, pw1, pw2, pw3;
#define MLA_PKW(P, B) cvtpk_s(P[B], P[B + 1])
        pw0 = (u32x4){MLA_PKW(p0, 0), MLA_PKW(p0, 2), MLA_PKW(p0, 4), MLA_PKW(p0, 6)}; pw1 = (u32x4){MLA_PKW(p0, 8), MLA_PKW(p0, 10), MLA_PKW(p0, 12), MLA_PKW(p0, 14)};
        pw2 = (u32x4){MLA_PKW(p1, 0), MLA_PKW(p1, 2), MLA_PKW(p1, 4), MLA_PKW(p1, 6)}; pw3 = (u32x4){MLA_PKW(p1, 8), MLA_PKW(p1, 10), MLA_PKW(p1, 12), MLA_PKW(p1, 14)};
#undef MLA_PKW
        pv(o, vb0 + slot * VSLOT, __builtin_bit_cast(bf16x8, pw0), __builtin_bit_cast(bf16x8, pw1), __builtin_bit_cast(bf16x8, pw2), __builtin_bit_cast(bf16x8, pw3));
        slot = (slot == NSLOT - 1) ? 0 : slot + 1; slot2 = (slot2 == NSLOT - 1) ? 0 : slot2 + 1;
    }
    { auto rr = __builtin_amdgcn_permlane32_swap(__float_as_uint(l), __float_as_uint(l), false, false); l = __uint_as_float(rr[0]) + __uint_as_float(rr[1]); }
    if (hi == 0) wsf[32 + r32] = l; asm volatile("s_waitcnt lgkmcnt(0)" ::: "memory");
    float rli[16];
#pragma unroll
    for (int r = 0; r < 16; ++r) rli[r] = __builtin_amdgcn_rcpf(wsf[32 + crow(r, hi)]);
    unsigned short* Ow = O + (rowbase + q0 + wid * QBLK) * OP + 512 + h * 64;
    { __attribute__((address_space(3))) unsigned short* stg = (__attribute__((address_space(3))) unsigned short*)((lds_cptr)shm + LDS_OST) + wid * 2048;
#pragma unroll
      for (int r = 0; r < 16; ++r) { const int orow = crow(r, hi);
#pragma unroll
          for (int d0 = 0; d0 < 2; ++d0) stg[orow * 64 + d0 * 32 + r32] = (unsigned short)(cvtpk_s(o[d0][r] * rli[r], 0.f) & 0xffffu); }
      asm volatile("s_waitcnt lgkmcnt(0)" ::: "memory");
#pragma unroll
      for (int i = 0; i < 4; ++i) { const int row = i * 8 + (lane >> 3), ch = lane & 7; const u32x4 v = *(const __attribute__((address_space(3))) u32x4*)(stg + row * 64 + ch * 8); *(u32x4*)(Ow + (long)row * OP + ch * 8) = v; } }
    asm volatile("s_waitcnt vmcnt(0) lgkmcnt(0)\n\ts_barrier" ::: "memory");
#undef MLA_DMA
}

#define MLA_SB() __builtin_amdgcn_sched_barrier(0)
#define MLA_PIN(x) asm volatile("" : "+v"(x))
#define MLA_LDK(kp, d0, h) (*(const __attribute__((address_space(3))) bf16x8*)((kp) + (d0) * 2048 + (h) * 512))
#define MLA_E4(P, B) do { P[B] = __builtin_amdgcn_exp2f(P[B]); P[B + 1] = __builtin_amdgcn_exp2f(P[B + 1]); P[B + 2] = __builtin_amdgcn_exp2f(P[B + 2]); P[B + 3] = __builtin_amdgcn_exp2f(P[B + 3]); MLA_PIN(P); } while (0)
#define MLA_A4(P, B) do { sacc += P[B]; sacc += P[B + 1]; sacc += P[B + 2]; sacc += P[B + 3]; MLA_PIN(sacc); } while (0)
#define MLA_PK2(W, I, P, B) do { W[I] = cvtpk_s(P[B], P[B + 1]); W[I + 1] = cvtpk_s(P[B + 2], P[B + 3]); MLA_PIN(W); } while (0)
#define MLA_MF(C, K, Q) C = __builtin_amdgcn_mfma_f32_32x32x16_bf16(K, Q, C, 0, 0, 0)
#define MLA_MF0(C, K, Q) C = __builtin_amdgcn_mfma_f32_32x32x16_bf16(K, Q, negm, 0, 0, 0)
#define MLA_SOFT(P0, P1) do { float sacc = 0.f; \
    MLA_E4(P0, 0); MLA_E4(P0, 4); MLA_E4(P0, 8); MLA_E4(P0, 12); MLA_E4(P1, 0); MLA_E4(P1, 4); MLA_E4(P1, 8); MLA_E4(P1, 12); \
    MLA_A4(P0, 0); MLA_A4(P0, 4); MLA_A4(P0, 8); MLA_A4(P0, 12); MLA_A4(P1, 0); MLA_A4(P1, 4); MLA_A4(P1, 8); MLA_A4(P1, 12); \
    MLA_PK2(pw0, 0, P0, 0); MLA_PK2(pw0, 2, P0, 4); MLA_PK2(pw1, 0, P0, 8); MLA_PK2(pw1, 2, P0, 12); MLA_PK2(pw2, 0, P1, 0); MLA_PK2(pw2, 2, P1, 4); MLA_PK2(pw3, 0, P1, 8); MLA_PK2(pw3, 2, P1, 12); \
    l_reg += sacc; } while (0)
#define MLA_REF(C0, C1, RESC_O) do { const float rm_ = rowmax(C0, C1); \
    if (__builtin_expect(__any(rm_ > (float)THRL), 0)) { const float dl_ = fmaxf(rm_, 0.f); mhat += dl_; \
        _Pragma("unroll") for (int r = 0; r < 16; ++r) { C0[r] -= dl_; C1[r] -= dl_; } \
        _Pragma("unroll") for (int r = 0; r < 16; ++r) negm[r] = -mhat; MLA_PIN(negm); \
        const float f_ = __builtin_amdgcn_exp2f(-dl_); l_reg *= f_; \
        if (RESC_O) { if (hi == 0) wsf[r32] = f_; asm volatile("s_waitcnt lgkmcnt(0)" ::: "memory"); \
            _Pragma("unroll") for (int r = 0; r < 16; ++r) { const float g_ = wsf[crow(r, hi)]; o[0][r] *= g_; o[1][r] *= g_; } } } } while (0)
#define MLA_STEP(C0, C1, P0, P1, t, JB, WAITN, GK, GV) do { \
    MLA_WAIT_BAR(WAITN); \
    if (GK) { glds16(ksrc + (long)((t) + 3) * KVBLK * KVP, (unsigned)__builtin_amdgcn_readfirstlane(kdst + s0 * KSLOT)); \
              if (lane < 32) glds16(psrc + (long)((t) + 3) * KVBLK * PEP, (unsigned)__builtin_amdgcn_readfirstlane(pdst + s0 * KSLOT)); } \
    if (GV) { glds16(vsrc + (long)((t) + 2) * KVBLK * KVP, (unsigned)__builtin_amdgcn_readfirstlane(vdst + s2 * VSLOT)); } \
    { const lds_cptr kp = kp0 + s1 * KSLOT; float sacc = 0.f; bf16x8 ka0, ka1, kb0, kb1; \
      ka0 = MLA_LDK(kp, 0, 0); ka1 = MLA_LDK(kp, 0, 1); MLA_E4(P0, 0); MLA_E4(P0, 4); MLA_SB(); \
      kb0 = MLA_LDK(kp, 1, 0); kb1 = MLA_LDK(kp, 1, 1); \
      MLA_MF0(C0, ka0, qr[0]); MLA_E4(P0, 8); MLA_SB(); \
      MLA_MF0(C1, ka1, qr[0]); MLA_E4(P0, 12); MLA_A4(P0, 0); MLA_SB(); \
      ka0 = MLA_LDK(kp, 2, 0); ka1 = MLA_LDK(kp, 2, 1); \
      MLA_MF(C0, kb0, qr[1]); MLA_E4(P1, 0); MLA_A4(P0, 4); MLA_SB(); \
      MLA_MF(C1, kb1, qr[1]); MLA_E4(P1, 4); MLA_A4(P0, 8); MLA_PK2(pw0, 0, P0, 0); MLA_SB(); \
      kb0 = MLA_LDK(kp, 3, 0); kb1 = MLA_LDK(kp, 3, 1); \
      MLA_MF(C0, ka0, qr[2]); MLA_E4(P1, 8); MLA_A4(P0, 12); MLA_PK2(pw0, 2, P0, 4); MLA_SB(); \
      MLA_MF(C1, ka1, qr[2]); MLA_E4(P1, 12); MLA_A4(P1, 0); MLA_PK2(pw1, 0, P0, 8); MLA_SB(); \
      ka0 = MLA_LDK(kp, 4, 0); ka1 = MLA_LDK(kp, 4, 1); \
      MLA_MF(C0, kb0, qr[3]); MLA_A4(P1, 4); MLA_PK2(pw1, 2, P0, 12); MLA_SB(); \
      MLA_MF(C1, kb1, qr[3]); MLA_A4(P1, 8); MLA_PK2(pw2, 0, P1, 0); MLA_SB(); \
      kb0 = MLA_LDK(kp, 5, 0); kb1 = MLA_LDK(kp, 5, 1); \
      MLA_MF(C0, ka0, qr[4]); MLA_A4(P1, 12); MLA_PK2(pw2, 2, P1, 4); MLA_SB(); \
      MLA_MF(C1, ka1, qr[4]); MLA_PK2(pw3, 0, P1, 8); MLA_SB(); \
      MLA_MF(C0, kb0, qr[5]); MLA_PK2(pw3, 2, P1, 12); MLA_SB(); \
      MLA_MF(C1, kb1, qr[5]); MLA_SB(); \
      l_reg += sacc; } \
    pv(o, vb0 + s0 * VSLOT, __builtin_bit_cast(bf16x8, pw0), __builtin_bit_cast(bf16x8, pw1), __builtin_bit_cast(bf16x8, pw2), __builtin_bit_cast(bf16x8, pw3)); \
    if ((JB) >= 0) cmask(C0, C1, (JB), qrel, hi); \
    MLA_REF(C0, C1, true); \
    { const int s_ = s0; s0 = s1; s1 = s2; s2 = s_; } \
} while (0)

template <int THRL> __device__ __forceinline__ void unit_pipe(int b, int h, int qb, const unsigned short* Q, const unsigned short* KV, const unsigned short* KPE, unsigned short* O, char* shm, const int wave_) {
    int tid_ = tid_from_wave(wave_); asm volatile("" : "+v"(tid_));
    const int tid = tid_, lane = tid & 63, r32 = lane & 31, hi = lane >> 5; const int wid = __builtin_amdgcn_readfirstlane(tid >> 6);
    const long rowbase = (long)b * SEQ; const int q0 = qb * QB;
    const unsigned short* Qw = Q + (rowbase + q0 + wid * QBLK) * QP + h * 96;
    const unsigned short* Kh = KV + rowbase * KVP + h * 128; const unsigned short* Vh = Kh + 64; const unsigned short* Ph = KPE + rowbase * PEP;
    const unsigned lds0 = (unsigned)(uintptr_t)shm;
    __attribute__((address_space(3))) float* wsf = (__attribute__((address_space(3))) float*)((lds_cptr)shm + LDS_WS) + wid * 64;
    const unsigned short* ksrc = Kh + (long)lane * KVP + wid * 8;
    const unsigned short* psrc = Ph + (long)(32 * (wid & 1) + r32) * PEP + (wid >> 1) * 8;
    const unsigned short* vsrc = Vh + (long)(16 * (wid & 3) + (lane >> 2)) * KVP + (wid >> 2) * 32 + (lane & 3) * 8;
    const unsigned kdst = lds0 + LDS_K + wid * 1024, pdst = lds0 + LDS_K + (8 + (wid >> 1)) * 1024 + (wid & 1) * 512, vdst = lds0 + LDS_V + wid * 1024;
    const int vb0 = (int)(lds0 + LDS_V) + ((lane >> 4) & 1) * 32 + (lane & 3) * 8 + (4 * hi + ((lane & 15) >> 2)) * 64;
    const lds_cptr kp0 = (lds_cptr)shm + LDS_K + hi * 1024 + r32 * 16;
    const int NT = (q0 + QB) / KVBLK;
    bf16x8 qr[6];
#pragma unroll
    for (int d0 = 0; d0 < 6; ++d0) qr[d0] = *reinterpret_cast<const bf16x8*>(&Qw[(long)r32 * QP + d0 * 16 + hi * 8]);
    asm volatile("s_waitcnt vmcnt(0)" ::: "memory");
    glds16(ksrc, (unsigned)__builtin_amdgcn_readfirstlane(kdst)); if (lane < 32) glds16(psrc, (unsigned)__builtin_amdgcn_readfirstlane(pdst));
    glds16(ksrc + (long)KVBLK * KVP, (unsigned)__builtin_amdgcn_readfirstlane(kdst + KSLOT)); if (lane < 32) glds16(psrc + (long)KVBLK * PEP, (unsigned)__builtin_amdgcn_readfirstlane(pdst + KSLOT)); glds16(vsrc, (unsigned)__builtin_amdgcn_readfirstlane(vdst));
    glds16(ksrc + (long)2 * KVBLK * KVP, (unsigned)__builtin_amdgcn_readfirstlane(kdst + 2 * KSLOT)); if (lane < 32) glds16(psrc + (long)2 * KVBLK * PEP, (unsigned)__builtin_amdgcn_readfirstlane(pdst + 2 * KSLOT)); glds16(vsrc + (long)KVBLK * KVP, (unsigned)__builtin_amdgcn_readfirstlane(vdst + VSLOT));
    float mhat = 0.f, l_reg = 0.f; f32x16 o[2]; o[0] = f32x16{}; o[1] = f32x16{}; f32x16 negm = f32x16{}; MLA_PIN(negm);
    const int qrel = wid * QBLK + r32;
    f32x16 pA0, pA1, pB0, pB1; u32x4 pw0, pw1, pw2, pw3;
    int s0 = 0, s1 = 1, s2 = 2;
    MLA_WAIT_BAR(6);
    { const lds_cptr kp = kp0;
      pA0 = f32x16{}; pA1 = f32x16{};
#pragma unroll
      for (int d0 = 0; d0 < 6; ++d0) { const bf16x8 k0 = MLA_LDK(kp, d0, 0), k1 = MLA_LDK(kp, d0, 1); MLA_MF(pA0, k0, qr[d0]); MLA_MF(pA1, k1, qr[d0]); } }
    { const float rm_ = rowmax(pA0, pA1); mhat = rm_;
#pragma unroll
      for (int r = 0; r < 16; ++r) { pA0[r] -= rm_; pA1[r] -= rm_; negm[r] = -mhat; }
      MLA_PIN(negm); }
    int t = 0;
    MLA_STEP(pB0, pB1, pA0, pA1, t, -1, 3, true, true); ++t;
    for (; t + 1 <= NT - 6; t += 2) {
        MLA_STEP(pA0, pA1, pB0, pB1, t, -1, 3, true, true);
        MLA_STEP(pB0, pB1, pA0, pA1, t + 1, -1, 3, true, true);
    }
    MLA_STEP(pA0, pA1, pB0, pB1, t, 0, 3, true, true); ++t;
    MLA_STEP(pB0, pB1, pA0, pA1, t, 1, 3, true, true); ++t;
    MLA_STEP(pA0, pA1, pB0, pB1, t, 2, 3, false, true); ++t;
    MLA_STEP(pB0, pB1, pA0, pA1, t, 3, 1, false, false); ++t;
    MLA_WAIT_BAR(0);
    MLA_SOFT(pB0, pB1);
    pv(o, vb0 + s0 * VSLOT, __builtin_bit_cast(bf16x8, pw0), __builtin_bit_cast(bf16x8, pw1), __builtin_bit_cast(bf16x8, pw2), __builtin_bit_cast(bf16x8, pw3));
    { auto rr = __builtin_amdgcn_permlane32_swap(__float_as_uint(l_reg), __float_as_uint(l_reg), false, false); l_reg = __uint_as_float(rr[0]) + __uint_as_float(rr[1]); }
    if (hi == 0) wsf[32 + r32] = l_reg; asm volatile("s_waitcnt lgkmcnt(0)" ::: "memory");
    float rli[16];
#pragma unroll
    for (int r = 0; r < 16; ++r) rli[r] = __builtin_amdgcn_rcpf(wsf[32 + crow(r, hi)]);
    unsigned short* Ow = O + (rowbase + q0 + wid * QBLK) * OP + 512 + h * 64;
    { __attribute__((address_space(3))) unsigned short* stg = (__attribute__((address_space(3))) unsigned short*)((lds_cptr)shm + LDS_OST) + wid * 2048;
#pragma unroll
      for (int r = 0; r < 16; ++r) { const int orow = crow(r, hi);
#pragma unroll
          for (int d0 = 0; d0 < 2; ++d0) stg[orow * 64 + d0 * 32 + r32] = (unsigned short)(cvtpk_s(o[d0][r] * rli[r], 0.f) & 0xffffu); }
      asm volatile("s_waitcnt lgkmcnt(0)" ::: "memory");
#pragma unroll
      for (int i = 0; i < 4; ++i) { const int row = i * 8 + (lane >> 3), ch = lane & 7; const u32x4 v = *(const __attribute__((address_space(3))) u32x4*)(stg + row * 64 + ch * 8); *(u32x4*)(Ow + (long)row * OP + ch * 8) = v; } }
    asm volatile("s_waitcnt vmcnt(0) lgkmcnt(0)\n\ts_barrier" ::: "memory");
}

constexpr int S4_V = NSLOT * KSLOT, S4_WS = S4_V + 4 * VSLOT, S4_OST = S4_WS + NW * 64 * 4, S4_TOTAL = S4_OST + NW * 4096;
#define MLA_R1(C0, C1, P0, P1, kp) do { float sacc = 0.f; bf16x8 ka0, ka1, kb0, kb1; \
      ka0 = MLA_LDK(kp, 0, 0); ka1 = MLA_LDK(kp, 0, 1); MLA_E4(P0, 0); MLA_E4(P0, 4); MLA_SB(); \
      kb0 = MLA_LDK(kp, 1, 0); kb1 = MLA_LDK(kp, 1, 1); \
      MLA_MF0(C0, ka0, qr[0]); MLA_E4(P0, 8); MLA_SB(); \
      MLA_MF0(C1, ka1, qr[0]); MLA_E4(P0, 12); MLA_A4(P0, 0); MLA_SB(); \
      ka0 = MLA_LDK(kp, 2, 0); ka1 = MLA_LDK(kp, 2, 1); \
      MLA_MF(C0, kb0, qr[1]); MLA_E4(P1, 0); MLA_A4(P0, 4); MLA_SB(); \
      MLA_MF(C1, kb1, qr[1]); MLA_E4(P1, 4); MLA_A4(P0, 8); MLA_PK2(pw0, 0, P0, 0); MLA_SB(); \
      kb0 = MLA_LDK(kp, 3, 0); kb1 = MLA_LDK(kp, 3, 1); \
      MLA_MF(C0, ka0, qr[2]); MLA_E4(P1, 8); MLA_A4(P0, 12); MLA_PK2(pw0, 2, P0, 4); MLA_SB(); \
      MLA_MF(C1, ka1, qr[2]); MLA_E4(P1, 12); MLA_A4(P1, 0); MLA_PK2(pw1, 0, P0, 8); MLA_SB(); \
      ka0 = MLA_LDK(kp, 4, 0); ka1 = MLA_LDK(kp, 4, 1); \
      MLA_MF(C0, kb0, qr[3]); MLA_A4(P1, 4); MLA_PK2(pw1, 2, P0, 12); MLA_SB(); \
      MLA_MF(C1, kb1, qr[3]); MLA_A4(P1, 8); MLA_PK2(pw2, 0, P1, 0); MLA_SB(); \
      kb0 = MLA_LDK(kp, 5, 0); kb1 = MLA_LDK(kp, 5, 1); \
      MLA_MF(C0, ka0, qr[4]); MLA_A4(P1, 12); MLA_PK2(pw2, 2, P1, 4); MLA_SB(); \
      MLA_MF(C1, ka1, qr[4]); MLA_PK2(pw3, 0, P1, 8); MLA_SB(); \
      MLA_MF(C0, kb0, qr[5]); MLA_PK2(pw3, 2, P1, 12); MLA_SB(); \
      MLA_MF(C1, kb1, qr[5]); MLA_SB(); \
      l_reg += sacc; } while (0)
#define MLA_PVW(slot) pv(o, vb0 + (slot) * VSLOT, __builtin_bit_cast(bf16x8, pw0), __builtin_bit_cast(bf16x8, pw1), __builtin_bit_cast(bf16x8, pw2), __builtin_bit_cast(bf16x8, pw3))
#define MLA_DMA4(t, GK, GV) do { \
    if (GK) { glds16(ksrc + (long)((t) + 3) * KVBLK * KVP, (unsigned)__builtin_amdgcn_readfirstlane(kdst + s0 * KSLOT)); \
              if (lane < 32) glds16(psrc + (long)((t) + 3) * KVBLK * PEP, (unsigned)__builtin_amdgcn_readfirstlane(pdst + s0 * KSLOT)); } \
    if (GV) { glds16(vsrc + (long)((t) + 2) * KVBLK * KVP, (unsigned)__builtin_amdgcn_readfirstlane(vdst + (((t) + 2) & 3) * VSLOT)); } } while (0)
#define MLA_REFB(C0, C1) do { const float rm_ = rowmax(C0, C1); \
      if (__builtin_expect(__any(rm_ > (float)THRL), 0)) { const float dl_ = fmaxf(rm_, 0.f); mhat += dl_; \
          _Pragma("unroll") for (int r = 0; r < 16; ++r) { C0[r] -= dl_; C1[r] -= dl_; } \
          _Pragma("unroll") for (int r = 0; r < 16; ++r) negm[r] = -mhat; MLA_PIN(negm); \
          const float f_ = __builtin_amdgcn_exp2f(-dl_); l_reg *= f_; if (hi == 0) wsf[r32] = f_; resc = true; } } while (0)
#define MLA_RESCB() do { if (resc) { asm volatile("s_waitcnt lgkmcnt(0)" ::: "memory"); _Pragma("unroll") for (int r = 0; r < 16; ++r) { const float g_ = wsf[crow(r, hi)]; o[0][r] *= g_; o[1][r] *= g_; } resc = false; } } while (0)
#define MLA_STEPS(C0, C1, P0, P1, t, JB, WAITN, GK, GV, HASPV) do { \
    MLA_WAIT_BAR(WAITN); MLA_DMA4(t, GK, GV); \
    if (LATE) { if (HASPV) { MLA_PVW(((t) + 3) & 3); } MLA_RESCB(); } \
    { const lds_cptr kp = kp0 + s1 * KSLOT; MLA_R1(C0, C1, P0, P1, kp); } \
    if (!LATE) { MLA_PVW((t) & 3); } \
    if ((JB) >= 0) cmask(C0, C1, (JB), qrel, hi); \
    if (LATE) MLA_REFB(C0, C1); else MLA_REF(C0, C1, true); \
    { const int s_ = s0; s0 = s1; s1 = s2; s2 = s_; } } while (0)

template <int THRL, bool LATE> __device__ __forceinline__ void unit_stag(int b, int h, int qb, const unsigned short* Q, const unsigned short* KV, const unsigned short* KPE, unsigned short* O, char* shm, const int wave_) {
    int tid_ = tid_from_wave(wave_); asm volatile("" : "+v"(tid_));
    const int tid = tid_, lane = tid & 63, r32 = lane & 31, hi = lane >> 5; const int wid = __builtin_amdgcn_readfirstlane(tid >> 6);
    const long rowbase = (long)b * SEQ; const int q0 = qb * QB;
    const unsigned short* Qw = Q + (rowbase + q0 + wid * QBLK) * QP + h * 96;
    const unsigned short* Kh = KV + rowbase * KVP + h * 128; const unsigned short* Vh = Kh + 64; const unsigned short* Ph = KPE + rowbase * PEP;
    const unsigned lds0 = (unsigned)(uintptr_t)shm;
    __attribute__((address_space(3))) float* wsf = (__attribute__((address_space(3))) float*)((lds_cptr)shm + S4_WS) + wid * 64;
    const unsigned short* ksrc = Kh + (long)lane * KVP + wid * 8;
    const unsigned short* psrc = Ph + (long)(32 * (wid & 1) + r32) * PEP + (wid >> 1) * 8;
    const unsigned short* vsrc = Vh + (long)(16 * (wid & 3) + (lane >> 2)) * KVP + (wid >> 2) * 32 + (lane & 3) * 8;
    const unsigned kdst = lds0 + LDS_K + wid * 1024, pdst = lds0 + LDS_K + (8 + (wid >> 1)) * 1024 + (wid & 1) * 512, vdst = lds0 + S4_V + wid * 1024;
    const int vb0 = (int)(lds0 + S4_V) + ((lane >> 4) & 1) * 32 + (lane & 3) * 8 + (4 * hi + ((lane & 15) >> 2)) * 64;
    const lds_cptr kp0 = (lds_cptr)shm + LDS_K + hi * 1024 + r32 * 16;
    const int NT = (q0 + QB) / KVBLK;
    bf16x8 qr[6];
#pragma unroll
    for (int d0 = 0; d0 < 6; ++d0) qr[d0] = *reinterpret_cast<const bf16x8*>(&Qw[(long)r32 * QP + d0 * 16 + hi * 8]);
    asm volatile("s_waitcnt vmcnt(0)" ::: "memory");
    glds16(ksrc, (unsigned)__builtin_amdgcn_readfirstlane(kdst)); if (lane < 32) glds16(psrc, (unsigned)__builtin_amdgcn_readfirstlane(pdst));
    glds16(ksrc + (long)KVBLK * KVP, (unsigned)__builtin_amdgcn_readfirstlane(kdst + KSLOT)); if (lane < 32) glds16(psrc + (long)KVBLK * PEP, (unsigned)__builtin_amdgcn_readfirstlane(pdst + KSLOT)); glds16(vsrc, (unsigned)__builtin_amdgcn_readfirstlane(vdst));
    glds16(ksrc + (long)2 * KVBLK * KVP, (unsigned)__builtin_amdgcn_readfirstlane(kdst + 2 * KSLOT)); if (lane < 32) glds16(psrc + (long)2 * KVBLK * PEP, (unsigned)__builtin_amdgcn_readfirstlane(pdst + 2 * KSLOT)); glds16(vsrc + (long)KVBLK * KVP, (unsigned)__builtin_amdgcn_readfirstlane(vdst + VSLOT));
    float mhat = 0.f, l_reg = 0.f; f32x16 o[2]; o[0] = f32x16{}; o[1] = f32x16{}; f32x16 negm = f32x16{}; MLA_PIN(negm);
    const int qrel = wid * QBLK + r32; bool resc = false;
    f32x16 pA0, pA1, pB0, pB1; u32x4 pw0, pw1, pw2, pw3;
    int s0 = 0, s1 = 1, s2 = 2;
    MLA_WAIT_BAR(6);
    { const lds_cptr kp = kp0;
      pA0 = f32x16{}; pA1 = f32x16{};
#pragma unroll
      for (int d0 = 0; d0 < 6; ++d0) { const bf16x8 k0 = MLA_LDK(kp, d0, 0), k1 = MLA_LDK(kp, d0, 1); MLA_MF(pA0, k0, qr[d0]); MLA_MF(pA1, k1, qr[d0]); } }
    { const float rm_ = rowmax(pA0, pA1); mhat = rm_;
#pragma unroll
      for (int r = 0; r < 16; ++r) { pA0[r] -= rm_; pA1[r] -= rm_; negm[r] = -mhat; }
      MLA_PIN(negm); }
    int t = 0;
    MLA_STEPS(pB0, pB1, pA0, pA1, t, -1, 3, true, true, false); ++t;
    for (; t + 1 <= NT - 6; t += 2) {
        MLA_STEPS(pA0, pA1, pB0, pB1, t, -1, 3, true, true, true);
        MLA_STEPS(pB0, pB1, pA0, pA1, t + 1, -1, 3, true, true, true);
    }
    MLA_STEPS(pA0, pA1, pB0, pB1, t, 0, 3, true, true, true); ++t;
    MLA_STEPS(pB0, pB1, pA0, pA1, t, 1, 3, true, true, true); ++t;
    MLA_STEPS(pA0, pA1, pB0, pB1, t, 2, 3, false, true, true); ++t;
    MLA_STEPS(pB0, pB1, pA0, pA1, t, 3, 1, false, false, true); ++t;
    MLA_WAIT_BAR(0);
    if (LATE) { MLA_PVW((NT - 2) & 3); MLA_RESCB(); }
    MLA_SOFT(pB0, pB1);
    MLA_PVW((NT - 1) & 3);
    { auto rr = __builtin_amdgcn_permlane32_swap(__float_as_uint(l_reg), __float_as_uint(l_reg), false, false); l_reg = __uint_as_float(rr[0]) + __uint_as_float(rr[1]); }
    if (hi == 0) wsf[32 + r32] = l_reg; asm volatile("s_waitcnt lgkmcnt(0)" ::: "memory");
    float rli[16];
#pragma unroll
    for (int r = 0; r < 16; ++r) rli[r] = __builtin_amdgcn_rcpf(wsf[32 + crow(r, hi)]);
    unsigned short* Ow = O + (rowbase + q0 + wid * QBLK) * OP + 512 + h * 64;
    { __attribute__((address_space(3))) unsigned short* stg = (__attribute__((address_space(3))) unsigned short*)((lds_cptr)shm + S4_OST) + wid * 2048;
#pragma unroll
      for (int r = 0; r < 16; ++r) { const int orow = crow(r, hi);
#pragma unroll
          for (int d0 = 0; d0 < 2; ++d0) stg[orow * 64 + d0 * 32 + r32] = (unsigned short)(cvtpk_s(o[d0][r] * rli[r], 0.f) & 0xffffu); }
      asm volatile("s_waitcnt lgkmcnt(0)" ::: "memory");
#pragma unroll
      for (int i = 0; i < 4; ++i) { const int row = i * 8 + (lane >> 3), ch = lane & 7; const u32x4 v = *(const __attribute__((address_space(3))) u32x4*)(stg + row * 64 + ch * 8); *(u32x4*)(Ow + (long)row * OP + ch * 8) = v; } }
    asm volatile("s_waitcnt vmcnt(0) lgkmcnt(0)\n\ts_barrier" ::: "memory");
}
__device__ __forceinline__ void phase(char* lds, const unsigned short* Q, const unsigned short* KV, const unsigned short* KPE, unsigned short* O, int vcu, int G, const int wave_) {
    for (int v = vcu; v < 256; v += G) { const int s = v & 7, bh = v >> 3;
#pragma unroll 1
        for (int i = 0; i < 4; ++i) { const int qb = (i == 0) ? s : (i == 1) ? 15 - s : (i == 2) ? 16 + s : 31 - s; if (qb == 0) unit(bh >> 3, bh & 7, qb, Q, KV, KPE, O, lds, wave_); else if (wave_ < 4) unit_stag<8, false>(bh >> 3, bh & 7, qb, Q, KV, KPE, O, lds, wave_); else unit_stag<8, true>(bh >> 3, bh & 7, qb, Q, KV, KPE, O, lds, wave_); } }
}
#undef MLA_WAIT_BAR
}

namespace evm {
using bf16x8 = __attribute__((ext_vector_type(8))) short;
using s16x4 = __attribute__((ext_vector_type(4))) short;
using f32x16 = __attribute__((ext_vector_type(16))) float;
using u32x4 = __attribute__((ext_vector_type(4))) unsigned;
typedef __attribute__((address_space(3))) char* lds_ptr;
constexpr int PP = 1792, VNP = 1088;
constexpr int LDS_VT = 0, LDS_WS = 65536, LDS_OST = LDS_WS + 2048, LDS_TOTAL = 139264;
__device__ __forceinline__ s16x4 trr(int addr) { s16x4 v; asm volatile("ds_read_b64_tr_b16 %0,%1" : "=&v"(v) : "v"(addr) : "memory"); return v; }
#define EVM_TR(dst, addr, off) asm volatile("ds_read_b64_tr_b16 %0,%1 offset:%c2" : "=&v"(dst) : "v"(addr), "i"(off) : "memory")
__device__ __forceinline__ float bflo(unsigned u) { return __uint_as_float(u << 16); }
__device__ __forceinline__ float bfhi(unsigned u) { return __uint_as_float(u & 0xffff0000u); }

__device__ __forceinline__ void unit(int un, const unsigned short* proj, const float* sinks, const float* ln_g, const float* ln_b, const unsigned short* wsb, const float* b_s, unsigned short* mix, char* shm, const int wave_) {
    int tid_ = tid_from_wave(wave_); asm volatile("" : "+v"(tid_));
    const int tid = tid_, lane = tid & 63, r32 = lane & 31, hi = lane >> 5; const int wid = __builtin_amdgcn_readfirstlane(tid >> 6);
    const int row0 = un * 128, tblk = (un & 63) * 128, seq0 = row0 - tblk;
    const lds_ptr L = (lds_ptr)shm; const unsigned lds0 = (unsigned)(uintptr_t)shm;
    for (int i = 0; i < 16; ++i) { const int tl = wid * 16 + i, grow = row0 + tl;
        const u32x4 w = *(const u32x4*)(proj + (size_t)grow * PP + 1280 + lane * 8);
        float x[8] = {bflo(w.x), bfhi(w.x), bflo(w.y), bfhi(w.y), bflo(w.z), bfhi(w.z), bflo(w.w), bfhi(w.w)};
        float s = 0.f;
#pragma unroll
        for (int j = 0; j < 8; ++j) s += x[j];
#pragma unroll
        for (int o = 1; o < 64; o <<= 1) s += __shfl_xor(s, o);
        const float mu = s * (1.f / 512.f); float qq = 0.f;
#pragma unroll
        for (int j = 0; j < 8; ++j) { x[j] -= mu; qq += x[j] * x[j]; }
#pragma unroll
        for (int o = 1; o < 64; o <<= 1) qq += __shfl_xor(qq, o);
        const float rstd = 1.0f / sqrtf(qq * (1.f / 512.f) + 1e-6f);
        const f32x4 g0 = ((const f32x4*)ln_g)[lane * 2], g1 = ((const f32x4*)ln_g)[lane * 2 + 1], b0 = ((const f32x4*)ln_b)[lane * 2], b1 = ((const f32x4*)ln_b)[lane * 2 + 1];
        u32x4 ov; ov.x = pg8::cvt_pk_bf16(x[0] * rstd * g0.x + b0.x, x[1] * rstd * g0.y + b0.y); ov.y = pg8::cvt_pk_bf16(x[2] * rstd * g0.z + b0.z, x[3] * rstd * g0.w + b0.w);
        ov.z = pg8::cvt_pk_bf16(x[4] * rstd * g1.x + b1.x, x[5] * rstd * g1.y + b1.y); ov.w = pg8::cvt_pk_bf16(x[6] * rstd * g1.z + b1.z, x[7] * rstd * g1.w + b1.w);
        *(__attribute__((address_space(3))) u32x4*)(L + tl * VNP + lane * 16) = ov; }
    __syncthreads();
    { const int g = wid;
      const int trb = (int)lds0 + ((lane >> 4) & 1) * 32 + (lane & 3) * 8 + (8 * hi + ((lane & 15) >> 2)) * VNP + g * 128;
#pragma unroll 1
      for (int i = 0; i < 4; ++i) { f32x16 a0 = f32x16{}, a1 = f32x16{};
          for (int s = 0; s < 2 * i + 2; ++s) {
              const bf16x8 A = *(const bf16x8*)(wsb + ((size_t)(g * 128 + 32 * i + r32) * 128 + 16 * s + 8 * hi));
              const int ad = trb + s * 16 * VNP; s16x4 l0, h0, l1, h1;
              EVM_TR(l0, ad, 0); EVM_TR(h0, ad, 4 * VNP); EVM_TR(l1, ad, 64); EVM_TR(h1, ad, 64 + 4 * VNP);
              asm volatile("s_waitcnt lgkmcnt(0)" : "+v"(l0), "+v"(h0), "+v"(l1), "+v"(h1) :: "memory"); __builtin_amdgcn_sched_barrier(0);
              const bf16x8 B0 = (bf16x8){l0[0], l0[1], l0[2], l0[3], h0[0], h0[1], h0[2], h0[3]}, B1 = (bf16x8){l1[0], l1[1], l1[2], l1[3], h1[0], h1[1], h1[2], h1[3]};
              a0 = __builtin_amdgcn_mfma_f32_32x32x16_bf16(A, B0, a0, 0, 0, 0); a1 = __builtin_amdgcn_mfma_f32_32x32x16_bf16(A, B1, a1, 0, 0, 0); }
#pragma unroll
          for (int r = 0; r < 16; ++r) { const int t = 32 * i + (r & 3) + 8 * (r >> 2) + 4 * hi; const float bs = b_s[g * 128 + t];
              const unsigned short* up = proj + (size_t)(row0 + t) * PP + 768 + g * 64 + r32; unsigned short* op = mix + (size_t)(row0 + t) * 1024 + 512 + g * 64 + r32;
              const float u0 = __uint_as_float(((unsigned)up[0]) << 16), u1 = __uint_as_float(((unsigned)up[32]) << 16);
              op[0] = (unsigned short)(pg8::cvt_pk_bf16(u0 * (a0[r] + bs), 0.f) & 0xffffu); op[32] = (unsigned short)(pg8::cvt_pk_bf16(u1 * (a1[r] + bs), 0.f) & 0xffffu); } } }
    asm volatile("s_waitcnt vmcnt(0) lgkmcnt(0)" ::: "memory");
    __syncthreads();
    { const int h = wid, kvh = h >> 2; const bool first = (tblk == 0);
#pragma unroll
      for (int T = 0; T < 8; ++T) { const int jt = T & 3; if (first && jt < 2) continue;
          const unsigned short* src = proj + (size_t)(seq0 + tblk - 128 + 64 * jt + 16 * (wid & 3) + (lane >> 2)) * PP + 640 + (T >> 2) * 64 + (wid >> 2) * 32 + (lane & 3) * 8;
          mla::glds16(src, (unsigned)__builtin_amdgcn_readfirstlane(lds0 + LDS_VT + T * 8192 + wid * 1024)); }
      asm volatile("s_waitcnt vmcnt(0)\n\ts_barrier" ::: "memory");
      const float slope2 = __builtin_amdgcn_exp2f(-(float)(h + 1)) * 1.4426950408889634f, sink2 = sinks[h] * 1.4426950408889634f;
      const int vb0 = (int)(lds0 + LDS_VT) + ((lane >> 4) & 1) * 32 + (lane & 3) * 8 + (4 * hi + ((lane & 15) >> 2)) * 64 + kvh * 4 * 8192;
      __attribute__((address_space(3))) float* wsf = (__attribute__((address_space(3))) float*)(L + LDS_WS) + wid * 64;
      __attribute__((address_space(3))) unsigned short* stg = (__attribute__((address_space(3))) unsigned short*)(L + LDS_OST) + wid * 2048;
#pragma unroll 1
      for (int i = 0; i < 4; ++i) {
          bf16x8 qr[4];
#pragma unroll
          for (int d0 = 0; d0 < 4; ++d0) qr[d0] = *(const bf16x8*)(proj + (size_t)(row0 + 32 * i + r32) * PP + h * 64 + d0 * 16 + hi * 8);
          f32x16 S[5]; float mx = sink2;
#pragma unroll
          for (int jj = 0; jj < 5; ++jj) { const int j = i + jj; S[jj] = f32x16{};
              if (first && j < 4) continue;
              const unsigned short* kp = proj + (size_t)(seq0 + tblk - 128 + 32 * j + r32) * PP + 512 + kvh * 64 + hi * 8;
              bf16x8 kf[4];
#pragma unroll
              for (int d0 = 0; d0 < 4; ++d0) kf[d0] = *(const bf16x8*)(kp + d0 * 16);
#pragma unroll
              for (int d0 = 0; d0 < 4; ++d0) S[jj] = __builtin_amdgcn_mfma_f32_32x32x16_bf16(kf[d0], qr[d0], S[jj], 0, 0, 0);
#pragma unroll
              for (int r = 0; r < 16; ++r) { const int dist = (128 + 32 * i + r32) - (32 * j + (r & 3) + 8 * (r >> 2) + 4 * hi);
                  const float v = S[jj][r] - slope2 * (float)dist; const bool ok = dist >= 0 && dist < 128;
                  S[jj][r] = ok ? v : -INFINITY; mx = fmaxf(mx, S[jj][r]); } }
          { auto rr = __builtin_amdgcn_permlane32_swap(__float_as_uint(mx), __float_as_uint(mx), false, false); mx = fmaxf(__uint_as_float(rr[0]), __uint_as_float(rr[1])); }
          float l = 0.f; f32x16 o[2]; o[0] = f32x16{}; o[1] = f32x16{};
#pragma unroll
          for (int jj = 0; jj < 5; ++jj) { const int j = i + jj;
              if (first && j < 4) continue;
#pragma unroll
              for (int r = 0; r < 16; ++r) { S[jj][r] = __builtin_amdgcn_exp2f(S[jj][r] - mx); l += S[jj][r]; }
              u32x4 pw0, pw1;
              pw0 = (u32x4){mla::cvtpk_s(S[jj][0], S[jj][1]), mla::cvtpk_s(S[jj][2], S[jj][3]), mla::cvtpk_s(S[jj][4], S[jj][5]), mla::cvtpk_s(S[jj][6], S[jj][7])};
              pw1 = (u32x4){mla::cvtpk_s(S[jj][8], S[jj][9]), mla::cvtpk_s(S[jj][10], S[jj][11]), mla::cvtpk_s(S[jj][12], S[jj][13]), mla::cvtpk_s(S[jj][14], S[jj][15])};
              const int va = vb0 + (j >> 1) * 8192 + (j & 1) * 2048;
#pragma unroll
              for (int d0 = 0; d0 < 2; ++d0) { s16x4 l0, h0, l1, h1;
                  EVM_TR(l0, va, d0 * 4096); EVM_TR(h0, va, d0 * 4096 + 512); EVM_TR(l1, va, d0 * 4096 + 1024); EVM_TR(h1, va, d0 * 4096 + 1024 + 512);
                  asm volatile("s_waitcnt lgkmcnt(0)" : "+v"(l0), "+v"(h0), "+v"(l1), "+v"(h1) :: "memory"); __builtin_amdgcn_sched_barrier(0);
                  const bf16x8 V0 = (bf16x8){l0[0], l0[1], l0[2], l0[3], h0[0], h0[1], h0[2], h0[3]}, V1 = (bf16x8){l1[0], l1[1], l1[2], l1[3], h1[0], h1[1], h1[2], h1[3]};
                  o[d0] = __builtin_amdgcn_mfma_f32_32x32x16_bf16(__builtin_bit_cast(bf16x8, pw0), V0, o[d0], 0, 0, 0);
                  o[d0] = __builtin_amdgcn_mfma_f32_32x32x16_bf16(__builtin_bit_cast(bf16x8, pw1), V1, o[d0], 0, 0, 0); } }
          { auto rr = __builtin_amdgcn_permlane32_swap(__float_as_uint(l), __float_as_uint(l), false, false); l = __uint_as_float(rr[0]) + __uint_as_float(rr[1]); }
          l += __builtin_amdgcn_exp2f(sink2 - mx);
          if (hi == 0) wsf[r32] = l; asm volatile("s_waitcnt lgkmcnt(0)" ::: "memory");
#pragma unroll
          for (int r = 0; r < 16; ++r) { const int orow = (r & 3) + 8 * (r >> 2) + 4 * hi; const float rl = __builtin_amdgcn_rcpf(wsf[orow]);
#pragma unroll
              for (int d0 = 0; d0 < 2; ++d0) stg[orow * 64 + d0 * 32 + r32] = (unsigned short)(mla::cvtpk_s(o[d0][r] * rl, 0.f) & 0xffffu); }
          asm volatile("s_waitcnt lgkmcnt(0)" ::: "memory");
          unsigned short* Ow = mix + (size_t)(row0 + 32 * i) * 1024 + h * 64;
#pragma unroll
          for (int k = 0; k < 4; ++k) { const int row = k * 8 + (lane >> 3), ch = lane & 7; const u32x4 v = *(const __attribute__((address_space(3))) u32x4*)(stg + row * 64 + ch * 8); *(u32x4*)(Ow + (size_t)row * 1024 + ch * 8) = v; }
          asm volatile("s_waitcnt lgkmcnt(0)" ::: "memory");
      } }
    asm volatile("s_waitcnt vmcnt(0) lgkmcnt(0)" ::: "memory");
    __syncthreads();
}
#undef EVM_TR
}

constexpr int NWAVES = 8;
constexpr int BATCH = 4, SEQ = 8192, DM = 1024, NTOK = BATCH * SEQ;
constexpr int EVEN_IN = 1792, ODD_IN = 2336, ODD_IN_PAD = 2560, FF = 2816, FFE = 3584, NEXP = 8, ADA = 6144;
constexpr float NORM_EPS = 1e-6f, LOG2E = 1.4426950408889634f;
constexpr float QS_EVEN = 0.125f * LOG2E;
constexpr float QS_ODD = 0.10206207261596577f * LOG2E;
#ifndef MK_PER_PHASE
#define MK_PER_PHASE 0
#endif
constexpr int NPH = 20;
#ifndef MK_DUPMASK
#define MK_DUPMASK 0u
#endif
#ifndef MK_PROBE_NULLEPI
#define MK_PROBE_NULLEPI 0
#endif
#ifndef MK_CLKPH
#define MK_CLKPH -1
#endif
#define CLKW ((volatile LAS unsigned long long*)(lds0 + LDSCTL_OFF + 768))
#define CLK0(k) do { if (MK_CLKPH == (k) && wave_s == 0) { CLKW[0] = __builtin_amdgcn_s_memtime(); CLKW[1] = __builtin_amdgcn_s_memrealtime(); } } while (0)
#ifndef MK_CLKDUR
#define MK_CLKDUR 0
#endif
#define CLK1(k) do { if (MK_CLKPH == (k) && wave_s == 0) { const unsigned long long c1_ = __builtin_amdgcn_s_memtime(), r1_ = __builtin_amdgcn_s_memrealtime(); CLKW[2] = MK_CLKDUR ? (r1_ - CLKW[1]) / 10ull : (c1_ - CLKW[0]) * 100ull / (r1_ - CLKW[1]); } } while (0)
#define NREP(k) ((((unsigned)MK_DUPMASK >> (k)) & 1u) ? 2 : 1)

constexpr size_t MiB = 1u << 20, KiB = 1024;
constexpr size_t WS_CTL = 0, CTL_ZERO_BYTES = 128 * KiB;
constexpr size_t WS_MOD = 1 * MiB;
constexpr size_t WS_ROPEC = 1 * MiB + 256 * KiB, WS_ROPES = WS_ROPEC + 512 * KiB;
constexpr size_t WS_TOKE = 2 * MiB + 256 * KiB, WS_TOKG = WS_TOKE + 256 * KiB, WS_TOKS = WS_TOKG + 256 * KiB;
constexpr size_t WS_SA = 3 * MiB + 512 * KiB;
constexpr size_t WS_PEXP = WS_TOKS + 256 * KiB, WS_WSB = WS_PEXP + 64 * KiB;
constexpr size_t WS_WEGU = 4 * MiB;
constexpr size_t WS_WED = 60 * MiB;
constexpr float WSC_GU = 32.f, WSC_D = 64.f;
constexpr size_t WS_H = 88 * MiB;
constexpr size_t WS_HN = 152 * MiB;
constexpr size_t WS_PROJ = 216 * MiB;
constexpr size_t WS_MIX0 = 328 * MiB;
constexpr size_t WS_ACT = 216 * MiB;
constexpr size_t WS_QN = 376 * MiB, WS_KVN = 408 * MiB, WS_KPE = 424 * MiB, WS_MIX1 = 426 * MiB;
constexpr size_t WS_Q = 216 * MiB, WS_KV = 264 * MiB;
constexpr size_t WS_WNE = 490 * MiB;
constexpr size_t WS_WIN0 = WS_WNE, WS_WO0 = WS_WIN0 + 3584 * KiB, WS_WGU0 = WS_WO0 + 2 * MiB, WS_WD0 = WS_WGU0 + 11 * MiB, WS_WIN1 = WS_WD0 + 5632 * KiB,
                 WS_WQB = WS_WIN1 + 5 * MiB, WS_WKVB = WS_WQB + 768 * KiB, WS_WO1 = WS_WKVB + 512 * KiB, WS_WNE_END = WS_WO1 + 2 * MiB;
constexpr int MOE_ROWS = 264 * 256;
constexpr size_t WS_XS = 152 * MiB;
constexpr size_t WS_HN2 = 218 * MiB;
constexpr size_t WS_Y = 152 * MiB;
constexpr size_t WS_ACTE = 284 * MiB;
constexpr size_t WS_END = 522 * MiB;
static_assert(WS_WNE_END <= WS_END && WS_MIX1 + 64 * MiB <= WS_WNE && WS_ACTE + (size_t)MOE_ROWS * FFE <= WS_END && WS_WED + (size_t)8 * DM * FFE <= WS_H && WS_H + (size_t)NTOK * DM * 2 <= WS_HN
              && WS_XS + (size_t)MOE_ROWS * DM <= WS_HN2 && WS_HN2 + (size_t)NTOK * DM <= WS_ACTE && WS_Y + (size_t)MOE_ROWS * DM * 2 <= WS_ACTE && WS_ACT + (size_t)NTOK * FF * 2 <= WS_MIX0 + 64 * MiB, "d_ws map");
constexpr int CW_TMO = 0, CW_CODE = 1, CW_BAR = 4096, CW_CNT = 8192, CW_CUR = 9216, CW_CM0 = 16384, CW_CM1 = CW_CM0 + 2048, CW_CMG = CW_CM1 + 2560, CW_CM_END = CW_CMG + 5632;
static_assert(CW_CM_END * 4 <= (int)CTL_ZERO_BYTES, "control words inside the memset");
constexpr int RING_BYTES = 131072, LDS_BYTES = 147456, LDSCTL_OFF = LDS_BYTES - 1024, MISC_OFF = LDSCTL_OFF + 320;

typedef unsigned v2u __attribute__((ext_vector_type(2)));
__device__ __forceinline__ unsigned pk2(float lo, float hi) { return pg8::cvt_pk_bf16(lo, hi); }
__device__ __forceinline__ float bflo(unsigned u) { return __uint_as_float(u << 16); }
__device__ __forceinline__ float bfhi(unsigned u) { return __uint_as_float(u & 0xffff0000u); }
__device__ __forceinline__ float bf2f(bf16 h) { return __uint_as_float(((unsigned)h) << 16); }
template <int CTRL> __device__ __forceinline__ float dpp_f(float v) { return __int_as_float(__builtin_amdgcn_update_dpp(0, __float_as_int(v), CTRL, 0xF, 0xF, true)); }
__device__ __forceinline__ float wave_sum(float v) {
    v += dpp_f<0xB1>(v); v += dpp_f<0x4E>(v); v += dpp_f<0x141>(v); v += dpp_f<0x140>(v);
    { auto r = __builtin_amdgcn_permlane16_swap(__float_as_uint(v), __float_as_uint(v), false, false); v = __uint_as_float(r[0]) + __uint_as_float(r[1]); }
    { auto r = __builtin_amdgcn_permlane32_swap(__float_as_uint(v), __float_as_uint(v), false, false); v = __uint_as_float(r[0]) + __uint_as_float(r[1]); }
    return v;
}
__device__ __forceinline__ float rsqrt_f(float x) { return 1.0f / sqrtf(x); }

struct Ctx { LAS unsigned char* lds; int tid, lane, wave, vcu, G, gw, NGW; };

__device__ __forceinline__ void transpose_item(const float* W, int K, int N, bf16* WT, int row_base, bool pp, LAS float* scr, int kb, int nb, int lane) {
    const int k0 = 64 * kb, n0 = 32 * nb;
    float tv_[32];
#pragma unroll
    for (int i = 0; i < 32; ++i) tv_[i] = W[(size_t)(k0 + 2 * i + (lane >> 5)) * N + n0 + (lane & 31)];
#pragma unroll
    for (int i = 0; i < 32; ++i) scr[(2 * i + (lane >> 5)) * 33 + (lane & 31)] = tv_[i];
    LDS_WAIT(); asm volatile("" ::: "memory");
    const int c = lane & 7;
#pragma unroll
    for (int j = 0; j < 4; ++j) { const int n = (lane >> 3) + 8 * j; const LAS float* s = scr + (8 * c) * 33 + n;
        v4u o; o.x = pk2(s[0 * 33], s[1 * 33]); o.y = pk2(s[2 * 33], s[3 * 33]); o.z = pk2(s[4 * 33], s[5 * 33]); o.w = pk2(s[6 * 33], s[7 * 33]);
        const int nd = pp ? ((n < 16) ? 2 * n : 2 * (n - 16) + 1) : n;
        *(v4u*)(WT + (size_t)(row_base + nd) * K + k0 + 8 * c) = o; }
    LDS_WAIT(); asm volatile("" ::: "memory");
}
__device__ __forceinline__ void transpose_item8(const float* W, int K, int N, unsigned char* WT, int row_base, float sc, LAS float* scr, int kb, int nb, int lane) {
    const int k0 = 64 * kb, n0 = 32 * nb;
    f32x4 tv_[8];
#pragma unroll
    for (int i = 0; i < 8; ++i) tv_[i] = *(const f32x4*)(W + (size_t)(k0 + 8 * i + (lane >> 3)) * N + n0 + 4 * (lane & 7));
#pragma unroll
    for (int i = 0; i < 8; ++i) { LAS float* d = scr + (8 * i + (lane >> 3)) * 33 + 4 * (lane & 7); d[0] = tv_[i].x; d[1] = tv_[i].y; d[2] = tv_[i].z; d[3] = tv_[i].w; }
    LDS_WAIT(); asm volatile("" ::: "memory");
    const int c = lane & 7;
#pragma unroll
    for (int j = 0; j < 4; ++j) { const int n = (lane >> 3) + 8 * j; const LAS float* s = scr + (8 * c) * 33 + n;
        v2u o; o.x = pg8::pack4_fp8(s[0 * 33] * sc, s[1 * 33] * sc, s[2 * 33] * sc, s[3 * 33] * sc); o.y = pg8::pack4_fp8(s[4 * 33] * sc, s[5 * 33] * sc, s[6 * 33] * sc, s[7 * 33] * sc);
        *(v2u*)(WT + (size_t)(row_base + n) * K + k0 + 8 * c) = o; }
    LDS_WAIT(); asm volatile("" ::: "memory");
}
__device__ __forceinline__ void amax_item(const float* W, int N, unsigned* cm, int row_base, bool pp, int kb, int nb, int lane) {
    const int k0 = 64 * kb, n0 = 32 * nb; float mx = 0.f;
#pragma unroll
    for (int i = 0; i < 32; ++i) mx = fmaxf(mx, fabsf(W[(size_t)(k0 + 2 * i + (lane >> 5)) * N + n0 + (lane & 31)]));
    mx = fmaxf(mx, __shfl_xor(mx, 32));
    if (lane < 32) { const int n = lane, nd = pp ? ((n < 16) ? 2 * n : 2 * (n - 16) + 1) : n; atomicMax(cm + row_base + nd, __float_as_uint(mx)); }
}
__device__ __forceinline__ void transpose_item_i8(const float* W, int K, int N, unsigned char* WT, int row_base, const unsigned* cm, LAS float* scr, int kb, int nb, int lane, bool pp = false) {
    const int k0 = 64 * kb, n0 = 32 * nb;
    float tv_[32];
#pragma unroll
    for (int i = 0; i < 32; ++i) tv_[i] = W[(size_t)(k0 + 2 * i + (lane >> 5)) * N + n0 + (lane & 31)];
#pragma unroll
    for (int i = 0; i < 32; ++i) scr[(2 * i + (lane >> 5)) * 33 + (lane & 31)] = tv_[i];
    LDS_WAIT(); asm volatile("" ::: "memory");
    const int c = lane & 7;
#pragma unroll
    for (int j = 0; j < 4; ++j) { const int n = (lane >> 3) + 8 * j; const LAS float* s = scr + (8 * c) * 33 + n;
        const int nd = pp ? ((n < 16) ? 2 * n : 2 * (n - 16) + 1) : n;
        const float cmv = __uint_as_float(cm[row_base + nd]), qs = cmv > 0.f ? 127.f / cmv : 0.f;
        v2u o; o.x = pg8::pack4_i8(s[0 * 33] * qs, s[1 * 33] * qs, s[2 * 33] * qs, s[3 * 33] * qs); o.y = pg8::pack4_i8(s[4 * 33] * qs, s[5 * 33] * qs, s[6 * 33] * qs, s[7 * 33] * qs);
        *(v2u*)(WT + (size_t)(row_base + nd) * K + k0 + 8 * c) = o; }
    LDS_WAIT(); asm volatile("" ::: "memory");
}
struct In {
    const float *x, *c, *e_ada_w, *e_ada_b, *e_nmix_g, *e_w_in, *e_sinks, *e_ln_g, *e_ln_b, *e_w_s, *e_b_s, *e_w_o, *e_nffn_g, *e_wg, *e_wu, *e_wd,
                *o_ada_w, *o_ada_b, *o_nmix_g, *o_w_in, *o_conv_w, *o_qn_g, *o_w_qb, *o_kvn_g, *o_w_kvb, *o_w_o, *o_nffn_g, *o_rw, *o_rb, *o_xg, *o_xu, *o_xd, *fin_g;
};
struct TD8 { const float* W; unsigned char* WT; int K, N, k0, n0, half, inter; float sc; };
__device__ __forceinline__ TD8 td8_decode(int t, const In& I, unsigned char* ws) {
    TD8 d; const int m = t / 1792, rr = t % 1792, e = rr / 224, r2 = rr % 224;
    if (m < 2) { d.W = (m ? I.o_xu : I.o_xg) + (size_t)e * DM * FFE; d.WT = ws + WS_WEGU + (size_t)e * 7168 * DM; d.K = DM; d.N = FFE; d.k0 = 64 * (r2 / 14); d.n0 = 256 * (r2 % 14); d.half = m; d.inter = 1; d.sc = WSC_GU; }
    else { d.W = I.o_xd + (size_t)e * FFE * DM; d.WT = ws + WS_WED + (size_t)e * DM * FFE; d.K = FFE; d.N = DM; d.k0 = 64 * (r2 / 4); d.n0 = 256 * (r2 % 4); d.half = 0; d.inter = 0; d.sc = WSC_D; }
    return d;
}
__device__ __forceinline__ void expert_tiles8(const Ctx& C, const In& I, unsigned char* ws) {
    constexpr int TP = 260, NTILE = 3 * 1792;
    LAS float* const buf0 = (LAS float*)C.lds; LAS float* const buf1 = buf0 + 64 * TP;
    int tile = C.vcu; if (tile >= NTILE) return;
    TD8 d = td8_decode(tile, I, ws);
    f32x4 r[8];
#pragma unroll
    for (int i = 0; i < 8; ++i) r[i] = *(const f32x4*)(d.W + (size_t)(d.k0 + 8 * C.wave + i) * d.N + d.n0 + 4 * C.lane);
    for (int it = 0; ; ++it) {
        LAS float* const buf = (it & 1) ? buf1 : buf0;
#pragma unroll
        for (int i = 0; i < 8; ++i) *(LAS f32x4*)(buf + (8 * C.wave + i) * TP + 4 * C.lane) = r[i];
        const TD8 c = d; const int nxt = tile + C.G;
        if (nxt < NTILE) { d = td8_decode(nxt, I, ws);
#pragma unroll
            for (int i = 0; i < 8; ++i) r[i] = *(const f32x4*)(d.W + (size_t)(d.k0 + 8 * C.wave + i) * d.N + d.n0 + 4 * C.lane); }
        LDS_WAIT(); __syncthreads();
        { const int nl = 32 * C.wave + (C.lane & 31), kh = C.lane >> 5, n = c.n0 + nl;
          const LAS float* s = buf + (32 * kh) * TP + nl; float v[32];
#pragma unroll
          for (int j = 0; j < 32; ++j) v[j] = s[j * TP] * c.sc;
          v4u o0, o1;
          o0.x = pg8::pack4_fp8(v[0], v[1], v[2], v[3]); o0.y = pg8::pack4_fp8(v[4], v[5], v[6], v[7]); o0.z = pg8::pack4_fp8(v[8], v[9], v[10], v[11]); o0.w = pg8::pack4_fp8(v[12], v[13], v[14], v[15]);
          o1.x = pg8::pack4_fp8(v[16], v[17], v[18], v[19]); o1.y = pg8::pack4_fp8(v[20], v[21], v[22], v[23]); o1.z = pg8::pack4_fp8(v[24], v[25], v[26], v[27]); o1.w = pg8::pack4_fp8(v[28], v[29], v[30], v[31]);
          const int row = c.inter ? (256 * (n >> 7) + (n & 127) + 128 * c.half) : n;
          v4u* dst = (v4u*)(c.WT + (size_t)row * c.K + c.k0 + 32 * kh); dst[0] = o0; dst[1] = o1; }
        if (nxt >= NTILE) break;
        tile = nxt;
    }
    __syncthreads();
}
__device__ __forceinline__ void p0_prologue(const Ctx& C, const In& I, unsigned char* ws) {
    if (blockIdx.x < 192) {
        const int layer = blockIdx.x / 96, cb = blockIdx.x % 96, j0 = cb * 64 + 4 * (C.lane & 15), rsub = C.lane >> 4;
        const float* W = layer ? I.o_ada_w : I.e_ada_w; const float* Bv = layer ? I.o_ada_b : I.e_ada_b;
        f32x4 acc[4]; acc[0] = acc[1] = acc[2] = acc[3] = (f32x4){0.f, 0.f, 0.f, 0.f};
#pragma unroll 1
        for (int ch = 0; ch < 4; ++ch) { const int k0 = C.wave * 128 + ch * 32; f32x4 wv[8];
#pragma unroll
            for (int i = 0; i < 8; ++i) wv[i] = *(const f32x4*)(W + (size_t)(k0 + 4 * i + rsub) * ADA + j0);
#pragma unroll
            for (int i = 0; i < 8; ++i) { const int k = k0 + 4 * i + rsub;
#pragma unroll
                for (int bb = 0; bb < 4; ++bb) { const float cv = I.c[bb * DM + k]; acc[bb] += wv[i] * (cv / (1.f + __expf(-cv))); } } }
#pragma unroll
        for (int bb = 0; bb < 4; ++bb)
#pragma unroll
            for (int e = 0; e < 4; ++e) { float v = acc[bb][e]; v += __shfl_xor(v, 16); v += __shfl_xor(v, 32); acc[bb][e] = v; }
        LAS float* red = (LAS float*)C.lds;
        if (C.lane < 16) {
#pragma unroll
            for (int bb = 0; bb < 4; ++bb) *(LAS f32x4*)(red + (C.wave * 4 + bb) * 64 + 4 * C.lane) = acc[bb]; }
        __syncthreads();
        if (C.tid < 256) { const int bb = C.tid >> 6, col = C.tid & 63; float s = 0.f;
#pragma unroll
            for (int w = 0; w < 8; ++w) s += red[(w * 4 + bb) * 64 + col];
            ((float*)(ws + WS_MOD))[(size_t)(layer * BATCH + bb) * ADA + cb * 64 + col] = s + Bv[cb * 64 + col]; }
        __syncthreads();
    }
    {
        bf16* wsb = (bf16*)(ws + WS_WSB);
        for (int idx = blockIdx.x * 512 + C.tid; idx < 8 * 128 * 128; idx += C.G * 512) { const int t = (idx >> 7) & 127, sp = idx & 127; wsb[idx] = (bf16)(pk2((sp <= t) ? I.e_w_s[idx] : 0.f, 0.f) & 0xffffu); }
        float* ct = (float*)(ws + WS_ROPEC); float* st = (float*)(ws + WS_ROPES);
        for (int idx = blockIdx.x * 512 + C.tid; idx < SEQ * 16; idx += C.G * 512) { const int pos = idx >> 4, i = idx & 15;
            const double inv = (double)exp2f(-(float)i * (13.287712379549449f / 16.0f));
            const double rev = (double)((float)pos * (float)inv) * 0.15915494309189535;
            const float fr = (float)(rev - __builtin_rint(rev));
            ct[idx] = __builtin_amdgcn_cosf(fr); st[idx] = __builtin_amdgcn_sinf(fr); }
    }
    LAS float* scr = (LAS float*)(C.lds + C.wave * 16384);
    constexpr int I_IN0 = 16 * 56, I_O = 16 * 32, I_GU0 = 16 * 88, I_D0 = 44 * 32, I_IN1 = 16 * 73, I_QB = 8 * 24, I_KVB = 4 * 32, I_XG1 = 16 * 112, I_XD1 = 56 * 32;
    constexpr int NITEMS = I_IN0 + I_O + 2 * I_GU0 + I_D0 + I_IN1 + I_QB + I_KVB + I_O;
    for (int it = C.gw; it < NITEMS; it += C.NGW) {
        int r = it;
        if (r < I_IN0) { const int kb = r / 56, nb = r % 56; amax_item(I.e_w_in, EVEN_IN, (unsigned*)(ws + WS_CTL) + CW_CM0, nb * 32, false, kb, nb, C.lane); continue; } r -= I_IN0;
        if (r < I_O) { const int kb = r / 32, nb = r % 32; transpose_item(I.e_w_o, DM, DM, (bf16*)(ws + WS_WO0), nb * 32, false, scr, kb, nb, C.lane); continue; } r -= I_O;
        if (r < I_GU0) { const int kb = r / 88, nb = r % 88, n0 = nb * 32; amax_item(I.e_wg, FF, (unsigned*)(ws + WS_CTL) + CW_CMG, 256 * (n0 >> 7) + (n0 & 127), false, kb, nb, C.lane); continue; } r -= I_GU0;
        if (r < I_GU0) { const int kb = r / 88, nb = r % 88, n0 = nb * 32; amax_item(I.e_wu, FF, (unsigned*)(ws + WS_CTL) + CW_CMG, 256 * (n0 >> 7) + (n0 & 127) + 128, false, kb, nb, C.lane); continue; } r -= I_GU0;
        if (r < I_D0) { const int kb = r / 32, nb = r % 32; transpose_item8(I.e_wd, FF, DM, (unsigned char*)(ws + WS_WD0), nb * 32, WSC_D, scr, kb, nb, C.lane); continue; } r -= I_D0;
        if (r < I_IN1) { const int kb = r / 73, nb = r % 73; amax_item(I.o_w_in, ODD_IN, (unsigned*)(ws + WS_CTL) + CW_CM1, nb * 32, nb == 72, kb, nb, C.lane); continue; } r -= I_IN1;
        if (r < I_QB) { const int kb = r / 24, nb = r % 24; transpose_item(I.o_w_qb, 512, 768, (bf16*)(ws + WS_WQB), nb * 32, (nb % 3) == 2, scr, kb, nb, C.lane); continue; } r -= I_QB;
        if (r < I_KVB) { const int kb = r / 32, nb = r % 32; transpose_item(I.o_w_kvb, 256, 1024, (bf16*)(ws + WS_WKVB), nb * 32, false, scr, kb, nb, C.lane); continue; } r -= I_KVB;
        if (r < I_O) { const int kb = r / 32, nb = r % 32; transpose_item(I.o_w_o, DM, DM, (bf16*)(ws + WS_WO1), nb * 32, false, scr, kb, nb, C.lane); continue; } r -= I_O;
    }
    __syncthreads();
    expert_tiles8(C, I, ws);
}

__device__ __forceinline__ void unpack8(const v4u w, float (&x)[8]) { x[0] = bflo(w.x); x[1] = bfhi(w.x); x[2] = bflo(w.y); x[3] = bfhi(w.y); x[4] = bflo(w.z); x[5] = bfhi(w.z); x[6] = bflo(w.w); x[7] = bfhi(w.w); }
template <bool IN_F32> __device__ __forceinline__ void load_row16(const void* h, int m, int lane, float (&x)[2][8]) {
    if (IN_F32) { const f32x4* p = (const f32x4*)((const float*)h + (size_t)m * DM) + 2 * lane;
#pragma unroll
        for (int j = 0; j < 2; ++j) { const f32x4 a = p[128 * j], b = p[128 * j + 1]; x[j][0] = a.x; x[j][1] = a.y; x[j][2] = a.z; x[j][3] = a.w; x[j][4] = b.x; x[j][5] = b.y; x[j][6] = b.z; x[j][7] = b.w; } }
    else { const v4u* p = (const v4u*)((const bf16*)h + (size_t)m * DM) + lane;
#pragma unroll
        for (int j = 0; j < 2; ++j) unpack8(p[64 * j], x[j]); }
}
template <bool IN_F32, bool OUT8> __device__ __forceinline__ void modulate2(const Ctx& C, const void* h, const float* g, const float* shift, const float* scale, void* hn) {
    for (int m0 = 2 * C.gw; m0 < NTOK; m0 += 2 * C.NGW) {
        const int b = m0 >> 13;
        float x[2][2][8];
        load_row16<IN_F32>(h, m0, C.lane, x[0]); load_row16<IN_F32>(h, m0 + 1, C.lane, x[1]);
        float r[2];
#pragma unroll
        for (int rr = 0; rr < 2; ++rr) { float s = 0.f;
#pragma unroll
            for (int j = 0; j < 2; ++j)
#pragma unroll
                for (int k = 0; k < 8; ++k) s += x[rr][j][k] * x[rr][j][k];
            r[rr] = rsqrt_f(wave_sum(s) * (1.f / DM) + NORM_EPS); }
#pragma unroll
        for (int j = 0; j < 2; ++j) { const int c4 = 2 * C.lane + 128 * j;
            const f32x4 g0 = ((const f32x4*)g)[c4], g1 = ((const f32x4*)g)[c4 + 1], s0 = ((const f32x4*)(scale + (size_t)b * ADA))[c4], s1 = ((const f32x4*)(scale + (size_t)b * ADA))[c4 + 1],
                        h0 = ((const f32x4*)(shift + (size_t)b * ADA))[c4], h1 = ((const f32x4*)(shift + (size_t)b * ADA))[c4 + 1];
            const float mg[8] = {g0.x * (s0.x + 1.f), g0.y * (s0.y + 1.f), g0.z * (s0.z + 1.f), g0.w * (s0.w + 1.f), g1.x * (s1.x + 1.f), g1.y * (s1.y + 1.f), g1.z * (s1.z + 1.f), g1.w * (s1.w + 1.f)};
            const float sh[8] = {h0.x, h0.y, h0.z, h0.w, h1.x, h1.y, h1.z, h1.w};
#pragma unroll
            for (int rr = 0; rr < 2; ++rr) { float o[8];
#pragma unroll
                for (int k = 0; k < 8; ++k) o[k] = x[rr][j][k] * r[rr] * mg[k] + sh[k];
                if (OUT8) { v2u w; w.x = pg8::pack4_fp8(o[0], o[1], o[2], o[3]); w.y = pg8::pack4_fp8(o[4], o[5], o[6], o[7]); ((v2u*)((unsigned char*)hn + (size_t)(m0 + rr) * DM))[C.lane + 64 * j] = w; }
                else { v4u w; w.x = pk2(o[0], o[1]); w.y = pk2(o[2], o[3]); w.z = pk2(o[4], o[5]); w.w = pk2(o[6], o[7]); ((v4u*)((bf16*)hn + (size_t)(m0 + rr) * DM))[C.lane + 64 * j] = w; } } }
    }
}

template <bool IN_F32> __device__ __forceinline__ void modulate2_i8(const Ctx& C, const void* h, const float* g, const float* shift, const float* scale, unsigned char* hn, float* sa) {
    for (int m0 = 2 * C.gw; m0 < NTOK; m0 += 2 * C.NGW) {
        const int b = m0 >> 13;
        float x[2][2][8];
        load_row16<IN_F32>(h, m0, C.lane, x[0]); load_row16<IN_F32>(h, m0 + 1, C.lane, x[1]);
        float r[2];
#pragma unroll
        for (int rr = 0; rr < 2; ++rr) { float s = 0.f;
#pragma unroll
            for (int j = 0; j < 2; ++j)
#pragma unroll
                for (int k = 0; k < 8; ++k) s += x[rr][j][k] * x[rr][j][k];
            r[rr] = rsqrt_f(wave_sum(s) * (1.f / DM) + NORM_EPS); }
        float mx[2] = {0.f, 0.f};
#pragma unroll
        for (int j = 0; j < 2; ++j) { const int c4 = 2 * C.lane + 128 * j;
            const f32x4 g0 = ((const f32x4*)g)[c4], g1 = ((const f32x4*)g)[c4 + 1], s0 = ((const f32x4*)(scale + (size_t)b * ADA))[c4], s1 = ((const f32x4*)(scale + (size_t)b * ADA))[c4 + 1],
                        h0 = ((const f32x4*)(shift + (size_t)b * ADA))[c4], h1 = ((const f32x4*)(shift + (size_t)b * ADA))[c4 + 1];
            const float mg[8] = {g0.x * (s0.x + 1.f), g0.y * (s0.y + 1.f), g0.z * (s0.z + 1.f), g0.w * (s0.w + 1.f), g1.x * (s1.x + 1.f), g1.y * (s1.y + 1.f), g1.z * (s1.z + 1.f), g1.w * (s1.w + 1.f)};
            const float sh[8] = {h0.x, h0.y, h0.z, h0.w, h1.x, h1.y, h1.z, h1.w};
#pragma unroll
            for (int rr = 0; rr < 2; ++rr)
#pragma unroll
                for (int k = 0; k < 8; ++k) { x[rr][j][k] = x[rr][j][k] * r[rr] * mg[k] + sh[k]; mx[rr] = fmaxf(mx[rr], fabsf(x[rr][j][k])); } }
#pragma unroll
        for (int rr = 0; rr < 2; ++rr) {
#pragma unroll
            for (int o = 1; o < 64; o <<= 1) mx[rr] = fmaxf(mx[rr], __shfl_xor(mx[rr], o));
            const float qs = mx[rr] > 0.f ? 127.f / mx[rr] : 0.f;
            if (C.lane == 0) sa[m0 + rr] = mx[rr] * (1.f / 127.f);
#pragma unroll
            for (int j = 0; j < 2; ++j) { v2u w; w.x = pg8::pack4_i8(x[rr][j][0] * qs, x[rr][j][1] * qs, x[rr][j][2] * qs, x[rr][j][3] * qs); w.y = pg8::pack4_i8(x[rr][j][4] * qs, x[rr][j][5] * qs, x[rr][j][6] * qs, x[rr][j][7] * qs);
                ((v2u*)(hn + (size_t)(m0 + rr) * DM))[C.lane + 64 * j] = w; } }
    }
}

__device__ __forceinline__ void odd_pre(const Ctx& C, const bf16* proj, const float* conv_w, const float* qn_g, const float* kvn_g, const float* ctab, const float* stab,
                                        bf16* mix, bf16* qn, bf16* kvn, bf16* kpe) {
    for (int m0 = 2 * C.gw; m0 < NTOK; m0 += 2 * C.NGW) {
        const int pos0 = m0 & (SEQ - 1); const bf16* pr = proj + (size_t)m0 * ODD_IN_PAD; const int c0 = C.lane * 8;
        float z[4][8];
#pragma unroll
        for (int i = 0; i < 4; ++i) { const int dt = 2 - i;
            if (pos0 >= dt) { const bf16* p2 = pr - (ptrdiff_t)dt * ODD_IN_PAD; float a[8], xx[8]; unpack8(*(const v4u*)(p2 + 512 + c0), a); unpack8(*(const v4u*)(p2 + 1024 + c0), xx);
#pragma unroll
                for (int k = 0; k < 8; ++k) z[i][k] = a[k] * xx[k]; }
            else {
#pragma unroll
                for (int k = 0; k < 8; ++k) z[i][k] = 0.f; } }
        float cw[3][8];
#pragma unroll
        for (int jj = 0; jj < 3; ++jj) { const f32x4 w0 = *(const f32x4*)(conv_w + jj * 512 + c0), w1 = *(const f32x4*)(conv_w + jj * 512 + c0 + 4); cw[jj][0] = w0.x; cw[jj][1] = w0.y; cw[jj][2] = w0.z; cw[jj][3] = w0.w; cw[jj][4] = w1.x; cw[jj][5] = w1.y; cw[jj][6] = w1.z; cw[jj][7] = w1.w; }
#pragma unroll
        for (int rr = 0; rr < 2; ++rr) { const bf16* p1 = pr + (size_t)rr * ODD_IN_PAD; const int m = m0 + rr;
            float gb[8]; unpack8(*(const v4u*)(p1 + c0), gb); float y[8];
#pragma unroll
            for (int k = 0; k < 8; ++k) y[k] = gb[k] * (cw[0][k] * z[rr][k] + cw[1][k] * z[rr + 1][k] + cw[2][k] * z[rr + 2][k]);
            { v4u o; o.x = pk2(y[0], y[1]); o.y = pk2(y[2], y[3]); o.z = pk2(y[4], y[5]); o.w = pk2(y[6], y[7]); *(v4u*)(mix + (size_t)m * DM + c0) = o; }
            { float x[8]; unpack8(*(const v4u*)(p1 + 1536 + c0), x); float s = 0.f;
#pragma unroll
              for (int k = 0; k < 8; ++k) s += x[k] * x[k];
              const float r = rsqrt_f(wave_sum(s) * (1.f / 512.f) + NORM_EPS);
              const f32x4 g0 = *(const f32x4*)(qn_g + c0), g1 = *(const f32x4*)(qn_g + c0 + 4);
              v4u o; o.x = pk2(x[0] * r * g0.x, x[1] * r * g0.y); o.y = pk2(x[2] * r * g0.z, x[3] * r * g0.w); o.z = pk2(x[4] * r * g1.x, x[5] * r * g1.y); o.w = pk2(x[6] * r * g1.z, x[7] * r * g1.w);
              *(v4u*)(qn + (size_t)m * 512 + c0) = o; }
            { const v2u w = *(const v2u*)(p1 + 2048 + C.lane * 4); const float x[4] = {bflo(w.x), bfhi(w.x), bflo(w.y), bfhi(w.y)};
              const float s = (x[0] * x[0] + x[1] * x[1]) + (x[2] * x[2] + x[3] * x[3]);
              const float r = rsqrt_f(wave_sum(s) * (1.f / 256.f) + NORM_EPS);
              const f32x4 g0 = *(const f32x4*)(kvn_g + C.lane * 4);
              v2u o; o.x = pk2(x[0] * r * g0.x, x[1] * r * g0.y); o.y = pk2(x[2] * r * g0.z, x[3] * r * g0.w);
              *(v2u*)(kvn + (size_t)m * 256 + C.lane * 4) = o; }
            if (C.lane < 16) { const int pos = pos0 + rr; const unsigned w = *(const unsigned*)(p1 + 2304 + 2 * C.lane); const float x1 = bflo(w), x2 = bfhi(w), cs = ctab[pos * 16 + C.lane], sn = stab[pos * 16 + C.lane];
                *(unsigned*)(kpe + (size_t)m * 32 + 2 * C.lane) = pk2(x1 * cs - x2 * sn, x1 * sn + x2 * cs); } }
    }
}

__device__ __forceinline__ void modulate_route(const Ctx& C, const bf16* h, const float* g, const float* shift, const float* scale, const float* rw, const float* rb,
                                               unsigned char* hn, int* tok_e, float* tok_g, unsigned* counts) {
    volatile LAS unsigned* hist = (volatile LAS unsigned*)(C.lds + LDSCTL_OFF);
    f32x4 w[2][8][2];
#pragma unroll
    for (int j = 0; j < 2; ++j)
#pragma unroll
        for (int k = 0; k < 8; ++k) { const float* p = rw + (size_t)(512 * j + 8 * C.lane + k) * 8; w[j][k][0] = *(const f32x4*)p; w[j][k][1] = *(const f32x4*)(p + 4); }
    for (int m0 = 2 * C.gw; m0 < NTOK; m0 += 2 * C.NGW) {
        const int b = m0 >> 13;
        float x[2][2][8];
        load_row16<false>(h, m0, C.lane, x[0]); load_row16<false>(h, m0 + 1, C.lane, x[1]);
        float r[2];
#pragma unroll
        for (int rr = 0; rr < 2; ++rr) { float s = 0.f;
#pragma unroll
            for (int j = 0; j < 2; ++j)
#pragma unroll
                for (int k = 0; k < 8; ++k) s += x[rr][j][k] * x[rr][j][k];
            r[rr] = rsqrt_f(wave_sum(s) * (1.f / DM) + NORM_EPS); }
        f32x4 la[2], lb[2]; la[0] = la[1] = lb[0] = lb[1] = (f32x4){0.f, 0.f, 0.f, 0.f};
#pragma unroll
        for (int j = 0; j < 2; ++j) { const int c4 = 2 * C.lane + 128 * j;
            const f32x4 g0 = ((const f32x4*)g)[c4], g1 = ((const f32x4*)g)[c4 + 1], s0 = ((const f32x4*)(scale + (size_t)b * ADA))[c4], s1 = ((const f32x4*)(scale + (size_t)b * ADA))[c4 + 1],
                        h0 = ((const f32x4*)(shift + (size_t)b * ADA))[c4], h1 = ((const f32x4*)(shift + (size_t)b * ADA))[c4 + 1];
            const float mg[8] = {g0.x * (s0.x + 1.f), g0.y * (s0.y + 1.f), g0.z * (s0.z + 1.f), g0.w * (s0.w + 1.f), g1.x * (s1.x + 1.f), g1.y * (s1.y + 1.f), g1.z * (s1.z + 1.f), g1.w * (s1.w + 1.f)};
            const float sh[8] = {h0.x, h0.y, h0.z, h0.w, h1.x, h1.y, h1.z, h1.w};
#pragma unroll
            for (int rr = 0; rr < 2; ++rr) { float o[8];
#pragma unroll
                for (int k = 0; k < 8; ++k) { o[k] = x[rr][j][k] * r[rr] * mg[k] + sh[k]; la[rr] += w[j][k][0] * o[k]; lb[rr] += w[j][k][1] * o[k]; }
                v2u wv; wv.x = pg8::pack4_fp8(o[0], o[1], o[2], o[3]); wv.y = pg8::pack4_fp8(o[4], o[5], o[6], o[7]); ((v2u*)(hn + (size_t)(m0 + rr) * DM))[C.lane + 64 * j] = wv; } }
#pragma unroll
        for (int rr = 0; rr < 2; ++rr) { const int m = m0 + rr;
            float lg[8] = {la[rr].x, la[rr].y, la[rr].z, la[rr].w, lb[rr].x, lb[rr].y, lb[rr].z, lb[rr].w};
#pragma unroll
            for (int e = 0; e < 8; ++e) lg[e] = wave_sum(lg[e]) + rb[e];
            int e0 = 0; float v0 = lg[0];
#pragma unroll
            for (int e = 1; e < 8; ++e) if (lg[e] > v0) { v0 = lg[e]; e0 = e; }
            int e1 = -1; float v1 = -INFINITY;
#pragma unroll
            for (int e = 0; e < 8; ++e) if (e != e0 && lg[e] > v1) { v1 = lg[e]; e1 = e; }
            const float p1 = __expf(v1 - v0), g0 = 1.f / (1.f + p1), g1 = p1 * g0;
            if (C.lane == 0) { tok_e[2 * m] = e0; tok_e[2 * m + 1] = e1; tok_g[2 * m] = g0; tok_g[2 * m + 1] = g1;
                __hip_atomic_fetch_add((LAS unsigned*)&hist[e0], 1u, __ATOMIC_RELAXED, __HIP_MEMORY_SCOPE_WORKGROUP); __hip_atomic_fetch_add((LAS unsigned*)&hist[e1], 1u, __ATOMIC_RELAXED, __HIP_MEMORY_SCOPE_WORKGROUP); } }
    }
    LDS_WAIT(); __syncthreads();
    if (C.tid < 8) { const unsigned n = hist[C.tid]; if (n) __hip_atomic_fetch_add(counts + 64 * C.tid, n, __ATOMIC_RELAXED, __HIP_MEMORY_SCOPE_AGENT); }
    __syncthreads();
}

__device__ __forceinline__ void moe_pstart(const unsigned* counts, int (&pstart)[8], int (&pend)[8]) {
    int acc = 0;
#pragma unroll
    for (int e = 0; e < 8; ++e) { const int n = (int)__hip_atomic_load(counts + 64 * e, __ATOMIC_RELAXED, __HIP_MEMORY_SCOPE_AGENT); pstart[e] = acc; acc += (n + 255) >> 8; pend[e] = acc; }
}
__device__ __forceinline__ void moe_gather(const Ctx& C, const unsigned char* hn, const int* tok_e, const unsigned* counts, unsigned* cursor, int* tok_slot, unsigned char* xs, int* pexp) {
    int pstart[8], pend[8]; moe_pstart(counts, pstart, pend);
    if (blockIdx.x == 0 && C.tid < 273) { int e = 0;
#pragma unroll
        for (int k = 0; k < 7; ++k) e += (C.tid >= pend[k]) ? 1 : 0;
        pexp[C.tid] = (C.tid == 272) ? pend[7] : e; }
    for (int task = C.gw; task < NTOK / 16; task += C.NGW) {
        const int tok = task * 16 + (C.lane & 15); const bool act = C.lane < 16;
        const int e0 = act ? tok_e[2 * tok] : -1, e1 = act ? tok_e[2 * tok + 1] : -2;
        int s0 = 0, s1 = 0;
        const unsigned long long lt = (1ull << C.lane) - 1ull;
#pragma unroll
        for (int e = 0; e < 8; ++e) { const unsigned long long m0 = __ballot(e0 == e), m1 = __ballot(e1 == e); const int n0 = __popcll(m0), n1 = __popcll(m1);
            unsigned base = 0u; if (C.lane == 0 && (n0 + n1) > 0) base = __hip_atomic_fetch_add(cursor + 64 * e, (unsigned)(n0 + n1), __ATOMIC_RELAXED, __HIP_MEMORY_SCOPE_AGENT);
            base = (unsigned)__builtin_amdgcn_readfirstlane((int)base) + (unsigned)pstart[e] * 256u;
            if (e0 == e) s0 = (int)base + __popcll(m0 & lt); if (e1 == e) s1 = (int)base + n0 + __popcll(m1 & lt); }
        if (act) { tok_slot[2 * tok] = s0; tok_slot[2 * tok + 1] = s1; }
#pragma unroll 4
        for (int i = 0; i < 16; ++i) { const int d0 = __shfl(s0, i), d1 = __shfl(s1, i);
            const v4u a = ((const v4u*)(hn + (size_t)(task * 16 + i) * DM))[C.lane];
            ((v4u*)(xs + (size_t)d0 * DM))[C.lane] = a; ((v4u*)(xs + (size_t)d1 * DM))[C.lane] = a; }
    }
}

__device__ __forceinline__ void final_rows(int gw, int NGW, int lane, const bf16* h, float* out, const bf16* y, const int* tok_slot, const float* tok_g, const float* gate, const float* fin_g, int s_ready, int mode) {
    for (int m0 = 2 * gw; m0 < NTOK; m0 += 2 * NGW) {
        const int b = m0 >> 13;
        int sl[2][2]; bool sel[2];
#pragma unroll
        for (int rr = 0; rr < 2; ++rr) { sl[rr][0] = __builtin_amdgcn_readfirstlane(tok_slot[2 * (m0 + rr)]); sl[rr][1] = __builtin_amdgcn_readfirstlane(tok_slot[2 * (m0 + rr) + 1]);
            const bool ready = sl[rr][0] < s_ready && sl[rr][1] < s_ready; sel[rr] = mode ? !ready : ready; }
        if (!sel[0] && !sel[1]) continue;
        float v[2][2][8]; float r[2];
#pragma unroll
        for (int rr = 0; rr < 2; ++rr) { const int m = m0 + rr; const float g0 = tok_g[2 * m], g1 = tok_g[2 * m + 1];
            float hx[2][8], ya[2][8], yb[2][8];
            load_row16<false>(h, m, lane, hx); load_row16<false>(y, sl[rr][0], lane, ya); load_row16<false>(y, sl[rr][1], lane, yb);
            float s = 0.f;
#pragma unroll
            for (int j = 0; j < 2; ++j) { const int c4 = 2 * lane + 128 * j; const f32x4 t0 = ((const f32x4*)(gate + (size_t)b * ADA))[c4], t1 = ((const f32x4*)(gate + (size_t)b * ADA))[c4 + 1];
                const float gt[8] = {t0.x, t0.y, t0.z, t0.w, t1.x, t1.y, t1.z, t1.w};
#pragma unroll
                for (int k = 0; k < 8; ++k) { v[rr][j][k] = hx[j][k] + gt[k] * (g0 * ya[j][k] + g1 * yb[j][k]); s += v[rr][j][k] * v[rr][j][k]; } }
            r[rr] = s; }
#pragma unroll
        for (int rr = 0; rr < 2; ++rr) r[rr] = rsqrt_f(wave_sum(r[rr]) * (1.f / DM) + NORM_EPS);
#pragma unroll
        for (int rr = 0; rr < 2; ++rr) { if (!sel[rr]) continue;
#pragma unroll
            for (int j = 0; j < 2; ++j) { const int c4 = 2 * lane + 128 * j; const f32x4 f0 = ((const f32x4*)fin_g)[c4], f1 = ((const f32x4*)fin_g)[c4 + 1];
                f32x4* op = (f32x4*)(out + (size_t)(m0 + rr) * DM) + c4;
                op[0] = (f32x4){v[rr][j][0] * r[rr] * f0.x, v[rr][j][1] * r[rr] * f0.y, v[rr][j][2] * r[rr] * f0.z, v[rr][j][3] * r[rr] * f0.w};
                op[1] = (f32x4){v[rr][j][4] * r[rr] * f1.x, v[rr][j][5] * r[rr] * f1.y, v[rr][j][6] * r[rr] * f1.z, v[rr][j][7] * r[rr] * f1.w}; } }
    }
}

struct Args { In in; float* out; unsigned char* ws; int ph_lo, ph_hi; };
__global__ void __launch_bounds__(NWAVES * 64, 2) fwd(Args args) {
    extern __shared__ __attribute__((aligned(16))) unsigned char lds_raw[];
#define MKCTX() Ctx C; { int t_ = tid_from_wave(wave_s); asm volatile("" : "+v"(t_)); C.lds = (LAS unsigned char*)lds_raw; C.tid = t_; C.lane = t_ & 63; C.wave = __builtin_amdgcn_readfirstlane(t_ >> 6); \
        C.G = gridDim.x; const int bx_ = blockIdx.x; C.vcu = (C.G % 8 == 0) ? (bx_ % 8) * (C.G / 8) + bx_ / 8 : bx_; C.gw = C.vcu * NWAVES + C.wave; C.NGW = C.G * NWAVES; }
    LAS unsigned char* const lds0 = (LAS unsigned char*)lds_raw;
    const int wave_s = __builtin_amdgcn_readfirstlane((int)(threadIdx.x >> 6));
    unsigned char* ws = args.ws; const In& I = args.in;
    unsigned* ctl = (unsigned*)(ws + WS_CTL);
    for (int u = threadIdx.x; u < (LDS_BYTES - LDSCTL_OFF) / 4; u += NWAVES * 64) ((LAS unsigned*)(lds0 + LDSCTL_OFF))[u] = 0u;
    __syncthreads();
    XcdBarrier bar; bar.bar = ctl + CW_BAR; bar.x = 0; bar.st = nullptr; bar.wave = wave_s;
    if (!MK_PER_PHASE) bar = xcd_barrier_post(ctl + CW_BAR, (volatile LAS unsigned*)(lds0 + MISC_OFF) + 8, wave_s);
    const int lo = args.ph_lo, hi = args.ph_hi;
#define IN(k) (lo <= (k) && (k) < hi)
#define SEAM(k) do { if (!MK_PER_PHASE && IN(k) && IN((k) + 1)) xcd_barrier(bar); } while (0)

    bf16* const hbuf = (bf16*)(ws + WS_H);
    const float* mod0 = (const float*)(ws + WS_MOD); const float* mod1 = mod0 + BATCH * ADA;
    bf16* const HN = (bf16*)(ws + WS_HN); bf16* const PROJ = (bf16*)(ws + WS_PROJ); bf16* const MIX0 = (bf16*)(ws + WS_MIX0); bf16* const ACT = (bf16*)(ws + WS_ACT);
    bf16* const QN = (bf16*)(ws + WS_QN); bf16* const KVN = (bf16*)(ws + WS_KVN); bf16* const KPE = (bf16*)(ws + WS_KPE); bf16* const MIX1 = (bf16*)(ws + WS_MIX1);
    bf16* const Q = (bf16*)(ws + WS_Q); bf16* const KV = (bf16*)(ws + WS_KV); unsigned char* const HN2 = ws + WS_HN2; unsigned char* const XS = ws + WS_XS; unsigned char* const ACTE = ws + WS_ACTE; bf16* const YB = (bf16*)(ws + WS_Y);
    const float* ctab = (const float*)(ws + WS_ROPEC); const float* stab = (const float*)(ws + WS_ROPES);
    int* const pexp = (int*)(ws + WS_PEXP); int* tok_e = (int*)(ws + WS_TOKE); float* tok_g = (float*)(ws + WS_TOKG); int* tok_slot = (int*)(ws + WS_TOKS);

    CLK0(0);
    if (IN(0)) for (int rep_ = 0; rep_ < NREP(0); ++rep_) { MKCTX(); p0_prologue(C, I, ws); } if (!MK_CLKDUR) CLK1(0); SEAM(0); if (MK_CLKDUR) CLK1(0);
    CLK0(1);
    if (IN(1)) for (int rep_ = 0; rep_ < NREP(1); ++rep_) { MKCTX(); modulate2_i8<true>(C, I.x, I.e_nmix_g, mod0 + 0 * DM, mod0 + 1 * DM, (unsigned char*)HN, (float*)(ws + WS_SA));
        { LAS float* scr = (LAS float*)(C.lds + C.wave * 16384);
          for (int it = C.gw; it < 16 * 56; it += C.NGW) { const int kb = it / 56, nb = it % 56; transpose_item_i8(I.e_w_in, DM, EVEN_IN, ws + WS_WIN0, nb * 32, ctl + CW_CM0, scr, kb, nb, C.lane); } } } if (!MK_CLKDUR) CLK1(1); SEAM(1); if (MK_CLKDUR) CLK1(1);
    CLK0(2);
    if (IN(2)) for (int rep_ = 0; rep_ < NREP(2); ++rep_) { MKCTX(); pg8::Gemm g{HN, (const bf16*)(ws + WS_WIN0), NTOK, EVEN_IN, DM / 2}; pg8::StaticOrder S; S.init(NTOK, EVEN_IN, C.G, (int)blockIdx.x);
        pg8::EpiProj0I E{PROJ, EVEN_IN, QS_EVEN, (const float*)(ws + WS_SA), ctl + CW_CM0}; pg8::gemm_phase<pg8::EpiProj0I, pg8::StaticOrder, true, true, false, true>(C.lds, g, S, E, wave_s);
        { const int nwg = (NTOK / 256) * (EVEN_IN / 256), first_idle = nwg - 3 * C.G;
          const bool tail_ok = first_idle > 0 && first_idle < C.G;
          if (!tail_ok || (int)blockIdx.x >= first_idle) {
              LAS float* scr = (LAS float*)(C.lds + C.wave * 16384); const int wv = tail_ok ? ((int)blockIdx.x - first_idle) * NWAVES + C.wave : C.gw, nwv = tail_ok ? (C.G - first_idle) * NWAVES : C.NGW;
              for (int it = wv; it < 2 * 16 * 88; it += nwv) { const int half = it / (16 * 88), r = it % (16 * 88), kb = r / 88, nb = r % 88, n0 = nb * 32;
                  transpose_item_i8(half ? I.e_wu : I.e_wg, DM, FF, ws + WS_WGU0, 256 * (n0 >> 7) + (n0 & 127) + 128 * half, ctl + CW_CMG, scr, kb, nb, C.lane); }
              for (int it = wv; it < 16 * 73; it += nwv) { const int kb = it / 73, nb = it % 73; transpose_item_i8(I.o_w_in, DM, ODD_IN, ws + WS_WIN1, nb * 32, ctl + CW_CM1, scr, kb, nb, C.lane, nb == 72); } } }
    } if (!MK_CLKDUR) CLK1(2); SEAM(2); if (MK_CLKDUR) CLK1(2);
    CLK0(3);
    if (IN(3)) for (int rep_ = 0; rep_ < NREP(3); ++rep_) { MKCTX(); for (int un = C.vcu; un < NTOK / 128; un += C.G) evm::unit(un, PROJ, I.e_sinks, I.e_ln_g, I.e_ln_b, (const bf16*)(ws + WS_WSB), I.e_b_s, MIX0, (char*)lds_raw, wave_s); } if (!MK_CLKDUR) CLK1(3); SEAM(3); if (MK_CLKDUR) CLK1(3);
    CLK0(4);
    if (IN(4)) for (int rep_ = 0; rep_ < NREP(4); ++rep_) { MKCTX(); pg8::Gemm g{MIX0, (const bf16*)(ws + WS_WO0), NTOK, DM, DM}; pg8::StaticOrder S; S.init(NTOK, DM, C.G, (int)blockIdx.x);
        pg8::EpiResGateH<true> E{I.x, hbuf, DM, mod0 + 2 * DM, ADA, SEQ, 1.0f}; pg8::gemm_phase<pg8::EpiResGateH<true>, pg8::StaticOrder, true, true>(C.lds, g, S, E, wave_s); } if (!MK_CLKDUR) CLK1(4); SEAM(4); if (MK_CLKDUR) CLK1(4);
    CLK0(5);
    if (IN(5)) for (int rep_ = 0; rep_ < NREP(5); ++rep_) { MKCTX(); modulate2_i8<false>(C, hbuf, I.e_nffn_g, mod0 + 3 * DM, mod0 + 4 * DM, (unsigned char*)HN, (float*)(ws + WS_SA)); } if (!MK_CLKDUR) CLK1(5); SEAM(5); if (MK_CLKDUR) CLK1(5);
    CLK0(6);
    if (IN(6)) for (int rep_ = 0; rep_ < NREP(6); ++rep_) { MKCTX(); pg8::Gemm g{HN, (const bf16*)(ws + WS_WGU0), NTOK, 2 * FF, DM / 2}; pg8::StaticOrder S; S.init(NTOK, 2 * FF, C.G, (int)blockIdx.x);
        pg8::EpiSwiGLUI8 E{(unsigned char*)ACT, FF, (const float*)(ws + WS_SA), ctl + CW_CMG}; pg8::gemm_phase<pg8::EpiSwiGLUI8, pg8::StaticOrder, true, true, false, true>(C.lds, g, S, E, wave_s); } if (!MK_CLKDUR) CLK1(6); SEAM(6); if (MK_CLKDUR) CLK1(6);
    CLK0(7);
    if (IN(7)) for (int rep_ = 0; rep_ < NREP(7); ++rep_) { MKCTX(); pg8::Gemm g{ACT, (const bf16*)(ws + WS_WD0), NTOK, DM, FF / 2}; pg8::StaticOrder S; S.init(NTOK, DM, C.G, (int)blockIdx.x);
        pg8::EpiResGateH<false> E{hbuf, hbuf, DM, mod0 + 5 * DM, ADA, SEQ, 1.0f / WSC_D}; pg8::gemm_phase<pg8::EpiResGateH<false>, pg8::StaticOrder, true, true, true>(C.lds, g, S, E, wave_s); } if (!MK_CLKDUR) CLK1(7); SEAM(7); if (MK_CLKDUR) CLK1(7);
    CLK0(8);
    if (IN(8)) for (int rep_ = 0; rep_ < NREP(8); ++rep_) { MKCTX(); modulate2_i8<false>(C, hbuf, I.o_nmix_g, mod1 + 0 * DM, mod1 + 1 * DM, (unsigned char*)HN, (float*)(ws + WS_SA)); } if (!MK_CLKDUR) CLK1(8); SEAM(8); if (MK_CLKDUR) CLK1(8);
    CLK0(9);
    if (IN(9)) for (int rep_ = 0; rep_ < NREP(9); ++rep_) { MKCTX(); pg8::Gemm g{HN, (const bf16*)(ws + WS_WIN1), NTOK, ODD_IN_PAD, DM / 2}; pg8::StaticOrder S; S.init(NTOK, ODD_IN_PAD, C.G, (int)blockIdx.x);
        pg8::EpiBf16PlainI E{PROJ, ODD_IN_PAD, (const float*)(ws + WS_SA), ctl + CW_CM1}; pg8::gemm_phase<pg8::EpiBf16PlainI, pg8::StaticOrder, true, true, false, true>(C.lds, g, S, E, wave_s); } if (!MK_CLKDUR) CLK1(9); SEAM(9); if (MK_CLKDUR) CLK1(9);
    CLK0(10);
    if (IN(10)) for (int rep_ = 0; rep_ < NREP(10); ++rep_) { MKCTX(); odd_pre(C, PROJ, I.o_conv_w, I.o_qn_g, I.o_kvn_g, ctab, stab, MIX1, QN, KVN, KPE); } if (!MK_CLKDUR) CLK1(10); SEAM(10); if (MK_CLKDUR) CLK1(10);
    CLK0(11);
    if (IN(11)) for (int rep_ = 0; rep_ < NREP(11); ++rep_) { MKCTX();
        { pg8::Gemm g{QN, (const bf16*)(ws + WS_WQB), NTOK, 768, 512}; pg8::StaticOrder S; S.init(NTOK, 768, C.G, (int)blockIdx.x);
          pg8::EpiQRope E{Q, 768, ctab, stab, QS_ODD, SEQ - 1}; pg8::gemm_phase<pg8::EpiQRope, pg8::StaticOrder, true, true>(C.lds, g, S, E, wave_s); }
        { pg8::Gemm g{KVN, (const bf16*)(ws + WS_WKVB), NTOK, 1024, 256}; pg8::StaticOrder S; S.init(NTOK, 1024, C.G, (int)blockIdx.x, (C.G == 256) ? 128 : 0);
          pg8::EpiBf16Plain E{KV, 1024, 1.0f}; pg8::gemm_phase<pg8::EpiBf16Plain, pg8::StaticOrder, true, true>(C.lds, g, S, E, wave_s); }
    } if (!MK_CLKDUR) CLK1(11); SEAM(11); if (MK_CLKDUR) CLK1(11);
    CLK0(12);
    if (IN(12)) for (int rep_ = 0; rep_ < NREP(12); ++rep_) { MKCTX(); mla::phase((char*)lds_raw, Q, KV, KPE, MIX1, C.vcu, C.G, wave_s); } if (!MK_CLKDUR) CLK1(12); SEAM(12); if (MK_CLKDUR) CLK1(12);
    CLK0(13);
    if (IN(13)) for (int rep_ = 0; rep_ < NREP(13); ++rep_) { MKCTX(); pg8::Gemm g{MIX1, (const bf16*)(ws + WS_WO1), NTOK, DM, DM}; pg8::StaticOrder S; S.init(NTOK, DM, C.G, (int)blockIdx.x);
        pg8::EpiResGateH<false> E{hbuf, hbuf, DM, mod1 + 2 * DM, ADA, SEQ, 1.0f}; pg8::gemm_phase<pg8::EpiResGateH<false>, pg8::StaticOrder, true, true>(C.lds, g, S, E, wave_s); } if (!MK_CLKDUR) CLK1(13); SEAM(13); if (MK_CLKDUR) CLK1(13);
    CLK0(14);
    if (IN(14)) for (int rep_ = 0; rep_ < NREP(14); ++rep_) { MKCTX(); modulate_route(C, hbuf, I.o_nffn_g, mod1 + 3 * DM, mod1 + 4 * DM, I.o_rw, I.o_rb, HN2, tok_e, tok_g, ctl + CW_CNT); } if (!MK_CLKDUR) CLK1(14); SEAM(14); if (MK_CLKDUR) CLK1(14);
    CLK0(15);
    if (IN(15)) for (int rep_ = 0; rep_ < NREP(15); ++rep_) { MKCTX(); moe_gather(C, HN2, tok_e, ctl + CW_CNT, ctl + CW_CUR, tok_slot, XS, pexp); } if (!MK_CLKDUR) CLK1(15); SEAM(15); if (MK_CLKDUR) CLK1(15);
    CLK0(16);
    if (IN(16)) for (int rep_ = 0; rep_ < NREP(16); ++rep_) { MKCTX();
        const int P = __builtin_amdgcn_readfirstlane(pexp[272]);
        pg8::MoeOrder<28, false> S{C.G, C.vcu, 0, P * 28, pexp, 0};
        pg8::Gemm g{(const bf16*)XS, (const bf16*)(ws + WS_WEGU), 0, 0, DM / 2};
#if MK_PROBE_NULLEPI
        if (rep_ == 1) { pg8::EpiNull E0; pg8::gemm_phase<pg8::EpiNull, pg8::MoeOrder<28, false>, true, true, true>(C.lds, g, S, E0, wave_s); } else
#endif
        { pg8::EpiSwiGLU8 E{ACTE, FFE, 1.0f / WSC_GU}; pg8::gemm_phase<pg8::EpiSwiGLU8, pg8::MoeOrder<28, false>, true, true, true>(C.lds, g, S, E, wave_s); }
    } if (!MK_CLKDUR) CLK1(16); SEAM(16); if (MK_CLKDUR) CLK1(16);
    CLK0(17);
    if (IN(17)) for (int rep_ = 0; rep_ < NREP(17); ++rep_) { MKCTX();
        const int P = __builtin_amdgcn_readfirstlane(pexp[272]); const int nfull = (P * 4 / C.G) * C.G;
        pg8::MoeOrder<4, false> S{C.G, C.vcu, 0, nfull, pexp, 0};
        pg8::Gemm g{(const bf16*)ACTE, (const bf16*)(ws + WS_WED), 0, 0, FFE / 2};
        pg8::EpiBf16Plain E{YB, DM, 1.0f / WSC_D}; pg8::gemm_phase<pg8::EpiBf16Plain, pg8::MoeOrder<4, false>, true, true, true>(C.lds, g, S, E, wave_s);
    } if (!MK_CLKDUR) CLK1(17); SEAM(17); if (MK_CLKDUR) CLK1(17);
    CLK0(18);
    if (IN(18)) { MKCTX();
        const int P = __builtin_amdgcn_readfirstlane(pexp[272]); const int nfull = (P * 4 / C.G) * C.G, nleft = P * 4 - nfull;
        if (C.vcu < nleft) {
            pg8::MoeOrder<4, false> S{C.G, C.vcu, 0, P * 4, pexp, nfull};
            pg8::Gemm g{(const bf16*)ACTE, (const bf16*)(ws + WS_WED), 0, 0, FFE / 2};
            pg8::EpiBf16Plain E{YB, DM, 1.0f / WSC_D}; pg8::gemm_phase<pg8::EpiBf16Plain, pg8::MoeOrder<4, false>, true, true, true>(C.lds, g, S, E, wave_s);
        } else {
            final_rows((C.vcu - nleft) * NWAVES + C.wave, (C.G - nleft) * NWAVES, C.lane, hbuf, args.out, YB, tok_slot, tok_g, mod1 + 5 * DM, I.fin_g, (nfull / 4) * 256, 0);
        }
    } SEAM(18);
    if (IN(19)) { MKCTX();
        const int P = __builtin_amdgcn_readfirstlane(pexp[272]); const int nfull = (P * 4 / C.G) * C.G;
        final_rows(C.gw, C.NGW, C.lane, hbuf, args.out, YB, tok_slot, tok_g, mod1 + 5 * DM, I.fin_g, (nfull / 4) * 256, 1);
    }
    if (MK_CLKDUR) CLK1(18);
    if (MK_CLKPH >= 0 && blockIdx.x == 0 && wave_s == 0) { const unsigned long long mhz_ = CLKW[2], r0_ = __builtin_amdgcn_s_memrealtime(); while (__builtin_amdgcn_s_memrealtime() - r0_ < mhz_ * 100ull) __builtin_amdgcn_s_sleep(8); }
#undef IN
#undef SEAM
}

extern "C" void kernel_launch(void* const* d_in, const int* in_sizes, int n_in, void* d_out, int out_size, void* d_ws, size_t ws_size, hipStream_t stream) {
    static int grid = 0;
    if (grid == 0) {
        if (n_in != 33 || in_sizes[0] != NTOK * DM || out_size != NTOK * DM || ws_size < WS_END) { fprintf(stderr, "kernel_launch: unexpected shapes (n_in %d, in0 %d, out %d, ws %zu < %zu); nothing launched\n", n_in, n_in > 0 ? in_sizes[0] : -1, out_size, ws_size, (size_t)WS_END); grid = -1; return; }
        int dev = 0, cus = 0, per_cu = 0;
        if (hipGetDevice(&dev) != hipSuccess || hipDeviceGetAttribute(&cus, hipDeviceAttributeMultiprocessorCount, dev) != hipSuccess) { grid = -1; return; }
        if (hipFuncSetAttribute((const void*)fwd, hipFuncAttributeMaxDynamicSharedMemorySize, LDS_BYTES) != hipSuccess) { fprintf(stderr, "kernel_launch: hipFuncSetAttribute failed\n"); grid = -1; return; }
        if (hipOccupancyMaxActiveBlocksPerMultiprocessor(&per_cu, (const void*)fwd, NWAVES * 64, LDS_BYTES) != hipSuccess || per_cu < 1) fprintf(stderr, "kernel_launch: occupancy query reports %d\n", per_cu);
        (void)hipGetLastError();
        grid = cus;
    }
    if (grid < 0) return;
    if (hipMemsetAsync((char*)d_ws + WS_CTL, 0, CTL_ZERO_BYTES, stream) != hipSuccess) return;
    Args a{};
    const float** ip = (const float**)&a.in;
    for (int i = 0; i < 33; ++i) ip[i] = (const float*)d_in[i];
    a.out = (float*)d_out; a.ws = (unsigned char*)d_ws;
#if MK_PER_PHASE
    for (int p = 0; p < NPH; ++p) { a.ph_lo = p; a.ph_hi = p + 1; hipLaunchKernelGGL(fwd, dim3(grid), dim3(NWAVES * 64), LDS_BYTES, stream, a); }
#else
    a.ph_lo = 0; a.ph_hi = NPH; hipLaunchKernelGGL(fwd, dim3(grid), dim3(NWAVES * 64), LDS_BYTES, stream, a);
#endif
}
```

```cpp
#include <hip/hip_runtime.h>
#include <cstdio>
#include <cstdint>
#include <cmath>
__device__ __forceinline__ int tid_from_wave(int wave) { unsigned l_; asm volatile("v_mbcnt_lo_u32_b32 %0, -1, 0\n\tv_mbcnt_hi_u32_b32 %0, -1, %0" : "=v"(l_)); return wave * 64 + (int)l_; }
namespace pg8 {
#define PG8_LAS __attribute__((address_space(3)))
typedef unsigned short bf16_t;
typedef short bf16x8 __attribute__((ext_vector_type(8)));
typedef float f32x4 __attribute__((ext_vector_type(4)));
typedef unsigned u32x4 __attribute__((ext_vector_type(4)));
typedef int v8i_t __attribute__((ext_vector_type(8)));
typedef int v4i_t __attribute__((ext_vector_type(4)));
typedef unsigned u32x2 __attribute__((ext_vector_type(2)));
constexpr int BM = 256, BK = 64, HALF = 128, HTB = HALF * BK * 2  , STAGE_BYTES = 8 * HTB, NXCD = 8, WGM = 8;

__host__ __device__ __forceinline__ int lds_byte(int r, int c) { const int st = (r >> 4) * 2 + (c >> 5), rr = r & 15, cc = c & 31, ob = rr * 64 + cc * 2; return st * 1024 + (ob ^ (((ob >> 9) & 1) << 5)); }
__host__ __device__ __forceinline__ void stage_rc(int b, int& R, int& C) { const int st = b / 1024, sb = b % 1024, swz = sb ^ (((sb >> 9) & 1) << 5); R = (st >> 1) * 16 + swz / 64; C = (st & 1) * 32 + (swz % 64) / 2; }
__host__ __device__ __forceinline__ int perm32(int rho) { const int n = rho >> 4, i = rho & 15; return 8 * (i >> 2) + 4 * n + (i & 3); }

struct Unit { int pm, pn, pb, po; };
struct Gemm { const bf16_t* A; const bf16_t* Bt; int M, N, K; };

struct StaticOrder {
    int nM, nN, nwg, G, c, skew;
    __host__ __device__ void init(int M, int N, int G_, int c_, int skew_ = 0) { nM = M / BM; nN = N / BM; nwg = nM * nN; G = G_; c = c_; skew = skew_; }
    __host__ __device__ bool next(int i, Unit& u) const {
        if (i > 0 && c < skew) return false;
        const long L = (i == 0) ? (long)c : (long)G + (long)(i - 1) * (G - skew) + (c - skew); if (L >= nwg) return false;
        int wgid = (int)L; { const int q = nwg / NXCD, r = nwg % NXCD, xcd = wgid % NXCD, off = wgid / NXCD; wgid = (xcd < r ? xcd * (q + 1) : r * (q + 1) + (xcd - r) * q) + off; }
        const int nig = WGM * nN, gid = wgid / nig, fm = gid * WGM, gsz = (nM - fm) < WGM ? (nM - fm) : WGM;
        u.pm = fm + ((wgid % nig) % gsz); u.pn = (wgid % nig) / gsz; u.pb = u.pn; u.po = u.pm; return true;
    }
    __device__ __forceinline__ void a_ready(const Unit&) const {}
    __device__ __forceinline__ void done(const Unit&) const {}
};
#ifndef MOE_PG
#define MOE_PG 8
#endif
#ifndef MOE_NC
#define MOE_NC 7
#endif
template <int NT, bool A_REL> struct MoeOrder {
    int G, c, p0, nunits; const int* pexp; int l0;
    __device__ __forceinline__ bool next(int i, Unit& u) const {
        int pl, n;
        if (NT == 28 && G == 256 && l0 == 0) {
            const int per = (nunits + 7) >> 3, x = c >> 5, j = c & 31, s = 32 * i + j; if (s >= per) return false;
            const int L = x * per + s; if (L >= nunits) return false;
            constexpr int PG = MOE_PG;
            const int P = nunits / 28, full = (P / PG) * (PG * 28);
            constexpr int NC = MOE_NC, NQ = 28 / NC;
            if (L < full) { const int t = L / (NC * PG), r = L - t * (NC * PG), g = t / NQ, q = t - g * NQ; pl = PG * g + (r % PG); n = NC * q + (r / PG); }
            else { const int L2 = L - full; pl = (P / PG) * PG + L2 / 28; n = L2 % 28; }
        } else {
        const int L = l0 + i * G + c; if (L >= nunits) return false;
        pl = L / NT; n = L - pl * NT; }
        const int p = p0 + pl;
        const int e = __builtin_amdgcn_readfirstlane(pexp[p]);
        u.pm = A_REL ? pl : p; u.po = A_REL ? p : pl; u.pn = n; u.pb = e * NT + n; return true;
    }
    __device__ __forceinline__ void a_ready(const Unit&) const {}
    __device__ __forceinline__ void done(const Unit&) const {}
};

__device__ __forceinline__ unsigned cvt_pk_bf16(float lo, float hi) { unsigned r; asm volatile("v_cvt_pk_bf16_f32 %0, %1, %2" : "=v"(r) : "v"(lo), "v"(hi)); return r; }
typedef float f32x2 __attribute__((ext_vector_type(2)));
__device__ __forceinline__ f32x2 gelu_pk(f32x2 v) {
    const f32x2 av = __builtin_elementwise_abs(v), d = av * 0.2316418882f + 1.0f;
    f32x2 t; t.x = __builtin_amdgcn_rcpf(d.x); t.y = __builtin_amdgcn_rcpf(d.y);
    f32x2 q = t * 0.5307027145f + (-0.7265760135f); q = q * t + 0.7107068705f; q = q * t + (-0.142248368f); q = q * t + 0.127414796f; q = q * t;
    const f32x2 s = (v * v) * (-0.72134752044f);
    f32x2 e; e.x = __builtin_amdgcn_exp2f(s.x); e.y = __builtin_amdgcn_exp2f(s.y);
    const f32x2 m = v * (q * e), r = v - m;
    f32x2 o; o.x = v.x < 0.f ? m.x : r.x; o.y = v.y < 0.f ? m.y : r.y; return o;
}
__device__ __forceinline__ f32x4 gelu4(f32x4 v) { const f32x2 a = gelu_pk((f32x2){v[0], v[1]}), b = gelu_pk((f32x2){v[2], v[3]}); return (f32x4){a.x, a.y, b.x, b.y}; }
__device__ __forceinline__ float silu1(float x) { return x * __builtin_amdgcn_rcpf(1.0f + __builtin_amdgcn_exp2f(-1.4426950408889634f * x)); }
__device__ __forceinline__ u32x4 pack8(f32x4 v0, f32x4 v1) { u32x4 w; w.x = cvt_pk_bf16(v0[0], v0[1]); w.y = cvt_pk_bf16(v0[2], v0[3]); w.z = cvt_pk_bf16(v1[0], v1[1]); w.w = cvt_pk_bf16(v1[2], v1[3]); return w; }

__device__ __forceinline__ f32x2 swiglu_pk(f32x2 g, f32x2 u, float s) {
    const float k = __builtin_amdgcn_rcpf(s * s);
    const f32x2 t = g * (-1.4426950408889634f * s); f32x2 e; e.x = __builtin_amdgcn_exp2f(t.x); e.y = __builtin_amdgcn_exp2f(t.y);
    const f32x2 d = e * k + k; f32x2 r; r.x = __builtin_amdgcn_rcpf(d.x); r.y = __builtin_amdgcn_rcpf(d.y);
    return (g * u) * r;
}
struct EpiNull {
    static constexpr bool PERM = true, AFTER_DRAIN = false;
    __device__ __forceinline__ void operator()(const f32x4 (&acc)[2][2][4][2], const Unit&, int, int, int, int) const {}
};
struct EpiKeep {
    static constexpr bool PERM = true, AFTER_DRAIN = false;
    __device__ __forceinline__ void operator()(const f32x4 (&acc)[2][2][4][2], const Unit&, int, int, int, int) const {
#pragma unroll
        for (int ai = 0; ai < 2; ++ai)
#pragma unroll
            for (int bj = 0; bj < 2; ++bj)
#pragma unroll
                for (int m = 0; m < 4; ++m)
#pragma unroll
                    for (int n = 0; n < 2; ++n) asm volatile("" :: "v"(acc[ai][bj][m][n]));
    }
};
struct EpiBf16Plain {
    static constexpr bool PERM = true, AFTER_DRAIN = false;
    bf16_t* O; int ldc; float scale;
    __device__ __forceinline__ void operator()(const f32x4 (&acc)[2][2][4][2], const Unit& u, int wr, int wc, int fr, int fq) const {
        const int row0 = u.po * BM + wr * 64 + fr, col0 = u.pn * BM + wc * 32 + 8 * fq;
#pragma unroll
        for (int ai = 0; ai < 2; ++ai)
#pragma unroll
            for (int m = 0; m < 4; ++m) { bf16_t* rowp = O + (size_t)(row0 + ai * HALF + m * 16) * ldc + col0;
#pragma unroll
                for (int bj = 0; bj < 2; ++bj) *(u32x4*)(rowp + bj * HALF) = pack8(acc[ai][bj][m][0] * scale, acc[ai][bj][m][1] * scale); }
    }
};
struct EpiProj0 {
    static constexpr bool PERM = true, AFTER_DRAIN = false;
    bf16_t* O; int ldc; float qscale;
    __device__ __forceinline__ void operator()(const f32x4 (&acc)[2][2][4][2], const Unit& u, int wr, int wc, int fr, int fq) const {
        const int row0 = u.po * BM + wr * 64 + fr, col0 = u.pn * BM + wc * 32 + 8 * fq;
        const int mode = u.pn < 2 ? 0 : (u.pn == 2 ? 1 : 2);
#pragma unroll
        for (int ai = 0; ai < 2; ++ai)
#pragma unroll
            for (int m = 0; m < 4; ++m) { bf16_t* rowp = O + (size_t)(row0 + ai * HALF + m * 16) * ldc + col0;
#pragma unroll
                for (int bj = 0; bj < 2; ++bj) { f32x4 v0 = acc[ai][bj][m][0], v1 = acc[ai][bj][m][1];
                    if (mode == 2) { v0 = gelu4(v0); v1 = gelu4(v1); } else if (mode == 0) { v0 = v0 * qscale; v1 = v1 * qscale; }
                    *(u32x4*)(rowp + bj * HALF) = pack8(v0, v1); } }
    }
};
struct EpiResGate {
    static constexpr bool PERM = false, AFTER_DRAIN = false;
    const float* base; float* out; int ldc; const float* gate; int gate_ld; int rows_per_batch;
    __device__ __forceinline__ void operator()(const f32x4 (&acc)[2][2][4][2], const Unit& u, int wr, int wc, int fr, int fq) const {
        const int row0 = u.po * BM + wr * 64 + fr, col0 = u.pn * BM + wc * 32 + 4 * fq;
        const float* gp = gate + (size_t)((u.po * BM) / rows_per_batch) * gate_ld + col0;
        f32x4 gv[2][2];
#pragma unroll
        for (int bj = 0; bj < 2; ++bj)
#pragma unroll
            for (int n = 0; n < 2; ++n) gv[bj][n] = *(const f32x4*)(gp + bj * HALF + n * 16);
#pragma unroll
        for (int ai = 0; ai < 2; ++ai)
#pragma unroll
            for (int m = 0; m < 4; ++m) { const size_t off = (size_t)(row0 + ai * HALF + m * 16) * ldc + col0;
#pragma unroll
                for (int bj = 0; bj < 2; ++bj)
#pragma unroll
                    for (int n = 0; n < 2; ++n) { const f32x4 bs = *(const f32x4*)(base + off + bj * HALF + n * 16); *(f32x4*)(out + off + bj * HALF + n * 16) = bs + gv[bj][n] * acc[ai][bj][m][n]; } }
    }
};
template <bool BASE_F32> struct EpiResGateH {
    static constexpr bool PERM = true, AFTER_DRAIN = false;
    const void* base; bf16_t* out; int ldc; const float* gate; int gate_ld; int rows_per_batch; float ascale;
    __device__ __forceinline__ void operator()(const f32x4 (&acc)[2][2][4][2], const Unit& u, int wr, int wc, int fr, int fq) const {
        const int row0 = u.po * BM + wr * 64 + fr, col0 = u.pn * BM + wc * 32 + 8 * fq;
        const float* gp = gate + (size_t)((u.po * BM) / rows_per_batch) * gate_ld + col0;
        f32x4 gv[2][2];
#pragma unroll
        for (int bj = 0; bj < 2; ++bj)
#pragma unroll
            for (int n = 0; n < 2; ++n) gv[bj][n] = *(const f32x4*)(gp + bj * HALF + n * 4) * ascale;
        if constexpr (!BASE_F32) {
            u32x4 bh[2][4][2];
#pragma unroll
            for (int ai = 0; ai < 2; ++ai)
#pragma unroll
                for (int m = 0; m < 4; ++m) { const size_t off = (size_t)(row0 + ai * HALF + m * 16) * ldc + col0;
#pragma unroll
                    for (int bj = 0; bj < 2; ++bj) bh[ai][m][bj] = *(const u32x4*)((const bf16_t*)base + off + bj * HALF); }
            asm volatile("" ::: "memory");
#pragma unroll
            for (int ai = 0; ai < 2; ++ai)
#pragma unroll
                for (int m = 0; m < 4; ++m) { const size_t off = (size_t)(row0 + ai * HALF + m * 16) * ldc + col0;
#pragma unroll
                    for (int bj = 0; bj < 2; ++bj) { const u32x4 w = bh[ai][m][bj];
                        const f32x4 b0 = (f32x4){__uint_as_float(w.x << 16), __uint_as_float(w.x & 0xffff0000u), __uint_as_float(w.y << 16), __uint_as_float(w.y & 0xffff0000u)};
                        const f32x4 b1 = (f32x4){__uint_as_float(w.z << 16), __uint_as_float(w.z & 0xffff0000u), __uint_as_float(w.w << 16), __uint_as_float(w.w & 0xffff0000u)};
                        *(u32x4*)(out + off + bj * HALF) = pack8(b0 + gv[bj][0] * acc[ai][bj][m][0], b1 + gv[bj][1] * acc[ai][bj][m][1]); } }
            asm volatile("" ::: "memory");
        } else {
#pragma unroll
        for (int ai = 0; ai < 2; ++ai) {
            f32x4 bf[4][2][2];
#pragma unroll
            for (int m = 0; m < 4; ++m) { const size_t off = (size_t)(row0 + ai * HALF + m * 16) * ldc + col0;
#pragma unroll
                for (int bj = 0; bj < 2; ++bj) { bf[m][bj][0] = *(const f32x4*)((const float*)base + off + bj * HALF); bf[m][bj][1] = *(const f32x4*)((const float*)base + off + bj * HALF + 4); } }
            asm volatile("" ::: "memory");
#pragma unroll
            for (int m = 0; m < 4; ++m) { const size_t off = (size_t)(row0 + ai * HALF + m * 16) * ldc + col0;
#pragma unroll
                for (int bj = 0; bj < 2; ++bj) { const f32x4 b0 = bf[m][bj][0], b1 = bf[m][bj][1];
                    *(u32x4*)(out + off + bj * HALF) = pack8(b0 + gv[bj][0] * acc[ai][bj][m][0], b1 + gv[bj][1] * acc[ai][bj][m][1]); } }
            asm volatile("" ::: "memory");
        } }
    }
};
struct EpiSwiGLU {
    static constexpr bool PERM = true, AFTER_DRAIN = false;
    bf16_t* O; int ldc;
    __device__ __forceinline__ void operator()(const f32x4 (&acc)[2][2][4][2], const Unit& u, int wr, int wc, int fr, int fq) const {
        const int row0 = u.po * BM + wr * 64 + fr, col0 = u.pn * HALF + wc * 32 + 8 * fq;
#pragma unroll
        for (int ai = 0; ai < 2; ++ai)
#pragma unroll
            for (int m = 0; m < 4; ++m) { bf16_t* rowp = O + (size_t)(row0 + ai * HALF + m * 16) * ldc + col0;
                f32x4 r0, r1;
#pragma unroll
                for (int j = 0; j < 4; j += 2) { const f32x2 a = swiglu_pk((f32x2){acc[ai][0][m][0][j], acc[ai][0][m][0][j + 1]}, (f32x2){acc[ai][1][m][0][j], acc[ai][1][m][0][j + 1]}, 1.0f);
                    const f32x2 b = swiglu_pk((f32x2){acc[ai][0][m][1][j], acc[ai][0][m][1][j + 1]}, (f32x2){acc[ai][1][m][1][j], acc[ai][1][m][1][j + 1]}, 1.0f);
                    r0[j] = a.x; r0[j + 1] = a.y; r1[j] = b.x; r1[j + 1] = b.y; }
                *(u32x4*)rowp = pack8(r0, r1); }
    }
};
__device__ __forceinline__ float clamp448(float x) { return __builtin_fminf(__builtin_fmaxf(x, -448.f), 448.f); }
__device__ __forceinline__ unsigned pack4_fp8(float a, float b, float c, float d) { int w = 0; w = __builtin_amdgcn_cvt_pk_fp8_f32(clamp448(a), clamp448(b), w, false); w = __builtin_amdgcn_cvt_pk_fp8_f32(clamp448(c), clamp448(d), w, true); return (unsigned)w; }
__device__ __forceinline__ unsigned pack4_i8(float a, float b, float c, float d) {
    const int ia = (int)__builtin_rintf(__builtin_fminf(__builtin_fmaxf(a, -127.f), 127.f)), ib = (int)__builtin_rintf(__builtin_fminf(__builtin_fmaxf(b, -127.f), 127.f)), ic = (int)__builtin_rintf(__builtin_fminf(__builtin_fmaxf(c, -127.f), 127.f)), id = (int)__builtin_rintf(__builtin_fminf(__builtin_fmaxf(d, -127.f), 127.f));
    return ((unsigned)ia & 0xffu) | (((unsigned)ib & 0xffu) << 8) | (((unsigned)ic & 0xffu) << 16) | ((unsigned)id << 24); }
struct EpiSwiGLU8 {
    static constexpr bool PERM = true, AFTER_DRAIN = false;
    unsigned char* O; int ldc; float s;
    __device__ __forceinline__ void operator()(const f32x4 (&acc)[2][2][4][2], const Unit& u, int wr, int wc, int fr, int fq) const {
        const int row0 = u.po * BM + wr * 64 + fr, col0 = u.pn * HALF + wc * 32 + 8 * fq;
#pragma unroll
        for (int ai = 0; ai < 2; ++ai)
#pragma unroll
            for (int m = 0; m < 4; ++m) { unsigned char* rowp = O + (size_t)(row0 + ai * HALF + m * 16) * ldc + col0;
                f32x4 r0, r1;
#pragma unroll
                for (int j = 0; j < 4; j += 2) { const f32x2 a = swiglu_pk((f32x2){acc[ai][0][m][0][j], acc[ai][0][m][0][j + 1]}, (f32x2){acc[ai][1][m][0][j], acc[ai][1][m][0][j + 1]}, s);
                    const f32x2 b = swiglu_pk((f32x2){acc[ai][0][m][1][j], acc[ai][0][m][1][j + 1]}, (f32x2){acc[ai][1][m][1][j], acc[ai][1][m][1][j + 1]}, s);
                    r0[j] = a.x; r0[j + 1] = a.y; r1[j] = b.x; r1[j + 1] = b.y; }
                u32x2 w; w.x = pack4_fp8(r0[0], r0[1], r0[2], r0[3]); w.y = pack4_fp8(r1[0], r1[1], r1[2], r1[3]); *(u32x2*)rowp = w;
                asm volatile("" ::: "memory"); }
    }
};
__device__ __forceinline__ void colscales(const unsigned* cm, int col0, f32x4 (&sv)[2][2]) {
#pragma unroll
    for (int bj = 0; bj < 2; ++bj)
#pragma unroll
        for (int n = 0; n < 2; ++n) { const u32x4 w = *(const u32x4*)(cm + col0 + bj * HALF + n * 4); sv[bj][n] = (f32x4){__uint_as_float(w.x), __uint_as_float(w.y), __uint_as_float(w.z), __uint_as_float(w.w)} * (1.0f / 127.0f); }
}
struct EpiSwiGLUI {
    static constexpr bool PERM = true, AFTER_DRAIN = false;
    bf16_t* O; int ldc; const float* sa; const unsigned* cm;
    __device__ __forceinline__ void operator()(const f32x4 (&acc)[2][2][4][2], const Unit& u, int wr, int wc, int fr, int fq) const {
        const int row0 = u.po * BM + wr * 64 + fr, col0 = u.pn * HALF + wc * 32 + 8 * fq;
        f32x4 sv[2][2]; colscales(cm, u.pn * BM + wc * 32 + 8 * fq, sv);
float sar[2][4];
#pragma unroll
for (int ai = 0; ai < 2; ++ai)
#pragma unroll
    for (int m = 0; m < 4; ++m) sar[ai][m] = sa[row0 + ai * HALF + m * 16];
#pragma unroll
        for (int ai = 0; ai < 2; ++ai)
#pragma unroll
            for (int m = 0; m < 4; ++m) { const int row = row0 + ai * HALF + m * 16; bf16_t* rowp = O + (size_t)row * ldc + col0; const float s = sar[ai][m];
                f32x4 r0, r1;
#pragma unroll
                for (int j = 0; j < 4; j += 2) { const v4i_t g0 = __builtin_bit_cast(v4i_t, acc[ai][0][m][0]), g1 = __builtin_bit_cast(v4i_t, acc[ai][0][m][1]), u0 = __builtin_bit_cast(v4i_t, acc[ai][1][m][0]), u1 = __builtin_bit_cast(v4i_t, acc[ai][1][m][1]);
                    const f32x2 a = swiglu_pk((f32x2){(float)g0[j] * sv[0][0][j], (float)g0[j + 1] * sv[0][0][j + 1]}, (f32x2){(float)u0[j] * sv[1][0][j], (float)u0[j + 1] * sv[1][0][j + 1]}, s);
                    const f32x2 b = swiglu_pk((f32x2){(float)g1[j] * sv[0][1][j], (float)g1[j + 1] * sv[0][1][j + 1]}, (f32x2){(float)u1[j] * sv[1][1][j], (float)u1[j + 1] * sv[1][1][j + 1]}, s);
                    r0[j] = a.x; r0[j + 1] = a.y; r1[j] = b.x; r1[j + 1] = b.y; }
                *(u32x4*)rowp = pack8(r0, r1);
                asm volatile("" ::: "memory"); }
    }
};
struct EpiSwiGLUI8 {
    static constexpr bool PERM = true, AFTER_DRAIN = false;
    unsigned char* O; int ldc; const float* sa; const unsigned* cm;
    __device__ __forceinline__ void operator()(const f32x4 (&acc)[2][2][4][2], const Unit& u, int wr, int wc, int fr, int fq) const {
        const int row0 = u.po * BM + wr * 64 + fr, col0 = u.pn * HALF + wc * 32 + 8 * fq;
        f32x4 sv[2][2]; colscales(cm, u.pn * BM + wc * 32 + 8 * fq, sv);
float sar[2][4];
#pragma unroll
for (int ai = 0; ai < 2; ++ai)
#pragma unroll
    for (int m = 0; m < 4; ++m) sar[ai][m] = sa[row0 + ai * HALF + m * 16];
#pragma unroll
        for (int ai = 0; ai < 2; ++ai)
#pragma unroll
            for (int m = 0; m < 4; ++m) { const int row = row0 + ai * HALF + m * 16; unsigned char* rowp = O + (size_t)row * ldc + col0; const float s = sar[ai][m];
                f32x4 r0, r1;
#pragma unroll
                for (int j = 0; j < 4; j += 2) { const v4i_t g0 = __builtin_bit_cast(v4i_t, acc[ai][0][m][0]), g1 = __builtin_bit_cast(v4i_t, acc[ai][0][m][1]), u0 = __builtin_bit_cast(v4i_t, acc[ai][1][m][0]), u1 = __builtin_bit_cast(v4i_t, acc[ai][1][m][1]);
                    const f32x2 a = swiglu_pk((f32x2){(float)g0[j] * sv[0][0][j], (float)g0[j + 1] * sv[0][0][j + 1]}, (f32x2){(float)u0[j] * sv[1][0][j], (float)u0[j + 1] * sv[1][0][j + 1]}, s);
                    const f32x2 b = swiglu_pk((f32x2){(float)g1[j] * sv[0][1][j], (float)g1[j + 1] * sv[0][1][j + 1]}, (f32x2){(float)u1[j] * sv[1][1][j], (float)u1[j + 1] * sv[1][1][j + 1]}, s);
                    r0[j] = a.x; r0[j + 1] = a.y; r1[j] = b.x; r1[j + 1] = b.y; }
                { u32x2 w; w.x = pack4_fp8(r0[0], r0[1], r0[2], r0[3]); w.y = pack4_fp8(r1[0], r1[1], r1[2], r1[3]); *(u32x2*)rowp = w; }
                asm volatile("" ::: "memory"); }
    }
};
struct EpiProj0I {
    static constexpr bool PERM = true, AFTER_DRAIN = false;
    bf16_t* O; int ldc; float qscale; const float* sa; const unsigned* cm;
    __device__ __forceinline__ void operator()(const f32x4 (&acc)[2][2][4][2], const Unit& u, int wr, int wc, int fr, int fq) const {
        const int row0 = u.po * BM + wr * 64 + fr, col0 = u.pn * BM + wc * 32 + 8 * fq; const float sw = (u.pn < 2 ? qscale : 1.0f);
        f32x4 sv[2][2]; colscales(cm, col0, sv);
        const bool act = u.pn >= 3;
float sar[2][4];
#pragma unroll
for (int ai = 0; ai < 2; ++ai)
#pragma unroll
    for (int m = 0; m < 4; ++m) sar[ai][m] = sa[row0 + ai * HALF + m * 16];
#pragma unroll
        for (int ai = 0; ai < 2; ++ai)
#pragma unroll
            for (int m = 0; m < 4; ++m) { const int row = row0 + ai * HALF + m * 16; bf16_t* rowp = O + (size_t)row * ldc + col0; const float s = sar[ai][m] * sw;
#pragma unroll
                for (int bj = 0; bj < 2; ++bj) { const v4i_t i0 = __builtin_bit_cast(v4i_t, acc[ai][bj][m][0]), i1 = __builtin_bit_cast(v4i_t, acc[ai][bj][m][1]);
                    f32x4 v0 = (f32x4){(float)i0[0], (float)i0[1], (float)i0[2], (float)i0[3]} * sv[bj][0] * s, v1 = (f32x4){(float)i1[0], (float)i1[1], (float)i1[2], (float)i1[3]} * sv[bj][1] * s;
                    if (act) { v0 = gelu4(v0); v1 = gelu4(v1); }
                    *(u32x4*)(rowp + bj * HALF) = pack8(v0, v1); } }
    }
};
struct EpiBf16PlainI {
    static constexpr bool PERM = true, AFTER_DRAIN = false;
    bf16_t* O; int ldc; const float* sa; const unsigned* cm;
    __device__ __forceinline__ void operator()(const f32x4 (&acc)[2][2][4][2], const Unit& u, int wr, int wc, int fr, int fq) const {
        const int row0 = u.po * BM + wr * 64 + fr, col0 = u.pn * BM + wc * 32 + 8 * fq;
        f32x4 sv[2][2]; colscales(cm, col0, sv);
float sar[2][4];
#pragma unroll
for (int ai = 0; ai < 2; ++ai)
#pragma unroll
    for (int m = 0; m < 4; ++m) sar[ai][m] = sa[row0 + ai * HALF + m * 16];
#pragma unroll
        for (int ai = 0; ai < 2; ++ai)
#pragma unroll
            for (int m = 0; m < 4; ++m) { const int row = row0 + ai * HALF + m * 16; bf16_t* rowp = O + (size_t)row * ldc + col0; const float s = sar[ai][m];
#pragma unroll
                for (int bj = 0; bj < 2; ++bj) { const v4i_t i0 = __builtin_bit_cast(v4i_t, acc[ai][bj][m][0]), i1 = __builtin_bit_cast(v4i_t, acc[ai][bj][m][1]);
                    *(u32x4*)(rowp + bj * HALF) = pack8((f32x4){(float)i0[0], (float)i0[1], (float)i0[2], (float)i0[3]} * sv[bj][0] * s, (f32x4){(float)i1[0], (float)i1[1], (float)i1[2], (float)i1[3]} * sv[bj][1] * s); } }
    }
};
struct EpiSwiGLU8I {
    static constexpr bool PERM = true, AFTER_DRAIN = false;
    unsigned char* O; int ldc; const float* sa; const float* swp;
    __device__ __forceinline__ void operator()(const f32x4 (&acc)[2][2][4][2], const Unit& u, int wr, int wc, int fr, int fq) const {
        const int row0 = u.po * BM + wr * 64 + fr, col0 = u.pn * HALF + wc * 32 + 8 * fq; const float sw = *swp;
float sar[2][4];
#pragma unroll
for (int ai = 0; ai < 2; ++ai)
#pragma unroll
    for (int m = 0; m < 4; ++m) sar[ai][m] = sa[row0 + ai * HALF + m * 16];
#pragma unroll
        for (int ai = 0; ai < 2; ++ai)
#pragma unroll
            for (int m = 0; m < 4; ++m) { const int row = row0 + ai * HALF + m * 16; unsigned char* rowp = O + (size_t)row * ldc + col0; const float s = sar[ai][m] * sw;
                f32x4 r0, r1;
#pragma unroll
                for (int j = 0; j < 4; j += 2) { const v4i_t g0 = __builtin_bit_cast(v4i_t, acc[ai][0][m][0]), g1 = __builtin_bit_cast(v4i_t, acc[ai][0][m][1]), u0 = __builtin_bit_cast(v4i_t, acc[ai][1][m][0]), u1 = __builtin_bit_cast(v4i_t, acc[ai][1][m][1]);
                    const f32x2 a = swiglu_pk((f32x2){(float)g0[j], (float)g0[j + 1]}, (f32x2){(float)u0[j], (float)u0[j + 1]}, s);
                    const f32x2 b = swiglu_pk((f32x2){(float)g1[j], (float)g1[j + 1]}, (f32x2){(float)u1[j], (float)u1[j + 1]}, s);
                    r0[j] = a.x; r0[j + 1] = a.y; r1[j] = b.x; r1[j + 1] = b.y; }
                u32x2 w; w.x = pack4_fp8(r0[0], r0[1], r0[2], r0[3]); w.y = pack4_fp8(r1[0], r1[1], r1[2], r1[3]); *(u32x2*)rowp = w;
                asm volatile("" ::: "memory"); }
    }
};
struct EpiQRope {
    static constexpr bool PERM = true, AFTER_DRAIN = false;
    bf16_t* O; int ldc; const float* ctab; const float* stab; float qscale; int seq_mask;
    __device__ __forceinline__ void operator()(const f32x4 (&acc)[2][2][4][2], const Unit& u, int wr, int wc, int fr, int fq) const {
        const int row0 = u.po * BM + wr * 64 + fr, col0 = u.pn * BM + wc * 32 + 8 * fq;
#pragma unroll
        for (int ai = 0; ai < 2; ++ai)
#pragma unroll
            for (int m = 0; m < 4; ++m) { const int row = row0 + ai * HALF + m * 16; bf16_t* rowp = O + (size_t)row * ldc + col0; const int pos = row & seq_mask;
#pragma unroll
                for (int bj = 0; bj < 2; ++bj) { f32x4 v0 = acc[ai][bj][m][0] * qscale, v1 = acc[ai][bj][m][1] * qscale;
                    const int off = (col0 + bj * HALF) % 96;
                    if (off >= 64) { const int i0 = (off - 64) >> 1; const f32x4 cs = *(const f32x4*)(ctab + pos * 16 + i0), sn = *(const f32x4*)(stab + pos * 16 + i0);
                        const f32x4 a = v0, b = v1;
                        v0[0] = a[0] * cs[0] - a[1] * sn[0]; v0[1] = a[0] * sn[0] + a[1] * cs[0]; v0[2] = a[2] * cs[1] - a[3] * sn[1]; v0[3] = a[2] * sn[1] + a[3] * cs[1];
                        v1[0] = b[0] * cs[2] - b[1] * sn[2]; v1[1] = b[0] * sn[2] + b[1] * cs[2]; v1[2] = b[2] * cs[3] - b[3] * sn[3]; v1[3] = b[2] * sn[3] + b[3] * cs[3]; }
                    *(u32x4*)(rowp + bj * HALF) = pack8(v0, v1); }
                asm volatile("" ::: "memory"); }
    }
};

#ifndef PG8_F8_ASM_STAGE
#define PG8_F8_ASM_STAGE 0
#endif
template <class Epi, class Sched, bool ALIGN_EPI = false, bool SP2 = false, bool F8 = false, bool I8 = false, bool PF = false>
__device__ __forceinline__ void gemm_phase(PG8_LAS unsigned char* lds, const Gemm g, const Sched& S, const Epi& E, const int wave_) {
    int tid_ = tid_from_wave(wave_); asm volatile("" : "+v"(tid_));
    const int tid = tid_, wid = __builtin_amdgcn_readfirstlane(tid >> 6), lane = tid & 63, wr = wid >> 2, wc = wid & 3, fr = lane & 15, fq = lane >> 4;
    const int K = g.K, nt = K / BK;
    unsigned voffA[2], voffB[2];
#pragma unroll
    for (int i = 0; i < 2; ++i) { int R, C; stage_rc(tid * 16 + i * 8192, R, C); const int Rb = Epi::PERM ? ((R & ~31) + perm32(R & 31)) : R;
        voffA[i] = (unsigned)(R * K + C) * 2u; voffB[i] = (unsigned)(Rb * K + C) * 2u; }
    const size_t kstep = (size_t)(BK * 2);
    const size_t hstep = (size_t)HALF * K * 2;
    const size_t tstep = 2 * hstep;
    const unsigned lds_a32 = (unsigned)(uintptr_t)lds;
    const unsigned ldsw = (unsigned)wid * 1024u;
    const int aoff = lds_byte(wr * 64 + fr, fq * 8), boff = lds_byte(wc * 32 + fr, fq * 8);
#define PG8_SA(b, h) (((b) * 2 + (h)) * HTB)
#define PG8_SB(b, h) ((4 + (b) * 2 + (h)) * HTB)
#define PG8_STAGE(bufoff, gbase, voff) do { _Pragma("unroll") for (int _i = 0; _i < 2; ++_i) { \
        if constexpr (F8 && PG8_F8_ASM_STAGE) { unsigned keep_; asm volatile("s_mov_b32 %0, m0\n\ts_mov_b32 m0, %3\n\ts_nop 0\n\tglobal_load_lds_dwordx4 %1, %2\n\ts_mov_b32 m0, %0" : "=&s"(keep_) : "v"((voff)[_i]), "s"((const char*)(gbase)), "s"((unsigned)__builtin_amdgcn_readfirstlane((int)(lds_a32 + (unsigned)(bufoff) + ldsw + (unsigned)(_i * 8192)))) : "memory"); } \
        else __builtin_amdgcn_global_load_lds((const unsigned*)((const char*)(gbase) + (voff)[_i]), (PG8_LAS unsigned*)(lds + (bufoff) + ldsw + _i * 8192), 16, 0, 0); } } while (0)
#define PG8_LDA(dst, b, h) do { _Pragma("unroll") for (int m = 0; m < 4; ++m) _Pragma("unroll") for (int k = 0; k < 2; ++k) dst[m][k] = *(const PG8_LAS bf16x8*)(lds + PG8_SA(b, h) + aoff + m * 2048 + k * 1024); } while (0)
#define PG8_LDB(dst, b, h) do { _Pragma("unroll") for (int n = 0; n < 2; ++n) _Pragma("unroll") for (int k = 0; k < 2; ++k) dst[n][k] = *(const PG8_LAS bf16x8*)(lds + PG8_SB(b, h) + boff + n * 2048 + k * 1024); } while (0)
#define PG8_MMA(ai, bj, At, Bt) do { __builtin_amdgcn_s_setprio(1); _Pragma("unroll") for (int m = 0; m < 4; ++m) _Pragma("unroll") for (int n = 0; n < 2; ++n) { \
        if constexpr (F8) { const v8i_t b8_ = __builtin_shufflevector(__builtin_bit_cast(v4i_t, Bt[n][0]), __builtin_bit_cast(v4i_t, Bt[n][1]), 0, 1, 2, 3, 4, 5, 6, 7), a8_ = __builtin_shufflevector(__builtin_bit_cast(v4i_t, At[m][0]), __builtin_bit_cast(v4i_t, At[m][1]), 0, 1, 2, 3, 4, 5, 6, 7); \
            asm volatile("v_mfma_f32_16x16x128_f8f6f4 %0, %1, %2, %0" : "+v"(acc[ai][bj][m][n]) : "v"(b8_), "v"(a8_)); } \
        else if constexpr (I8) { _Pragma("unroll") for (int k = 0; k < 2; ++k) acc[ai][bj][m][n] = __builtin_bit_cast(f32x4, __builtin_amdgcn_mfma_i32_16x16x64_i8(__builtin_bit_cast(v4i_t, Bt[n][k]), __builtin_bit_cast(v4i_t, At[m][k]), __builtin_bit_cast(v4i_t, acc[ai][bj][m][n]), 0, 0, 0)); } \
        else { _Pragma("unroll") for (int k = 0; k < 2; ++k) acc[ai][bj][m][n] = __builtin_amdgcn_mfma_f32_16x16x32_bf16(Bt[n][k], At[m][k], acc[ai][bj][m][n], 0, 0, 0); } } __builtin_amdgcn_s_setprio(0); } while (0)
#define PG8_MF(ai, bj, m, n, At, Bt) do { \
        if constexpr (F8) { const v8i_t b8_ = __builtin_shufflevector(__builtin_bit_cast(v4i_t, Bt[n][0]), __builtin_bit_cast(v4i_t, Bt[n][1]), 0, 1, 2, 3, 4, 5, 6, 7), a8_ = __builtin_shufflevector(__builtin_bit_cast(v4i_t, At[m][0]), __builtin_bit_cast(v4i_t, At[m][1]), 0, 1, 2, 3, 4, 5, 6, 7); \
            asm volatile("v_mfma_f32_16x16x128_f8f6f4 %0, %1, %2, %0" : "+v"(acc[ai][bj][m][n]) : "v"(b8_), "v"(a8_)); } \
        else if constexpr (I8) { _Pragma("unroll") for (int k = 0; k < 2; ++k) acc[ai][bj][m][n] = __builtin_bit_cast(f32x4, __builtin_amdgcn_mfma_i32_16x16x64_i8(__builtin_bit_cast(v4i_t, Bt[n][k]), __builtin_bit_cast(v4i_t, At[m][k]), __builtin_bit_cast(v4i_t, acc[ai][bj][m][n]), 0, 0, 0)); } \
        else { _Pragma("unroll") for (int k = 0; k < 2; ++k) acc[ai][bj][m][n] = __builtin_amdgcn_mfma_f32_16x16x32_bf16(Bt[n][k], At[m][k], acc[ai][bj][m][n], 0, 0, 0); } } while (0)
#define PG8_RA(dst, b, h, m, k) dst[m][k] = *(const PG8_LAS bf16x8*)(lds + PG8_SA(b, h) + aoff + (m) * 2048 + (k) * 1024)
#define PG8_RB(dst, b, h, n, k) dst[n][k] = *(const PG8_LAS bf16x8*)(lds + PG8_SB(b, h) + boff + (n) * 2048 + (k) * 1024)
#define PG8_X1(b) do { __builtin_amdgcn_s_setprio(1); \
        PG8_MF(0, 0, 0, 0, At, B0); PG8_RB(B1, b, 1, 0, 0); PG8_SCHED; PG8_MF(0, 0, 0, 1, At, B0); PG8_RB(B1, b, 1, 0, 1); PG8_SCHED; PG8_MF(0, 0, 1, 0, At, B0); PG8_RB(B1, b, 1, 1, 0); PG8_SCHED; PG8_MF(0, 0, 1, 1, At, B0); PG8_RB(B1, b, 1, 1, 1); PG8_SCHED; \
        PG8_MF(0, 0, 2, 0, At, B0); PG8_MF(0, 0, 2, 1, At, B0); PG8_MF(0, 0, 3, 0, At, B0); PG8_MF(0, 0, 3, 1, At, B0); PG8_SCHED; \
        PG8_MF(0, 1, 0, 0, At, B1); PG8_RA(At2, b, 1, 0, 0); PG8_SCHED; PG8_MF(0, 1, 0, 1, At, B1); PG8_RA(At2, b, 1, 0, 1); PG8_SCHED; PG8_MF(0, 1, 1, 0, At, B1); PG8_RA(At2, b, 1, 1, 0); PG8_SCHED; PG8_MF(0, 1, 1, 1, At, B1); PG8_RA(At2, b, 1, 1, 1); PG8_SCHED; \
        PG8_MF(0, 1, 2, 0, At, B1); PG8_RA(At2, b, 1, 2, 0); PG8_SCHED; PG8_MF(0, 1, 2, 1, At, B1); PG8_RA(At2, b, 1, 2, 1); PG8_SCHED; PG8_MF(0, 1, 3, 0, At, B1); PG8_RA(At2, b, 1, 3, 0); PG8_SCHED; PG8_MF(0, 1, 3, 1, At, B1); PG8_RA(At2, b, 1, 3, 1); PG8_SCHED; \
        __builtin_amdgcn_s_setprio(0); } while (0)
#define PG8_X2(b) do { __builtin_amdgcn_s_setprio(1); \
        PG8_MF(1, 0, 0, 0, At2, B0); PG8_RA(At, (b) ^ 1, 0, 0, 0); PG8_SCHED; PG8_MF(1, 0, 0, 1, At2, B0); PG8_RA(At, (b) ^ 1, 0, 0, 1); PG8_SCHED; PG8_MF(1, 0, 1, 0, At2, B0); PG8_RA(At, (b) ^ 1, 0, 1, 0); PG8_SCHED; PG8_MF(1, 0, 1, 1, At2, B0); PG8_RA(At, (b) ^ 1, 0, 1, 1); PG8_SCHED; \
        PG8_MF(1, 0, 2, 0, At2, B0); PG8_RA(At, (b) ^ 1, 0, 2, 0); PG8_SCHED; PG8_MF(1, 0, 2, 1, At2, B0); PG8_RA(At, (b) ^ 1, 0, 2, 1); PG8_SCHED; PG8_MF(1, 0, 3, 0, At2, B0); PG8_RA(At, (b) ^ 1, 0, 3, 0); PG8_SCHED; PG8_MF(1, 0, 3, 1, At2, B0); PG8_RA(At, (b) ^ 1, 0, 3, 1); PG8_SCHED; \
        PG8_MF(1, 1, 0, 0, At2, B1); PG8_RB(B0, (b) ^ 1, 0, 0, 0); PG8_SCHED; PG8_MF(1, 1, 0, 1, At2, B1); PG8_RB(B0, (b) ^ 1, 0, 0, 1); PG8_SCHED; PG8_MF(1, 1, 1, 0, At2, B1); PG8_RB(B0, (b) ^ 1, 0, 1, 0); PG8_SCHED; PG8_MF(1, 1, 1, 1, At2, B1); PG8_RB(B0, (b) ^ 1, 0, 1, 1); PG8_SCHED; \
        PG8_MF(1, 1, 2, 0, At2, B1); PG8_MF(1, 1, 2, 1, At2, B1); PG8_MF(1, 1, 3, 0, At2, B1); PG8_MF(1, 1, 3, 1, At2, B1); __builtin_amdgcn_s_setprio(0); } while (0)
#define PG8_WAIT_V(n) asm volatile("s_waitcnt vmcnt(" #n ")" ::: "memory")
#define PG8_WAIT_L(n) asm volatile("s_waitcnt lgkmcnt(" #n ")" ::: "memory")
#define PG8_BAR __builtin_amdgcn_s_barrier()
#define PG8_SCHED __builtin_amdgcn_sched_barrier(0)
    Unit cur, nxt; int ui = 0;
    if (!S.next(0, cur)) return;
    f32x4 acc[2][2][4][2];
#pragma unroll
    for (int a = 0; a < 2; ++a)
#pragma unroll
        for (int b = 0; b < 2; ++b)
#pragma unroll
            for (int m = 0; m < 4; ++m)
#pragma unroll
                for (int n = 0; n < 2; ++n) acc[a][b][m][n] = (f32x4){0.f, 0.f, 0.f, 0.f};
    bf16x8 At[4][2], B0[2][2], B1[2][2]; bf16x8 At2[PF ? 4 : 1][2];
    const char* cA = (const char*)g.A + (size_t)cur.pm * tstep; const char* cB = (const char*)g.Bt + (size_t)cur.pb * tstep;
    S.a_ready(cur);
    if constexpr (PF) {
        PG8_STAGE(PG8_SA(0, 0), cA, voffA); PG8_STAGE(PG8_SB(0, 0), cB, voffB); PG8_STAGE(PG8_SA(0, 1), cA + hstep, voffA); PG8_STAGE(PG8_SB(0, 1), cB + hstep, voffB);
        PG8_STAGE(PG8_SA(1, 0), cA + kstep, voffA); PG8_STAGE(PG8_SB(1, 0), cB + kstep, voffB);
        if (wr == 1) { PG8_STAGE(PG8_SA(1, 1), cA + hstep + kstep, voffA); PG8_STAGE(PG8_SB(1, 1), cB + hstep + kstep, voffB); }
        PG8_WAIT_V(8); PG8_BAR;
        PG8_LDA(At, 0, 0); PG8_LDB(B0, 0, 0); __builtin_amdgcn_s_waitcnt(0xC07F);
        if (wr == 1) PG8_BAR;
    } else
    if constexpr (SP2) {
        PG8_STAGE(PG8_SB(0, 0), cB, voffB); PG8_STAGE(PG8_SB(0, 1), cB + hstep, voffB); PG8_STAGE(PG8_SA(0, 0), cA, voffA); PG8_STAGE(PG8_SA(0, 1), cA + hstep, voffA);
        if (wr == 1) PG8_BAR;
        PG8_WAIT_V(2); PG8_BAR;
        PG8_STAGE(PG8_SB(1, 0), cB + kstep, voffB); PG8_STAGE(PG8_SA(1, 0), cA + kstep, voffA); PG8_STAGE(PG8_SB(1, 1), cB + hstep + kstep, voffB);
        PG8_WAIT_V(6); PG8_BAR;
    } else {
        PG8_STAGE(PG8_SB(0, 0), cB, voffB); PG8_STAGE(PG8_SA(0, 0), cA, voffA); PG8_STAGE(PG8_SB(0, 1), cB + hstep, voffB); PG8_STAGE(PG8_SA(0, 1), cA + hstep, voffA);
        if (wr == 1) PG8_BAR;
        PG8_WAIT_V(4); PG8_BAR;
        PG8_STAGE(PG8_SB(1, 0), cB + kstep, voffB); PG8_STAGE(PG8_SA(1, 0), cA + kstep, voffA); PG8_STAGE(PG8_SB(1, 1), cB + hstep + kstep, voffB);
        PG8_WAIT_V(6); PG8_BAR;
    }
    for (;;) {
        const bool has_next = S.next(ui + 1, nxt);
        const char* nA = has_next ? (const char*)g.A + (size_t)nxt.pm * tstep : cA; const char* nB = has_next ? (const char*)g.Bt + (size_t)nxt.pb * tstep : cB;
        for (int t = 0; t < nt; t += 2) {
            const bool last = (t == nt - 2);
            const char* a1 = cA + (size_t)(t + 1) * kstep;
            const char* a2 = last ? nA : cA + (size_t)(t + 2) * kstep; const char* b2 = last ? nB : cB + (size_t)(t + 2) * kstep;
            const char* a3 = a2 + kstep; const char* b3 = b2 + kstep;
            if (last && has_next) S.a_ready(nxt);
            if constexpr (PF) {
            PG8_STAGE(wr ? PG8_SA(0, 0) : PG8_SA(1, 1), wr ? a2 : a1 + hstep, voffA); PG8_STAGE(wr ? PG8_SB(0, 0) : PG8_SB(1, 1), wr ? b2 : cB + (size_t)(t + 1) * kstep + hstep, voffB);
            PG8_WAIT_V(8); PG8_BAR;
            PG8_X1(0); __builtin_amdgcn_s_waitcnt(0xC07F); PG8_BAR; PG8_SCHED;
            PG8_STAGE(wr ? PG8_SA(0, 1) : PG8_SA(0, 0), wr ? a2 + hstep : a2, voffA); PG8_STAGE(wr ? PG8_SB(0, 1) : PG8_SB(0, 0), wr ? b2 + hstep : b2, voffB);
            PG8_WAIT_V(8); PG8_BAR;
            PG8_X2(0); __builtin_amdgcn_s_waitcnt(0xC07F); PG8_BAR; PG8_SCHED;
            PG8_STAGE(wr ? PG8_SA(1, 0) : PG8_SA(0, 1), wr ? a3 : a2 + hstep, voffA); PG8_STAGE(wr ? PG8_SB(1, 0) : PG8_SB(0, 1), wr ? b3 : b2 + hstep, voffB);
            PG8_WAIT_V(8); PG8_BAR;
            PG8_X1(1); __builtin_amdgcn_s_waitcnt(0xC07F); PG8_BAR; PG8_SCHED;
            PG8_STAGE(wr ? PG8_SA(1, 1) : PG8_SA(1, 0), wr ? a3 + hstep : a3, voffA); PG8_STAGE(wr ? PG8_SB(1, 1) : PG8_SB(1, 0), wr ? b3 + hstep : b3, voffB);
            PG8_WAIT_V(8); PG8_BAR;
            PG8_X2(1); __builtin_amdgcn_s_waitcnt(0xC07F); PG8_BAR; PG8_SCHED;
            } else
            if constexpr (SP2) {
            PG8_LDB(B0, 0, 0); PG8_LDB(B1, 0, 1); PG8_SCHED; PG8_LDA(At, 0, 0); PG8_STAGE(PG8_SA(1, 1), a1 + hstep, voffA);
            PG8_WAIT_V(8); PG8_WAIT_L(0); PG8_BAR; PG8_MMA(0, 0, At, B0); PG8_MMA(0, 1, At, B1); PG8_BAR; PG8_SCHED;
            PG8_LDA(At, 0, 1); PG8_STAGE(PG8_SB(0, 0), b2, voffB); PG8_STAGE(PG8_SB(0, 1), b2 + hstep, voffB); PG8_STAGE(PG8_SA(0, 0), a2, voffA);
            PG8_WAIT_V(8); PG8_WAIT_L(0); PG8_BAR; PG8_MMA(1, 0, At, B0); PG8_MMA(1, 1, At, B1); PG8_BAR; PG8_SCHED;
            PG8_LDB(B0, 1, 0); PG8_LDB(B1, 1, 1); PG8_SCHED; PG8_LDA(At, 1, 0); PG8_STAGE(PG8_SA(0, 1), a2 + hstep, voffA);
            PG8_WAIT_V(8); PG8_WAIT_L(0); PG8_BAR; PG8_MMA(0, 0, At, B0); PG8_MMA(0, 1, At, B1); PG8_BAR; PG8_SCHED;
            PG8_LDA(At, 1, 1); PG8_STAGE(PG8_SB(1, 0), b3, voffB); PG8_STAGE(PG8_SB(1, 1), b3 + hstep, voffB); PG8_STAGE(PG8_SA(1, 0), a3, voffA);
            PG8_WAIT_V(8); PG8_WAIT_L(0); PG8_BAR; PG8_MMA(1, 0, At, B0); PG8_MMA(1, 1, At, B1); PG8_BAR; PG8_SCHED;
            } else {
            PG8_LDB(B0, 0, 0); PG8_SCHED; PG8_LDA(At, 0, 0); PG8_STAGE(PG8_SA(1, 1), a1 + hstep, voffA);
            PG8_WAIT_L(8); PG8_BAR; PG8_WAIT_L(0); PG8_MMA(0, 0, At, B0); PG8_BAR; PG8_SCHED;
            PG8_LDB(B1, 0, 1); PG8_STAGE(PG8_SB(0, 0), b2, voffB);
            PG8_BAR; PG8_WAIT_L(0); PG8_MMA(0, 1, At, B1); PG8_BAR;
            PG8_LDA(At, 0, 1); PG8_STAGE(PG8_SA(0, 0), a2, voffA);
            PG8_BAR; PG8_WAIT_L(0); PG8_MMA(1, 0, At, B0); PG8_BAR; PG8_SCHED;
            PG8_STAGE(PG8_SB(0, 1), b2 + hstep, voffB);
            PG8_WAIT_V(6); PG8_BAR; PG8_MMA(1, 1, At, B1); PG8_BAR;
            PG8_LDB(B0, 1, 0); PG8_SCHED; PG8_LDA(At, 1, 0); PG8_STAGE(PG8_SA(0, 1), a2 + hstep, voffA);
            PG8_WAIT_L(8); PG8_BAR; PG8_WAIT_L(0); PG8_MMA(0, 0, At, B0); PG8_BAR; PG8_SCHED;
            PG8_LDB(B1, 1, 1); PG8_STAGE(PG8_SB(1, 0), b3, voffB);
            PG8_BAR; PG8_WAIT_L(0); PG8_MMA(0, 1, At, B1); PG8_BAR;
            PG8_LDA(At, 1, 1); PG8_STAGE(PG8_SA(1, 0), a3, voffA);
            PG8_BAR; PG8_WAIT_L(0); PG8_MMA(1, 0, At, B0); PG8_BAR; PG8_SCHED;
            PG8_STAGE(PG8_SB(1, 1), b3 + hstep, voffB);
            PG8_WAIT_V(6); PG8_BAR; PG8_MMA(1, 1, At, B1); PG8_BAR;
            }
        }
        if constexpr (ALIGN_EPI) { if (wr == 0) PG8_BAR; }
        if constexpr (F8) asm volatile("s_nop 15\n\ts_nop 7" ::: "memory");
        if constexpr (!Epi::AFTER_DRAIN) { int t2_ = tid_from_wave(wave_); asm volatile("" : "+v"(t2_)); const int l2_ = t2_ & 63;
            E(acc, cur, wr, wc, l2_ & 15, l2_ >> 4); S.done(cur); }
        if (!has_next) break;
#pragma unroll
        for (int a = 0; a < 2; ++a)
#pragma unroll
            for (int b = 0; b < 2; ++b)
#pragma unroll
                for (int m = 0; m < 4; ++m)
#pragma unroll
                    for (int n = 0; n < 2; ++n) acc[a][b][m][n] = (f32x4){0.f, 0.f, 0.f, 0.f};
        cur = nxt; cA = nA; cB = nB; ++ui;
        if constexpr (ALIGN_EPI) { if (wr == 1) PG8_BAR; }
    }
    PG8_WAIT_V(0);
    if constexpr (!ALIGN_EPI) { if (wr == 0) PG8_BAR; }
    PG8_BAR;
    if constexpr (Epi::AFTER_DRAIN) { E.fused(acc, cur, wr, wc, fr, fq, lds, wid, lane); S.done(cur); }
#undef PG8_SA
#undef PG8_SB
#undef PG8_STAGE
#undef PG8_LDA
#undef PG8_LDB
#undef PG8_MMA
#undef PG8_MF
#undef PG8_RA
#undef PG8_RB
#undef PG8_X1
#undef PG8_X2
#undef PG8_WAIT_V
#undef PG8_WAIT_L
#undef PG8_BAR
#undef PG8_SCHED
}
}
#define GAS __attribute__((address_space(1)))
#define LAS __attribute__((address_space(3)))
typedef unsigned short bf16;
typedef unsigned v4u __attribute__((ext_vector_type(4)));
typedef float f32x4 __attribute__((ext_vector_type(4)));
typedef short bf16x8 __attribute__((ext_vector_type(8)));
typedef GAS unsigned gu32;
typedef GAS unsigned long long gu64;
#define RLX_AGENT __ATOMIC_RELAXED, __HIP_MEMORY_SCOPE_AGENT
#define LDS_WAIT() asm volatile("s_waitcnt lgkmcnt(0)" ::: "memory")
#define VM_WAIT() asm volatile("s_waitcnt vmcnt(0)" ::: "memory")
__device__ __forceinline__ unsigned long long rt() { return __builtin_amdgcn_s_memrealtime(); }

#define XB_TMO      128
#define XB_XCNT(j)  (256  + 64 * (j))
#define XB_XSUB(j)  (1280 + 64 * (j))
#define XB_XGEN(j)  (2304 + 64 * (j))
#define XB_TOP      3328
#define XB_TOPGEN   3392
#define XCD_BAR_WORDS 3456
#define XB_SPIN_CAP (1u << 18)

__device__ __forceinline__ unsigned xb_ld(unsigned* p)              { return __hip_atomic_load(p, __ATOMIC_RELAXED, __HIP_MEMORY_SCOPE_AGENT); }
__device__ __forceinline__ unsigned xb_add(unsigned* p, unsigned v) { return __hip_atomic_fetch_add(p, v, __ATOMIC_RELAXED, __HIP_MEMORY_SCOPE_AGENT); }
__device__ __forceinline__ unsigned xb_xcc_id() { return (unsigned)__builtin_amdgcn_s_getreg((3 << 11) | 20) & 0xFu; }
#define XB_SPIN(cond, bar) do { unsigned _sp = 0; while (cond) { __builtin_amdgcn_s_sleep(1); \
    if ((++_sp & 255u) == 0u) { if (xb_ld(&(bar)[XB_TMO])) break; if (_sp > XB_SPIN_CAP) { atomicAdd(&(bar)[XB_TMO], 1u); break; } } } } while (0)

struct XcdBarrier {
    unsigned* bar; unsigned x; int wave;
    volatile LAS unsigned* st;
};

__device__ __forceinline__ XcdBarrier xcd_barrier_post(unsigned* bar, volatile LAS unsigned* st, int wave) {
    XcdBarrier b; b.bar = bar; b.x = xb_xcc_id(); b.st = st; b.wave = wave;
    if (tid_from_wave(wave) == 0) (void)xb_add(&bar[XB_XCNT(b.x)], 1u);
    return b;
}
__device__ __forceinline__ void xcd_barrier_complete(unsigned* bar, unsigned x, unsigned& nloc, unsigned& nx) {
    const unsigned G = gridDim.x * gridDim.y * gridDim.z;
    unsigned sum, cnt, mine, sp = 0u;
    for (;;) {
        sum = 0u; cnt = 0u; mine = 0u;
#pragma unroll
        for (unsigned j = 0; j < 16; ++j) { const unsigned c = xb_ld(&bar[XB_XCNT(j)]); sum += c; cnt += (c > 0u) ? 1u : 0u; mine = (j == x) ? c : mine; }
        if (sum == G) break;
        __builtin_amdgcn_s_sleep(1);
        if ((++sp & 255u) == 0u) { if (xb_ld(&bar[XB_TMO])) break; if (sp > XB_SPIN_CAP) { atomicAdd(&bar[XB_TMO], 1u); break; } }
    }
    nloc = mine > 0u ? mine : 1u; nx = cnt > 0u ? cnt : 1u;
}

__device__ __forceinline__ void xcd_barrier(const XcdBarrier& b) {
    asm volatile("s_waitcnt vmcnt(0)" ::: "memory");
    __syncthreads();
    if (tid_from_wave(b.wave) == 0) {
        unsigned* bar = b.bar;
        __builtin_amdgcn_s_waitcnt(0);
        unsigned nloc = b.st[0], nx = b.st[1];
        if (nloc == 0u) { xcd_barrier_complete(bar, b.x, nloc, nx); b.st[0] = nloc; b.st[1] = nx; }
        const unsigned old = xb_add(&bar[XB_XSUB(b.x)], 1u);
        const unsigned gen = old / nloc;
        if (old + 1u == (gen + 1u) * nloc) {
            __builtin_amdgcn_fence(__ATOMIC_RELEASE, "agent");
            asm volatile("s_waitcnt vmcnt(0)" ::: "memory");
            const unsigned og = xb_add(&bar[XB_TOP], 1u);
            const unsigned tg = og / nx;
            if (og + 1u == (tg + 1u) * nx) xb_add(&bar[XB_TOPGEN], 1u);
            else XB_SPIN(xb_ld(&bar[XB_TOPGEN]) == tg, bar);
            __builtin_amdgcn_fence(__ATOMIC_ACQUIRE, "agent");
            xb_add(&bar[XB_XGEN(b.x)], 1u);
            asm volatile("s_waitcnt vmcnt(0)" ::: "memory");
        } else {
            XB_SPIN(xb_ld(&bar[XB_XGEN(b.x)]) == gen, bar);
            __builtin_amdgcn_fence(__ATOMIC_ACQUIRE, "agent");
            asm volatile("s_waitcnt vmcnt(0)" ::: "memory");
        }
    }
    __syncthreads();
}

namespace mla {
using bf16x8 = __attribute__((ext_vector_type(8))) short;
using s16x4 = __attribute__((ext_vector_type(4))) short;
using f32x16 = __attribute__((ext_vector_type(16))) float;
using u32x4 = __attribute__((ext_vector_type(4))) unsigned;
typedef __attribute__((address_space(3))) const char* lds_cptr;
constexpr int SEQ = 8192, NW = 8, QBLK = 32, QB = 256, KVBLK = 64, NSLOT = 3, KSLOT = 12288, VSLOT = 8192;
constexpr int QP = 768, KVP = 1024, PEP = 32, OP = 1024;
constexpr int LDS_K = 0, LDS_V = NSLOT * KSLOT, LDS_WS = LDS_V + NSLOT * VSLOT, LDS_OST = LDS_WS + NW * 64 * 4, LDS_TOTAL = LDS_OST + NW * 4096;
__device__ __forceinline__ int crow(int r, int hi) { return (r & 3) + 8 * (r >> 2) + 4 * hi; }
__device__ __forceinline__ void glds16(const void* gsrc, unsigned lds_dst) { unsigned keep;
    asm volatile("s_mov_b32 %0, m0\n\ts_mov_b32 m0, %2\n\ts_nop 0\n\tglobal_load_lds_dwordx4 %1, off\n\ts_mov_b32 m0, %0" : "=&s"(keep) : "v"(gsrc), "s"(lds_dst) : "memory"); }
__device__ __forceinline__ float max3f(float a, float b, float c) { float r; asm("v_max3_f32 %0, %1, %2, %3" : "=v"(r) : "v"(a), "v"(b), "v"(c)); return r; }
typedef float f32x2_t __attribute__((ext_vector_type(2))); typedef __bf16 bf16x2_t __attribute__((ext_vector_type(2)));
__device__ __forceinline__ unsigned cvtpk_s(float lo, float hi) { f32x2_t v = {lo, hi}; bf16x2_t b = __builtin_convertvector(v, bf16x2_t); return __builtin_bit_cast(unsigned, b); }
__device__ __forceinline__ void cmask(f32x16& p0, f32x16& p1, int jb, int qrel, int hi) {
    const float NEG = -INFINITY; const int kb = 64 * jb + 4 * hi;
#pragma unroll
    for (int r = 0; r < 16; ++r) { const int kv = kb + (r & 3) + 8 * (r >> 2); if (kv > qrel) p0[r] = NEG; if (kv + 32 > qrel) p1[r] = NEG; }
}
__device__ __forceinline__ float rowmax(const f32x16& p0, const f32x16& p1) {
    float a = max3f(p0[0], p0[1], p1[0]), b = max3f(p0[2], p0[3], p1[1]); a = max3f(a, p1[2], p1[3]);
#pragma unroll
    for (int r = 4; r < 16; r += 4) { a = max3f(a, p0[r], p0[r + 1]); b = max3f(b, p0[r + 2], p0[r + 3]); a = max3f(a, p1[r], p1[r + 1]); b = max3f(b, p1[r + 2], p1[r + 3]); }
    const float m = fmaxf(a, b);
    auto rr = __builtin_amdgcn_permlane32_swap(__float_as_uint(m), __float_as_uint(m), false, false);
    return fmaxf(__uint_as_float(rr[0]), __uint_as_float(rr[1]));
}
__device__ __forceinline__ void pv(f32x16* o, int vb, bf16x8 pa0, bf16x8 pa1, bf16x8 pa2, bf16x8 pa3) {
#pragma unroll
    for (int d0 = 0; d0 < 2; ++d0) { s16x4 lo[4], hi[4];
#pragma unroll
        for (int ks = 0; ks < 4; ++ks) {
            asm volatile("ds_read_b64_tr_b16 %0,%1 offset:%c2" : "=&v"(lo[ks]) : "v"(vb), "i"(d0 * 4096 + ks * 1024) : "memory");
            asm volatile("ds_read_b64_tr_b16 %0,%1 offset:%c2" : "=&v"(hi[ks]) : "v"(vb), "i"(d0 * 4096 + ks * 1024 + 512) : "memory"); }
        asm volatile("s_waitcnt lgkmcnt(0)" ::: "memory"); __builtin_amdgcn_sched_barrier(0);
#define MLA_PK(k) (bf16x8){lo[k][0], lo[k][1], lo[k][2], lo[k][3], hi[k][0], hi[k][1], hi[k][2], hi[k][3]}
        o[d0] = __builtin_amdgcn_mfma_f32_32x32x16_bf16(pa0, MLA_PK(0), o[d0], 0, 0, 0);
        o[d0] = __builtin_amdgcn_mfma_f32_32x32x16_bf16(pa1, MLA_PK(1), o[d0], 0, 0, 0);
        o[d0] = __builtin_amdgcn_mfma_f32_32x32x16_bf16(pa2, MLA_PK(2), o[d0], 0, 0, 0);
        o[d0] = __builtin_amdgcn_mfma_f32_32x32x16_bf16(pa3, MLA_PK(3), o[d0], 0, 0, 0);
#undef MLA_PK
    }
}
#define MLA_WAIT_BAR(N) asm volatile("s_waitcnt vmcnt(" #N ") lgkmcnt(0)\n\ts_barrier" ::: "memory")

__device__ __forceinline__ void unit(int b, int h, int qb, const unsigned short* Q, const unsigned short* KV, const unsigned short* KPE, unsigned short* O, char* shm, const int wave_) {
    int tid_ = tid_from_wave(wave_); asm volatile("" : "+v"(tid_));
    const int tid = tid_, lane = tid & 63, r32 = lane & 31, hi = lane >> 5; const int wid = __builtin_amdgcn_readfirstlane(tid >> 6);
    const long rowbase = (long)b * SEQ; const int q0 = qb * QB;
    const unsigned short* Qw = Q + (rowbase + q0 + wid * QBLK) * QP + h * 96;
    const unsigned short* Kh = KV + rowbase * KVP + h * 128; const unsigned short* Vh = Kh + 64; const unsigned short* Ph = KPE + rowbase * PEP;
    const unsigned lds0 = (unsigned)(uintptr_t)shm;
    __attribute__((address_space(3))) float* wsf = (__attribute__((address_space(3))) float*)((lds_cptr)shm + LDS_WS) + wid * 64;
    const unsigned short* ksrc = Kh + (long)lane * KVP + wid * 8;
    const unsigned short* psrc = Ph + (long)(32 * (wid & 1) + r32) * PEP + (wid >> 1) * 8;
    const unsigned short* vsrc = Vh + (long)(16 * (wid & 3) + (lane >> 2)) * KVP + (wid >> 2) * 32 + (lane & 3) * 8;
    const unsigned kdst = lds0 + LDS_K + wid * 1024, pdst = lds0 + LDS_K + (8 + (wid >> 1)) * 1024 + (wid & 1) * 512, vdst = lds0 + LDS_V + wid * 1024;
#define MLA_DMA(t, s) do { glds16(ksrc + (long)(t) * KVBLK * KVP, (unsigned)__builtin_amdgcn_readfirstlane(kdst + (s) * KSLOT)); \
        if (lane < 32) glds16(psrc + (long)(t) * KVBLK * PEP, (unsigned)__builtin_amdgcn_readfirstlane(pdst + (s) * KSLOT)); \
        glds16(vsrc + (long)(t) * KVBLK * KVP, (unsigned)__builtin_amdgcn_readfirstlane(vdst + (s) * VSLOT)); } while (0)
    const int vb0 = (int)(lds0 + LDS_V) + ((lane >> 4) & 1) * 32 + (lane & 3) * 8 + (4 * hi + ((lane & 15) >> 2)) * 64;
    const lds_cptr kp0 = (lds_cptr)shm + LDS_K + hi * 1024 + r32 * 16;
    const int NT = (q0 + QB) / KVBLK;
    bf16x8 qr[6];
#pragma unroll
    for (int d0 = 0; d0 < 6; ++d0) qr[d0] = *reinterpret_cast<const bf16x8*>(&Qw[(long)r32 * QP + d0 * 16 + hi * 8]);
    asm volatile("s_waitcnt vmcnt(0)" ::: "memory");
    MLA_DMA(0, 0); MLA_DMA(1, 1);
    float m = -INFINITY, l = 0.f; f32x16 o[2]; o[0] = f32x16{}; o[1] = f32x16{};
    const int qrel = wid * QBLK + r32;
    int slot = 0, slot2 = 2;
    for (int t = 0; t < NT; ++t) {
        if (t + 1 < NT) MLA_WAIT_BAR(3); else MLA_WAIT_BAR(0);
        if (t + 2 < NT) MLA_DMA(t + 2, slot2);
        f32x16 p0 = f32x16{}, p1 = f32x16{};
        { const lds_cptr kp = kp0 + slot * KSLOT;
#pragma unroll
          for (int d0 = 0; d0 < 6; ++d0) { const bf16x8 b0 = *(const __attribute__((address_space(3))) bf16x8*)(kp + d0 * 2048), b1 = *(const __attribute__((address_space(3))) bf16x8*)(kp + d0 * 2048 + 512);
              p0 = __builtin_amdgcn_mfma_f32_32x32x16_bf16(b0, qr[d0], p0, 0, 0, 0); p1 = __builtin_amdgcn_mfma_f32_32x32x16_bf16(b1, qr[d0], p1, 0, 0, 0); } }
        { const int jb = t - (NT - 4); if (jb >= 0) cmask(p0, p1, jb, qrel, hi); }
        const float rm = rowmax(p0, p1), mn = fmaxf(m, rm);
        if (__any(mn > m)) {
            const float al = __builtin_amdgcn_exp2f(m - mn); l *= al; m = mn;
            if (hi == 0) wsf[r32] = al;
            asm volatile("s_waitcnt lgkmcnt(0)" ::: "memory");
#pragma unroll
            for (int r = 0; r < 16; ++r) { const float f = wsf[crow(r, hi)]; o[0][r] *= f; o[1][r] *= f; }
        }
        float sacc = 0.f;
#pragma unroll
        for (int r = 0; r < 16; ++r) { p0[r] = __builtin_amdgcn_exp2f(p0[r] - m); p1[r] = __builtin_amdgcn_exp2f(p1[r] - m); sacc += p0[r] + p1[r]; }
        l += sacc;
        u32x4 pw0, pw1, pw2, pw3;
#define MLA_PKW(P, B) cvtpk_s(P[B], P[B + 1])
        pw0 = (u32x4){MLA_PKW(p0, 0), MLA_PKW(p0, 2), MLA_PKW(p0, 4), MLA_PKW(p0, 6)}; pw1 = (u32x4){MLA_PKW(p0, 8), MLA_PKW(p0, 10), MLA_PKW(p0, 12), MLA_PKW(p0, 14)};
        pw2 = (u32x4){MLA_PKW(p1, 0), MLA_PKW(p1, 2), MLA_PKW(p1, 4), MLA_PKW(p1, 6)}; pw3 = (u32x4){MLA_PKW(p1, 8), MLA_PKW(p1, 10), MLA_PKW(p1, 12), MLA_PKW(p1, 14)};
#undef MLA_PKW
        pv(o, vb0 + slot * VSLOT, __builtin_bit_cast(bf16x8, pw0), __builtin_bit_cast(bf16x8, pw1), __builtin_bit_cast(bf16x8, pw2), __builtin_bit_cast(bf16x8, pw3));
        slot = (slot == NSLOT - 1) ? 0 : slot + 1; slot2 = (slot2 == NSLOT - 1) ? 0 : slot2 + 1;
    }
    { auto rr = __builtin_amdgcn_permlane32_swap(__float_as_uint(l), __float_as_uint(l), false, false); l = __uint_as_float(rr[0]) + __uint_as_float(rr[1]); }
    if (hi == 0) wsf[32 + r32] = l; asm volatile("s_waitcnt lgkmcnt(0)" ::: "memory");
    float rli[16];
#pragma unroll
    for (int r = 0; r < 16; ++r) rli[r] = __builtin_amdgcn_rcpf(wsf[32 + crow(r, hi)]);
    unsigned short* Ow = O + (rowbase + q0 + wid * QBLK) * OP + 512 + h * 64;
    { __attribute__((address_space(3))) unsigned short* stg = (__attribute__((address_space(3))) unsigned short*)((lds_cptr)shm + LDS_OST) + wid * 2048;
#pragma unroll
      for (int r = 0; r < 16; ++r) { const int orow = crow(r, hi);
#pragma unroll
          for (int d0 = 0; d0 < 2; ++d0) stg[orow * 64 + d0 * 32 + r32] = (unsigned short)(cvtpk_s(o[d0][r] * rli[r], 0.f) & 0xffffu); }
      asm volatile("s_waitcnt lgkmcnt(0)" ::: "memory");
#pragma unroll
      for (int i = 0; i < 4; ++i) { const int row = i * 8 + (lane >> 3), ch = lane & 7; const u32x4 v = *(const __attribute__((address_space(3))) u32x4*)(stg + row * 64 + ch * 8); *(u32x4*)(Ow + (long)row * OP + ch * 8) = v; } }
    asm volatile("s_waitcnt vmcnt(0) lgkmcnt(0)\n\ts_barrier" ::: "memory");
#undef MLA_DMA
}

#define MLA_SB() __builtin_amdgcn_sched_barrier(0)
#define MLA_PIN(x) asm volatile("" : "+v"(x))
#define MLA_LDK(kp, d0, h) (*(const __attribute__((address_space(3))) bf16x8*)((kp) + (d0) * 2048 + (h) * 512))
#define MLA_E4(P, B) do { P[B] = __builtin_amdgcn_exp2f(P[B]); P[B + 1] = __builtin_amdgcn_exp2f(P[B + 1]); P[B + 2] = __builtin_amdgcn_exp2f(P[B + 2]); P[B + 3] = __builtin_amdgcn_exp2f(P[B + 3]); MLA_PIN(P); } while (0)
#define MLA_A4(P, B) do { sacc += P[B]; sacc += P[B + 1]; sacc += P[B + 2]; sacc += P[B + 3]; MLA_PIN(sacc); } while (0)
#define MLA_PK2(W, I, P, B) do { W[I] = cvtpk_s(P[B], P[B + 1]); W[I + 1] = cvtpk_s(P[B + 2], P[B + 3]); MLA_PIN(W); } while (0)
#define MLA_MF(C, K, Q) C = __builtin_amdgcn_mfma_f32_32x32x16_bf16(K, Q, C, 0, 0, 0)
#define MLA_MF0(C, K, Q) C = __builtin_amdgcn_mfma_f32_32x32x16_bf16(K, Q, negm, 0, 0, 0)
#define MLA_SOFT(P0, P1) do { float sacc = 0.f; \
    MLA_E4(P0, 0); MLA_E4(P0, 4); MLA_E4(P0, 8); MLA_E4(P0, 12); MLA_E4(P1, 0); MLA_E4(P1, 4); MLA_E4(P1, 8); MLA_E4(P1, 12); \
    MLA_A4(P0, 0); MLA_A4(P0, 4); MLA_A4(P0, 8); MLA_A4(P0, 12); MLA_A4(P1, 0); MLA_A4(P1, 4); MLA_A4(P1, 8); MLA_A4(P1, 12); \
    MLA_PK2(pw0, 0, P0, 0); MLA_PK2(pw0, 2, P0, 4); MLA_PK2(pw1, 0, P0, 8); MLA_PK2(pw1, 2, P0, 12); MLA_PK2(pw2, 0, P1, 0); MLA_PK2(pw2, 2, P1, 4); MLA_PK2(pw3, 0, P1, 8); MLA_PK2(pw3, 2, P1, 12); \
    l_reg += sacc; } while (0)
#define MLA_REF(C0, C1, RESC_O) do { const float rm_ = rowmax(C0, C1); \
    if (__builtin_expect(__any(rm_ > (float)THRL), 0)) { const float dl_ = fmaxf(rm_, 0.f); mhat += dl_; \
        _Pragma("unroll") for (int r = 0; r < 16; ++r) { C0[r] -= dl_; C1[r] -= dl_; } \
        _Pragma("unroll") for (int r = 0; r < 16; ++r) negm[r] = -mhat; MLA_PIN(negm); \
        const float f_ = __builtin_amdgcn_exp2f(-dl_); l_reg *= f_; \
        if (RESC_O) { if (hi == 0) wsf[r32] = f_; asm volatile("s_waitcnt lgkmcnt(0)" ::: "memory"); \
            _Pragma("unroll") for (int r = 0; r < 16; ++r) { const float g_ = wsf[crow(r, hi)]; o[0][r] *= g_; o[1][r] *= g_; } } } } while (0)
#define MLA_STEP(C0, C1, P0, P1, t, JB, WAITN, GK, GV) do { \
    MLA_WAIT_BAR(WAITN); \
    if (GK) { glds16(ksrc + (long)((t) + 3) * KVBLK * KVP, (unsigned)__builtin_amdgcn_readfirstlane(kdst + s0 * KSLOT)); \
              if (lane < 32) glds16(psrc + (long)((t) + 3) * KVBLK * PEP, (unsigned)__builtin_amdgcn_readfirstlane(pdst + s0 * KSLOT)); } \
    if (GV) { glds16(vsrc + (long)((t) + 2) * KVBLK * KVP, (unsigned)__builtin_amdgcn_readfirstlane(vdst + s2 * VSLOT)); } \
    { const lds_cptr kp = kp0 + s1 * KSLOT; float sacc = 0.f; bf16x8 ka0, ka1, kb0, kb1; \
      ka0 = MLA_LDK(kp, 0, 0); ka1 = MLA_LDK(kp, 0, 1); MLA_E4(P0, 0); MLA_E4(P0, 4); MLA_SB(); \
      kb0 = MLA_LDK(kp, 1, 0); kb1 = MLA_LDK(kp, 1, 1); \
      MLA_MF0(C0, ka0, qr[0]); MLA_E4(P0, 8); MLA_SB(); \
      MLA_MF0(C1, ka1, qr[0]); MLA_E4(P0, 12); MLA_A4(P0, 0); MLA_SB(); \
      ka0 = MLA_LDK(kp, 2, 0); ka1 = MLA_LDK(kp, 2, 1); \
      MLA_MF(C0, kb0, qr[1]); MLA_E4(P1, 0); MLA_A4(P0, 4); MLA_SB(); \
      MLA_MF(C1, kb1, qr[1]); MLA_E4(P1, 4); MLA_A4(P0, 8); MLA_PK2(pw0, 0, P0, 0); MLA_SB(); \
      kb0 = MLA_LDK(kp, 3, 0); kb1 = MLA_LDK(kp, 3, 1); \
      MLA_MF(C0, ka0, qr[2]); MLA_E4(P1, 8); MLA_A4(P0, 12); MLA_PK2(pw0, 2, P0, 4); MLA_SB(); \
      MLA_MF(C1, ka1, qr[2]); MLA_E4(P1, 12); MLA_A4(P1, 0); MLA_PK2(pw1, 0, P0, 8); MLA_SB(); \
      ka0 = MLA_LDK(kp, 4, 0); ka1 = MLA_LDK(kp, 4, 1); \
      MLA_MF(C0, kb0, qr[3]); MLA_A4(P1, 4); MLA_PK2(pw1, 2, P0, 12); MLA_SB(); \
      MLA_MF(C1, kb1, qr[3]); MLA_A4(P1, 8); MLA_PK2(pw2, 0, P1, 0); MLA_SB(); \
      kb0 = MLA_LDK(kp, 5, 0); kb1 = MLA_LDK(kp, 5, 1); \
      MLA_MF(C0, ka0, qr[4]); MLA_A4(P1, 12); MLA_PK2(pw2, 2, P1, 4); MLA_SB(); \
      MLA_MF(C1, ka1, qr[4]); MLA_PK2(pw3, 0, P1, 8); MLA_SB(); \
      MLA_MF(C0, kb0, qr[5]); MLA_PK2(pw3, 2, P1, 12); MLA_SB(); \
      MLA_MF(C1, kb1, qr[5]); MLA_SB(); \
      l_reg += sacc; } \
    pv(o, vb0 + s0 * VSLOT, __builtin_bit_cast(bf16x8, pw0), __builtin_bit_cast(bf16x8, pw1), __builtin_bit_cast(bf16x8, pw2), __builtin_bit_cast(bf16x8, pw3)); \
    if ((JB) >= 0) cmask(C0, C1, (JB), qrel, hi); \
    MLA_REF(C0, C1, true); \
    { const int s_ = s0; s0 = s1; s1 = s2; s2 = s_; } \
} while (0)

template <int THRL> __device__ __forceinline__ void unit_pipe(int b, int h, int qb, const unsigned short* Q, const unsigned short* KV, const unsigned short* KPE, unsigned short* O, char* shm, const int wave_) {
    int tid_ = tid_from_wave(wave_); asm volatile("" : "+v"(tid_));
    const int tid = tid_, lane = tid & 63, r32 = lane & 31, hi = lane >> 5; const int wid = __builtin_amdgcn_readfirstlane(tid >> 6);
    const long rowbase = (long)b * SEQ; const int q0 = qb * QB;
    const unsigned short* Qw = Q + (rowbase + q0 + wid * QBLK) * QP + h * 96;
    const unsigned short* Kh = KV + rowbase * KVP + h * 128; const unsigned short* Vh = Kh + 64; const unsigned short* Ph = KPE + rowbase * PEP;
    const unsigned lds0 = (unsigned)(uintptr_t)shm;
    __attribute__((address_space(3))) float* wsf = (__attribute__((address_space(3))) float*)((lds_cptr)shm + LDS_WS) + wid * 64;
    const unsigned short* ksrc = Kh + (long)lane * KVP + wid * 8;
    const unsigned short* psrc = Ph + (long)(32 * (wid & 1) + r32) * PEP + (wid >> 1) * 8;
    const unsigned short* vsrc = Vh + (long)(16 * (wid & 3) + (lane >> 2)) * KVP + (wid >> 2) * 32 + (lane & 3) * 8;
    const unsigned kdst = lds0 + LDS_K + wid * 1024, pdst = lds0 + LDS_K + (8 + (wid >> 1)) * 1024 + (wid & 1) * 512, vdst = lds0 + LDS_V + wid * 1024;
    const int vb0 = (int)(lds0 + LDS_V) + ((lane >> 4) & 1) * 32 + (lane & 3) * 8 + (4 * hi + ((lane & 15) >> 2)) * 64;
    const lds_cptr kp0 = (lds_cptr)shm + LDS_K + hi * 1024 + r32 * 16;
    const int NT = (q0 + QB) / KVBLK;
    bf16x8 qr[6];
#pragma unroll
    for (int d0 = 0; d0 < 6; ++d0) qr[d0] = *reinterpret_cast<const bf16x8*>(&Qw[(long)r32 * QP + d0 * 16 + hi * 8]);
    asm volatile("s_waitcnt vmcnt(0)" ::: "memory");
    glds16(ksrc, (unsigned)__builtin_amdgcn_readfirstlane(kdst)); if (lane < 32) glds16(psrc, (unsigned)__builtin_amdgcn_readfirstlane(pdst));
    glds16(ksrc + (long)KVBLK * KVP, (unsigned)__builtin_amdgcn_readfirstlane(kdst + KSLOT)); if (lane < 32) glds16(psrc + (long)KVBLK * PEP, (unsigned)__builtin_amdgcn_readfirstlane(pdst + KSLOT)); glds16(vsrc, (unsigned)__builtin_amdgcn_readfirstlane(vdst));
    glds16(ksrc + (long)2 * KVBLK * KVP, (unsigned)__builtin_amdgcn_readfirstlane(kdst + 2 * KSLOT)); if (lane < 32) glds16(psrc + (long)2 * KVBLK * PEP, (unsigned)__builtin_amdgcn_readfirstlane(pdst + 2 * KSLOT)); glds16(vsrc + (long)KVBLK * KVP, (unsigned)__builtin_amdgcn_readfirstlane(vdst + VSLOT));
    float mhat = 0.f, l_reg = 0.f; f32x16 o[2]; o[0] = f32x16{}; o[1] = f32x16{}; f32x16 negm = f32x16{}; MLA_PIN(negm);
    const int qrel = wid * QBLK + r32;
    f32x16 pA0, pA1, pB0, pB1; u32x4 pw0, pw1, pw2, pw3;
    int s0 = 0, s1 = 1, s2 = 2;
    MLA_WAIT_BAR(6);
    { const lds_cptr kp = kp0;
      pA0 = f32x16{}; pA1 = f32x16{};
#pragma unroll
      for (int d0 = 0; d0 < 6; ++d0) { const bf16x8 k0 = MLA_LDK(kp, d0, 0), k1 = MLA_LDK(kp, d0, 1); MLA_MF(pA0, k0, qr[d0]); MLA_MF(pA1, k1, qr[d0]); } }
    { const float rm_ = rowmax(pA0, pA1); mhat = rm_;
#pragma unroll
      for (int r = 0; r < 16; ++r) { pA0[r] -= rm_; pA1[r] -= rm_; negm[r] = -mhat; }
      MLA_PIN(negm); }
    int t = 0;
    MLA_STEP(pB0, pB1, pA0, pA1, t, -1, 3, true, true); ++t;
    for (; t + 1 <= NT - 6; t += 2) {
        MLA_STEP(pA0, pA1, pB0, pB1, t, -1, 3, true, true);
        MLA_STEP(pB0, pB1, pA0, pA1, t + 1, -1, 3, true, true);
    }
    MLA_STEP(pA0, pA1, pB0, pB1, t, 0, 3, true, true); ++t;
    MLA_STEP(pB0, pB1, pA0, pA1, t, 1, 3, true, true); ++t;
    MLA_STEP(pA0, pA1, pB0, pB1, t, 2, 3, false, true); ++t;
    MLA_STEP(pB0, pB1, pA0, pA1, t, 3, 1, false, false); ++t;
    MLA_WAIT_BAR(0);
    MLA_SOFT(pB0, pB1);
    pv(o, vb0 + s0 * VSLOT, __builtin_bit_cast(bf16x8, pw0), __builtin_bit_cast(bf16x8, pw1), __builtin_bit_cast(bf16x8, pw2), __builtin_bit_cast(bf16x8, pw3));
    { auto rr = __builtin_amdgcn_permlane32_swap(__float_as_uint(l_reg), __float_as_uint(l_reg), false, false); l_reg = __uint_as_float(rr[0]) + __uint_as_float(rr[1]); }
    if (hi == 0) wsf[32 + r32] = l_reg; asm volatile("s_waitcnt lgkmcnt(0)" ::: "memory");
    float rli[16];
#pragma unroll
    for (int r = 0; r < 16; ++r) rli[r] = __builtin_amdgcn_rcpf(wsf[32 + crow(r, hi)]);
    unsigned short* Ow = O + (rowbase + q0 + wid * QBLK) * OP + 512 + h * 64;
    { __attribute__((address_space(3))) unsigned short* stg = (__attribute__((address_space(3))) unsigned short*)((lds_cptr)shm + LDS_OST) + wid * 2048;
#pragma unroll
      for (int r = 0; r < 16; ++r) { const int orow = crow(r, hi);
#pragma unroll
          for (int d0 = 0; d0 < 2; ++d0) stg[orow * 64 + d0 * 32 + r32] = (unsigned short)(cvtpk_s(o[d0][r] * rli[r], 0.f) & 0xffffu); }
      asm volatile("s_waitcnt lgkmcnt(0)" ::: "memory");
#pragma unroll
      for (int i = 0; i < 4; ++i) { const int row = i * 8 + (lane >> 3), ch = lane & 7; const u32x4 v = *(const __attribute__((address_space(3))) u32x4*)(stg + row * 64 + ch * 8); *(u32x4*)(Ow + (long)row * OP + ch * 8) = v; } }
    asm volatile("s_waitcnt vmcnt(0) lgkmcnt(0)\n\ts_barrier" ::: "memory");
}

constexpr int S4_V = NSLOT * KSLOT, S4_WS = S4_V + 4 * VSLOT, S4_OST = S4_WS + NW * 64 * 4, S4_TOTAL = S4_OST + NW * 4096;
#define MLA_R1(C0, C1, P0, P1, kp) do { float sacc = 0.f; bf16x8 ka0, ka1, kb0, kb1; \
      ka0 = MLA_LDK(kp, 0, 0); ka1 = MLA_LDK(kp, 0, 1); MLA_E4(P0, 0); MLA_E4(P0, 4); MLA_SB(); \
      kb0 = MLA_LDK(kp, 1, 0); kb1 = MLA_LDK(kp, 1, 1); \
      MLA_MF0(C0, ka0, qr[0]); MLA_E4(P0, 8); MLA_SB(); \
      MLA_MF0(C1, ka1, qr[0]); MLA_E4(P0, 12); MLA_A4(P0, 0); MLA_SB(); \
      ka0 = MLA_LDK(kp, 2, 0); ka1 = MLA_LDK(kp, 2, 1); \
      MLA_MF(C0, kb0, qr[1]); MLA_E4(P1, 0); MLA_A4(P0, 4); MLA_SB(); \
      MLA_MF(C1, kb1, qr[1]); MLA_E4(P1, 4); MLA_A4(P0, 8); MLA_PK2(pw0, 0, P0, 0); MLA_SB(); \
      kb0 = MLA_LDK(kp, 3, 0); kb1 = MLA_LDK(kp, 3, 1); \
      MLA_MF(C0, ka0, qr[2]); MLA_E4(P1, 8); MLA_A4(P0, 12); MLA_PK2(pw0, 2, P0, 4); MLA_SB(); \
      MLA_MF(C1, ka1, qr[2]); MLA_E4(P1, 12); MLA_A4(P1, 0); MLA_PK2(pw1, 0, P0, 8); MLA_SB(); \
      ka0 = MLA_LDK(kp, 4, 0); ka1 = MLA_LDK(kp, 4, 1); \
      MLA_MF(C0, kb0, qr[3]); MLA_A4(P1, 4); MLA_PK2(pw1, 2, P0, 12); MLA_SB(); \
      MLA_MF(C1, kb1, qr[3]); MLA_A4(P1, 8); MLA_PK2(pw2, 0, P1, 0); MLA_SB(); \
      kb0 = MLA_LDK(kp, 5, 0); kb1 = MLA_LDK(kp, 5, 1); \
      MLA_MF(C0, ka0, qr[4]); MLA_A4(P1, 12); MLA_PK2(pw2, 2, P1, 4); MLA_SB(); \
      MLA_MF(C1, ka1, qr[4]); MLA_PK2(pw3, 0, P1, 8); MLA_SB(); \
      MLA_MF(C0, kb0, qr[5]); MLA_PK2(pw3, 2, P1, 12); MLA_SB(); \
      MLA_MF(C1, kb1, qr[5]); MLA_SB(); \
      l_reg += sacc; } while (0)
#define MLA_PVW(slot) pv(o, vb0 + (slot) * VSLOT, __builtin_bit_cast(bf16x8, pw0), __builtin_bit_cast(bf16x8, pw1), __builtin_bit_cast(bf16x8, pw2), __builtin_bit_cast(bf16x8, pw3))
#define MLA_DMA4(t, GK, GV) do { \
    if (GK) { glds16(ksrc + (long)((t) + 3) * KVBLK * KVP, (unsigned)__builtin_amdgcn_readfirstlane(kdst + s0 * KSLOT)); \
              if (lane < 32) glds16(psrc + (long)((t) + 3) * KVBLK * PEP, (unsigned)__builtin_amdgcn_readfirstlane(pdst + s0 * KSLOT)); } \
    if (GV) { glds16(vsrc + (long)((t) + 2) * KVBLK * KVP, (unsigned)__builtin_amdgcn_readfirstlane(vdst + (((t) + 2) & 3) * VSLOT)); } } while (0)
#define MLA_REFB(C0, C1) do { const float rm_ = rowmax(C0, C1); \
      if (__builtin_expect(__any(rm_ > (float)THRL), 0)) { const float dl_ = fmaxf(rm_, 0.f); mhat += dl_; \
          _Pragma("unroll") for (int r = 0; r < 16; ++r) { C0[r] -= dl_; C1[r] -= dl_; } \
          _Pragma("unroll") for (int r = 0; r < 16; ++r) negm[r] = -mhat; MLA_PIN(negm); \
          const float f_ = __builtin_amdgcn_exp2f(-dl_); l_reg *= f_; if (hi == 0) wsf[r32] = f_; resc = true; } } while (0)
#define MLA_RESCB() do { if (resc) { asm volatile("s_waitcnt lgkmcnt(0)" ::: "memory"); _Pragma("unroll") for (int r = 0; r < 16; ++r) { const float g_ = wsf[crow(r, hi)]; o[0][r] *= g_; o[1][r] *= g_; } resc = false; } } while (0)
#define MLA_STEPS(C0, C1, P0, P1, t, JB, WAITN, GK, GV, HASPV) do { \
    MLA_WAIT_BAR(WAITN); \
    if (LATE) { if (HASPV) { MLA_PVW(((t) + 3) & 3); } MLA_RESCB(); MLA_DMA4(t, GK, GV); } \
    { const lds_cptr kp = kp0 + s1 * KSLOT; __builtin_amdgcn_s_setprio(1); MLA_R1(C0, C1, P0, P1, kp); __builtin_amdgcn_s_setprio(0); } \
    if (!LATE) { MLA_DMA4(t, GK, GV); MLA_PVW((t) & 3); } \
    if ((JB) >= 0) cmask(C0, C1, (JB), qrel, hi); \
    if (LATE) MLA_REFB(C0, C1); else MLA_REF(C0, C1, true); \
    { const int s_ = s0; s0 = s1; s1 = s2; s2 = s_; } } while (0)

template <int THRL, bool LATE> __device__ __forceinline__ void unit_stag(int b, int h, int qb, const unsigned short* Q, const unsigned short* KV, const unsigned short* KPE, unsigned short* O, char* shm, const int wave_) {
    int tid_ = tid_from_wave(wave_); asm volatile("" : "+v"(tid_));
    const int tid = tid_, lane = tid & 63, r32 = lane & 31, hi = lane >> 5; const int wid = __builtin_amdgcn_readfirstlane(tid >> 6);
    const long rowbase = (long)b * SEQ; const int q0 = qb * QB;
    const unsigned short* Qw = Q + (rowbase + q0 + wid * QBLK) * QP + h * 96;
    const unsigned short* Kh = KV + rowbase * KVP + h * 128; const unsigned short* Vh = Kh + 64; const unsigned short* Ph = KPE + rowbase * PEP;
    const unsigned lds0 = (unsigned)(uintptr_t)shm;
    __attribute__((address_space(3))) float* wsf = (__attribute__((address_space(3))) float*)((lds_cptr)shm + S4_WS) + wid * 64;
    const unsigned short* ksrc = Kh + (long)lane * KVP + wid * 8;
    const unsigned short* psrc = Ph + (long)(32 * (wid & 1) + r32) * PEP + (wid >> 1) * 8;
    const unsigned short* vsrc = Vh + (long)(16 * (wid & 3) + (lane >> 2)) * KVP + (wid >> 2) * 32 + (lane & 3) * 8;
    const unsigned kdst = lds0 + LDS_K + wid * 1024, pdst = lds0 + LDS_K + (8 + (wid >> 1)) * 1024 + (wid & 1) * 512, vdst = lds0 + S4_V + wid * 1024;
    const int vb0 = (int)(lds0 + S4_V) + ((lane >> 4) & 1) * 32 + (lane & 3) * 8 + (4 * hi + ((lane & 15) >> 2)) * 64;
    const lds_cptr kp0 = (lds_cptr)shm + LDS_K + hi * 1024 + r32 * 16;
    const int NT = (q0 + QB) / KVBLK;
    bf16x8 qr[6];
#pragma unroll
    for (int d0 = 0; d0 < 6; ++d0) qr[d0] = *reinterpret_cast<const bf16x8*>(&Qw[(long)r32 * QP + d0 * 16 + hi * 8]);
    asm volatile("s_waitcnt vmcnt(0)" ::: "memory");
    glds16(ksrc, (unsigned)__builtin_amdgcn_readfirstlane(kdst)); if (lane < 32) glds16(psrc, (unsigned)__builtin_amdgcn_readfirstlane(pdst));
    glds16(ksrc + (long)KVBLK * KVP, (unsigned)__builtin_amdgcn_readfirstlane(kdst + KSLOT)); if (lane < 32) glds16(psrc + (long)KVBLK * PEP, (unsigned)__builtin_amdgcn_readfirstlane(pdst + KSLOT)); glds16(vsrc, (unsigned)__builtin_amdgcn_readfirstlane(vdst));
    glds16(ksrc + (long)2 * KVBLK * KVP, (unsigned)__builtin_amdgcn_readfirstlane(kdst + 2 * KSLOT)); if (lane < 32) glds16(psrc + (long)2 * KVBLK * PEP, (unsigned)__builtin_amdgcn_readfirstlane(pdst + 2 * KSLOT)); glds16(vsrc + (long)KVBLK * KVP, (unsigned)__builtin_amdgcn_readfirstlane(vdst + VSLOT));
    float mhat = 0.f, l_reg = 0.f; f32x16 o[2]; o[0] = f32x16{}; o[1] = f32x16{}; f32x16 negm = f32x16{}; MLA_PIN(negm);
    const int qrel = wid * QBLK + r32; bool resc = false;
    f32x16 pA0, pA1, pB0, pB1; u32x4 pw0, pw1, pw2, pw3;
    int s0 = 0, s1 = 1, s2 = 2;
    MLA_WAIT_BAR(6);
    { const lds_cptr kp = kp0;
      pA0 = f32x16{}; pA1 = f32x16{};
#pragma unroll
      for (int d0 = 0; d0 < 6; ++d0) { const bf16x8 k0 = MLA_LDK(kp, d0, 0), k1 = MLA_LDK(kp, d0, 1); MLA_MF(pA0, k0, qr[d0]); MLA_MF(pA1, k1, qr[d0]); } }
    { const float rm_ = rowmax(pA0, pA1); mhat = rm_;
#pragma unroll
      for (int r = 0; r < 16; ++r) { pA0[r] -= rm_; pA1[r] -= rm_; negm[r] = -mhat; }
      MLA_PIN(negm); }
    int t = 0;
    MLA_STEPS(pB0, pB1, pA0, pA1, t, -1, 3, true, true, false); ++t;
    for (; t + 1 <= NT - 6; t += 2) {
        MLA_STEPS(pA0, pA1, pB0, pB1, t, -1, 3, true, true, true);
        MLA_STEPS(pB0, pB1, pA0, pA1, t + 1, -1, 3, true, true, true);
    }
    MLA_STEPS(pA0, pA1, pB0, pB1, t, 0, 3, true, true, true); ++t;
    MLA_STEPS(pB0, pB1, pA0, pA1, t, 1, 3, true, true, true); ++t;
    MLA_STEPS(pA0, pA1, pB0, pB1, t, 2, 3, false, true, true); ++t;
    MLA_STEPS(pB0, pB1, pA0, pA1, t, 3, 1, false, false, true); ++t;
    MLA_WAIT_BAR(0);
    if (LATE) { MLA_PVW((NT - 2) & 3); MLA_RESCB(); }
    MLA_SOFT(pB0, pB1);
    MLA_PVW((NT - 1) & 3);
    { auto rr = __builtin_amdgcn_permlane32_swap(__float_as_uint(l_reg), __float_as_uint(l_reg), false, false); l_reg = __uint_as_float(rr[0]) + __uint_as_float(rr[1]); }
    if (hi == 0) wsf[32 + r32] = l_reg; asm volatile("s_waitcnt lgkmcnt(0)" ::: "memory");
    float rli[16];
#pragma unroll
    for (int r = 0; r < 16; ++r) rli[r] = __builtin_amdgcn_rcpf(wsf[32 + crow(r, hi)]);
    unsigned short* Ow = O + (rowbase + q0 + wid * QBLK) * OP + 512 + h * 64;
    { __attribute__((address_space(3))) unsigned short* stg = (__attribute__((address_space(3))) unsigned short*)((lds_cptr)shm + S4_OST) + wid * 2048;
#pragma unroll
      for (int r = 0; r < 16; ++r) { const int orow = crow(r, hi);
#pragma unroll
          for (int d0 = 0; d0 < 2; ++d0) stg[orow * 64 + d0 * 32 + r32] = (unsigned short)(cvtpk_s(o[d0][r] * rli[r], 0.f) & 0xffffu); }
      asm volatile("s_waitcnt lgkmcnt(0)" ::: "memory");
#pragma unroll
      for (int i = 0; i < 4; ++i) { const int row = i * 8 + (lane >> 3), ch = lane & 7; const u32x4 v = *(const __attribute__((address_space(3))) u32x4*)(stg + row * 64 + ch * 8); *(u32x4*)(Ow + (long)row * OP + ch * 8) = v; } }
    asm volatile("s_waitcnt vmcnt(0) lgkmcnt(0)\n\ts_barrier" ::: "memory");
}
__device__ __forceinline__ void phase(char* lds, const unsigned short* Q, const unsigned short* KV, const unsigned short* KPE, unsigned short* O, int vcu, int G, const int wave_) {
    for (int v = vcu; v < 256; v += G) { const int s = v & 7, bh = v >> 3;
#pragma unroll 1
        for (int i = 0; i < 4; ++i) { const int qb = (i == 0) ? s : (i == 1) ? 15 - s : (i == 2) ? 16 + s : 31 - s; if (qb == 0) unit(bh >> 3, bh & 7, qb, Q, KV, KPE, O, lds, wave_); else if (wave_ < 4) unit_stag<8, false>(bh >> 3, bh & 7, qb, Q, KV, KPE, O, lds, wave_); else unit_stag<8, true>(bh >> 3, bh & 7, qb, Q, KV, KPE, O, lds, wave_); } }
}
#undef MLA_WAIT_BAR
}

namespace evm {
template <int CTRL> __device__ __forceinline__ float dppf(float v) { return __int_as_float(__builtin_amdgcn_update_dpp(0, __float_as_int(v), CTRL, 0xF, 0xF, true)); }
__device__ __forceinline__ float wsum(float v) {
    v += dppf<0xB1>(v); v += dppf<0x4E>(v); v += dppf<0x141>(v); v += dppf<0x140>(v);
    { auto r = __builtin_amdgcn_permlane16_swap(__float_as_uint(v), __float_as_uint(v), false, false); v = __uint_as_float(r[0]) + __uint_as_float(r[1]); }
    { auto r = __builtin_amdgcn_permlane32_swap(__float_as_uint(v), __float_as_uint(v), false, false); v = __uint_as_float(r[0]) + __uint_as_float(r[1]); }
    return v;
}
using bf16x8 = __attribute__((ext_vector_type(8))) short;
using s16x4 = __attribute__((ext_vector_type(4))) short;
using f32x16 = __attribute__((ext_vector_type(16))) float;
using u32x4 = __attribute__((ext_vector_type(4))) unsigned;
typedef __attribute__((address_space(3))) char* lds_ptr;
constexpr int PP = 1792, VNP = 1088;
constexpr int LDS_VT = 0, LDS_WS = 65536, LDS_OST = LDS_WS + 2048, LDS_TOTAL = 139264;
__device__ __forceinline__ s16x4 trr(int addr) { s16x4 v; asm volatile("ds_read_b64_tr_b16 %0,%1" : "=&v"(v) : "v"(addr) : "memory"); return v; }
#define EVM_TR(dst, addr, off) asm volatile("ds_read_b64_tr_b16 %0,%1 offset:%c2" : "=&v"(dst) : "v"(addr), "i"(off) : "memory")
__device__ __forceinline__ float bflo(unsigned u) { return __uint_as_float(u << 16); }
__device__ __forceinline__ float bfhi(unsigned u) { return __uint_as_float(u & 0xffff0000u); }

__device__ __forceinline__ void unit(int un, const unsigned short* proj, const float* sinks, const float* ln_g, const float* ln_b, const unsigned short* wsb, const float* b_s, unsigned short* mix, char* shm, const int wave_) {
    int tid_ = tid_from_wave(wave_); asm volatile("" : "+v"(tid_));
    const int tid = tid_, lane = tid & 63, r32 = lane & 31, hi = lane >> 5; const int wid = __builtin_amdgcn_readfirstlane(tid >> 6);
    const int row0 = un * 128, tblk = (un & 63) * 128, seq0 = row0 - tblk;
    const lds_ptr L = (lds_ptr)shm; const unsigned lds0 = (unsigned)(uintptr_t)shm;
    u32x4 wrow[16];
#pragma unroll
    for (int i = 0; i < 16; ++i) wrow[i] = *(const u32x4*)(proj + (size_t)(row0 + wid * 16 + i) * PP + 1280 + lane * 8);
#pragma unroll
    for (int i = 0; i < 16; ++i) { const int tl = wid * 16 + i;
        const u32x4 w = wrow[i];
        float x[8] = {bflo(w.x), bfhi(w.x), bflo(w.y), bfhi(w.y), bflo(w.z), bfhi(w.z), bflo(w.w), bfhi(w.w)};
        float s = 0.f;
#pragma unroll
        for (int j = 0; j < 8; ++j) s += x[j];
        s = wsum(s);
        const float mu = s * (1.f / 512.f); float qq = 0.f;
#pragma unroll
        for (int j = 0; j < 8; ++j) { x[j] -= mu; qq += x[j] * x[j]; }
        qq = wsum(qq);
        const float rstd = 1.0f / sqrtf(qq * (1.f / 512.f) + 1e-6f);
        const f32x4 g0 = ((const f32x4*)ln_g)[lane * 2], g1 = ((const f32x4*)ln_g)[lane * 2 + 1], b0 = ((const f32x4*)ln_b)[lane * 2], b1 = ((const f32x4*)ln_b)[lane * 2 + 1];
        u32x4 ov; ov.x = pg8::cvt_pk_bf16(x[0] * rstd * g0.x + b0.x, x[1] * rstd * g0.y + b0.y); ov.y = pg8::cvt_pk_bf16(x[2] * rstd * g0.z + b0.z, x[3] * rstd * g0.w + b0.w);
        ov.z = pg8::cvt_pk_bf16(x[4] * rstd * g1.x + b1.x, x[5] * rstd * g1.y + b1.y); ov.w = pg8::cvt_pk_bf16(x[6] * rstd * g1.z + b1.z, x[7] * rstd * g1.w + b1.w);
        *(__attribute__((address_space(3))) u32x4*)(L + tl * VNP + lane * 16) = ov; }
    __syncthreads();
    { const int g = wid;
      const int trb = (int)lds0 + ((lane >> 4) & 1) * 32 + (lane & 3) * 8 + (8 * hi + ((lane & 15) >> 2)) * VNP + g * 128;
      f32x16 acc0[4], acc1[4];
#pragma unroll
      for (int i = 0; i < 4; ++i) { f32x16 a0 = f32x16{}, a1 = f32x16{};
          bf16x8 Af[8];
#pragma unroll
          for (int s = 0; s < 2 * i + 2; ++s) Af[s] = *(const bf16x8*)(wsb + ((size_t)(g * 128 + 32 * i + r32) * 128 + 16 * s + 8 * hi));
#pragma unroll
          for (int s = 0; s < 2 * i + 2; ++s) {
              const bf16x8 A = Af[s];
              const int ad = trb + s * 16 * VNP; s16x4 l0, h0, l1, h1;
              EVM_TR(l0, ad, 0); EVM_TR(h0, ad, 4 * VNP); EVM_TR(l1, ad, 64); EVM_TR(h1, ad, 64 + 4 * VNP);
              asm volatile("s_waitcnt lgkmcnt(0)" : "+v"(l0), "+v"(h0), "+v"(l1), "+v"(h1) :: "memory"); __builtin_amdgcn_sched_barrier(0);
              const bf16x8 B0 = (bf16x8){l0[0], l0[1], l0[2], l0[3], h0[0], h0[1], h0[2], h0[3]}, B1 = (bf16x8){l1[0], l1[1], l1[2], l1[3], h1[0], h1[1], h1[2], h1[3]};
              a0 = __builtin_amdgcn_mfma_f32_32x32x16_bf16(A, B0, a0, 0, 0, 0); a1 = __builtin_amdgcn_mfma_f32_32x32x16_bf16(A, B1, a1, 0, 0, 0); }
          acc0[i] = a0; acc1[i] = a1; }
      asm volatile("s_waitcnt lgkmcnt(0)" ::: "memory");
      __syncthreads();
      { __attribute__((address_space(3))) float* sg = (__attribute__((address_space(3))) float*)L + wid * (64 * 68);
        const int tok8 = lane >> 3, ch = (lane & 7) * 8;
#pragma unroll
        for (int pass = 0; pass < 2; ++pass) {
            u32x4 uu[8];
#pragma unroll
            for (int it = 0; it < 8; ++it) uu[it] = *(const u32x4*)(proj + (size_t)(row0 + 64 * pass + it * 8 + tok8) * PP + 768 + g * 64 + ch);
#pragma unroll
            for (int ii = 0; ii < 2; ++ii)
#pragma unroll
                for (int r = 0; r < 16; ++r) { const int tl = 32 * ii + (r & 3) + 8 * (r >> 2) + 4 * hi; const float bs = b_s[g * 128 + 64 * pass + tl];
                    sg[tl * 68 + r32] = acc0[2 * pass + ii][r] + bs; sg[tl * 68 + 32 + r32] = acc1[2 * pass + ii][r] + bs; }
            asm volatile("s_waitcnt lgkmcnt(0)" ::: "memory");
#pragma unroll
            for (int it = 0; it < 8; ++it) { const int tl = it * 8 + tok8;
                const f32x4 s0 = *(const __attribute__((address_space(3))) f32x4*)(sg + tl * 68 + ch), s1 = *(const __attribute__((address_space(3))) f32x4*)(sg + tl * 68 + ch + 4);
                const u32x4 w = uu[it]; u32x4 o;
                o.x = pg8::cvt_pk_bf16(bflo(w.x) * s0.x, bfhi(w.x) * s0.y); o.y = pg8::cvt_pk_bf16(bflo(w.y) * s0.z, bfhi(w.y) * s0.w);
                o.z = pg8::cvt_pk_bf16(bflo(w.z) * s1.x, bfhi(w.z) * s1.y); o.w = pg8::cvt_pk_bf16(bflo(w.w) * s1.z, bfhi(w.w) * s1.w);
                *(u32x4*)(mix + (size_t)(row0 + 64 * pass + tl) * 1024 + 512 + g * 64 + ch) = o; }
            asm volatile("s_waitcnt lgkmcnt(0)" ::: "memory");
        } } }
    asm volatile("s_waitcnt vmcnt(0) lgkmcnt(0)" ::: "memory");
    __syncthreads();
    { const int h = wid, kvh = h >> 2; const bool first = (tblk == 0);
#pragma unroll
      for (int T = 0; T < 8; ++T) { const int jt = T & 3; if (first && jt < 2) continue;
          const unsigned short* src = proj + (size_t)(seq0 + tblk - 128 + 64 * jt + 16 * (wid & 3) + (lane >> 2)) * PP + 640 + (T >> 2) * 64 + (wid >> 2) * 32 + (lane & 3) * 8;
          mla::glds16(src, (unsigned)__builtin_amdgcn_readfirstlane(lds0 + LDS_VT + T * 8192 + wid * 1024)); }
      asm volatile("s_waitcnt vmcnt(0)\n\ts_barrier" ::: "memory");
      const float slope2 = __builtin_amdgcn_exp2f(-(float)(h + 1)) * 1.4426950408889634f, sink2 = sinks[h] * 1.4426950408889634f;
      const int vb0 = (int)(lds0 + LDS_VT) + ((lane >> 4) & 1) * 32 + (lane & 3) * 8 + (4 * hi + ((lane & 15) >> 2)) * 64 + kvh * 4 * 8192;
      __attribute__((address_space(3))) float* wsf = (__attribute__((address_space(3))) float*)(L + LDS_WS) + wid * 64;
      __attribute__((address_space(3))) unsigned short* stg = (__attribute__((address_space(3))) unsigned short*)(L + LDS_OST) + wid * 2048;
#pragma unroll 1
      for (int i = 0; i < 4; ++i) {
          bf16x8 qr[4];
#pragma unroll
          for (int d0 = 0; d0 < 4; ++d0) qr[d0] = *(const bf16x8*)(proj + (size_t)(row0 + 32 * i + r32) * PP + h * 64 + d0 * 16 + hi * 8);
          f32x16 S[5]; float mx = sink2;
          bf16x8 kfa[5][4];
#pragma unroll
          for (int jj = 0; jj < 5; ++jj) { const int j = i + jj;
              if (first && j < 4) continue;
              const unsigned short* kp = proj + (size_t)(seq0 + tblk - 128 + 32 * j + r32) * PP + 512 + kvh * 64 + hi * 8;
#pragma unroll
              for (int d0 = 0; d0 < 4; ++d0) kfa[jj][d0] = *(const bf16x8*)(kp + d0 * 16); }
#pragma unroll
          for (int jj = 0; jj < 5; ++jj) { const int j = i + jj; S[jj] = f32x16{};
              if (first && j < 4) continue;
#pragma unroll
              for (int d0 = 0; d0 < 4; ++d0) S[jj] = __builtin_amdgcn_mfma_f32_32x32x16_bf16(kfa[jj][d0], qr[d0], S[jj], 0, 0, 0);
#pragma unroll
              for (int r = 0; r < 16; ++r) { const int dist = (128 + 32 * i + r32) - (32 * j + (r & 3) + 8 * (r >> 2) + 4 * hi);
                  const float v = S[jj][r] - slope2 * (float)dist; const bool ok = dist >= 0 && dist < 128;
                  S[jj][r] = ok ? v : -INFINITY; mx = fmaxf(mx, S[jj][r]); } }
          { auto rr = __builtin_amdgcn_permlane32_swap(__float_as_uint(mx), __float_as_uint(mx), false, false); mx = fmaxf(__uint_as_float(rr[0]), __uint_as_float(rr[1])); }
          float l = 0.f; f32x16 o[2]; o[0] = f32x16{}; o[1] = f32x16{};
#pragma unroll
          for (int jj = 0; jj < 5; ++jj) { const int j = i + jj;
              if (first && j < 4) continue;
#pragma unroll
              for (int r = 0; r < 16; ++r) { S[jj][r] = __builtin_amdgcn_exp2f(S[jj][r] - mx); l += S[jj][r]; }
              u32x4 pw0, pw1;
              pw0 = (u32x4){mla::cvtpk_s(S[jj][0], S[jj][1]), mla::cvtpk_s(S[jj][2], S[jj][3]), mla::cvtpk_s(S[jj][4], S[jj][5]), mla::cvtpk_s(S[jj][6], S[jj][7])};
              pw1 = (u32x4){mla::cvtpk_s(S[jj][8], S[jj][9]), mla::cvtpk_s(S[jj][10], S[jj][11]), mla::cvtpk_s(S[jj][12], S[jj][13]), mla::cvtpk_s(S[jj][14], S[jj][15])};
              const int va = vb0 + (j >> 1) * 8192 + (j & 1) * 2048;
#pragma unroll
              for (int d0 = 0; d0 < 2; ++d0) { s16x4 l0, h0, l1, h1;
                  EVM_TR(l0, va, d0 * 4096); EVM_TR(h0, va, d0 * 4096 + 512); EVM_TR(l1, va, d0 * 4096 + 1024); EVM_TR(h1, va, d0 * 4096 + 1024 + 512);
                  asm volatile("s_waitcnt lgkmcnt(0)" : "+v"(l0), "+v"(h0), "+v"(l1), "+v"(h1) :: "memory"); __builtin_amdgcn_sched_barrier(0);
                  const bf16x8 V0 = (bf16x8){l0[0], l0[1], l0[2], l0[3], h0[0], h0[1], h0[2], h0[3]}, V1 = (bf16x8){l1[0], l1[1], l1[2], l1[3], h1[0], h1[1], h1[2], h1[3]};
                  o[d0] = __builtin_amdgcn_mfma_f32_32x32x16_bf16(__builtin_bit_cast(bf16x8, pw0), V0, o[d0], 0, 0, 0);
                  o[d0] = __builtin_amdgcn_mfma_f32_32x32x16_bf16(__builtin_bit_cast(bf16x8, pw1), V1, o[d0], 0, 0, 0); } }
          { auto rr = __builtin_amdgcn_permlane32_swap(__float_as_uint(l), __float_as_uint(l), false, false); l = __uint_as_float(rr[0]) + __uint_as_float(rr[1]); }
          l += __builtin_amdgcn_exp2f(sink2 - mx);
          if (hi == 0) wsf[r32] = l; asm volatile("s_waitcnt lgkmcnt(0)" ::: "memory");
#pragma unroll
          for (int r = 0; r < 16; ++r) { const int orow = (r & 3) + 8 * (r >> 2) + 4 * hi; const float rl = __builtin_amdgcn_rcpf(wsf[orow]);
#pragma unroll
              for (int d0 = 0; d0 < 2; ++d0) stg[orow * 64 + d0 * 32 + r32] = (unsigned short)(mla::cvtpk_s(o[d0][r] * rl, 0.f) & 0xffffu); }
          asm volatile("s_waitcnt lgkmcnt(0)" ::: "memory");
          unsigned short* Ow = mix + (size_t)(row0 + 32 * i) * 1024 + h * 64;
#pragma unroll
          for (int k = 0; k < 4; ++k) { const int row = k * 8 + (lane >> 3), ch = lane & 7; const u32x4 v = *(const __attribute__((address_space(3))) u32x4*)(stg + row * 64 + ch * 8); *(u32x4*)(Ow + (size_t)row * 1024 + ch * 8) = v; }
          asm volatile("s_waitcnt lgkmcnt(0)" ::: "memory");
      } }
    asm volatile("s_waitcnt vmcnt(0) lgkmcnt(0)" ::: "memory");
    __syncthreads();
}
#undef EVM_TR
}

constexpr int NWAVES = 8;
constexpr int BATCH = 4, SEQ = 8192, DM = 1024, NTOK = BATCH * SEQ;
constexpr int EVEN_IN = 1792, ODD_IN = 2336, ODD_IN_PAD = 2560, FF = 2816, FFE = 3584, NEXP = 8, ADA = 6144;
constexpr float NORM_EPS = 1e-6f, LOG2E = 1.4426950408889634f;
constexpr float QS_EVEN = 0.125f * LOG2E;
constexpr float QS_ODD = 0.10206207261596577f * LOG2E;
#ifndef MK_PER_PHASE
#define MK_PER_PHASE 0
#endif
constexpr int NPH = 20;
#ifndef MK_DUPMASK
#define MK_DUPMASK 0u
#endif
#ifndef MK_PROBE_NULLEPI
#define MK_PROBE_NULLEPI 0
#endif
#ifndef MK_CLKPH
#define MK_CLKPH -1
#endif
#define CLKW ((volatile LAS unsigned long long*)(lds0 + LDSCTL_OFF + 768))
#define CLK0(k) do { if (MK_CLKPH == (k) && wave_s == 0) { CLKW[0] = __builtin_amdgcn_s_memtime(); CLKW[1] = __builtin_amdgcn_s_memrealtime(); } } while (0)
#ifndef MK_CLKDUR
#define MK_CLKDUR 0
#endif
#define CLK1(k) do { if (MK_CLKPH == (k) && wave_s == 0) { const unsigned long long c1_ = __builtin_amdgcn_s_memtime(), r1_ = __builtin_amdgcn_s_memrealtime(); CLKW[2] = MK_CLKDUR ? (r1_ - CLKW[1]) / 10ull : (c1_ - CLKW[0]) * 100ull / (r1_ - CLKW[1]); } } while (0)
#define NREP(k) ((((unsigned)MK_DUPMASK >> (k)) & 1u) ? 2 : 1)

constexpr size_t MiB = 1u << 20, KiB = 1024;
constexpr size_t WS_CTL = 0, CTL_ZERO_BYTES = 128 * KiB;
constexpr size_t WS_MOD = 1 * MiB;
constexpr size_t WS_ROPEC = 1 * MiB + 256 * KiB, WS_ROPES = WS_ROPEC + 512 * KiB;
constexpr size_t WS_TOKE = 2 * MiB + 256 * KiB, WS_TOKG = WS_TOKE + 256 * KiB, WS_TOKS = WS_TOKG + 256 * KiB;
constexpr size_t WS_SA = 3 * MiB + 512 * KiB;
constexpr size_t WS_PEXP = WS_TOKS + 256 * KiB, WS_WSB = WS_PEXP + 64 * KiB;
constexpr size_t WS_WEGU = 4 * MiB;
constexpr size_t WS_WED = 60 * MiB;
constexpr float WSC_GU = 32.f, WSC_D = 64.f;
constexpr size_t WS_H = 88 * MiB;
constexpr size_t WS_HN = 152 * MiB;
constexpr size_t WS_PROJ = 216 * MiB;
constexpr size_t WS_MIX0 = 328 * MiB;
constexpr size_t WS_ACT = 216 * MiB;
constexpr size_t WS_QN = 376 * MiB, WS_KVN = 408 * MiB, WS_KPE = 424 * MiB, WS_MIX1 = 426 * MiB;
constexpr size_t WS_Q = 216 * MiB, WS_KV = 264 * MiB;
constexpr size_t WS_WNE = 490 * MiB;
constexpr size_t WS_WIN0 = WS_WNE, WS_WO0 = WS_WIN0 + 3584 * KiB, WS_WGU0 = WS_WO0 + 2 * MiB, WS_WD0 = WS_WGU0 + 11 * MiB, WS_WIN1 = WS_WD0 + 5632 * KiB,
                 WS_WQB = WS_WIN1 + 5 * MiB, WS_WKVB = WS_WQB + 768 * KiB, WS_WO1 = WS_WKVB + 512 * KiB, WS_WNE_END = WS_WO1 + 2 * MiB;
constexpr int MOE_ROWS = 264 * 256;
constexpr size_t WS_XS = 152 * MiB;
constexpr size_t WS_HN2 = 218 * MiB;
constexpr size_t WS_Y = 152 * MiB;
constexpr size_t WS_ACTE = 284 * MiB;
constexpr size_t WS_END = 522 * MiB;
static_assert(WS_WNE_END <= WS_END && WS_MIX1 + 64 * MiB <= WS_WNE && WS_ACTE + (size_t)MOE_ROWS * FFE <= WS_END && WS_WED + (size_t)8 * DM * FFE <= WS_H && WS_H + (size_t)NTOK * DM * 2 <= WS_HN
              && WS_XS + (size_t)MOE_ROWS * DM <= WS_HN2 && WS_HN2 + (size_t)NTOK * DM <= WS_ACTE && WS_Y + (size_t)MOE_ROWS * DM * 2 <= WS_ACTE && WS_ACT + (size_t)NTOK * FF * 2 <= WS_MIX0 + 64 * MiB, "d_ws map");
constexpr int CW_TMO = 0, CW_CODE = 1, CW_BAR = 4096, CW_CNT = 8192, CW_CUR = 9216, CW_CM0 = 16384, CW_CM1 = CW_CM0 + 2048, CW_CMG = CW_CM1 + 2560, CW_CM_END = CW_CMG + 5632;
static_assert(CW_CM_END * 4 <= (int)CTL_ZERO_BYTES, "control words inside the memset");
constexpr int RING_BYTES = 131072, LDS_BYTES = 147456, LDSCTL_OFF = LDS_BYTES - 1024, MISC_OFF = LDSCTL_OFF + 320;

typedef unsigned v2u __attribute__((ext_vector_type(2)));
__device__ __forceinline__ unsigned pk2(float lo, float hi) { return pg8::cvt_pk_bf16(lo, hi); }
__device__ __forceinline__ float bflo(unsigned u) { return __uint_as_float(u << 16); }
__device__ __forceinline__ float bfhi(unsigned u) { return __uint_as_float(u & 0xffff0000u); }
__device__ __forceinline__ float bf2f(bf16 h) { return __uint_as_float(((unsigned)h) << 16); }
template <int CTRL> __device__ __forceinline__ float dpp_f(float v) { return __int_as_float(__builtin_amdgcn_update_dpp(0, __float_as_int(v), CTRL, 0xF, 0xF, true)); }
__device__ __forceinline__ float wave_sum(float v) {
    v += dpp_f<0xB1>(v); v += dpp_f<0x4E>(v); v += dpp_f<0x141>(v); v += dpp_f<0x140>(v);
    { auto r = __builtin_amdgcn_permlane16_swap(__float_as_uint(v), __float_as_uint(v), false, false); v = __uint_as_float(r[0]) + __uint_as_float(r[1]); }
    { auto r = __builtin_amdgcn_permlane32_swap(__float_as_uint(v), __float_as_uint(v), false, false); v = __uint_as_float(r[0]) + __uint_as_float(r[1]); }
    return v;
}
__device__ __forceinline__ float wave_max(float v) {
    v = fmaxf(v, dpp_f<0xB1>(v)); v = fmaxf(v, dpp_f<0x4E>(v)); v = fmaxf(v, dpp_f<0x141>(v)); v = fmaxf(v, dpp_f<0x140>(v));
    { auto r = __builtin_amdgcn_permlane16_swap(__float_as_uint(v), __float_as_uint(v), false, false); v = fmaxf(__uint_as_float(r[0]), __uint_as_float(r[1])); }
    { auto r = __builtin_amdgcn_permlane32_swap(__float_as_uint(v), __float_as_uint(v), false, false); v = fmaxf(__uint_as_float(r[0]), __uint_as_float(r[1])); }
    return v;
}
__device__ __forceinline__ float rsqrt_f(float x) { return 1.0f / sqrtf(x); }

struct Ctx { LAS unsigned char* lds; int tid, lane, wave, vcu, G, gw, NGW; };

__device__ __forceinline__ void transpose_item(const float* W, int K, int N, bf16* WT, int row_base, bool pp, LAS float* scr, int kb, int nb, int lane) {
    const int k0 = 64 * kb, n0 = 32 * nb;
    float tv_[32];
#pragma unroll
    for (int i = 0; i < 32; ++i) tv_[i] = W[(size_t)(k0 + 2 * i + (lane >> 5)) * N + n0 + (lane & 31)];
#pragma unroll
    for (int i = 0; i < 32; ++i) scr[(2 * i + (lane >> 5)) * 33 + (lane & 31)] = tv_[i];
    LDS_WAIT(); asm volatile("" ::: "memory");
    const int c = lane & 7;
#pragma unroll
    for (int j = 0; j < 4; ++j) { const int n = (lane >> 3) + 8 * j; const LAS float* s = scr + (8 * c) * 33 + n;
        v4u o; o.x = pk2(s[0 * 33], s[1 * 33]); o.y = pk2(s[2 * 33], s[3 * 33]); o.z = pk2(s[4 * 33], s[5 * 33]); o.w = pk2(s[6 * 33], s[7 * 33]);
        const int nd = pp ? ((n < 16) ? 2 * n : 2 * (n - 16) + 1) : n;
        *(v4u*)(WT + (size_t)(row_base + nd) * K + k0 + 8 * c) = o; }
    LDS_WAIT(); asm volatile("" ::: "memory");
}
__device__ __forceinline__ void transpose_item8(const float* W, int K, int N, unsigned char* WT, int row_base, float sc, LAS float* scr, int kb, int nb, int lane) {
    const int k0 = 64 * kb, n0 = 32 * nb;
    f32x4 tv_[8];
#pragma unroll
    for (int i = 0; i < 8; ++i) tv_[i] = *(const f32x4*)(W + (size_t)(k0 + 8 * i + (lane >> 3)) * N + n0 + 4 * (lane & 7));
#pragma unroll
    for (int i = 0; i < 8; ++i) { LAS float* d = scr + (8 * i + (lane >> 3)) * 33 + 4 * (lane & 7); d[0] = tv_[i].x; d[1] = tv_[i].y; d[2] = tv_[i].z; d[3] = tv_[i].w; }
    LDS_WAIT(); asm volatile("" ::: "memory");
    const int c = lane & 7;
#pragma unroll
    for (int j = 0; j < 4; ++j) { const int n = (lane >> 3) + 8 * j; const LAS float* s = scr + (8 * c) * 33 + n;
        v2u o; o.x = pg8::pack4_fp8(s[0 * 33] * sc, s[1 * 33] * sc, s[2 * 33] * sc, s[3 * 33] * sc); o.y = pg8::pack4_fp8(s[4 * 33] * sc, s[5 * 33] * sc, s[6 * 33] * sc, s[7 * 33] * sc);
        *(v2u*)(WT + (size_t)(row_base + n) * K + k0 + 8 * c) = o; }
    LDS_WAIT(); asm volatile("" ::: "memory");
}
__device__ __forceinline__ void amax_item(const float* W, int N, unsigned* cm, int row_base, bool pp, int kb, int nb, int lane) {
    const int k0 = 64 * kb, n0 = 32 * nb; float mx = 0.f;
#pragma unroll
    for (int i = 0; i < 32; ++i) mx = fmaxf(mx, fabsf(W[(size_t)(k0 + 2 * i + (lane >> 5)) * N + n0 + (lane & 31)]));
    mx = fmaxf(mx, __shfl_xor(mx, 32));
    if (lane < 32) { const int n = lane, nd = pp ? ((n < 16) ? 2 * n : 2 * (n - 16) + 1) : n; atomicMax(cm + row_base + nd, __float_as_uint(mx)); }
}
__device__ __forceinline__ void transpose_item_i8(const float* W, int K, int N, unsigned char* WT, int row_base, const unsigned* cm, LAS float* scr, int kb, int nb, int lane, bool pp = false) {
    const int k0 = 64 * kb, n0 = 32 * nb;
    float tv_[32];
#pragma unroll
    for (int i = 0; i < 32; ++i) tv_[i] = W[(size_t)(k0 + 2 * i + (lane >> 5)) * N + n0 + (lane & 31)];
#pragma unroll
    for (int i = 0; i < 32; ++i) scr[(2 * i + (lane >> 5)) * 33 + (lane & 31)] = tv_[i];
    LDS_WAIT(); asm volatile("" ::: "memory");
    const int c = lane & 7;
#pragma unroll
    for (int j = 0; j < 4; ++j) { const int n = (lane >> 3) + 8 * j; const LAS float* s = scr + (8 * c) * 33 + n;
        const int nd = pp ? ((n < 16) ? 2 * n : 2 * (n - 16) + 1) : n;
        const float cmv = __uint_as_float(cm[row_base + nd]), qs = cmv > 0.f ? 127.f / cmv : 0.f;
        v2u o; o.x = pg8::pack4_i8(s[0 * 33] * qs, s[1 * 33] * qs, s[2 * 33] * qs, s[3 * 33] * qs); o.y = pg8::pack4_i8(s[4 * 33] * qs, s[5 * 33] * qs, s[6 * 33] * qs, s[7 * 33] * qs);
        *(v2u*)(WT + (size_t)(row_base + nd) * K + k0 + 8 * c) = o; }
    LDS_WAIT(); asm volatile("" ::: "memory");
}
struct In {
    const float *x, *c, *e_ada_w, *e_ada_b, *e_nmix_g, *e_w_in, *e_sinks, *e_ln_g, *e_ln_b, *e_w_s, *e_b_s, *e_w_o, *e_nffn_g, *e_wg, *e_wu, *e_wd,
                *o_ada_w, *o_ada_b, *o_nmix_g, *o_w_in, *o_conv_w, *o_qn_g, *o_w_qb, *o_kvn_g, *o_w_kvb, *o_w_o, *o_nffn_g, *o_rw, *o_rb, *o_xg, *o_xu, *o_xd, *fin_g;
};
struct TD8 { const float* W; unsigned char* WT; int K, N, k0, n0, half, inter; float sc; };
__device__ __forceinline__ TD8 td8_decode(int t, const In& I, unsigned char* ws) {
    TD8 d; const int m = t / 1792, rr = t % 1792, e = rr / 224, r2 = rr % 224;
    if (m < 2) { d.W = (m ? I.o_xu : I.o_xg) + (size_t)e * DM * FFE; d.WT = ws + WS_WEGU + (size_t)e * 7168 * DM; d.K = DM; d.N = FFE; d.k0 = 64 * (r2 / 14); d.n0 = 256 * (r2 % 14); d.half = m; d.inter = 1; d.sc = WSC_GU; }
    else { d.W = I.o_xd + (size_t)e * FFE * DM; d.WT = ws + WS_WED + (size_t)e * DM * FFE; d.K = FFE; d.N = DM; d.k0 = 64 * (r2 / 4); d.n0 = 256 * (r2 % 4); d.half = 0; d.inter = 0; d.sc = WSC_D; }
    return d;
}
__device__ __forceinline__ int et8_tile(int i, int first, int stride) { return first + i * stride; }
#define ET8_LOAD(R, D) do { _Pragma("unroll") for (int i_ = 0; i_ < 8; ++i_) R[i_] = *(const f32x4*)((D).W + (size_t)((D).k0 + 8 * C.wave + i_) * (D).N + (D).n0 + 4 * C.lane); } while (0)
#define ET8_STEP(R, buf, c) do { \
        _Pragma("unroll") for (int i_ = 0; i_ < 8; ++i_) *(LAS f32x4*)((buf) + (8 * C.wave + i_) * TP + 4 * C.lane) = R[i_]; } while (0)
#define ET8_EMIT(buf, c) do { const int nl = 32 * C.wave + (C.lane & 31), kh = C.lane >> 5, n = (c).n0 + nl; \
          const LAS float* s = (buf) + (32 * kh) * TP + nl; float v[32]; \
          _Pragma("unroll") for (int j = 0; j < 32; ++j) v[j] = s[j * TP] * (c).sc; \
          v4u o0, o1; \
          o0.x = pg8::pack4_fp8(v[0], v[1], v[2], v[3]); o0.y = pg8::pack4_fp8(v[4], v[5], v[6], v[7]); o0.z = pg8::pack4_fp8(v[8], v[9], v[10], v[11]); o0.w = pg8::pack4_fp8(v[12], v[13], v[14], v[15]); \
          o1.x = pg8::pack4_fp8(v[16], v[17], v[18], v[19]); o1.y = pg8::pack4_fp8(v[20], v[21], v[22], v[23]); o1.z = pg8::pack4_fp8(v[24], v[25], v[26], v[27]); o1.w = pg8::pack4_fp8(v[28], v[29], v[30], v[31]); \
          const int row = (c).inter ? (256 * (n >> 7) + (n & 127) + 128 * (c).half) : n; \
          v4u* dst = (v4u*)((c).WT + (size_t)row * (c).K + (c).k0 + 32 * kh); dst[0] = o0; dst[1] = o1; } while (0)
__device__ __forceinline__ void expert_tiles8(const Ctx& C, const In& I, unsigned char* ws) {
    constexpr int TP = 260, NTILE = 3 * 1792;
    LAS float* const buf0 = (LAS float*)C.lds; LAS float* const buf1 = buf0 + 64 * TP;
    int first, stride, nmine;
    if (C.G == 256) { const bool gv = blockIdx.x < 192; first = gv ? (int)blockIdx.x : 3840 + ((int)blockIdx.x - 192); stride = gv ? 192 : 64; nmine = gv ? 20 : 24; }
    else { first = C.vcu; stride = C.G; nmine = (first < NTILE) ? (NTILE - 1 - first) / stride + 1 : 0; }
    if (nmine <= 0) return;
    TD8 dA = td8_decode(et8_tile(0, first, stride), I, ws), dB = dA; f32x4 rA[8], rB[8];
    ET8_LOAD(rA, dA);
    if (nmine > 1) { dB = td8_decode(et8_tile(1, first, stride), I, ws); ET8_LOAD(rB, dB); }
    for (int it = 0; it < nmine; it += 2) {
        { const TD8 c = dA; ET8_STEP(rA, buf0, c);
          if (it + 2 < nmine) { dA = td8_decode(et8_tile(it + 2, first, stride), I, ws); ET8_LOAD(rA, dA); }
          LDS_WAIT(); __syncthreads();
          ET8_EMIT(buf0, c); }
        if (it + 1 < nmine) { const TD8 c = dB; ET8_STEP(rB, buf1, c);
          if (it + 3 < nmine) { dB = td8_decode(et8_tile(it + 3, first, stride), I, ws); ET8_LOAD(rB, dB); }
          LDS_WAIT(); __syncthreads();
          ET8_EMIT(buf1, c); }
    }
    __syncthreads();
}
#undef ET8_LOAD
#undef ET8_STEP
#undef ET8_EMIT
__device__ __forceinline__ void p0_prologue(const Ctx& C, const In& I, unsigned char* ws) {
    if (blockIdx.x < 192) {
        const int layer = blockIdx.x / 96, cb = blockIdx.x % 96, j0 = cb * 64 + 4 * (C.lane & 15), rsub = C.lane >> 4;
        const float* W = layer ? I.o_ada_w : I.e_ada_w; const float* Bv = layer ? I.o_ada_b : I.e_ada_b;
        f32x4 acc[4]; acc[0] = acc[1] = acc[2] = acc[3] = (f32x4){0.f, 0.f, 0.f, 0.f};
#pragma unroll 1
        for (int ch = 0; ch < 4; ++ch) { const int k0 = C.wave * 128 + ch * 32; f32x4 wv[8];
#pragma unroll
            for (int i = 0; i < 8; ++i) wv[i] = *(const f32x4*)(W + (size_t)(k0 + 4 * i + rsub) * ADA + j0);
#pragma unroll
            for (int i = 0; i < 8; ++i) { const int k = k0 + 4 * i + rsub;
#pragma unroll
                for (int bb = 0; bb < 4; ++bb) { const float cv = I.c[bb * DM + k]; acc[bb] += wv[i] * (cv / (1.f + __expf(-cv))); } } }
#pragma unroll
        for (int bb = 0; bb < 4; ++bb)
#pragma unroll
            for (int e = 0; e < 4; ++e) { float v = acc[bb][e]; v += __shfl_xor(v, 16); v += __shfl_xor(v, 32); acc[bb][e] = v; }
        LAS float* red = (LAS float*)C.lds;
        if (C.lane < 16) {
#pragma unroll
            for (int bb = 0; bb < 4; ++bb) *(LAS f32x4*)(red + (C.wave * 4 + bb) * 64 + 4 * C.lane) = acc[bb]; }
        __syncthreads();
        if (C.tid < 256) { const int bb = C.tid >> 6, col = C.tid & 63; float s = 0.f;
#pragma unroll
            for (int w = 0; w < 8; ++w) s += red[(w * 4 + bb) * 64 + col];
            ((float*)(ws + WS_MOD))[(size_t)(layer * BATCH + bb) * ADA + cb * 64 + col] = s + Bv[cb * 64 + col]; }
        __syncthreads();
    }
    {
        bf16* wsb = (bf16*)(ws + WS_WSB);
        for (int idx = blockIdx.x * 512 + C.tid; idx < 8 * 128 * 128; idx += C.G * 512) { const int t = (idx >> 7) & 127, sp = idx & 127; wsb[idx] = (bf16)(pk2((sp <= t) ? I.e_w_s[idx] : 0.f, 0.f) & 0xffffu); }
        float* ct = (float*)(ws + WS_ROPEC); float* st = (float*)(ws + WS_ROPES);
        for (int idx = blockIdx.x * 512 + C.tid; idx < SEQ * 16; idx += C.G * 512) { const int pos = idx >> 4, i = idx & 15;
            const double inv = (double)exp2f(-(float)i * (13.287712379549449f / 16.0f));
            const double rev = (double)((float)pos * (float)inv) * 0.15915494309189535;
            const float fr = (float)(rev - __builtin_rint(rev));
            ct[idx] = __builtin_amdgcn_cosf(fr); st[idx] = __builtin_amdgcn_sinf(fr); }
    }
    LAS float* scr = (LAS float*)(C.lds + C.wave * 16384);
    constexpr int I_IN0 = 16 * 56, I_O = 16 * 32, I_GU0 = 16 * 88, I_D0 = 44 * 32, I_IN1 = 16 * 73, I_QB = 8 * 24, I_KVB = 4 * 32, I_XG1 = 16 * 112, I_XD1 = 56 * 32;
    constexpr int NITEMS = I_IN0 + I_O + 2 * I_GU0 + I_D0 + I_IN1 + I_QB + I_KVB + I_O;
    for (int it = C.gw; it < NITEMS; it += C.NGW) {
        int r = it;
        if (r < I_IN0) { const int kb = r / 56, nb = r % 56; amax_item(I.e_w_in, EVEN_IN, (unsigned*)(ws + WS_CTL) + CW_CM0, nb * 32, false, kb, nb, C.lane); continue; } r -= I_IN0;
        if (r < I_O) { const int kb = r / 32, nb = r % 32; transpose_item(I.e_w_o, DM, DM, (bf16*)(ws + WS_WO0), nb * 32, false, scr, kb, nb, C.lane); continue; } r -= I_O;
        if (r < I_GU0) { const int kb = r / 88, nb = r % 88, n0 = nb * 32; amax_item(I.e_wg, FF, (unsigned*)(ws + WS_CTL) + CW_CMG, 256 * (n0 >> 7) + (n0 & 127), false, kb, nb, C.lane); continue; } r -= I_GU0;
        if (r < I_GU0) { const int kb = r / 88, nb = r % 88, n0 = nb * 32; amax_item(I.e_wu, FF, (unsigned*)(ws + WS_CTL) + CW_CMG, 256 * (n0 >> 7) + (n0 & 127) + 128, false, kb, nb, C.lane); continue; } r -= I_GU0;
        if (r < I_D0) { const int kb = r / 32, nb = r % 32; transpose_item8(I.e_wd, FF, DM, (unsigned char*)(ws + WS_WD0), nb * 32, WSC_D, scr, kb, nb, C.lane); continue; } r -= I_D0;
        if (r < I_IN1) { const int kb = r / 73, nb = r % 73; amax_item(I.o_w_in, ODD_IN, (unsigned*)(ws + WS_CTL) + CW_CM1, nb * 32, nb == 72, kb, nb, C.lane); continue; } r -= I_IN1;
        if (r < I_QB) { const int kb = r / 24, nb = r % 24; transpose_item(I.o_w_qb, 512, 768, (bf16*)(ws + WS_WQB), nb * 32, (nb % 3) == 2, scr, kb, nb, C.lane); continue; } r -= I_QB;
        if (r < I_KVB) { const int kb = r / 32, nb = r % 32; transpose_item(I.o_w_kvb, 256, 1024, (bf16*)(ws + WS_WKVB), nb * 32, false, scr, kb, nb, C.lane); continue; } r -= I_KVB;
        if (r < I_O) { const int kb = r / 32, nb = r % 32; transpose_item(I.o_w_o, DM, DM, (bf16*)(ws + WS_WO1), nb * 32, false, scr, kb, nb, C.lane); continue; } r -= I_O;
    }
    __syncthreads();
    expert_tiles8(C, I, ws);
}

__device__ __forceinline__ void unpack8(const v4u w, float (&x)[8]) { x[0] = bflo(w.x); x[1] = bfhi(w.x); x[2] = bflo(w.y); x[3] = bfhi(w.y); x[4] = bflo(w.z); x[5] = bfhi(w.z); x[6] = bflo(w.w); x[7] = bfhi(w.w); }
template <bool IN_F32> __device__ __forceinline__ void load_row16(const void* h, int m, int lane, float (&x)[2][8]) {
    if (IN_F32) { const f32x4* p = (const f32x4*)((const float*)h + (size_t)m * DM) + 2 * lane;
#pragma unroll
        for (int j = 0; j < 2; ++j) { const f32x4 a = p[128 * j], b = p[128 * j + 1]; x[j][0] = a.x; x[j][1] = a.y; x[j][2] = a.z; x[j][3] = a.w; x[j][4] = b.x; x[j][5] = b.y; x[j][6] = b.z; x[j][7] = b.w; } }
    else { const v4u* p = (const v4u*)((const bf16*)h + (size_t)m * DM) + lane;
#pragma unroll
        for (int j = 0; j < 2; ++j) unpack8(p[64 * j], x[j]); }
}
template <bool IN_F32> struct RowPair {
    v4u w[2][IN_F32 ? 4 : 2];
    __device__ __forceinline__ void issue(const void* h, int m0, int lane) {
#pragma unroll
        for (int rr = 0; rr < 2; ++rr) {
            if (IN_F32) { const v4u* p = (const v4u*)((const float*)h + (size_t)(m0 + rr) * DM) + 2 * lane; w[rr][0] = p[0]; w[rr][1] = p[1]; w[rr][2] = p[128]; w[rr][3] = p[129]; }
            else { const v4u* p = (const v4u*)((const bf16*)h + (size_t)(m0 + rr) * DM) + lane; w[rr][0] = p[0]; w[rr][1] = p[64]; } }
    }
    __device__ __forceinline__ void unpack(float (&x)[2][2][8]) const {
#pragma unroll
        for (int rr = 0; rr < 2; ++rr)
#pragma unroll
            for (int j = 0; j < 2; ++j) {
                if (IN_F32) { const v4u a = w[rr][2 * j], b = w[rr][2 * j + 1]; x[rr][j][0] = __uint_as_float(a.x); x[rr][j][1] = __uint_as_float(a.y); x[rr][j][2] = __uint_as_float(a.z); x[rr][j][3] = __uint_as_float(a.w);
                    x[rr][j][4] = __uint_as_float(b.x); x[rr][j][5] = __uint_as_float(b.y); x[rr][j][6] = __uint_as_float(b.z); x[rr][j][7] = __uint_as_float(b.w); }
                else unpack8(w[rr][j], x[rr][j]); }
    }
};
template <bool IN_F32, bool OUT8> __device__ __forceinline__ void modulate2(const Ctx& C, const void* h, const float* g, const float* shift, const float* scale, void* hn) {
    RowPair<IN_F32> nx; if (2 * C.gw < NTOK) nx.issue(h, 2 * C.gw, C.lane);
    for (int m0 = 2 * C.gw; m0 < NTOK; m0 += 2 * C.NGW) {
        const int b = m0 >> 13;
        float x[2][2][8];
        nx.unpack(x); if (m0 + 2 * C.NGW < NTOK) nx.issue(h, m0 + 2 * C.NGW, C.lane);
        float r[2];
#pragma unroll
        for (int rr = 0; rr < 2; ++rr) { float s = 0.f;
#pragma unroll
            for (int j = 0; j < 2; ++j)
#pragma unroll
                for (int k = 0; k < 8; ++k) s += x[rr][j][k] * x[rr][j][k];
            r[rr] = rsqrt_f(wave_sum(s) * (1.f / DM) + NORM_EPS); }
#pragma unroll
        for (int j = 0; j < 2; ++j) { const int c4 = 2 * C.lane + 128 * j;
            const f32x4 g0 = ((const f32x4*)g)[c4], g1 = ((const f32x4*)g)[c4 + 1], s0 = ((const f32x4*)(scale + (size_t)b * ADA))[c4], s1 = ((const f32x4*)(scale + (size_t)b * ADA))[c4 + 1],
                        h0 = ((const f32x4*)(shift + (size_t)b * ADA))[c4], h1 = ((const f32x4*)(shift + (size_t)b * ADA))[c4 + 1];
            const float mg[8] = {g0.x * (s0.x + 1.f), g0.y * (s0.y + 1.f), g0.z * (s0.z + 1.f), g0.w * (s0.w + 1.f), g1.x * (s1.x + 1.f), g1.y * (s1.y + 1.f), g1.z * (s1.z + 1.f), g1.w * (s1.w + 1.f)};
            const float sh[8] = {h0.x, h0.y, h0.z, h0.w, h1.x, h1.y, h1.z, h1.w};
#pragma unroll
            for (int rr = 0; rr < 2; ++rr) { float o[8];
#pragma unroll
                for (int k = 0; k < 8; ++k) o[k] = x[rr][j][k] * r[rr] * mg[k] + sh[k];
                if (OUT8) { v2u w; w.x = pg8::pack4_fp8(o[0], o[1], o[2], o[3]); w.y = pg8::pack4_fp8(o[4], o[5], o[6], o[7]); ((v2u*)((unsigned char*)hn + (size_t)(m0 + rr) * DM))[C.lane + 64 * j] = w; }
                else { v4u w; w.x = pk2(o[0], o[1]); w.y = pk2(o[2], o[3]); w.z = pk2(o[4], o[5]); w.w = pk2(o[6], o[7]); ((v4u*)((bf16*)hn + (size_t)(m0 + rr) * DM))[C.lane + 64 * j] = w; } } }
    }
}

template <bool IN_F32> __device__ __forceinline__ void modulate2_i8(const Ctx& C, const void* h, const float* g, const float* shift, const float* scale, unsigned char* hn, float* sa) {
    RowPair<IN_F32> nx; if (2 * C.gw < NTOK) nx.issue(h, 2 * C.gw, C.lane);
    for (int m0 = 2 * C.gw; m0 < NTOK; m0 += 2 * C.NGW) {
        const int b = m0 >> 13;
        float x[2][2][8];
        nx.unpack(x); if (m0 + 2 * C.NGW < NTOK) nx.issue(h, m0 + 2 * C.NGW, C.lane);
        float r[2];
#pragma unroll
        for (int rr = 0; rr < 2; ++rr) { float s = 0.f;
#pragma unroll
            for (int j = 0; j < 2; ++j)
#pragma unroll
                for (int k = 0; k < 8; ++k) s += x[rr][j][k] * x[rr][j][k];
            r[rr] = rsqrt_f(wave_sum(s) * (1.f / DM) + NORM_EPS); }
        float mx[2] = {0.f, 0.f};
#pragma unroll
        for (int j = 0; j < 2; ++j) { const int c4 = 2 * C.lane + 128 * j;
            const f32x4 g0 = ((const f32x4*)g)[c4], g1 = ((const f32x4*)g)[c4 + 1], s0 = ((const f32x4*)(scale + (size_t)b * ADA))[c4], s1 = ((const f32x4*)(scale + (size_t)b * ADA))[c4 + 1],
                        h0 = ((const f32x4*)(shift + (size_t)b * ADA))[c4], h1 = ((const f32x4*)(shift + (size_t)b * ADA))[c4 + 1];
            const float mg[8] = {g0.x * (s0.x + 1.f), g0.y * (s0.y + 1.f), g0.z * (s0.z + 1.f), g0.w * (s0.w + 1.f), g1.x * (s1.x + 1.f), g1.y * (s1.y + 1.f), g1.z * (s1.z + 1.f), g1.w * (s1.w + 1.f)};
            const float sh[8] = {h0.x, h0.y, h0.z, h0.w, h1.x, h1.y, h1.z, h1.w};
#pragma unroll
            for (int rr = 0; rr < 2; ++rr)
#pragma unroll
                for (int k = 0; k < 8; ++k) { x[rr][j][k] = x[rr][j][k] * r[rr] * mg[k] + sh[k]; mx[rr] = fmaxf(mx[rr], fabsf(x[rr][j][k])); } }
#pragma unroll
        for (int rr = 0; rr < 2; ++rr) {
            mx[rr] = wave_max(mx[rr]);
            const float qs = mx[rr] > 0.f ? 127.f / mx[rr] : 0.f;
            if (C.lane == 0) sa[m0 + rr] = mx[rr] * (1.f / 127.f);
#pragma unroll
            for (int j = 0; j < 2; ++j) { v2u w; w.x = pg8::pack4_i8(x[rr][j][0] * qs, x[rr][j][1] * qs, x[rr][j][2] * qs, x[rr][j][3] * qs); w.y = pg8::pack4_i8(x[rr][j][4] * qs, x[rr][j][5] * qs, x[rr][j][6] * qs, x[rr][j][7] * qs);
                ((v2u*)(hn + (size_t)(m0 + rr) * DM))[C.lane + 64 * j] = w; } }
    }
}

struct OddRaw {
    v4u zg[4], zx[4], gb[2], ql[2]; v2u kv[2]; unsigned rp[2];
    __device__ __forceinline__ void issue(const bf16* proj, int m0, int lane) {
        const int pos0 = m0 & (SEQ - 1); const bf16* pr = proj + (size_t)m0 * ODD_IN_PAD; const int c0 = lane * 8;
#pragma unroll
        for (int i = 0; i < 4; ++i) { const int dt = 2 - i;
            if (pos0 >= dt) { const bf16* p2 = pr - (ptrdiff_t)dt * ODD_IN_PAD; zg[i] = *(const v4u*)(p2 + 512 + c0); zx[i] = *(const v4u*)(p2 + 1024 + c0); }
            else { zg[i] = (v4u){0u, 0u, 0u, 0u}; zx[i] = (v4u){0u, 0u, 0u, 0u}; } }
#pragma unroll
        for (int rr = 0; rr < 2; ++rr) { const bf16* p1 = pr + (size_t)rr * ODD_IN_PAD;
            gb[rr] = *(const v4u*)(p1 + c0); ql[rr] = *(const v4u*)(p1 + 1536 + c0); kv[rr] = *(const v2u*)(p1 + 2048 + lane * 4);
            rp[rr] = (lane < 16) ? *(const unsigned*)(p1 + 2304 + 2 * lane) : 0u; }
    }
};
__device__ __forceinline__ void odd_pre(const Ctx& C, const bf16* proj, const float* conv_w, const float* qn_g, const float* kvn_g, const float* ctab, const float* stab,
                                        bf16* mix, bf16* qn, bf16* kvn, bf16* kpe) {
    const int c0 = C.lane * 8;
    float cw[3][8];
#pragma unroll
    for (int jj = 0; jj < 3; ++jj) { const f32x4 w0 = *(const f32x4*)(conv_w + jj * 512 + c0), w1 = *(const f32x4*)(conv_w + jj * 512 + c0 + 4); cw[jj][0] = w0.x; cw[jj][1] = w0.y; cw[jj][2] = w0.z; cw[jj][3] = w0.w; cw[jj][4] = w1.x; cw[jj][5] = w1.y; cw[jj][6] = w1.z; cw[jj][7] = w1.w; }
    OddRaw nx; if (2 * C.gw < NTOK) nx.issue(proj, 2 * C.gw, C.lane);
    for (int m0 = 2 * C.gw; m0 < NTOK; m0 += 2 * C.NGW) {
        const int pos0 = m0 & (SEQ - 1);
        const OddRaw cu = nx; if (m0 + 2 * C.NGW < NTOK) nx.issue(proj, m0 + 2 * C.NGW, C.lane);
        float z[4][8];
#pragma unroll
        for (int i = 0; i < 4; ++i) { float a[8], xx[8]; unpack8(cu.zg[i], a); unpack8(cu.zx[i], xx);
#pragma unroll
            for (int k = 0; k < 8; ++k) z[i][k] = a[k] * xx[k]; }
#pragma unroll
        for (int rr = 0; rr < 2; ++rr) { const int m = m0 + rr;
            float gb[8]; unpack8(cu.gb[rr], gb); float y[8];
#pragma unroll
            for (int k = 0; k < 8; ++k) y[k] = gb[k] * (cw[0][k] * z[rr][k] + cw[1][k] * z[rr + 1][k] + cw[2][k] * z[rr + 2][k]);
            { v4u o; o.x = pk2(y[0], y[1]); o.y = pk2(y[2], y[3]); o.z = pk2(y[4], y[5]); o.w = pk2(y[6], y[7]); *(v4u*)(mix + (size_t)m * DM + c0) = o; }
            { float x[8]; unpack8(cu.ql[rr], x); float s = 0.f;
#pragma unroll
              for (int k = 0; k < 8; ++k) s += x[k] * x[k];
              const float r = rsqrt_f(wave_sum(s) * (1.f / 512.f) + NORM_EPS);
              const f32x4 g0 = *(const f32x4*)(qn_g + c0), g1 = *(const f32x4*)(qn_g + c0 + 4);
              v4u o; o.x = pk2(x[0] * r * g0.x, x[1] * r * g0.y); o.y = pk2(x[2] * r * g0.z, x[3] * r * g0.w); o.z = pk2(x[4] * r * g1.x, x[5] * r * g1.y); o.w = pk2(x[6] * r * g1.z, x[7] * r * g1.w);
              *(v4u*)(qn + (size_t)m * 512 + c0) = o; }
            { const v2u w = cu.kv[rr]; const float x[4] = {bflo(w.x), bfhi(w.x), bflo(w.y), bfhi(w.y)};
              const float s = (x[0] * x[0] + x[1] * x[1]) + (x[2] * x[2] + x[3] * x[3]);
              const float r = rsqrt_f(wave_sum(s) * (1.f / 256.f) + NORM_EPS);
              const f32x4 g0 = *(const f32x4*)(kvn_g + C.lane * 4);
              v2u o; o.x = pk2(x[0] * r * g0.x, x[1] * r * g0.y); o.y = pk2(x[2] * r * g0.z, x[3] * r * g0.w);
              *(v2u*)(kvn + (size_t)m * 256 + C.lane * 4) = o; }
            if (C.lane < 16) { const int pos = pos0 + rr; const unsigned w = cu.rp[rr]; const float x1 = bflo(w), x2 = bfhi(w), cs = ctab[pos * 16 + C.lane], sn = stab[pos * 16 + C.lane];
                *(unsigned*)(kpe + (size_t)m * 32 + 2 * C.lane) = pk2(x1 * cs - x2 * sn, x1 * sn + x2 * cs); } }
    }
}

__device__ __forceinline__ void modulate_route(const Ctx& C, const bf16* h, const float* g, const float* shift, const float* scale, const float* rw, const float* rb,
                                               unsigned char* hn, int* tok_e, float* tok_g, unsigned* counts) {
    volatile LAS unsigned* hist = (volatile LAS unsigned*)(C.lds + LDSCTL_OFF);
    f32x4 w[2][8][2];
#pragma unroll
    for (int j = 0; j < 2; ++j)
#pragma unroll
        for (int k = 0; k < 8; ++k) { const float* p = rw + (size_t)(512 * j + 8 * C.lane + k) * 8; w[j][k][0] = *(const f32x4*)p; w[j][k][1] = *(const f32x4*)(p + 4); }
    RowPair<false> nx; if (2 * C.gw < NTOK) nx.issue(h, 2 * C.gw, C.lane);
    for (int m0 = 2 * C.gw; m0 < NTOK; m0 += 2 * C.NGW) {
        const int b = m0 >> 13;
        float x[2][2][8];
        nx.unpack(x); if (m0 + 2 * C.NGW < NTOK) nx.issue(h, m0 + 2 * C.NGW, C.lane);
        float r[2];
#pragma unroll
        for (int rr = 0; rr < 2; ++rr) { float s = 0.f;
#pragma unroll
            for (int j = 0; j < 2; ++j)
#pragma unroll
                for (int k = 0; k < 8; ++k) s += x[rr][j][k] * x[rr][j][k];
            r[rr] = rsqrt_f(wave_sum(s) * (1.f / DM) + NORM_EPS); }
        f32x4 la[2], lb[2]; la[0] = la[1] = lb[0] = lb[1] = (f32x4){0.f, 0.f, 0.f, 0.f};
#pragma unroll
        for (int j = 0; j < 2; ++j) { const int c4 = 2 * C.lane + 128 * j;
            const f32x4 g0 = ((const f32x4*)g)[c4], g1 = ((const f32x4*)g)[c4 + 1], s0 = ((const f32x4*)(scale + (size_t)b * ADA))[c4], s1 = ((const f32x4*)(scale + (size_t)b * ADA))[c4 + 1],
                        h0 = ((const f32x4*)(shift + (size_t)b * ADA))[c4], h1 = ((const f32x4*)(shift + (size_t)b * ADA))[c4 + 1];
            const float mg[8] = {g0.x * (s0.x + 1.f), g0.y * (s0.y + 1.f), g0.z * (s0.z + 1.f), g0.w * (s0.w + 1.f), g1.x * (s1.x + 1.f), g1.y * (s1.y + 1.f), g1.z * (s1.z + 1.f), g1.w * (s1.w + 1.f)};
            const float sh[8] = {h0.x, h0.y, h0.z, h0.w, h1.x, h1.y, h1.z, h1.w};
#pragma unroll
            for (int rr = 0; rr < 2; ++rr) { float o[8];
#pragma unroll
                for (int k = 0; k < 8; ++k) { o[k] = x[rr][j][k] * r[rr] * mg[k] + sh[k]; la[rr] += w[j][k][0] * o[k]; lb[rr] += w[j][k][1] * o[k]; }
                v2u wv; wv.x = pg8::pack4_fp8(o[0], o[1], o[2], o[3]); wv.y = pg8::pack4_fp8(o[4], o[5], o[6], o[7]); ((v2u*)(hn + (size_t)(m0 + rr) * DM))[C.lane + 64 * j] = wv; } }
#pragma unroll
        for (int rr = 0; rr < 2; ++rr) { const int m = m0 + rr;
            float lg[8] = {la[rr].x, la[rr].y, la[rr].z, la[rr].w, lb[rr].x, lb[rr].y, lb[rr].z, lb[rr].w};
#pragma unroll
            for (int e = 0; e < 8; ++e) lg[e] = wave_sum(lg[e]) + rb[e];
            int e0 = 0; float v0 = lg[0];
#pragma unroll
            for (int e = 1; e < 8; ++e) if (lg[e] > v0) { v0 = lg[e]; e0 = e; }
            int e1 = -1; float v1 = -INFINITY;
#pragma unroll
            for (int e = 0; e < 8; ++e) if (e != e0 && lg[e] > v1) { v1 = lg[e]; e1 = e; }
            const float p1 = __expf(v1 - v0), g0 = 1.f / (1.f + p1), g1 = p1 * g0;
            if (C.lane == 0) { tok_e[2 * m] = e0; tok_e[2 * m + 1] = e1; tok_g[2 * m] = g0; tok_g[2 * m + 1] = g1;
                __hip_atomic_fetch_add((LAS unsigned*)&hist[e0], 1u, __ATOMIC_RELAXED, __HIP_MEMORY_SCOPE_WORKGROUP); __hip_atomic_fetch_add((LAS unsigned*)&hist[e1], 1u, __ATOMIC_RELAXED, __HIP_MEMORY_SCOPE_WORKGROUP); } }
    }
    LDS_WAIT(); __syncthreads();
    if (C.tid < 8) { const unsigned n = hist[C.tid]; if (n) __hip_atomic_fetch_add(counts + 64 * C.tid, n, __ATOMIC_RELAXED, __HIP_MEMORY_SCOPE_AGENT); }
    __syncthreads();
}

__device__ __forceinline__ void moe_pstart(const unsigned* counts, int (&pstart)[8], int (&pend)[8]) {
    int acc = 0;
#pragma unroll
    for (int e = 0; e < 8; ++e) { const int n = (int)__hip_atomic_load(counts + 64 * e, __ATOMIC_RELAXED, __HIP_MEMORY_SCOPE_AGENT); pstart[e] = acc; acc += (n + 255) >> 8; pend[e] = acc; }
}
__device__ __forceinline__ void moe_gather(const Ctx& C, const unsigned char* hn, const int* tok_e, const unsigned* counts, unsigned* cursor, int* tok_slot, unsigned char* xs, int* pexp) {
    int pstart[8], pend[8]; moe_pstart(counts, pstart, pend);
    if (blockIdx.x == 0 && C.tid < 273) { int e = 0;
#pragma unroll
        for (int k = 0; k < 7; ++k) e += (C.tid >= pend[k]) ? 1 : 0;
        pexp[C.tid] = (C.tid == 272) ? pend[7] : e; }
    for (int task = C.gw; task < NTOK / 16; task += C.NGW) {
        const int tok = task * 16 + (C.lane & 15); const bool act = C.lane < 16;
        v4u a[16];
#pragma unroll
        for (int i = 0; i < 16; ++i) a[i] = ((const v4u*)(hn + (size_t)(task * 16 + i) * DM))[C.lane];
        const int e0 = act ? tok_e[2 * tok] : -1, e1 = act ? tok_e[2 * tok + 1] : -2;
        const unsigned long long lt = (1ull << C.lane) - 1ull;
        unsigned long long m0[8], m1[8]; int myn = 0;
#pragma unroll
        for (int e = 0; e < 8; ++e) { m0[e] = __ballot(e0 == e); m1[e] = __ballot(e1 == e); if (C.lane == e) myn = __popcll(m0[e]) + __popcll(m1[e]); }
        unsigned mybase = 0u; if (C.lane < 8 && myn > 0) mybase = __hip_atomic_fetch_add(cursor + 64 * C.lane, (unsigned)myn, __ATOMIC_RELAXED, __HIP_MEMORY_SCOPE_AGENT);
        int s0 = 0, s1 = 0;
#pragma unroll
        for (int e = 0; e < 8; ++e) { const unsigned base = (unsigned)__builtin_amdgcn_readlane((int)mybase, e) + (unsigned)pstart[e] * 256u;
            if (e0 == e) s0 = (int)base + __popcll(m0[e] & lt); if (e1 == e) s1 = (int)base + __popcll(m0[e]) + __popcll(m1[e] & lt); }
        if (act) { tok_slot[2 * tok] = s0; tok_slot[2 * tok + 1] = s1; }
#pragma unroll
        for (int i = 0; i < 16; ++i) { const int d0 = __builtin_amdgcn_readlane(s0, i), d1 = __builtin_amdgcn_readlane(s1, i);
            ((v4u*)(xs + (size_t)d0 * DM))[C.lane] = a[i]; ((v4u*)(xs + (size_t)d1 * DM))[C.lane] = a[i]; }
    }
}

__device__ __forceinline__ void final_rows(int gw, int NGW, int lane, const bf16* h, float* out, const bf16* y, const int* tok_slot, const float* tok_g, const float* gate, const float* fin_g, int s_ready, int mode) {
    int nsl[4] = {0, 0, 0, 0};
    struct Raw { v4u hx[2][2], ya[2][2], yb[2][2]; float g0[2], g1[2]; int sl[2][2]; bool sel[2]; bool any; };
    Raw nr; nr.any = false;
    auto issue_rows = [&](Raw& r, int m0, const int (&s4)[4]) {
#pragma unroll
        for (int rr = 0; rr < 2; ++rr) { r.sl[rr][0] = __builtin_amdgcn_readfirstlane(s4[2 * rr]); r.sl[rr][1] = __builtin_amdgcn_readfirstlane(s4[2 * rr + 1]);
            const bool ready = r.sl[rr][0] < s_ready && r.sl[rr][1] < s_ready; r.sel[rr] = mode ? !ready : ready; }
        r.any = r.sel[0] || r.sel[1];
        if (r.any) {
#pragma unroll
            for (int rr = 0; rr < 2; ++rr) { const int m = m0 + rr; r.g0[rr] = tok_g[2 * m]; r.g1[rr] = tok_g[2 * m + 1];
                const v4u* ph = (const v4u*)(h + (size_t)m * DM) + lane; const v4u* pa = (const v4u*)(y + (size_t)r.sl[rr][0] * DM) + lane; const v4u* pb = (const v4u*)(y + (size_t)r.sl[rr][1] * DM) + lane;
                r.hx[rr][0] = ph[0]; r.hx[rr][1] = ph[64]; r.ya[rr][0] = pa[0]; r.ya[rr][1] = pa[64]; r.yb[rr][0] = pb[0]; r.yb[rr][1] = pb[64]; } }
    };
    const int mfirst = 2 * gw, mstep = 2 * NGW;
    if (mfirst < NTOK) {
#pragma unroll
        for (int k = 0; k < 4; ++k) nsl[k] = tok_slot[2 * mfirst + k];
        issue_rows(nr, mfirst, nsl);
        if (mfirst + mstep < NTOK) {
#pragma unroll
            for (int k = 0; k < 4; ++k) nsl[k] = tok_slot[2 * (mfirst + mstep) + k]; } }
    for (int m0 = mfirst; m0 < NTOK; m0 += mstep) {
        const int b = m0 >> 13;
        const Raw cu = nr;
        if (m0 + mstep < NTOK) { issue_rows(nr, m0 + mstep, nsl);
            if (m0 + 2 * mstep < NTOK) {
#pragma unroll
                for (int k = 0; k < 4; ++k) nsl[k] = tok_slot[2 * (m0 + 2 * mstep) + k]; } }
        if (!cu.any) continue;
        float v[2][2][8]; float r[2];
#pragma unroll
        for (int rr = 0; rr < 2; ++rr) { const float g0 = cu.g0[rr], g1 = cu.g1[rr];
            float hx[2][8], ya[2][8], yb[2][8];
#pragma unroll
            for (int j = 0; j < 2; ++j) { unpack8(cu.hx[rr][j], hx[j]); unpack8(cu.ya[rr][j], ya[j]); unpack8(cu.yb[rr][j], yb[j]); }
            float s = 0.f;
#pragma unroll
            for (int j = 0; j < 2; ++j) { const int c4 = 2 * lane + 128 * j; const f32x4 t0 = ((const f32x4*)(gate + (size_t)b * ADA))[c4], t1 = ((const f32x4*)(gate + (size_t)b * ADA))[c4 + 1];
                const float gt[8] = {t0.x, t0.y, t0.z, t0.w, t1.x, t1.y, t1.z, t1.w};
#pragma unroll
                for (int k = 0; k < 8; ++k) { v[rr][j][k] = hx[j][k] + gt[k] * (g0 * ya[j][k] + g1 * yb[j][k]); s += v[rr][j][k] * v[rr][j][k]; } }
            r[rr] = s; }
#pragma unroll
        for (int rr = 0; rr < 2; ++rr) r[rr] = rsqrt_f(wave_sum(r[rr]) * (1.f / DM) + NORM_EPS);
#pragma unroll
        for (int rr = 0; rr < 2; ++rr) { if (!cu.sel[rr]) continue;
#pragma unroll
            for (int j = 0; j < 2; ++j) { const int c4 = 2 * lane + 128 * j; const f32x4 f0 = ((const f32x4*)fin_g)[c4], f1 = ((const f32x4*)fin_g)[c4 + 1];
                f32x4* op = (f32x4*)(out + (size_t)(m0 + rr) * DM) + c4;
                op[0] = (f32x4){v[rr][j][0] * r[rr] * f0.x, v[rr][j][1] * r[rr] * f0.y, v[rr][j][2] * r[rr] * f0.z, v[rr][j][3] * r[rr] * f0.w};
                op[1] = (f32x4){v[rr][j][4] * r[rr] * f1.x, v[rr][j][5] * r[rr] * f1.y, v[rr][j][6] * r[rr] * f1.z, v[rr][j][7] * r[rr] * f1.w}; } }
    }
}

struct Args { In in; float* out; unsigned char* ws; int ph_lo, ph_hi; };
__global__ void __launch_bounds__(NWAVES * 64, 2) fwd(Args args) {
    extern __shared__ __attribute__((aligned(16))) unsigned char lds_raw[];
#define MKCTX() Ctx C; { int t_ = tid_from_wave(wave_s); asm volatile("" : "+v"(t_)); C.lds = (LAS unsigned char*)lds_raw; C.tid = t_; C.lane = t_ & 63; C.wave = __builtin_amdgcn_readfirstlane(t_ >> 6); \
        C.G = gridDim.x; const int bx_ = blockIdx.x; C.vcu = (C.G % 8 == 0) ? (bx_ % 8) * (C.G / 8) + bx_ / 8 : bx_; C.gw = C.vcu * NWAVES + C.wave; C.NGW = C.G * NWAVES; }
    LAS unsigned char* const lds0 = (LAS unsigned char*)lds_raw;
    const int wave_s = __builtin_amdgcn_readfirstlane((int)(threadIdx.x >> 6));
    unsigned char* ws = args.ws; const In& I = args.in;
    unsigned* ctl = (unsigned*)(ws + WS_CTL);
    for (int u = threadIdx.x; u < (LDS_BYTES - LDSCTL_OFF) / 4; u += NWAVES * 64) ((LAS unsigned*)(lds0 + LDSCTL_OFF))[u] = 0u;
    __syncthreads();
    XcdBarrier bar; bar.bar = ctl + CW_BAR; bar.x = 0; bar.st = nullptr; bar.wave = wave_s;
    if (!MK_PER_PHASE) bar = xcd_barrier_post(ctl + CW_BAR, (volatile LAS unsigned*)(lds0 + MISC_OFF) + 8, wave_s);
    const int lo = args.ph_lo, hi = args.ph_hi;
#define IN(k) (lo <= (k) && (k) < hi)
#define SEAM(k) do { if (!MK_PER_PHASE && IN(k) && IN((k) + 1)) xcd_barrier(bar); } while (0)

    bf16* const hbuf = (bf16*)(ws + WS_H);
    const float* mod0 = (const float*)(ws + WS_MOD); const float* mod1 = mod0 + BATCH * ADA;
    bf16* const HN = (bf16*)(ws + WS_HN); bf16* const PROJ = (bf16*)(ws + WS_PROJ); bf16* const MIX0 = (bf16*)(ws + WS_MIX0); bf16* const ACT = (bf16*)(ws + WS_ACT);
    bf16* const QN = (bf16*)(ws + WS_QN); bf16* const KVN = (bf16*)(ws + WS_KVN); bf16* const KPE = (bf16*)(ws + WS_KPE); bf16* const MIX1 = (bf16*)(ws + WS_MIX1);
    bf16* const Q = (bf16*)(ws + WS_Q); bf16* const KV = (bf16*)(ws + WS_KV); unsigned char* const HN2 = ws + WS_HN2; unsigned char* const XS = ws + WS_XS; unsigned char* const ACTE = ws + WS_ACTE; bf16* const YB = (bf16*)(ws + WS_Y);
    const float* ctab = (const float*)(ws + WS_ROPEC); const float* stab = (const float*)(ws + WS_ROPES);
    int* const pexp = (int*)(ws + WS_PEXP); int* tok_e = (int*)(ws + WS_TOKE); float* tok_g = (float*)(ws + WS_TOKG); int* tok_slot = (int*)(ws + WS_TOKS);

    CLK0(0);
    if (IN(0)) for (int rep_ = 0; rep_ < NREP(0); ++rep_) { MKCTX(); p0_prologue(C, I, ws); } if (!MK_CLKDUR) CLK1(0); SEAM(0); if (MK_CLKDUR) CLK1(0);
    CLK0(1);
    if (IN(1)) for (int rep_ = 0; rep_ < NREP(1); ++rep_) { MKCTX(); modulate2_i8<true>(C, I.x, I.e_nmix_g, mod0 + 0 * DM, mod0 + 1 * DM, (unsigned char*)HN, (float*)(ws + WS_SA));
        { LAS float* scr = (LAS float*)(C.lds + C.wave * 16384);
          for (int it = C.gw; it < 16 * 56; it += C.NGW) { const int kb = it / 56, nb = it % 56; transpose_item_i8(I.e_w_in, DM, EVEN_IN, ws + WS_WIN0, nb * 32, ctl + CW_CM0, scr, kb, nb, C.lane); } } } if (!MK_CLKDUR) CLK1(1); SEAM(1); if (MK_CLKDUR) CLK1(1);
    CLK0(2);
    if (IN(2)) for (int rep_ = 0; rep_ < NREP(2); ++rep_) { MKCTX(); pg8::Gemm g{HN, (const bf16*)(ws + WS_WIN0), NTOK, EVEN_IN, DM / 2}; pg8::StaticOrder S; S.init(NTOK, EVEN_IN, C.G, (int)blockIdx.x);
        pg8::EpiProj0I E{PROJ, EVEN_IN, QS_EVEN, (const float*)(ws + WS_SA), ctl + CW_CM0}; pg8::gemm_phase<pg8::EpiProj0I, pg8::StaticOrder, true, true, false, true>(C.lds, g, S, E, wave_s);
        { const int nwg = (NTOK / 256) * (EVEN_IN / 256), first_idle = nwg - 3 * C.G;
          const bool tail_ok = first_idle > 0 && first_idle < C.G;
          if (!tail_ok || (int)blockIdx.x >= first_idle) {
              LAS float* scr = (LAS float*)(C.lds + C.wave * 16384); const int wv = tail_ok ? ((int)blockIdx.x - first_idle) * NWAVES + C.wave : C.gw, nwv = tail_ok ? (C.G - first_idle) * NWAVES : C.NGW;
              for (int it = wv; it < 2 * 16 * 88; it += nwv) { const int half = it / (16 * 88), r = it % (16 * 88), kb = r / 88, nb = r % 88, n0 = nb * 32;
                  transpose_item_i8(half ? I.e_wu : I.e_wg, DM, FF, ws + WS_WGU0, 256 * (n0 >> 7) + (n0 & 127) + 128 * half, ctl + CW_CMG, scr, kb, nb, C.lane); }
              for (int it = wv; it < 16 * 73; it += nwv) { const int kb = it / 73, nb = it % 73; transpose_item_i8(I.o_w_in, DM, ODD_IN, ws + WS_WIN1, nb * 32, ctl + CW_CM1, scr, kb, nb, C.lane, nb == 72); } } }
    } if (!MK_CLKDUR) CLK1(2); SEAM(2); if (MK_CLKDUR) CLK1(2);
    CLK0(3);
    if (IN(3)) for (int rep_ = 0; rep_ < NREP(3); ++rep_) { MKCTX(); for (int un = C.vcu; un < NTOK / 128; un += C.G) evm::unit(un, PROJ, I.e_sinks, I.e_ln_g, I.e_ln_b, (const bf16*)(ws + WS_WSB), I.e_b_s, MIX0, (char*)lds_raw, wave_s); } if (!MK_CLKDUR) CLK1(3); SEAM(3); if (MK_CLKDUR) CLK1(3);
    CLK0(4);
    if (IN(4)) for (int rep_ = 0; rep_ < NREP(4); ++rep_) { MKCTX(); pg8::Gemm g{MIX0, (const bf16*)(ws + WS_WO0), NTOK, DM, DM}; pg8::StaticOrder S; S.init(NTOK, DM, C.G, (int)blockIdx.x);
        pg8::EpiResGateH<true> E{I.x, hbuf, DM, mod0 + 2 * DM, ADA, SEQ, 1.0f}; pg8::gemm_phase<pg8::EpiResGateH<true>, pg8::StaticOrder, true, true>(C.lds, g, S, E, wave_s); } if (!MK_CLKDUR) CLK1(4); SEAM(4); if (MK_CLKDUR) CLK1(4);
    CLK0(5);
    if (IN(5)) for (int rep_ = 0; rep_ < NREP(5); ++rep_) { MKCTX(); modulate2_i8<false>(C, hbuf, I.e_nffn_g, mod0 + 3 * DM, mod0 + 4 * DM, (unsigned char*)HN, (float*)(ws + WS_SA)); } if (!MK_CLKDUR) CLK1(5); SEAM(5); if (MK_CLKDUR) CLK1(5);
    CLK0(6);
    if (IN(6)) for (int rep_ = 0; rep_ < NREP(6); ++rep_) { MKCTX(); pg8::Gemm g{HN, (const bf16*)(ws + WS_WGU0), NTOK, 2 * FF, DM / 2}; pg8::StaticOrder S; S.init(NTOK, 2 * FF, C.G, (int)blockIdx.x);
        pg8::EpiSwiGLUI8 E{(unsigned char*)ACT, FF, (const float*)(ws + WS_SA), ctl + CW_CMG}; pg8::gemm_phase<pg8::EpiSwiGLUI8, pg8::StaticOrder, true, true, false, true>(C.lds, g, S, E, wave_s); } if (!MK_CLKDUR) CLK1(6); SEAM(6); if (MK_CLKDUR) CLK1(6);
    CLK0(7);
    if (IN(7)) for (int rep_ = 0; rep_ < NREP(7); ++rep_) { MKCTX(); pg8::Gemm g{ACT, (const bf16*)(ws + WS_WD0), NTOK, DM, FF / 2}; pg8::StaticOrder S; S.init(NTOK, DM, C.G, (int)blockIdx.x);
        pg8::EpiResGateH<false> E{hbuf, hbuf, DM, mod0 + 5 * DM, ADA, SEQ, 1.0f / WSC_D}; pg8::gemm_phase<pg8::EpiResGateH<false>, pg8::StaticOrder, true, true, true>(C.lds, g, S, E, wave_s); } if (!MK_CLKDUR) CLK1(7); SEAM(7); if (MK_CLKDUR) CLK1(7);
    CLK0(8);
    if (IN(8)) for (int rep_ = 0; rep_ < NREP(8); ++rep_) { MKCTX(); modulate2_i8<false>(C, hbuf, I.o_nmix_g, mod1 + 0 * DM, mod1 + 1 * DM, (unsigned char*)HN, (float*)(ws + WS_SA)); } if (!MK_CLKDUR) CLK1(8); SEAM(8); if (MK_CLKDUR) CLK1(8);
    CLK0(9);
    if (IN(9)) for (int rep_ = 0; rep_ < NREP(9); ++rep_) { MKCTX(); pg8::Gemm g{HN, (const bf16*)(ws + WS_WIN1), NTOK, ODD_IN_PAD, DM / 2}; pg8::StaticOrder S; S.init(NTOK, ODD_IN_PAD, C.G, (int)blockIdx.x);
        pg8::EpiBf16PlainI E{PROJ, ODD_IN_PAD, (const float*)(ws + WS_SA), ctl + CW_CM1}; pg8::gemm_phase<pg8::EpiBf16PlainI, pg8::StaticOrder, true, true, false, true>(C.lds, g, S, E, wave_s); } if (!MK_CLKDUR) CLK1(9); SEAM(9); if (MK_CLKDUR) CLK1(9);
    CLK0(10);
    if (IN(10)) for (int rep_ = 0; rep_ < NREP(10); ++rep_) { MKCTX(); odd_pre(C, PROJ, I.o_conv_w, I.o_qn_g, I.o_kvn_g, ctab, stab, MIX1, QN, KVN, KPE); } if (!MK_CLKDUR) CLK1(10); SEAM(10); if (MK_CLKDUR) CLK1(10);
    CLK0(11);
    if (IN(11)) for (int rep_ = 0; rep_ < NREP(11); ++rep_) { MKCTX();
        { pg8::Gemm g{QN, (const bf16*)(ws + WS_WQB), NTOK, 768, 512}; pg8::StaticOrder S; S.init(NTOK, 768, C.G, (int)blockIdx.x);
          pg8::EpiQRope E{Q, 768, ctab, stab, QS_ODD, SEQ - 1}; pg8::gemm_phase<pg8::EpiQRope, pg8::StaticOrder, true, true>(C.lds, g, S, E, wave_s); }
        { pg8::Gemm g{KVN, (const bf16*)(ws + WS_WKVB), NTOK, 1024, 256}; pg8::StaticOrder S; S.init(NTOK, 1024, C.G, (int)blockIdx.x, (C.G == 256) ? 128 : 0);
          pg8::EpiBf16Plain E{KV, 1024, 1.0f}; pg8::gemm_phase<pg8::EpiBf16Plain, pg8::StaticOrder, true, true>(C.lds, g, S, E, wave_s); }
    } if (!MK_CLKDUR) CLK1(11); SEAM(11); if (MK_CLKDUR) CLK1(11);
    CLK0(12);
    if (IN(12)) for (int rep_ = 0; rep_ < NREP(12); ++rep_) { MKCTX(); mla::phase((char*)lds_raw, Q, KV, KPE, MIX1, C.vcu, C.G, wave_s); } if (!MK_CLKDUR) CLK1(12); SEAM(12); if (MK_CLKDUR) CLK1(12);
    CLK0(13);
    if (IN(13)) for (int rep_ = 0; rep_ < NREP(13); ++rep_) { MKCTX(); pg8::Gemm g{MIX1, (const bf16*)(ws + WS_WO1), NTOK, DM, DM}; pg8::StaticOrder S; S.init(NTOK, DM, C.G, (int)blockIdx.x);
        pg8::EpiResGateH<false> E{hbuf, hbuf, DM, mod1 + 2 * DM, ADA, SEQ, 1.0f}; pg8::gemm_phase<pg8::EpiResGateH<false>, pg8::StaticOrder, true, true>(C.lds, g, S, E, wave_s); } if (!MK_CLKDUR) CLK1(13); SEAM(13); if (MK_CLKDUR) CLK1(13);
    CLK0(14);
    if (IN(14)) for (int rep_ = 0; rep_ < NREP(14); ++rep_) { MKCTX(); modulate_route(C, hbuf, I.o_nffn_g, mod1 + 3 * DM, mod1 + 4 * DM, I.o_rw, I.o_rb, HN2, tok_e, tok_g, ctl + CW_CNT); } if (!MK_CLKDUR) CLK1(14); SEAM(14); if (MK_CLKDUR) CLK1(14);
    CLK0(15);
    if (IN(15)) for (int rep_ = 0; rep_ < NREP(15); ++rep_) { MKCTX(); moe_gather(C, HN2, tok_e, ctl + CW_CNT, ctl + CW_CUR, tok_slot, XS, pexp); } if (!MK_CLKDUR) CLK1(15); SEAM(15); if (MK_CLKDUR) CLK1(15);
    CLK0(16);
    if (IN(16)) for (int rep_ = 0; rep_ < NREP(16); ++rep_) { MKCTX();
        const int P = __builtin_amdgcn_readfirstlane(pexp[272]);
        pg8::MoeOrder<28, false> S{C.G, C.vcu, 0, P * 28, pexp, 0};
        pg8::Gemm g{(const bf16*)XS, (const bf16*)(ws + WS_WEGU), 0, 0, DM / 2};
#if MK_PROBE_NULLEPI
        if (rep_ == 1) { pg8::EpiNull E0; pg8::gemm_phase<pg8::EpiNull, pg8::MoeOrder<28, false>, true, true, true>(C.lds, g, S, E0, wave_s); } else
#endif
        { pg8::EpiSwiGLU8 E{ACTE, FFE, 1.0f / WSC_GU}; pg8::gemm_phase<pg8::EpiSwiGLU8, pg8::MoeOrder<28, false>, true, true, true>(C.lds, g, S, E, wave_s); }
    } if (!MK_CLKDUR) CLK1(16); SEAM(16); if (MK_CLKDUR) CLK1(16);
    CLK0(17);
    if (IN(17)) for (int rep_ = 0; rep_ < NREP(17); ++rep_) { MKCTX();
        const int P = __builtin_amdgcn_readfirstlane(pexp[272]); const int nfull = (P * 4 / C.G) * C.G;
        pg8::MoeOrder<4, false> S{C.G, C.vcu, 0, nfull, pexp, 0};
        pg8::Gemm g{(const bf16*)ACTE, (const bf16*)(ws + WS_WED), 0, 0, FFE / 2};
        pg8::EpiBf16Plain E{YB, DM, 1.0f / WSC_D}; pg8::gemm_phase<pg8::EpiBf16Plain, pg8::MoeOrder<4, false>, true, true, true>(C.lds, g, S, E, wave_s);
    } if (!MK_CLKDUR) CLK1(17); SEAM(17); if (MK_CLKDUR) CLK1(17);
    CLK0(18);
    if (IN(18)) { MKCTX();
        const int P = __builtin_amdgcn_readfirstlane(pexp[272]); const int nfull = (P * 4 / C.G) * C.G, nleft = P * 4 - nfull;
        if (C.vcu < nleft) {
            pg8::MoeOrder<4, false> S{C.G, C.vcu, 0, P * 4, pexp, nfull};
            pg8::Gemm g{(const bf16*)ACTE, (const bf16*)(ws + WS_WED), 0, 0, FFE / 2};
            pg8::EpiBf16Plain E{YB, DM, 1.0f / WSC_D}; pg8::gemm_phase<pg8::EpiBf16Plain, pg8::MoeOrder<4, false>, true, true, true>(C.lds, g, S, E, wave_s);
        } else {
            final_rows((C.vcu - nleft) * NWAVES + C.wave, (C.G - nleft) * NWAVES, C.lane, hbuf, args.out, YB, tok_slot, tok_g, mod1 + 5 * DM, I.fin_g, (nfull / 4) * 256, 0);
        }
    } SEAM(18);
    if (IN(19)) { MKCTX();
        const int P = __builtin_amdgcn_readfirstlane(pexp[272]); const int nfull = (P * 4 / C.G) * C.G;
        final_rows(C.gw, C.NGW, C.lane, hbuf, args.out, YB, tok_slot, tok_g, mod1 + 5 * DM, I.fin_g, (nfull / 4) * 256, 1);
    }
    if (MK_CLKDUR) CLK1(18);
    if (MK_CLKPH >= 0 && blockIdx.x == 0 && wave_s == 0) { const unsigned long long mhz_ = CLKW[2], r0_ = __builtin_amdgcn_s_memrealtime(); while (__builtin_amdgcn_s_memrealtime() - r0_ < mhz_ * 100ull) __builtin_amdgcn_s_sleep(8); }
#undef IN
#undef SEAM
}

extern "C" void kernel_launch(void* const* d_in, const int* in_sizes, int n_in, void* d_out, int out_size, void* d_ws, size_t ws_size, hipStream_t stream) {
    static int grid = 0;
    if (grid == 0) {
        if (n_in != 33 || in_sizes[0] != NTOK * DM || out_size != NTOK * DM || ws_size < WS_END) { fprintf(stderr, "kernel_launch: unexpected shapes (n_in %d, in0 %d, out %d, ws %zu < %zu); nothing launched\n", n_in, n_in > 0 ? in_sizes[0] : -1, out_size, ws_size, (size_t)WS_END); grid = -1; return; }
        int dev = 0, cus = 0, per_cu = 0;
        if (hipGetDevice(&dev) != hipSuccess || hipDeviceGetAttribute(&cus, hipDeviceAttributeMultiprocessorCount, dev) != hipSuccess) { grid = -1; return; }
        if (hipFuncSetAttribute((const void*)fwd, hipFuncAttributeMaxDynamicSharedMemorySize, LDS_BYTES) != hipSuccess) { fprintf(stderr, "kernel_launch: hipFuncSetAttribute failed\n"); grid = -1; return; }
        if (hipOccupancyMaxActiveBlocksPerMultiprocessor(&per_cu, (const void*)fwd, NWAVES * 64, LDS_BYTES) != hipSuccess || per_cu < 1) fprintf(stderr, "kernel_launch: occupancy query reports %d\n", per_cu);
        (void)hipGetLastError();
        grid = cus;
    }
    if (grid < 0) return;
    if (hipMemsetAsync((char*)d_ws + WS_CTL, 0, CTL_ZERO_BYTES, stream) != hipSuccess) return;
    Args a{};
    const float** ip = (const float**)&a.in;
    for (int i = 0; i < 33; ++i) ip[i] = (const float*)d_in[i];
    a.out = (float*)d_out; a.ws = (unsigned char*)d_ws;
#if MK_PER_PHASE
    for (int p = 0; p < NPH; ++p) { a.ph_lo = p; a.ph_hi = p + 1; hipLaunchKernelGGL(fwd, dim3(grid), dim3(NWAVES * 64), LDS_BYTES, stream, a); }
#else
    a.ph_lo = 0; a.ph_hi = NPH; hipLaunchKernelGGL(fwd, dim3(grid), dim3(NWAVES * 64), LDS_BYTES, stream, a);
#endif
}
```
